# Optimizing an MI355X kernel written in HIP

```python
import math
import jax, jax.numpy as jnp
from jax import lax
import numpy as np

D_MODEL = 1024
BATCH = 32
SEQ = 2048
DEPTH = 4

N_BRANCH = 4
BRANCH_WIDTH = 512
SSD_D_INNER = 512
SSD_HEADDIM = 64
SSD_HEADS = SSD_D_INNER // SSD_HEADDIM
SSD_GROUPS = 2
SSD_STATE = 128
SSD_CONV = 4
SSD_CHUNK = 128
SSD_XBC = SSD_D_INNER + 2 * SSD_GROUPS * SSD_STATE
GMLP_WIDTH = 512
GMLP_GROUPS = 4
GMLP_CHUNK = 128
MLA_HEADS = 4
MLA_Q_RANK = 384
MLA_KV_RANK = 128
MLA_NOPE = 128
MLA_ROPE = 64
MLA_V = 128
MLA_QK = MLA_NOPE + MLA_ROPE
ROPE_THETA = 10000.0
ATTN_BLOCK = 128
SC_WIDTH = 512
SC_KERNEL = 3
D_FF = 2816
NORM_EPS = 1e-6
IN_SIZES = (SSD_D_INNER, SSD_XBC, SSD_HEADS, 2 * GMLP_WIDTH, MLA_Q_RANK, MLA_KV_RANK, MLA_ROPE, 3 * SC_WIDTH, N_BRANCH * D_MODEL)
IN_TOTAL = sum(IN_SIZES)

kernel_name = "hybrid_gated_parallel_mixer_block"

F32 = jnp.float32


def rms_norm(x, w):
    x32 = x.astype(F32)
    y = x32 * lax.rsqrt(jnp.mean(x32 * x32, axis=-1, keepdims=True) + NORM_EPS)
    return (y * w.astype(F32)).astype(x.dtype)


def split_cols(x, sizes):
    out = []
    off = 0
    for s in sizes:
        out.append(x[..., off:off + s])
        off += s
    return out


def causal_dwconv(x, w):
    K = w.shape[0]
    L = x.shape[1]
    xp = jnp.pad(x, ((0, 0), (K - 1, 0), (0, 0)))
    out = xp[:, 0:L] * w[0]
    for k in range(1, K):
        out = out + xp[:, k:k + L] * w[k]
    return out


def swiglu(h, w_gu, w_down):
    g, u = jnp.split(h @ w_gu, 2, axis=-1)
    return (jax.nn.silu(g) * u) @ w_down


def apply_rope(x, cos, sin):
    x1, x2 = jnp.split(x.astype(F32), 2, axis=-1)
    out = jnp.concatenate([x1 * cos - x2 * sin, x2 * cos + x1 * sin], axis=-1)
    return out.astype(x.dtype)


def ssd_chunked_scan(xh, dt, A, Bg, Cg):
    b, L, H, P = xh.shape
    G, N = Bg.shape[2], Bg.shape[3]
    R = H // G
    Q = SSD_CHUNK
    c = L // Q
    dtc = dt.reshape(b, c, Q, G, R)
    a_cs = jnp.cumsum(dtc * A.reshape(G, R), axis=2)
    xdt = xh.astype(F32).reshape(b, c, Q, G, R, P) * dtc[..., None]
    Bc = Bg.astype(F32).reshape(b, c, Q, G, N)
    Cc = Cg.astype(F32).reshape(b, c, Q, G, N)
    causal = jnp.tril(jnp.ones((Q, Q), bool))[None, None, :, :, None, None]
    seg = a_cs[:, :, :, None] - a_cs[:, :, None, :]
    decay_in = jnp.exp(jnp.where(causal, seg, -jnp.inf))
    cb = jnp.einsum('bctgn,bcsgn->bctsg', Cc, Bc)
    y_diag = jnp.einsum('bctsgr,bcsgrp->bctgrp', cb[..., None] * decay_in, xdt)
    decay_out = jnp.exp(a_cs[:, :, -1:] - a_cs)
    states = jnp.einsum('bcsgn,bcsgrp->bcgrpn', Bc, xdt * decay_out[..., None])
    a_tot = a_cs[:, :, -1]

    def step(h, inp):
        a_c, s_c = inp
        return jnp.exp(a_c)[..., None, None] * h + s_c, h

    h0 = jnp.zeros((b, G, R, P, N), F32)
    _, prev = lax.scan(step, h0, (jnp.moveaxis(a_tot, 1, 0), jnp.moveaxis(states, 1, 0)))
    prev = jnp.moveaxis(prev, 0, 1)
    y_off = jnp.einsum('bctgn,bcgrpn->bctgrp', Cc, prev) * jnp.exp(a_cs)[..., None]
    return (y_diag + y_off).reshape(b, L, H, P).astype(xh.dtype)


def ssd_branch(z, xbc_raw, dt_raw, conv_w, conv_b, dt_bias, a_log, d_skip, norm_w):
    b, L, _ = z.shape
    xbc = jax.nn.silu(causal_dwconv(xbc_raw, conv_w) + conv_b)
    xs, Bm, Cm = split_cols(xbc, (SSD_D_INNER, SSD_GROUPS * SSD_STATE, SSD_GROUPS * SSD_STATE))
    dt = jax.nn.softplus(dt_raw.astype(F32) + dt_bias.astype(F32))
    A = -jnp.exp(a_log.astype(F32))
    xh = xs.reshape(b, L, SSD_HEADS, SSD_HEADDIM)
    y = ssd_chunked_scan(xh, dt, A,
                         Bm.reshape(b, L, SSD_GROUPS, SSD_STATE),
                         Cm.reshape(b, L, SSD_GROUPS, SSD_STATE))
    y = y + d_skip[:, None] * xh
    y = y.reshape(b, L, SSD_D_INNER) * jax.nn.silu(z)
    y = rms_norm(y.reshape(b, L, SSD_GROUPS, SSD_D_INNER // SSD_GROUPS),
                 norm_w.reshape(SSD_GROUPS, SSD_D_INNER // SSD_GROUPS))
    return y.reshape(b, L, SSD_D_INNER)


def gmlp_branch(uv_raw, v_norm, w_s, b_s):
    b, L, _ = uv_raw.shape
    Q = GMLP_CHUNK
    c = L // Q
    dg = GMLP_WIDTH // GMLP_GROUPS
    u, v = jnp.split(jax.nn.gelu(uv_raw, approximate=False), 2, axis=-1)
    v = rms_norm(v, v_norm).reshape(b, c, Q, GMLP_GROUPS, dg)
    w_causal = w_s * jnp.tril(jnp.ones((Q, Q), w_s.dtype))
    sv = jnp.einsum('gts,bcsgd->bctgd', w_causal, v) + b_s.T[:, :, None]
    return u * sv.reshape(b, L, GMLP_WIDTH)


def causal_block_attention(q, k, v, scale):
    b, L, H, dq = q.shape
    nblk = L // ATTN_BLOCK
    qb = jnp.swapaxes(q.reshape(b, nblk, ATTN_BLOCK, H, dq), 0, 1)
    key_pos = jnp.arange(L)

    def one_block(args):
        q_blk, i = args
        s = jnp.einsum('bqhd,bkhd->bhqk', q_blk, k).astype(F32) * scale
        q_pos = i * ATTN_BLOCK + jnp.arange(ATTN_BLOCK)
        mask = key_pos[None, :] <= q_pos[:, None]
        p = jax.nn.softmax(jnp.where(mask, s, -jnp.inf), axis=-1)
        return jnp.einsum('bhqk,bkhd->bqhd', p.astype(v.dtype), v)

    out = lax.map(one_block, (qb, jnp.arange(nblk)))
    return jnp.swapaxes(out, 0, 1).reshape(b, L, H, v.shape[-1])


def mla_branch(q_lat, kv_lat, k_pe, cos, sin, q_norm, w_qb, kv_norm, w_kvb, qk_q, qk_k):
    b, L, _ = q_lat.shape
    H = MLA_HEADS
    q = (rms_norm(q_lat, q_norm) @ w_qb).reshape(b, L, H, MLA_QK)
    kv = (rms_norm(kv_lat, kv_norm) @ w_kvb).reshape(b, L, H, MLA_NOPE + MLA_V)
    k_nope, v = kv[..., :MLA_NOPE], kv[..., MLA_NOPE:]
    k = jnp.concatenate([k_nope, jnp.broadcast_to(k_pe[:, :, None, :], (b, L, H, MLA_ROPE))], axis=-1)
    q = rms_norm(q, qk_q)
    k = rms_norm(k, qk_k)
    q = jnp.concatenate([q[..., :MLA_NOPE], apply_rope(q[..., MLA_NOPE:], cos, sin)], axis=-1)
    k = jnp.concatenate([k[..., :MLA_NOPE], apply_rope(k[..., MLA_NOPE:], cos, sin)], axis=-1)
    o = causal_block_attention(q, k, v, MLA_QK ** -0.5)
    return o.reshape(b, L, H * MLA_V)


def short_conv_branch(sc_raw, conv_w):
    bg, cg, xin = jnp.split(sc_raw, 3, axis=-1)
    return bg * causal_dwconv(cg * xin, conv_w)


def hybrid_mixer(h, cos, sin, w_in, ssd_conv_w, ssd_conv_b, ssd_dt_bias, ssd_a_log, ssd_d, ssd_norm,
                 gmlp_v_norm, gmlp_w_s, gmlp_b_s, mla_q_norm, mla_w_qb, mla_kv_norm, mla_w_kvb,
                 mla_qk_q, mla_qk_k, sc_conv_w, w_branch, w_out):
    b, L, _ = h.shape
    proj = h @ w_in
    z, xbc, dt_raw, uv, q_lat, kv_lat, k_pe, sc, gates = split_cols(proj, IN_SIZES)
    y_a = ssd_branch(z, xbc, dt_raw, ssd_conv_w, ssd_conv_b, ssd_dt_bias, ssd_a_log, ssd_d, ssd_norm)
    y_b = gmlp_branch(uv, gmlp_v_norm, gmlp_w_s, gmlp_b_s)
    y_c = mla_branch(q_lat, kv_lat, k_pe, cos, sin, mla_q_norm, mla_w_qb, mla_kv_norm, mla_w_kvb, mla_qk_q, mla_qk_k)
    y_d = short_conv_branch(sc, sc_conv_w)
    br = jnp.stack([y_a, y_b, y_c, y_d], axis=2)
    per = jnp.einsum('blnd,nde->blne', br, w_branch)
    gate = jax.nn.sigmoid(gates.reshape(b, L, N_BRANCH, D_MODEL))
    return jnp.sum(gate * per, axis=2) @ w_out


def setup_inputs(seed: int = 0) -> dict:
    key = jax.random.key(seed)
    ks = jax.random.split(key, 32)

    def nrm(k, shape, scale):
        return jax.random.normal(k, shape, F32) * scale

    def gain(k, shape):
        return 1.0 + 0.02 * jax.random.normal(k, shape, F32)

    dt0 = jnp.exp(jax.random.uniform(ks[9], (DEPTH, SSD_HEADS), F32, math.log(1e-3), math.log(1e-1)))
    return {
        "x": nrm(ks[0], (BATCH, SEQ, D_MODEL), 1.0),
        "positions": jnp.arange(SEQ, dtype=jnp.int32)[None, :] + jax.random.randint(ks[1], (BATCH, 1), 0, SEQ, dtype=jnp.int32),
        "ffn1_norm": gain(ks[2], (DEPTH, D_MODEL)),
        "ffn1_w_gu": nrm(ks[3], (DEPTH, D_MODEL, 2 * D_FF), D_MODEL ** -0.5),
        "ffn1_w_down": nrm(ks[4], (DEPTH, D_FF, D_MODEL), D_FF ** -0.5),
        "mix_norm": gain(ks[5], (DEPTH, D_MODEL)),
        "w_in": nrm(ks[6], (DEPTH, D_MODEL, IN_TOTAL), D_MODEL ** -0.5),
        "ssd_conv_w": nrm(ks[7], (DEPTH, SSD_CONV, SSD_XBC), SSD_CONV ** -0.5),
        "ssd_conv_b": nrm(ks[8], (DEPTH, SSD_XBC), 0.02),
        "ssd_dt_bias": dt0 + jnp.log(-jnp.expm1(-dt0)),
        "ssd_a_log": jnp.log(jax.random.uniform(ks[10], (DEPTH, SSD_HEADS), F32, 1.0, 16.0)),
        "ssd_d": 1.0 + 0.1 * jax.random.normal(ks[11], (DEPTH, SSD_HEADS), F32),
        "ssd_norm": gain(ks[12], (DEPTH, SSD_D_INNER)),
        "gmlp_v_norm": gain(ks[13], (DEPTH, GMLP_WIDTH)),
        "gmlp_w_s": nrm(ks[14], (DEPTH, GMLP_GROUPS, GMLP_CHUNK, GMLP_CHUNK), GMLP_CHUNK ** -0.5),
        "gmlp_b_s": 1.0 + 0.02 * jax.random.normal(ks[15], (DEPTH, GMLP_GROUPS, GMLP_CHUNK), F32),
        "mla_q_norm": gain(ks[16], (DEPTH, MLA_Q_RANK)),
        "mla_w_qb": nrm(ks[17], (DEPTH, MLA_Q_RANK, MLA_HEADS * MLA_QK), MLA_Q_RANK ** -0.5),
        "mla_kv_norm": gain(ks[18], (DEPTH, MLA_KV_RANK)),
        "mla_w_kvb": nrm(ks[19], (DEPTH, MLA_KV_RANK, MLA_HEADS * (MLA_NOPE + MLA_V)), MLA_KV_RANK ** -0.5),
        "mla_qk_q": gain(ks[20], (DEPTH, MLA_QK)),
        "mla_qk_k": gain(ks[21], (DEPTH, MLA_QK)),
        "sc_conv_w": nrm(ks[22], (DEPTH, SC_KERNEL, SC_WIDTH), SC_KERNEL ** -0.5),
        "w_branch": nrm(ks[23], (DEPTH, N_BRANCH, BRANCH_WIDTH, D_MODEL), BRANCH_WIDTH ** -0.5),
        "w_out": nrm(ks[24], (DEPTH, D_MODEL, D_MODEL), D_MODEL ** -0.5),
        "ffn2_norm": gain(ks[25], (DEPTH, D_MODEL)),
        "ffn2_w_gu": nrm(ks[26], (DEPTH, D_MODEL, 2 * D_FF), D_MODEL ** -0.5),
        "ffn2_w_down": nrm(ks[27], (DEPTH, D_FF, D_MODEL), D_FF ** -0.5),
    }


def reference(x, positions, ffn1_norm, ffn1_w_gu, ffn1_w_down, mix_norm, w_in, ssd_conv_w, ssd_conv_b,
              ssd_dt_bias, ssd_a_log, ssd_d, ssd_norm, gmlp_v_norm, gmlp_w_s, gmlp_b_s, mla_q_norm,
              mla_w_qb, mla_kv_norm, mla_w_kvb, mla_qk_q, mla_qk_k, sc_conv_w, w_branch, w_out,
              ffn2_norm, ffn2_w_gu, ffn2_w_down):
    inv_freq = ROPE_THETA ** (-jnp.arange(0, MLA_ROPE, 2, dtype=F32) / MLA_ROPE)
    ang = positions.astype(F32)[..., None] * inv_freq
    cos = jnp.cos(ang)[:, :, None, :]
    sin = jnp.sin(ang)[:, :, None, :]
    for l in range(DEPTH):
        x = x + 0.5 * swiglu(rms_norm(x, ffn1_norm[l]), ffn1_w_gu[l], ffn1_w_down[l])
        x = x + hybrid_mixer(rms_norm(x, mix_norm[l]), cos, sin, w_in[l], ssd_conv_w[l], ssd_conv_b[l],
                             ssd_dt_bias[l], ssd_a_log[l], ssd_d[l], ssd_norm[l], gmlp_v_norm[l],
                             gmlp_w_s[l], gmlp_b_s[l], mla_q_norm[l], mla_w_qb[l], mla_kv_norm[l],
                             mla_w_kvb[l], mla_qk_q[l], mla_qk_k[l], sc_conv_w[l], w_branch[l], w_out[l])
        x = x + 0.5 * swiglu(rms_norm(x, ffn2_norm[l]), ffn2_w_gu[l], ffn2_w_down[l])
    return x
```

```cpp
#include <hip/hip_runtime.h>
#include <hip/hip_cooperative_groups.h>
#include <cstdio>
namespace cg = cooperative_groups;

#ifndef PROBE
#define PROBE 0
#endif
#ifndef MULTI_LAUNCH
#define MULTI_LAUNCH 0
#endif

__device__ __forceinline__ int tid_now() { int t = threadIdx.x; asm volatile("" : "+v"(t)); return t; }
__device__ __forceinline__ int wg_now() { int t = blockIdx.x; asm volatile("" : "+s"(t)); return t; }
__device__ __forceinline__ int nwg_now() { int t = gridDim.x; asm volatile("" : "+s"(t)); return t; }
namespace pg8 {
#define PG8_LAS __attribute__((address_space(3)))
typedef unsigned short bf16_t;
typedef short bf16x8 __attribute__((ext_vector_type(8)));
typedef float f32x4 __attribute__((ext_vector_type(4)));
typedef unsigned u32x4 __attribute__((ext_vector_type(4)));
constexpr int BM = 256, BK = 64, HALF = 128, HTB = HALF * BK * 2  , STAGE_BYTES = 8 * HTB, NXCD = 8, WGM = 8;

__host__ __device__ __forceinline__ int lds_byte(int r, int c) { const int st = (r >> 4) * 2 + (c >> 5), rr = r & 15, cc = c & 31, ob = rr * 64 + cc * 2; return st * 1024 + (ob ^ (((ob >> 9) & 1) << 5)); }
__host__ __device__ __forceinline__ void stage_rc(int b, int& R, int& C) { const int st = b / 1024, sb = b % 1024, swz = sb ^ (((sb >> 9) & 1) << 5); R = (st >> 1) * 16 + swz / 64; C = (st & 1) * 32 + (swz % 64) / 2; }
__host__ __device__ __forceinline__ int perm32(int rho) { const int n = rho >> 4, i = rho & 15; return 8 * (i >> 2) + 4 * n + (i & 3); }

struct Unit { int pm, pn; };
struct Gemm { const bf16_t* A; const bf16_t* Bt; int M, N, K; };

struct StaticOrder {
    int nM, nN, nwg, G, c;
    __host__ __device__ void init(int M, int N, int G_, int c_) { nM = M / BM; nN = N / BM; nwg = nM * nN; G = G_; c = c_; }
    __host__ __device__ bool next(int i, Unit& u) const {
        const long L = (long)i * G + c; if (L >= nwg) return false;
        int wgid = (int)L; { const int q = nwg / NXCD, r = nwg % NXCD, xcd = wgid % NXCD, off = wgid / NXCD; wgid = (xcd < r ? xcd * (q + 1) : r * (q + 1) + (xcd - r) * q) + off; }
        const int nig = WGM * nN, gid = wgid / nig, fm = gid * WGM, gsz = (nM - fm) < WGM ? (nM - fm) : WGM;
        u.pm = fm + ((wgid % nig) % gsz); u.pn = (wgid % nig) / gsz; return true;
    }
    __device__ __forceinline__ void a_ready(const Unit&) const {}
    __device__ __forceinline__ void done(const Unit&) const {}
};

template <class Epi, class Sched>
__device__ __forceinline__ void gemm_phase(PG8_LAS unsigned char* lds, const Gemm g, const Sched& S, const Epi& E) {
    const int tid = tid_now(), wid = __builtin_amdgcn_readfirstlane(tid >> 6), lane = tid & 63, wr = wid >> 2, wc = wid & 3, fr = lane & 15, fq = lane >> 4;
    const int K = g.K, nt = K / BK;
    unsigned voffA[2], voffB[2];
#pragma unroll
    for (int i = 0; i < 2; ++i) { int R, C; stage_rc(tid * 16 + i * 8192, R, C); const int Rb = Epi::PERM ? ((R & ~31) + perm32(R & 31)) : R;
        voffA[i] = (unsigned)(R * K + C) * 2u; voffB[i] = (unsigned)(Rb * K + C) * 2u; }
    const size_t kstep = (size_t)(BK * 2);
    const size_t hstep = (size_t)HALF * K * 2;
    const size_t tstep = 2 * hstep;
    const unsigned ldsw = (unsigned)wid * 1024u;
    const int aoff = lds_byte(wr * 64 + fr, fq * 8), boff = lds_byte(wc * 32 + fr, fq * 8);
#define PG8_SA(b, h) (((b) * 2 + (h)) * HTB)
#define PG8_SB(b, h) ((4 + (b) * 2 + (h)) * HTB)
#define PG8_STAGE(bufoff, gbase, voff) do { _Pragma("unroll") for (int _i = 0; _i < 2; ++_i) \
        __builtin_amdgcn_global_load_lds((const unsigned*)((const char*)(gbase) + (voff)[_i]), (PG8_LAS unsigned*)(lds + (bufoff) + ldsw + _i * 8192), 16, 0, 0); } while (0)
#define PG8_LDA(dst, b, h) do { _Pragma("unroll") for (int m = 0; m < 4; ++m) _Pragma("unroll") for (int k = 0; k < 2; ++k) dst[m][k] = *(const PG8_LAS bf16x8*)(lds + PG8_SA(b, h) + aoff + m * 2048 + k * 1024); } while (0)
#define PG8_LDB(dst, b, h) do { _Pragma("unroll") for (int n = 0; n < 2; ++n) _Pragma("unroll") for (int k = 0; k < 2; ++k) dst[n][k] = *(const PG8_LAS bf16x8*)(lds + PG8_SB(b, h) + boff + n * 2048 + k * 1024); } while (0)
#define PG8_MMA(ai, bj, At, Bt) do { __builtin_amdgcn_s_setprio(1); _Pragma("unroll") for (int m = 0; m < 4; ++m) _Pragma("unroll") for (int n = 0; n < 2; ++n) _Pragma("unroll") for (int k = 0; k < 2; ++k) \
        acc[ai][bj][m][n] = __builtin_amdgcn_mfma_f32_16x16x32_bf16(Bt[n][k], At[m][k], acc[ai][bj][m][n], 0, 0, 0); __builtin_amdgcn_s_setprio(0); } while (0)
#define PG8_WAIT_V(n) asm volatile("s_waitcnt vmcnt(" #n ")" ::: "memory")
#define PG8_WAIT_L(n) asm volatile("s_waitcnt lgkmcnt(" #n ")" ::: "memory")
#define PG8_BAR __builtin_amdgcn_s_barrier()
#define PG8_SCHED __builtin_amdgcn_sched_barrier(0)
    Unit cur, nxt; int ui = 0;
    if (!S.next(0, cur)) return;
    f32x4 acc[2][2][4][2];
#pragma unroll
    for (int a = 0; a < 2; ++a)
#pragma unroll
        for (int b = 0; b < 2; ++b)
#pragma unroll
            for (int m = 0; m < 4; ++m)
#pragma unroll
                for (int n = 0; n < 2; ++n) acc[a][b][m][n] = (f32x4){0.f, 0.f, 0.f, 0.f};
    bf16x8 At[4][2], B0[2][2], B1[2][2];
    const char* cA = (const char*)g.A + (size_t)cur.pm * tstep; const char* cB = (const char*)g.Bt + (size_t)cur.pn * tstep;
    S.a_ready(cur);
    PG8_STAGE(PG8_SB(0, 0), cB, voffB); PG8_STAGE(PG8_SA(0, 0), cA, voffA); PG8_STAGE(PG8_SB(0, 1), cB + hstep, voffB); PG8_STAGE(PG8_SA(0, 1), cA + hstep, voffA);
    if (wr == 1) PG8_BAR;
    PG8_WAIT_V(4); PG8_BAR;
    PG8_STAGE(PG8_SB(1, 0), cB + kstep, voffB); PG8_STAGE(PG8_SA(1, 0), cA + kstep, voffA); PG8_STAGE(PG8_SB(1, 1), cB + hstep + kstep, voffB);
    PG8_WAIT_V(6); PG8_BAR;
    for (;;) {
        const bool has_next = S.next(ui + 1, nxt);
        const char* nA = has_next ? (const char*)g.A + (size_t)nxt.pm * tstep : cA; const char* nB = has_next ? (const char*)g.Bt + (size_t)nxt.pn * tstep : cB;
        for (int t = 0; t < nt; t += 2) {
            const bool last = (t == nt - 2);
            const char* a1 = cA + (size_t)(t + 1) * kstep;
            const char* a2 = last ? nA : cA + (size_t)(t + 2) * kstep; const char* b2 = last ? nB : cB + (size_t)(t + 2) * kstep;
            const char* a3 = a2 + kstep; const char* b3 = b2 + kstep;
            if (last && has_next) S.a_ready(nxt);
            PG8_LDB(B0, 0, 0); PG8_SCHED; PG8_LDA(At, 0, 0); PG8_STAGE(PG8_SA(1, 1), a1 + hstep, voffA);
            PG8_WAIT_L(8); PG8_BAR; PG8_WAIT_L(0); PG8_MMA(0, 0, At, B0); PG8_BAR; PG8_SCHED;
            PG8_LDB(B1, 0, 1); PG8_STAGE(PG8_SB(0, 0), b2, voffB);
            PG8_BAR; PG8_WAIT_L(0); PG8_MMA(0, 1, At, B1); PG8_BAR;
            PG8_LDA(At, 0, 1); PG8_STAGE(PG8_SA(0, 0), a2, voffA);
            PG8_BAR; PG8_WAIT_L(0); PG8_MMA(1, 0, At, B0); PG8_BAR; PG8_SCHED;
            PG8_STAGE(PG8_SB(0, 1), b2 + hstep, voffB);
            PG8_WAIT_V(6); PG8_BAR; PG8_MMA(1, 1, At, B1); PG8_BAR;
            PG8_LDB(B0, 1, 0); PG8_SCHED; PG8_LDA(At, 1, 0); PG8_STAGE(PG8_SA(0, 1), a2 + hstep, voffA);
            PG8_WAIT_L(8); PG8_BAR; PG8_WAIT_L(0); PG8_MMA(0, 0, At, B0); PG8_BAR; PG8_SCHED;
            PG8_LDB(B1, 1, 1); PG8_STAGE(PG8_SB(1, 0), b3, voffB);
            PG8_BAR; PG8_WAIT_L(0); PG8_MMA(0, 1, At, B1); PG8_BAR;
            PG8_LDA(At, 1, 1); PG8_STAGE(PG8_SA(1, 0), a3, voffA);
            PG8_BAR; PG8_WAIT_L(0); PG8_MMA(1, 0, At, B0); PG8_BAR; PG8_SCHED;
            PG8_STAGE(PG8_SB(1, 1), b3 + hstep, voffB);
            PG8_WAIT_V(6); PG8_BAR; PG8_MMA(1, 1, At, B1); PG8_BAR;
        }
        if constexpr (!Epi::AFTER_DRAIN) { E(acc, cur, wr, wc, fr, fq); S.done(cur); }
        if (!has_next) break;
#pragma unroll
        for (int a = 0; a < 2; ++a)
#pragma unroll
            for (int b = 0; b < 2; ++b)
#pragma unroll
                for (int m = 0; m < 4; ++m)
#pragma unroll
                    for (int n = 0; n < 2; ++n) acc[a][b][m][n] = (f32x4){0.f, 0.f, 0.f, 0.f};
        cur = nxt; cA = nA; cB = nB; ++ui;
    }
    PG8_WAIT_V(0);
    if (wr == 0) PG8_BAR;
    PG8_BAR;
    if constexpr (Epi::AFTER_DRAIN) { E.fused(acc, cur, wr, wc, fr, fq, lds, wid, lane); S.done(cur); }
#undef PG8_SA
#undef PG8_SB
#undef PG8_STAGE
#undef PG8_LDA
#undef PG8_LDB
#undef PG8_MMA
#undef PG8_WAIT_V
#undef PG8_WAIT_L
#undef PG8_BAR
#undef PG8_SCHED
}
}


using pg8::bf16_t; using pg8::bf16x8; using pg8::f32x4; using pg8::u32x4;
typedef short s16x4 __attribute__((ext_vector_type(4)));
typedef float f32x2 __attribute__((ext_vector_type(2)));
typedef float f32x16 __attribute__((ext_vector_type(16)));
typedef unsigned u32x2 __attribute__((ext_vector_type(2)));
typedef __bf16 bf16v2 __attribute__((ext_vector_type(2)));
#define LAS __attribute__((address_space(3)))
#define DI __device__ __forceinline__
#define XB_TMO      128
#define XB_XCNT(j)  (256  + 64 * (j))
#define XB_XSUB(j)  (1280 + 64 * (j))
#define XB_XGEN(j)  (2304 + 64 * (j))
#define XB_TOP      3328
#define XB_TOPGEN   3392
#define XCD_BAR_WORDS 3456
#define XB_SPIN_CAP (1u << 18)

__device__ __forceinline__ unsigned xb_ld(unsigned* p)              { return __hip_atomic_load(p, __ATOMIC_RELAXED, __HIP_MEMORY_SCOPE_AGENT); }
__device__ __forceinline__ unsigned xb_add(unsigned* p, unsigned v) { return __hip_atomic_fetch_add(p, v, __ATOMIC_RELAXED, __HIP_MEMORY_SCOPE_AGENT); }
__device__ __forceinline__ unsigned xb_xcc_id() { return (unsigned)__builtin_amdgcn_s_getreg((3 << 11) | 20) & 0xFu; }
#define XB_SPIN(cond, bar) do { unsigned _sp = 0; while (cond) { __builtin_amdgcn_s_sleep(1); \
    if ((++_sp & 255u) == 0u) { if (xb_ld(&(bar)[XB_TMO])) break; if (_sp > XB_SPIN_CAP) { atomicAdd(&(bar)[XB_TMO], 1u); break; } } } } while (0)

struct XcdBarrier {
    unsigned* bar; unsigned x;
    volatile LAS unsigned* st;
};

__device__ __forceinline__ XcdBarrier xcd_barrier_post(unsigned* bar, volatile LAS unsigned* st) {
    XcdBarrier b; b.bar = bar; b.x = xb_xcc_id(); b.st = st;
    if (threadIdx.x == 0) (void)xb_add(&bar[XB_XCNT(b.x)], 1u);
    return b;
}
__device__ __forceinline__ void xcd_barrier_complete(unsigned* bar, unsigned x, unsigned& nloc, unsigned& nx) {
    const unsigned G = (unsigned)nwg_now();
    unsigned sum, cnt, mine, sp = 0u;
    for (;;) {
        sum = 0u; cnt = 0u; mine = 0u;
#pragma unroll
        for (unsigned j = 0; j < 16; ++j) { const unsigned c = xb_ld(&bar[XB_XCNT(j)]); sum += c; cnt += (c > 0u) ? 1u : 0u; mine = (j == x) ? c : mine; }
        if (sum == G) break;
        __builtin_amdgcn_s_sleep(1);
        if ((++sp & 255u) == 0u) { if (xb_ld(&bar[XB_TMO])) break; if (sp > XB_SPIN_CAP) { atomicAdd(&bar[XB_TMO], 1u); break; } }
    }
    nloc = mine > 0u ? mine : 1u; nx = cnt > 0u ? cnt : 1u;
}

__device__ __forceinline__ void xcd_barrier(const XcdBarrier& b) {
    asm volatile("s_waitcnt vmcnt(0)" ::: "memory");
    __syncthreads();
    if (tid_now() == 0) {
        unsigned* bar = b.bar; unsigned bx = b.x; asm volatile("" : "+s"(bar), "+s"(bx));
        __builtin_amdgcn_s_waitcnt(0);
        unsigned nloc = b.st[0], nx = b.st[1];
        if (nloc == 0u) { xcd_barrier_complete(bar, bx, nloc, nx); b.st[0] = nloc; b.st[1] = nx; }
        const unsigned old = xb_add(&bar[XB_XSUB(bx)], 1u);
        const unsigned gen = old / nloc;
        if (old + 1u == (gen + 1u) * nloc) {
            __builtin_amdgcn_fence(__ATOMIC_RELEASE, "agent");
            asm volatile("s_waitcnt vmcnt(0)" ::: "memory");
            const unsigned og = xb_add(&bar[XB_TOP], 1u);
            const unsigned tg = og / nx;
            if (og + 1u == (tg + 1u) * nx) xb_add(&bar[XB_TOPGEN], 1u);
            else XB_SPIN(xb_ld(&bar[XB_TOPGEN]) == tg, bar);
            __builtin_amdgcn_fence(__ATOMIC_ACQUIRE, "agent");
            xb_add(&bar[XB_XGEN(bx)], 1u);
            asm volatile("s_waitcnt vmcnt(0)" ::: "memory");
        } else {
            XB_SPIN(xb_ld(&bar[XB_XGEN(bx)]) == gen, bar);
            __builtin_amdgcn_fence(__ATOMIC_ACQUIRE, "agent");
            asm volatile("s_waitcnt vmcnt(0)" ::: "memory");
        }
    }
    __syncthreads();
}


#define MFMA32(a, b, c) __builtin_amdgcn_mfma_f32_32x32x16_bf16((a), (b), (c), 0, 0, 0)

constexpr int T_ALL = 65536, SEQ = 2048, NGRP = 4, TG = 16384, BPG = 8, PLD = 4864;
constexpr float EPS = 1e-6f;
constexpr size_t SZ_GU = (size_t)5632 * 1024 * 2, SZ_D = (size_t)1024 * 2816 * 2;
constexpr size_t O_WGU1 = 0, O_WD1 = O_WGU1 + SZ_GU, O_WGU2 = O_WD1 + SZ_D, O_WD2 = O_WGU2 + SZ_GU, O_WIN = O_WD2 + SZ_D;
constexpr size_t O_WGATE = O_WIN + (size_t)4864 * 1024 * 2, O_WBR = O_WGATE + (size_t)4096 * 1024 * 2, O_WOUT = O_WBR + (size_t)4 * 1024 * 512 * 2;
constexpr size_t O_WQB = O_WOUT + (size_t)1024 * 1024 * 2, O_WKVB = O_WQB + (size_t)768 * 384 * 2, O_XN = O_WKVB + (size_t)1024 * 256 * 2;
constexpr size_t O_R0 = O_XN + (size_t)T_ALL * 1024 * 2;
constexpr size_t O_H = O_R0;
constexpr size_t O_PROJ = O_R0, O_XBCC = O_PROJ + (size_t)TG * PLD * 2, O_DTB = O_XBCC + (size_t)TG * 1024 * 2, O_AQ = O_DTB + (size_t)TG * 16 * 4;
constexpr size_t O_AKV = O_AQ + (size_t)TG * 384 * 2, O_QRAW = O_AKV + (size_t)TG * 256 * 2, O_KVRAW = O_QRAW + (size_t)TG * 768 * 2;
constexpr size_t O_QF = O_KVRAW + (size_t)TG * 1024 * 2, O_KF = O_QF + (size_t)TG * 768 * 2, O_VT = O_KF + (size_t)TG * 768 * 2;
constexpr size_t O_YRAW = O_VT + (size_t)TG * 512 * 2, O_YA = O_YRAW + (size_t)TG * 512 * 4;
constexpr size_t O_PB = O_YA + (size_t)4 * TG * 512 * 2, O_MIXB = O_PB + (size_t)4 * TG * 1024 * 2;
constexpr size_t O_ST = O_MIXB + (size_t)TG * 1024 * 2, O_ATOT = O_ST + (size_t)BPG * 16 * 8 * 8192 * 4;
constexpr size_t O_BAR = O_ATOT + 4096;
constexpr size_t O_CS = O_BAR + (size_t)XCD_BAR_WORDS * 4 + 256 - ((size_t)XCD_BAR_WORDS * 4) % 256;
constexpr size_t O_SSQ = O_CS + (size_t)T_ALL * 32 * 8;
constexpr size_t O_END = O_SSQ + (size_t)3 * T_ALL * 16 * 4;
constexpr size_t O_END_H = O_H + (size_t)T_ALL * 2816 * 2;
constexpr size_t WS_NEED = O_END > O_END_H ? O_END : O_END_H;
constexpr int LDS_BYTES = 147456;

struct Params { const float* in[28]; float* out; unsigned char* ws; int only_phase; int pad; };

DI unsigned pk2(float a, float b) { f32x2 v = {a, b}; return __builtin_bit_cast(unsigned, __builtin_convertvector(v, bf16v2)); }
DI bf16_t f2bf(float a) { return (bf16_t)(pk2(a, 0.f) & 0xffffu); }
DI float bf2f(bf16_t b) { return __uint_as_float(((unsigned)b) << 16); }
DI float bflo(unsigned u) { return __uint_as_float(u << 16); }
DI float bfhi(unsigned u) { return __uint_as_float(u & 0xffff0000u); }
#define UNPACK8(v, f) do { f[0] = bflo(v.x); f[1] = bfhi(v.x); f[2] = bflo(v.y); f[3] = bfhi(v.y); f[4] = bflo(v.z); f[5] = bfhi(v.z); f[6] = bflo(v.w); f[7] = bfhi(v.w); } while (0)
#define PACK8(f) ((u32x4){pk2(f[0], f[1]), pk2(f[2], f[3]), pk2(f[4], f[5]), pk2(f[6], f[7])})
DI float wave_sum(float v) {
#pragma unroll
    for (int o = 1; o < 64; o <<= 1) v += __shfl_xor(v, o);
    return v;
}
DI float silu_f(float x) { return x / (1.f + __expf(-x)); }
DI float sigmoid_f(float x) { return 1.f / (1.f + __expf(-x)); }
DI float gelu_f(float x) { return 0.5f * x * (1.f + erff(x * 0.70710678118654752f)); }
DI int crow(int i, int h) { return (i & 3) + 8 * (i >> 2) + 4 * h; }
DI float row_rstd(const float* ssq, int row) { const f32x4* q = (const f32x4*)(ssq + (size_t)row * 16); const f32x4 a = q[0], b = q[1], c = q[2], d = q[3]; const f32x4 t = (a + b) + (c + d);
    return rsqrtf(((t[0] + t[1]) + (t[2] + t[3])) * (1.f / 1024.f) + EPS); }

struct EpiStore {
    static constexpr bool PERM = true, AFTER_DRAIN = false;
    bf16_t* O; int ldc; int pnmask; const float* ssq;
    DI void operator()(const f32x4 (&acc)[2][2][4][2], const pg8::Unit& u, int wr, int wc, int fr, int fq) const {
        const int row0 = u.pm * 256 + wr * 64 + fr, col0 = (u.pn & pnmask) * 256 + wc * 32 + 8 * fq;
#pragma unroll
        for (int ai = 0; ai < 2; ++ai)
#pragma unroll
            for (int m = 0; m < 4; ++m) { bf16_t* rowp = O + (size_t)(row0 + ai * 128 + m * 16) * ldc + col0;
                const float rs = ssq ? row_rstd(ssq, row0 + ai * 128 + m * 16) : 1.f;
#pragma unroll
                for (int bj = 0; bj < 2; ++bj) { const f32x4 v0 = acc[ai][bj][m][0] * rs, v1 = acc[ai][bj][m][1] * rs;
                    u32x4 w; w.x = pk2(v0[0], v0[1]); w.y = pk2(v0[2], v0[3]); w.z = pk2(v1[0], v1[1]); w.w = pk2(v1[2], v1[3]);
                    *(u32x4*)(rowp + bj * 128) = w; } }
    }
};
struct EpiGU {
    static constexpr bool PERM = true, AFTER_DRAIN = false;
    bf16_t* H; const float* ssq;
    DI void operator()(const f32x4 (&acc)[2][2][4][2], const pg8::Unit& u, int wr, int wc, int fr, int fq) const {
        const int row0 = u.pm * 256 + wr * 64 + fr, col0 = u.pn * 128 + wc * 32 + 8 * fq;
#pragma unroll
        for (int ai = 0; ai < 2; ++ai)
#pragma unroll
            for (int m = 0; m < 4; ++m) { bf16_t* rowp = H + (size_t)(row0 + ai * 128 + m * 16) * 2816 + col0;
                const float rs = row_rstd(ssq, row0 + ai * 128 + m * 16);
                float o[8];
#pragma unroll
                for (int n = 0; n < 2; ++n)
#pragma unroll
                    for (int j = 0; j < 4; ++j) o[4 * n + j] = silu_f(acc[ai][0][m][n][j] * rs) * (acc[ai][1][m][n][j] * rs);
                *(u32x4*)rowp = PACK8(o); }
    }
};
struct EpiRes {
    static constexpr bool PERM = false, AFTER_DRAIN = false;
    float* X; bf16_t* XB; float* SSQ; float sc;
    DI void operator()(const f32x4 (&acc)[2][2][4][2], const pg8::Unit& u, int wr, int wc, int fr, int fq) const {
        const int row0 = u.pm * 256 + wr * 64 + fr, col0 = u.pn * 256 + wc * 32 + 4 * fq;
#pragma unroll
        for (int ai = 0; ai < 2; ++ai)
#pragma unroll
            for (int m = 0; m < 4; ++m) { const int row = row0 + ai * 128 + m * 16; const size_t ro = (size_t)row * 1024 + col0;
                float ss = 0.f;
#pragma unroll
                for (int bj = 0; bj < 2; ++bj)
#pragma unroll
                    for (int n = 0; n < 2; ++n) { f32x4* q = (f32x4*)(X + ro + bj * 128 + n * 16); const f32x4 v = *q + acc[ai][bj][m][n] * sc; *q = v;
                        *(u32x2*)(XB + ro + bj * 128 + n * 16) = (u32x2){pk2(v[0], v[1]), pk2(v[2], v[3])};
                        ss += v[0] * v[0] + v[1] * v[1] + v[2] * v[2] + v[3] * v[3]; }
                ss += __shfl_xor(ss, 16); ss += __shfl_xor(ss, 32);
                if (fq == 0) SSQ[(size_t)row * 16 + u.pn * 4 + wc] = ss; }
    }
};
struct EpiMerge {
    static constexpr bool PERM = false, AFTER_DRAIN = false;
    const bf16_t* P; bf16_t* MIX; const float* ssq;
    DI void operator()(const f32x4 (&acc)[2][2][4][2], const pg8::Unit& u, int wr, int wc, int fr, int fq) const {
        const int row0 = u.pm * 256 + wr * 64 + fr, e0 = u.pn * 64 + wc * 16 + 4 * fq;
#pragma unroll
        for (int ai = 0; ai < 2; ++ai)
#pragma unroll
            for (int m = 0; m < 4; ++m) { const size_t ro = (size_t)(row0 + ai * 128 + m * 16) * 1024 + e0;
                const float rs = row_rstd(ssq, row0 + ai * 128 + m * 16);
                float o[4] = {0.f, 0.f, 0.f, 0.f};
#pragma unroll
                for (int bj = 0; bj < 2; ++bj)
#pragma unroll
                    for (int n = 0; n < 2; ++n) { const u32x2 pv = *(const u32x2*)(P + (size_t)(2 * bj + n) * TG * 1024 + ro); const f32x4 g = acc[ai][bj][m][n] * rs;
                        o[0] += sigmoid_f(g[0]) * bflo(pv.x); o[1] += sigmoid_f(g[1]) * bfhi(pv.x); o[2] += sigmoid_f(g[2]) * bflo(pv.y); o[3] += sigmoid_f(g[3]) * bfhi(pv.y); }
                *(u32x2*)(MIX + ro) = (u32x2){pk2(o[0], o[1]), pk2(o[2], o[3])}; }
    }
};
struct BranchOrder {
    int G, c;
    DI bool next(int i, pg8::Unit& u) const { const int L = i * G + c; if (L >= 1024) return false; const int br = L >> 8, rem = L & 255; u.pm = br * 64 + (rem >> 2); u.pn = br * 4 + (rem & 3); return true; }
    DI void a_ready(const pg8::Unit&) const {}
    DI void done(const pg8::Unit&) const {}
};
template <class Epi> DI void run_gemm(LAS unsigned char* lds, const bf16_t* A, const bf16_t* Bt, int M, int N, int K, const Epi& E) {
    pg8::Gemm g{A, Bt, M, N, K}; pg8::StaticOrder S; S.init(M, N, nwg_now(), wg_now());
    pg8::gemm_phase<Epi, pg8::StaticOrder>(lds, g, S, E);
}

DI void conv_mat(const float* src, int ld, int c0, int nvalid, int kvalid, int mode, bf16_t* dst, int Nd, int Kd, LAS float* scr, int wg, int nwg, const float* ksc = nullptr) {
    const int tid = tid_now(); const int ntk = Kd >> 6, ntiles = (Nd >> 6) * ntk;
    for (int tile = wg; tile < ntiles; tile += nwg) {
        const int n0 = (tile / ntk) << 6, k0 = (tile % ntk) << 6;
        const int nn = tid & 63, kq = tid >> 6, n = n0 + nn;
        int col;
        if (mode == 1) { const int blk = n >> 7; col = ((blk & 1) ? 2816 : 0) + (blk >> 1) * 128 + (n & 127); }
        else if (mode == 2) { const int c = n & 255, br = 2 * (c >> 7) + ((c >> 4) & 1), e = 64 * (n >> 8) + 16 * ((c >> 5) & 3) + (c & 15); col = c0 + br * 1024 + e; }
        else col = c0 + n;
#pragma unroll
        for (int i = 0; i < 8; ++i) { const int kk = i * 8 + kq; float v = 0.f;
            if (k0 + kk < kvalid && n < nvalid) { v = src[(size_t)(k0 + kk) * ld + col]; if (ksc) v *= ksc[k0 + kk]; }
            scr[kk * 65 + nn] = v; }
        __syncthreads();
        { const int nr = tid >> 3, kc = tid & 7; const LAS float* sp = scr + (kc * 8) * 65 + nr;
          u32x4 o; o.x = pk2(sp[0], sp[65]); o.y = pk2(sp[130], sp[195]); o.z = pk2(sp[260], sp[325]); o.w = pk2(sp[390], sp[455]);
          *(u32x4*)(dst + (size_t)(n0 + nr) * Kd + k0 + kc * 8) = o; }
        __syncthreads();
    }
}
DI void convert_layer(const Params& p, int l, LAS float* scr, int wg, int nwg) {
    unsigned char* ws = p.ws;
    conv_mat(p.in[3] + (size_t)l * 1024 * 5632, 5632, 0, 5632, 1024, 1, (bf16_t*)(ws + O_WGU1), 5632, 1024, scr, wg, nwg, p.in[2] + l * 1024);
    conv_mat(p.in[26] + (size_t)l * 1024 * 5632, 5632, 0, 5632, 1024, 1, (bf16_t*)(ws + O_WGU2), 5632, 1024, scr, wg, nwg, p.in[25] + l * 1024);
    conv_mat(p.in[4] + (size_t)l * 2816 * 1024, 1024, 0, 1024, 2816, 0, (bf16_t*)(ws + O_WD1), 1024, 2816, scr, wg, nwg);
    conv_mat(p.in[27] + (size_t)l * 2816 * 1024, 1024, 0, 1024, 2816, 0, (bf16_t*)(ws + O_WD2), 1024, 2816, scr, wg, nwg);
    conv_mat(p.in[6] + (size_t)l * 1024 * 8776, 8776, 0, 4680, 1024, 0, (bf16_t*)(ws + O_WIN), 4864, 1024, scr, wg, nwg, p.in[5] + l * 1024);
    conv_mat(p.in[6] + (size_t)l * 1024 * 8776, 8776, 4680, 4096, 1024, 2, (bf16_t*)(ws + O_WGATE), 4096, 1024, scr, wg, nwg, p.in[5] + l * 1024);
#pragma unroll 1
    for (int i = 0; i < 4; ++i)
        conv_mat(p.in[23] + ((size_t)l * 4 + i) * 512 * 1024, 1024, 0, 1024, 512, 0, (bf16_t*)(ws + O_WBR) + (size_t)i * 1024 * 512, 1024, 512, scr, wg, nwg);
    conv_mat(p.in[24] + (size_t)l * 1024 * 1024, 1024, 0, 1024, 1024, 0, (bf16_t*)(ws + O_WOUT), 1024, 1024, scr, wg, nwg);
    conv_mat(p.in[17] + (size_t)l * 384 * 768, 768, 0, 768, 384, 0, (bf16_t*)(ws + O_WQB), 768, 384, scr, wg, nwg);
    conv_mat(p.in[19] + (size_t)l * 128 * 1024, 1024, 0, 1024, 128, 0, (bf16_t*)(ws + O_WKVB), 1024, 256, scr, wg, nwg);
}

DI void init_rows(const float* x, float* X, bf16_t* xb, float* ssq) {
    const int tidn = tid_now(); const int lane = tidn & 63, gwave = wg_now() * 8 + (tidn >> 6), ngw = nwg_now() * 8;
    for (int row = gwave; row < T_ALL; row += ngw) {
        const f32x4* xr = (const f32x4*)(x + (size_t)row * 1024);
        f32x4 v[4]; float ss = 0.f;
#pragma unroll
        for (int j = 0; j < 4; ++j) { v[j] = xr[lane + 64 * j]; ss += v[j][0] * v[j][0] + v[j][1] * v[j][1] + v[j][2] * v[j][2] + v[j][3] * v[j][3]; }
        ss = wave_sum(ss);
        u32x2* o = (u32x2*)(xb + (size_t)row * 1024); f32x4* c = (f32x4*)(X + (size_t)row * 1024);
#pragma unroll
        for (int j = 0; j < 4; ++j) { o[lane + 64 * j] = (u32x2){pk2(v[j][0], v[j][1]), pk2(v[j][2], v[j][3])}; c[lane + 64 * j] = v[j]; }
        if (lane < 16) ssq[(size_t)row * 16 + lane] = lane == 0 ? ss : 0.f;
    }
}
DI void zero_f32(float* q, int n) { const int tidn = tid_now(); for (int i = wg_now() * 512 + tidn; i < n; i += nwg_now() * 512) q[i] = 0.f; }

DI void prep1(const Params& p, int l, const bf16_t* proj, bf16_t* xbcc, float* dtb, bf16_t* aq, bf16_t* akv, bf16_t* yd) {
    const int tidn = tid_now(); const int gtid = wg_now() * 512 + tidn, gthreads = nwg_now() * 512;
    const float* cw = p.in[7] + l * 4096; const float* cb = p.in[8] + l * 1024;
    for (int idx = gtid; idx < (TG / 16) * 128; idx += gthreads) {
        const int c8 = (idx & 127) << 3, tl0 = (idx >> 7) << 4, s0 = tl0 & 2047;
        float w[4][8], bb[8], r0[8], r1[8], r2[8];
#pragma unroll
        for (int k = 0; k < 4; ++k) { const f32x4 a = *(const f32x4*)(cw + k * 1024 + c8), b = *(const f32x4*)(cw + k * 1024 + c8 + 4);
#pragma unroll
            for (int j = 0; j < 4; ++j) { w[k][j] = a[j]; w[k][4 + j] = b[j]; } }
        { const f32x4 a = *(const f32x4*)(cb + c8), b = *(const f32x4*)(cb + c8 + 4);
#pragma unroll
          for (int j = 0; j < 4; ++j) { bb[j] = a[j]; bb[4 + j] = b[j]; } }
        const bf16_t* src = proj + (size_t)tl0 * PLD + 512 + c8;
        if (s0 > 0) { const u32x4 v0 = *(const u32x4*)(src - 3 * PLD), v1 = *(const u32x4*)(src - 2 * PLD), v2 = *(const u32x4*)(src - PLD); UNPACK8(v0, r0); UNPACK8(v1, r1); UNPACK8(v2, r2); }
        else {
#pragma unroll
            for (int j = 0; j < 8; ++j) { r0[j] = 0.f; r1[j] = 0.f; r2[j] = 0.f; } }
#pragma unroll 4
        for (int tt = 0; tt < 16; ++tt) {
            const u32x4 v = *(const u32x4*)(src + (size_t)tt * PLD); float cur[8], o[8]; UNPACK8(v, cur);
#pragma unroll
            for (int j = 0; j < 8; ++j) { o[j] = silu_f(bb[j] + w[0][j] * r0[j] + w[1][j] * r1[j] + w[2][j] * r2[j] + w[3][j] * cur[j]); r0[j] = r1[j]; r1[j] = r2[j]; r2[j] = cur[j]; }
            *(u32x4*)(xbcc + (size_t)(tl0 + tt) * 1024 + c8) = PACK8(o);
        }
    }
    const float* sw = p.in[22] + l * 1536;
    for (int idx = gtid; idx < (TG / 16) * 64; idx += gthreads) {
        const int c8 = (idx & 63) << 3, tl0 = (idx >> 6) << 4, s0 = tl0 & 2047;
        float w[3][8], p1[8], p2[8];
#pragma unroll
        for (int k = 0; k < 3; ++k) { const f32x4 a = *(const f32x4*)(sw + k * 512 + c8), b = *(const f32x4*)(sw + k * 512 + c8 + 4);
#pragma unroll
            for (int j = 0; j < 4; ++j) { w[k][j] = a[j]; w[k][4 + j] = b[j]; } }
        const bf16_t* src = proj + (size_t)tl0 * PLD + c8;
        if (s0 > 0) { const u32x4 c1 = *(const u32x4*)(src - 2 * PLD + 3656), x1 = *(const u32x4*)(src - 2 * PLD + 4168), c2 = *(const u32x4*)(src - PLD + 3656), x2 = *(const u32x4*)(src - PLD + 4168);
            float a[8], b[8]; UNPACK8(c1, a); UNPACK8(x1, b);
#pragma unroll
            for (int j = 0; j < 8; ++j) p1[j] = a[j] * b[j];
            UNPACK8(c2, a); UNPACK8(x2, b);
#pragma unroll
            for (int j = 0; j < 8; ++j) p2[j] = a[j] * b[j]; }
        else {
#pragma unroll
            for (int j = 0; j < 8; ++j) { p1[j] = 0.f; p2[j] = 0.f; } }
#pragma unroll 4
        for (int tt = 0; tt < 16; ++tt) {
            const bf16_t* pr = src + (size_t)tt * PLD;
            const u32x4 vc = *(const u32x4*)(pr + 3656), vx = *(const u32x4*)(pr + 4168), vb = *(const u32x4*)(pr + 3144);
            float fc[8], fx[8], fb[8], o[8]; UNPACK8(vc, fc); UNPACK8(vx, fx); UNPACK8(vb, fb);
#pragma unroll
            for (int j = 0; j < 8; ++j) { const float cur = fc[j] * fx[j]; o[j] = fb[j] * (w[0][j] * p1[j] + w[1][j] * p2[j] + w[2][j] * cur); p1[j] = p2[j]; p2[j] = cur; }
            *(u32x4*)(yd + (size_t)(tl0 + tt) * 512 + c8) = PACK8(o);
        }
    }
    const int gwave = gtid >> 6, ngw = gthreads >> 6, lane = tidn & 63;
    const float* qn = p.in[16] + l * 384; const float* kn = p.in[18] + l * 128;
    for (int tl = gwave; tl < TG; tl += ngw) {
        const bf16_t* pr = proj + (size_t)tl * PLD;
        const u32x4 v = *(const u32x4*)(pr + 2568 + lane * 8); float f[8]; UNPACK8(v, f);
        float ss = 0.f;
#pragma unroll
        for (int j = 0; j < 8; ++j) ss += f[j] * f[j];
        const float ssq = wave_sum(lane < 48 ? ss : 0.f), ssk = wave_sum(lane >= 48 ? ss : 0.f);
        if (lane < 48) {
            const float rstd = rsqrtf(ssq * (1.f / 384.f) + EPS);
#pragma unroll
            for (int j = 0; j < 8; ++j) f[j] *= rstd * qn[lane * 8 + j];
            *(u32x4*)(aq + (size_t)tl * 384 + lane * 8) = PACK8(f);
        } else {
            const float rstd = rsqrtf(ssk * (1.f / 128.f) + EPS);
#pragma unroll
            for (int j = 0; j < 8; ++j) f[j] *= rstd * kn[(lane - 48) * 8 + j];
            *(u32x4*)(akv + (size_t)tl * 256 + (lane - 48) * 8) = PACK8(f);
            *(u32x4*)(akv + (size_t)tl * 256 + 128 + (lane - 48) * 8) = (u32x4){0u, 0u, 0u, 0u};
        }
        if (lane < 8) {
            const float xr = bf2f(pr[1536 + lane]) + p.in[9][l * 8 + lane];
            const float dt = xr > 20.f ? xr : log1pf(expf(xr));
            const float A = -expf(p.in[10][l * 8 + lane]);
            dtb[(size_t)tl * 16 + lane] = dt; dtb[(size_t)tl * 16 + 8 + lane] = dt * A;
        }
    }
}

DI void rope_table(const Params& p, f32x2* CS) {
    const int* pos = (const int*)p.in[1];
    const int tidn = tid_now();
    for (int idx = wg_now() * 512 + tidn; idx < T_ALL * 32; idx += nwg_now() * 512) {
        const float invf = exp2f(-(float)(idx & 31) * (13.287712379549449f / 32.f));
        const float ang = (float)pos[idx >> 5] * invf;
        CS[idx] = (f32x2){cosf(ang), sinf(ang)};
    }
}
DI void prep2_unit(const Params& p, int l, int g, const bf16_t* proj, const bf16_t* qraw, const bf16_t* kvraw, const f32x2* CS, bf16_t* Qf, bf16_t* Kf, bf16_t* Vt, int bl, int tile, LAS unsigned char* lds) {
    const int tid = tid_now(), wave = tid >> 6, lane = tid & 63;
    const float* wq = p.in[20] + l * 192; const float* wk = p.in[21] + l * 192;
    const float qscale = 0.07216878364870322f * 1.4426950408889634f;
    const float wq0 = wq[lane], wq1 = wq[64 + lane], wq2 = wq[128 + lane], wk0 = wk[lane], wk1 = wk[64 + lane], wk2 = wk[128 + lane];
    LAS bf16_t* img = (LAS bf16_t*)lds;
    const int t0 = tile * 64;
#pragma unroll 1
    for (int tt = 0; tt < 8; ++tt) {
        const int tloc = wave * 8 + tt, s = t0 + tloc; const size_t tl = (size_t)bl * SEQ + s;
        const f32x2 cssn = CS[((size_t)(g * BPG + bl) * SEQ + s) * 32 + (lane & 31)];
        const float cs = cssn[0], sn = cssn[1];
        const float kpe = bf2f(proj[tl * PLD + 3080 + lane]);
#pragma unroll
        for (int h = 0; h < 4; ++h) {
            const size_t ob = ((size_t)(bl * 4 + h) * SEQ + s) * 192;
            {
                const bf16_t* qr = qraw + tl * 768 + h * 192;
                float q0 = bf2f(qr[lane]), q1 = bf2f(qr[64 + lane]), q2 = bf2f(qr[128 + lane]);
                const float r = rsqrtf(wave_sum(q0 * q0 + q1 * q1 + q2 * q2) * (1.f / 192.f) + EPS);
                q0 *= r * wq0; q1 *= r * wq1; q2 *= r * wq2;
                const float qp = __shfl_xor(q2, 32);
                q2 = (lane < 32) ? q2 * cs - qp * sn : q2 * cs + qp * sn;
                bf16_t* qo = Qf + ob;
                qo[lane] = f2bf(q0 * qscale); qo[64 + lane] = f2bf(q1 * qscale); qo[128 + lane] = f2bf(q2 * qscale);
            }
            const bf16_t* kr = kvraw + tl * 1024 + h * 256;
            {
                float k0 = bf2f(kr[lane]), k1 = bf2f(kr[64 + lane]), k2 = kpe;
                const float r = rsqrtf(wave_sum(k0 * k0 + k1 * k1 + k2 * k2) * (1.f / 192.f) + EPS);
                k0 *= r * wk0; k1 *= r * wk1; k2 *= r * wk2;
                const float kp = __shfl_xor(k2, 32);
                k2 = (lane < 32) ? k2 * cs - kp * sn : k2 * cs + kp * sn;
                bf16_t* ko = Kf + ob;
                ko[lane] = f2bf(k0); ko[64 + lane] = f2bf(k1); ko[128 + lane] = f2bf(k2);
            }
            img[(h * 128 + lane) * 72 + tloc] = kr[128 + lane]; img[(h * 128 + 64 + lane) * 72 + tloc] = kr[192 + lane];
        }
    }
    __syncthreads();
#pragma unroll
    for (int i = 0; i < 8; ++i) {
        const int ch = tid + 512 * i, row = ch >> 3, cc = ch & 7;
        *(u32x4*)(Vt + ((size_t)(bl * 4 + (row >> 7)) * 128 + (row & 127)) * SEQ + t0 + cc * 8) = *(const LAS u32x4*)(lds + row * 144 + cc * 16);
    }
    __syncthreads();
}

constexpr int KP = 400, VP = 136, KBYTES = 64 * KP, VBYTES = 128 * VP, ASTAGE = KBYTES + VBYTES;
DI void attn_unit(const bf16_t* Qf, const bf16_t* Kf, const bf16_t* Vt, bf16_t* yc, int bh, int qb, LAS unsigned char* lds) {
    const int tid = tid_now(), wave = tid >> 6, lane = tid & 63, r31 = lane & 31, hh = lane >> 5;
    const int q0 = qb * 256, qrow = q0 + wave * 32 + r31;
    const bf16_t* Qp = Qf + ((size_t)bh * SEQ + qrow) * 192 + 8 * hh;
    bf16x8 qf[12];
#pragma unroll
    for (int kk = 0; kk < 12; ++kk) qf[kk] = *(const bf16x8*)(Qp + kk * 16);
    f32x16 o[4];
#pragma unroll
    for (int d = 0; d < 4; ++d)
#pragma unroll
        for (int i = 0; i < 16; ++i) o[d][i] = 0.f;
    float m = -1e30f, l = 0.f;
    const int ntiles = qb * 4 + 4;
    const bf16_t* Kb = Kf + (size_t)bh * SEQ * 192; const bf16_t* Vb = Vt + (size_t)bh * 128 * SEQ;
    int krow[3], kcc[3], vd[2], vcc[2];
#pragma unroll
    for (int i = 0; i < 3; ++i) { const int c = tid + 512 * i; krow[i] = c / 24; kcc[i] = c % 24; }
#pragma unroll
    for (int i = 0; i < 2; ++i) { const int c = tid + 512 * i; vd[i] = c >> 3; vcc[i] = c & 7; }
    u32x4 kreg[3], vreg[2];
#define ATT_GLOAD(j) do { _Pragma("unroll") for (int i = 0; i < 3; ++i) kreg[i] = *(const u32x4*)(Kb + (size_t)((j) * 64 + krow[i]) * 192 + kcc[i] * 8); \
        _Pragma("unroll") for (int i = 0; i < 2; ++i) vreg[i] = *(const u32x4*)(Vb + (size_t)vd[i] * SEQ + (j) * 64 + vcc[i] * 8); } while (0)
#define ATT_LSTORE(st) do { LAS unsigned char* b_ = lds + (st) * ASTAGE; \
        _Pragma("unroll") for (int i = 0; i < 3; ++i) *(LAS u32x4*)(b_ + krow[i] * KP + kcc[i] * 16) = kreg[i]; \
        _Pragma("unroll") for (int i = 0; i < 2; ++i) { LAS u32x2* d_ = (LAS u32x2*)(b_ + KBYTES + vd[i] * VP + vcc[i] * 16); d_[0] = (u32x2){vreg[i].x, vreg[i].y}; d_[1] = (u32x2){vreg[i].z, vreg[i].w}; } } while (0)
    ATT_GLOAD(0); ATT_LSTORE(0);
    __syncthreads();
    for (int j = 0; j < ntiles; ++j) {
        const int cur = j & 1;
        if (j + 1 < ntiles) ATT_GLOAD(j + 1);
        if (j * 64 <= q0 + wave * 32 + 31) {
            const LAS unsigned char* Kl = lds + cur * ASTAGE; const LAS unsigned char* Vl = Kl + KBYTES;
            f32x16 s0, s1;
#pragma unroll
            for (int i = 0; i < 16; ++i) { s0[i] = 0.f; s1[i] = 0.f; }
#pragma unroll
            for (int kk = 0; kk < 12; ++kk) {
                const bf16x8 a0 = *(const LAS bf16x8*)(Kl + r31 * KP + (kk * 16 + 8 * hh) * 2);
                const bf16x8 a1 = *(const LAS bf16x8*)(Kl + (32 + r31) * KP + (kk * 16 + 8 * hh) * 2);
                s0 = MFMA32(a0, qf[kk], s0); s1 = MFMA32(a1, qf[kk], s1);
            }
            if (j * 64 + 63 > q0 + wave * 32) {
#pragma unroll
                for (int i = 0; i < 16; ++i) { const int key = j * 64 + crow(i, hh); if (key > qrow) s0[i] = -1e30f; if (key + 32 > qrow) s1[i] = -1e30f; }
            }
            float mx = s0[0];
#pragma unroll
            for (int i = 1; i < 16; ++i) mx = fmaxf(mx, s0[i]);
#pragma unroll
            for (int i = 0; i < 16; ++i) mx = fmaxf(mx, s1[i]);
            mx = fmaxf(mx, __shfl_xor(mx, 32));
            const float mn = fmaxf(m, mx), alpha = __builtin_amdgcn_exp2f(m - mn);
            m = mn;
            float ls = 0.f;
#pragma unroll
            for (int i = 0; i < 16; ++i) { s0[i] = __builtin_amdgcn_exp2f(s0[i] - mn); s1[i] = __builtin_amdgcn_exp2f(s1[i] - mn); ls += s0[i] + s1[i]; }
            l = l * alpha + ls;
#pragma unroll
            for (int d = 0; d < 4; ++d)
#pragma unroll
                for (int i = 0; i < 16; ++i) o[d][i] *= alpha;
            bf16x8 pf[2][2];
#pragma unroll
            for (int s = 0; s < 2; ++s) {
                u32x4 w0, w1;
                w0.x = pk2(s0[8 * s], s0[8 * s + 1]); w0.y = pk2(s0[8 * s + 2], s0[8 * s + 3]); w0.z = pk2(s0[8 * s + 4], s0[8 * s + 5]); w0.w = pk2(s0[8 * s + 6], s0[8 * s + 7]);
                w1.x = pk2(s1[8 * s], s1[8 * s + 1]); w1.y = pk2(s1[8 * s + 2], s1[8 * s + 3]); w1.z = pk2(s1[8 * s + 4], s1[8 * s + 5]); w1.w = pk2(s1[8 * s + 6], s1[8 * s + 7]);
                pf[0][s] = __builtin_bit_cast(bf16x8, w0); pf[1][s] = __builtin_bit_cast(bf16x8, w1);
            }
#pragma unroll
            for (int d = 0; d < 4; ++d)
#pragma unroll
                for (int kb = 0; kb < 2; ++kb)
#pragma unroll
                    for (int s = 0; s < 2; ++s) {
                        const LAS unsigned char* vp = Vl + (d * 32 + r31) * VP + (kb * 32 + 16 * s + 4 * hh) * 2;
                        const s16x4 lo = *(const LAS s16x4*)vp, hi = *(const LAS s16x4*)(vp + 16);
                        const bf16x8 a = __builtin_shufflevector(lo, hi, 0, 1, 2, 3, 4, 5, 6, 7);
                        o[d] = MFMA32(a, pf[kb][s], o[d]);
                    }
        }
        if (j + 1 < ntiles) ATT_LSTORE(cur ^ 1);
        __syncthreads();
    }
#undef ATT_GLOAD
#undef ATT_LSTORE
    l += __shfl_xor(l, 32);
    const float inv = 1.f / l;
    const int bl = bh >> 2, h = bh & 3;
    bf16_t* op = yc + ((size_t)bl * SEQ + qrow) * 512 + h * 128 + 4 * hh;
#pragma unroll
    for (int d = 0; d < 4; ++d)
#pragma unroll
        for (int i4 = 0; i4 < 4; ++i4)
            *(u32x2*)(op + d * 32 + 8 * i4) = (u32x2){pk2(o[d][4 * i4] * inv, o[d][4 * i4 + 1] * inv), pk2(o[d][4 * i4 + 2] * inv, o[d][4 * i4 + 3] * inv)};
}

DI void gmlp_unit(const Params& p, int l, const bf16_t* proj, bf16_t* yb, int bl, int c, LAS unsigned char* lds) {
    const int tid = tid_now(), wave = tid >> 6, lane = tid & 63, r31 = lane & 31, hh = lane >> 5;
    const float* wsp = p.in[14] + (size_t)l * 4 * 128 * 128; const float* bs = p.in[15] + l * 512; const float* vn = p.in[13] + l * 512;
    const size_t tl0 = (size_t)bl * SEQ + c * 128;
    float w8[8];
#pragma unroll
    for (int j = 0; j < 8; ++j) w8[j] = vn[lane + 64 * j];
    LAS bf16_t* vt = (LAS bf16_t*)lds;
#pragma unroll 2
    for (int rr = 0; rr < 16; ++rr) {
        const int row = wave * 16 + rr;
        const bf16_t* vr = proj + (tl0 + row) * PLD + 2056 + lane;
        float f[8]; float ss = 0.f;
#pragma unroll
        for (int j = 0; j < 8; ++j) { f[j] = gelu_f(bf2f(vr[64 * j])); ss += f[j] * f[j]; }
        const float rstd = rsqrtf(wave_sum(ss) * (1.f / 512.f) + EPS);
#pragma unroll
        for (int j = 0; j < 8; ++j) vt[(lane + 64 * j) * 136 + row] = f2bf(f[j] * rstd * w8[j]);
    }
    __syncthreads();
    const int mb = wave & 3, nh = wave >> 2, trow = mb * 32 + r31;
#pragma unroll 1
    for (int g = 0; g < 4; ++g) {
        f32x16 a0, a1;
#pragma unroll
        for (int i = 0; i < 16; ++i) { a0[i] = 0.f; a1[i] = 0.f; }
        const float* wrow = wsp + ((size_t)g * 128 + trow) * 128 + 8 * hh;
#pragma unroll
        for (int kk = 0; kk < 8; ++kk) if (kk * 16 <= mb * 32 + 31) {
            const f32x4 x0 = *(const f32x4*)(wrow + kk * 16), x1 = *(const f32x4*)(wrow + kk * 16 + 4);
            const int sb = kk * 16 + 8 * hh;
            float f[8];
#pragma unroll
            for (int j = 0; j < 4; ++j) { f[j] = (sb + j <= trow) ? x0[j] : 0.f; f[4 + j] = (sb + 4 + j <= trow) ? x1[j] : 0.f; }
            const bf16x8 a = __builtin_bit_cast(bf16x8, PACK8(f));
            const bf16x8 b0 = *(const LAS bf16x8*)(vt + (g * 128 + nh * 64 + r31) * 136 + kk * 16 + 8 * hh);
            const bf16x8 b1 = *(const LAS bf16x8*)(vt + (g * 128 + nh * 64 + 32 + r31) * 136 + kk * 16 + 8 * hh);
            a0 = MFMA32(a, b0, a0); a1 = MFMA32(a, b1, a1);
        }
#pragma unroll
        for (int i = 0; i < 16; ++i) {
            const int t = mb * 32 + crow(i, hh); const float bias = bs[g * 128 + t];
            const bf16_t* ur = proj + (tl0 + t) * PLD + 1544 + g * 128 + nh * 64 + r31;
            bf16_t* orow = yb + (tl0 + t) * 512 + g * 128 + nh * 64 + r31;
            orow[0] = f2bf(gelu_f(bf2f(ur[0])) * (a0[i] + bias));
            orow[32] = f2bf(gelu_f(bf2f(ur[32])) * (a1[i] + bias));
        }
    }
    __syncthreads();
}

constexpr int SP = 136;
DI void scan128(float& v0, float& v1, int lane) {
#pragma unroll
    for (int o = 1; o < 64; o <<= 1) { const float n0 = __shfl_up(v0, o), n1 = __shfl_up(v1, o); if (lane >= o) { v0 += n0; v1 += n1; } }
    v1 += __shfl(v0, 63);
}
DI void ssd_states_unit(const bf16_t* xbcc, const float* dtb, float* ST, float* ATOT, int bl, int c, int grp, LAS unsigned char* lds) {
    const int tid = tid_now(), wave = tid >> 6, lane = tid & 63, r31 = lane & 31, hh = lane >> 5;
    LAS bf16_t* BT = (LAS bf16_t*)lds; LAS bf16_t* XT = (LAS bf16_t*)(lds + 34816); LAS float* WS = (LAS float*)(lds + 104448);
    const size_t row0 = (size_t)bl * SEQ + c * 128;
    if (wave < 4) {
        const int h = grp * 4 + wave;
        const float d0 = dtb[(row0 + lane) * 16 + h], d1 = dtb[(row0 + 64 + lane) * 16 + h];
        float v0 = dtb[(row0 + lane) * 16 + 8 + h], v1 = dtb[(row0 + 64 + lane) * 16 + 8 + h];
        scan128(v0, v1, lane);
        const float tot = __shfl(v1, 63);
        WS[wave * 128 + lane] = d0 * __expf(tot - v0); WS[wave * 128 + 64 + lane] = d1 * __expf(tot - v1);
        if (lane == 0) ATOT[(bl * 16 + c) * 8 + h] = tot;
    }
    __syncthreads();
#pragma unroll
    for (int i = 0; i < 4; ++i) {
        const int ch = tid + 512 * i, s = ch >> 4, n8 = (ch & 15) * 8;
        const u32x4 v = *(const u32x4*)(xbcc + (row0 + s) * 1024 + 512 + grp * 128 + n8);
        LAS bf16_t* d = BT + n8 * SP + s;
        d[0] = (bf16_t)(v.x & 0xffffu); d[SP] = (bf16_t)(v.x >> 16); d[2 * SP] = (bf16_t)(v.y & 0xffffu); d[3 * SP] = (bf16_t)(v.y >> 16);
        d[4 * SP] = (bf16_t)(v.z & 0xffffu); d[5 * SP] = (bf16_t)(v.z >> 16); d[6 * SP] = (bf16_t)(v.w & 0xffffu); d[7 * SP] = (bf16_t)(v.w >> 16);
    }
#pragma unroll
    for (int i = 0; i < 8; ++i) {
        const int ch = tid + 512 * i, s = ch >> 5, c8 = (ch & 31) * 8;
        const u32x4 v = *(const u32x4*)(xbcc + (row0 + s) * 1024 + grp * 256 + c8); float f[8]; UNPACK8(v, f);
        const float w = WS[(c8 >> 6) * 128 + s];
        LAS bf16_t* d = XT + c8 * SP + s;
#pragma unroll
        for (int j = 0; j < 8; ++j) d[j * SP] = f2bf(f[j] * w);
    }
    __syncthreads();
    const int hl = wave >> 1, pb = wave & 1;
    f32x16 acc[4];
#pragma unroll
    for (int nb = 0; nb < 4; ++nb)
#pragma unroll
        for (int i = 0; i < 16; ++i) acc[nb][i] = 0.f;
#pragma unroll
    for (int k = 0; k < 8; ++k) {
        const bf16x8 a = *(const LAS bf16x8*)(XT + (hl * 64 + pb * 32 + r31) * SP + k * 16 + 8 * hh);
#pragma unroll
        for (int nb = 0; nb < 4; ++nb) { const bf16x8 b = *(const LAS bf16x8*)(BT + (nb * 32 + r31) * SP + k * 16 + 8 * hh); acc[nb] = MFMA32(a, b, acc[nb]); }
    }
    float* so = ST + (((size_t)bl * 16 + c) * 8 + grp * 4 + hl) * 8192;
#pragma unroll
    for (int nb = 0; nb < 4; ++nb)
#pragma unroll
        for (int i = 0; i < 16; ++i) so[(pb * 32 + crow(i, hh)) * 128 + nb * 32 + r31] = acc[nb][i];
    __syncthreads();
}
DI void ssd_scan(float* ST, const float* ATOT) {
    const int tidn = tid_now();
    for (int idx = wg_now() * 512 + tidn; idx < 64 * 2048; idx += nwg_now() * 512) {
        const int bh = idx >> 11, e4 = idx & 2047, bl = bh >> 3, head = bh & 7;
        float* base = ST + ((size_t)bl * 16 * 8 + head) * 8192 + e4 * 4;
        f32x4 s[16];
#pragma unroll
        for (int c = 0; c < 16; ++c) s[c] = *(const f32x4*)(base + (size_t)c * 8 * 8192);
        f32x4 run = {0.f, 0.f, 0.f, 0.f};
#pragma unroll
        for (int c = 0; c < 16; ++c) { const float ea = __expf(ATOT[(bl * 16 + c) * 8 + head]); *(f32x4*)(base + (size_t)c * 8 * 8192) = run; run = run * ea + s[c]; }
    }
}
DI void ssd_out_unit(const Params& p, int l, const bf16_t* proj, const bf16_t* xbcc, const float* dtb, const float* ST, float* yraw, int bl, int c, int pair, LAS unsigned char* lds, LAS float* RS, int first) {
    const int tid = tid_now(), wave = tid >> 6, lane = tid & 63, r31 = lane & 31, hh = lane >> 5;
    LAS bf16_t* CL = (LAS bf16_t*)lds; LAS bf16_t* BL = (LAS bf16_t*)(lds + 34816); LAS bf16_t* XT = (LAS bf16_t*)(lds + 69632); LAS bf16_t* PV = (LAS bf16_t*)(lds + 104448);
    LAS float* ACS = (LAS float*)(lds + 139264); LAS float* DTL = (LAS float*)(lds + 140288); LAS float* OUT = (LAS float*)lds;
    const int grp = pair >> 1; const size_t row0 = (size_t)bl * SEQ + c * 128;
    if (wave < 2) {
        const int h = pair * 2 + wave;
        const float d0 = dtb[(row0 + lane) * 16 + h], d1 = dtb[(row0 + 64 + lane) * 16 + h];
        float v0 = dtb[(row0 + lane) * 16 + 8 + h], v1 = dtb[(row0 + 64 + lane) * 16 + 8 + h];
        scan128(v0, v1, lane);
        ACS[wave * 128 + lane] = v0; ACS[wave * 128 + 64 + lane] = v1; DTL[wave * 128 + lane] = d0; DTL[wave * 128 + 64 + lane] = d1;
    }
    __syncthreads();
#pragma unroll
    for (int i = 0; i < 4; ++i) {
        const int ch = tid + 512 * i, s = ch >> 4, n8 = (ch & 15) * 8;
        const bf16_t* xr = xbcc + (row0 + s) * 1024;
        *(LAS u32x4*)(CL + s * SP + n8) = *(const u32x4*)(xr + 768 + grp * 128 + n8);
        *(LAS u32x4*)(BL + s * SP + n8) = *(const u32x4*)(xr + 512 + grp * 128 + n8);
        const u32x4 v = *(const u32x4*)(xr + pair * 128 + n8); float f[8]; UNPACK8(v, f);
        const float w = DTL[(n8 >> 6) * 128 + s];
        LAS bf16_t* d = XT + n8 * SP + s;
#pragma unroll
        for (int j = 0; j < 8; ++j) d[j * SP] = f2bf(f[j] * w);
        const float* sp = ST + (((size_t)bl * 16 + c) * 8 + pair * 2) * 8192 + (size_t)s * 128 + n8;
        const f32x4 a = *(const f32x4*)sp, b = *(const f32x4*)(sp + 4);
        *(LAS u32x4*)(PV + s * SP + n8) = (u32x4){pk2(a[0], a[1]), pk2(a[2], a[3]), pk2(b[0], b[1]), pk2(b[2], b[3])};
    }
    __syncthreads();
    const int tb = wave >> 1, hl = wave & 1;
    f32x16 acc[2];
#pragma unroll
    for (int pb = 0; pb < 2; ++pb)
#pragma unroll
        for (int i = 0; i < 16; ++i) acc[pb][i] = 0.f;
    const LAS bf16_t* crw = CL + (tb * 32 + r31) * SP + 8 * hh;
#pragma unroll
    for (int k = 0; k < 8; ++k) {
        const bf16x8 b = *(const LAS bf16x8*)(crw + k * 16);
#pragma unroll
        for (int pb = 0; pb < 2; ++pb) { const bf16x8 a = *(const LAS bf16x8*)(PV + (hl * 64 + pb * 32 + r31) * SP + k * 16 + 8 * hh); acc[pb] = MFMA32(a, b, acc[pb]); }
    }
    const float at = ACS[hl * 128 + tb * 32 + r31], eat = __expf(at);
#pragma unroll
    for (int pb = 0; pb < 2; ++pb)
#pragma unroll
        for (int i = 0; i < 16; ++i) acc[pb][i] *= eat;
#pragma unroll 1
    for (int sb = 0; sb <= tb; ++sb) {
        f32x16 cbt;
#pragma unroll
        for (int i = 0; i < 16; ++i) cbt[i] = 0.f;
#pragma unroll
        for (int k = 0; k < 8; ++k) {
            const bf16x8 a = *(const LAS bf16x8*)(BL + (sb * 32 + r31) * SP + k * 16 + 8 * hh);
            const bf16x8 b = *(const LAS bf16x8*)(crw + k * 16);
            cbt = MFMA32(a, b, cbt);
        }
#pragma unroll
        for (int i = 0; i < 16; ++i) {
            const int sl = crow(i, hh); const float as = ACS[hl * 128 + sb * 32 + sl];
            const float mv = cbt[i] * __expf(fminf(at - as, 0.f));
            cbt[i] = (sb == tb && sl > r31) ? 0.f : mv;
        }
#pragma unroll
        for (int ks = 0; ks < 2; ++ks) {
            u32x4 w; w.x = pk2(cbt[8 * ks], cbt[8 * ks + 1]); w.y = pk2(cbt[8 * ks + 2], cbt[8 * ks + 3]); w.z = pk2(cbt[8 * ks + 4], cbt[8 * ks + 5]); w.w = pk2(cbt[8 * ks + 6], cbt[8 * ks + 7]);
            const bf16x8 pfr = __builtin_bit_cast(bf16x8, w);
#pragma unroll
            for (int pb = 0; pb < 2; ++pb) {
                const LAS bf16_t* vp = XT + (hl * 64 + pb * 32 + r31) * SP + sb * 32 + 16 * ks + 4 * hh;
                const s16x4 lo = *(const LAS s16x4*)vp, hi = *(const LAS s16x4*)(vp + 8);
                const bf16x8 a = __builtin_shufflevector(lo, hi, 0, 1, 2, 3, 4, 5, 6, 7);
                acc[pb] = MFMA32(a, pfr, acc[pb]);
            }
        }
    }
    __syncthreads();
#pragma unroll
    for (int pb = 0; pb < 2; ++pb)
#pragma unroll
        for (int i = 0; i < 16; ++i) OUT[(tb * 32 + r31) * 132 + hl * 64 + pb * 32 + crow(i, hh)] = acc[pb][i];
    __syncthreads();
#pragma unroll
    for (int i = 0; i < 4; ++i) {
        const int it = tid + 512 * i, t = it >> 4, c8 = (it & 15) * 8;
        const f32x4 y0 = *(const LAS f32x4*)(OUT + t * 132 + c8), y1 = *(const LAS f32x4*)(OUT + t * 132 + c8 + 4);
        const u32x4 xv = *(const u32x4*)(xbcc + (row0 + t) * 1024 + pair * 128 + c8), zv = *(const u32x4*)(proj + (row0 + t) * PLD + pair * 128 + c8);
        float fx[8], fz[8]; UNPACK8(xv, fx); UNPACK8(zv, fz);
        const float Dh = p.in[11][l * 8 + pair * 2 + (c8 >> 6)];
        f32x4 o0, o1;
#pragma unroll
        for (int j = 0; j < 4; ++j) { o0[j] = (y0[j] + Dh * fx[j]) * silu_f(fz[j]); o1[j] = (y1[j] + Dh * fx[4 + j]) * silu_f(fz[4 + j]); }
        float* op = yraw + (row0 + t) * 512 + pair * 128 + c8; *(f32x4*)op = o0; *(f32x4*)(op + 4) = o1;
        float ss = 0.f;
#pragma unroll
        for (int j = 0; j < 4; ++j) ss += o0[j] * o0[j] + o1[j] * o1[j];
        ss += __shfl_xor(ss, 1); ss += __shfl_xor(ss, 2); ss += __shfl_xor(ss, 4); ss += __shfl_xor(ss, 8);
        if ((tid & 15) == 0) RS[t] = first ? ss : RS[t] + ss;
    }
    __syncthreads();
}
DI void ssd_out_grp(const Params& p, int l, const bf16_t* proj, const bf16_t* xbcc, const float* dtb, const float* ST, float* yraw, bf16_t* ya, int bl, int c, int grp, LAS unsigned char* lds) {
    LAS float* RS = (LAS float*)(lds + 141312);
    ssd_out_unit(p, l, proj, xbcc, dtb, ST, yraw, bl, c, grp * 2, lds, RS, 1);
    ssd_out_unit(p, l, proj, xbcc, dtb, ST, yraw, bl, c, grp * 2 + 1, lds, RS, 0);
    const int tid = tid_now(); const size_t row0 = (size_t)bl * SEQ + c * 128;
    const float* nw = p.in[12] + l * 512 + grp * 256;
#pragma unroll
    for (int i = 0; i < 8; ++i) {
        const int it = tid + 512 * i, t = it >> 5, c8 = (it & 31) * 8;
        const float* yr = yraw + (row0 + t) * 512 + grp * 256 + c8;
        const f32x4 a = *(const f32x4*)yr, b = *(const f32x4*)(yr + 4), w0 = *(const f32x4*)(nw + c8), w1 = *(const f32x4*)(nw + c8 + 4);
        const float rstd = rsqrtf(RS[t] * (1.f / 256.f) + EPS);
        *(u32x4*)(ya + (row0 + t) * 512 + grp * 256 + c8) = (u32x4){pk2(a[0] * rstd * w0[0], a[1] * rstd * w0[1]), pk2(a[2] * rstd * w0[2], a[3] * rstd * w0[3]),
                                                                      pk2(b[0] * rstd * w1[0], b[1] * rstd * w1[1]), pk2(b[2] * rstd * w1[2], b[3] * rstd * w1[3])};
    }
    __syncthreads();
}
#if MULTI_LAUNCH
#define RUNPH(x) ((x) == p.only_phase)
#define GSYNC() do {} while (0)
#else
#define RUNPH(x) true
#define GSYNC() do { xcd_barrier(xb); if (PROBE & 1) xcd_barrier(xb); } while (0)
#endif
#define PH_BEGIN if (RUNPH(ph)) { unsigned char* ws = p.ws; float* X = p.out; asm volatile("" : "+s"(ws), "+s"(X)); const int wg = wg_now(), nwg = nwg_now();
#define PH_END } ++ph; GSYNC();
__global__ void __launch_bounds__(512) mega(Params p) {
    extern __shared__ __attribute__((aligned(16))) unsigned char smem[];
    LAS unsigned char* lds = (LAS unsigned char*)smem;
#if !MULTI_LAUNCH
    cg::grid_group grid = cg::this_grid();
    volatile LAS unsigned* xst = (volatile LAS unsigned*)(lds + LDS_BYTES - 16);
    if (threadIdx.x == 0) { xst[0] = 0u; xst[1] = 0u; }
    __syncthreads();
    const XcdBarrier xb = xcd_barrier_post((unsigned*)(p.ws + O_BAR), xst);
    grid.sync();
#endif
#define XN ((bf16_t*)(ws + O_XN))
#define SSQ0 ((float*)(ws + O_SSQ))
#define SSQ1 (SSQ0 + (size_t)T_ALL * 16)
#define SSQ2 (SSQ0 + (size_t)2 * T_ALL * 16)
#define H ((bf16_t*)(ws + O_H))
#define PROJ ((bf16_t*)(ws + O_PROJ))
#define XBCC ((bf16_t*)(ws + O_XBCC))
#define ST ((float*)(ws + O_ST))
#define ATOT ((float*)(ws + O_ATOT))
#define DTB ((float*)(ws + O_DTB))
#define AQ ((bf16_t*)(ws + O_AQ))
#define AKV ((bf16_t*)(ws + O_AKV))
#define QRAW ((bf16_t*)(ws + O_QRAW))
#define KVRAW ((bf16_t*)(ws + O_KVRAW))
#define QF ((bf16_t*)(ws + O_QF))
#define KF ((bf16_t*)(ws + O_KF))
#define VT ((bf16_t*)(ws + O_VT))
#define YRAW ((float*)(ws + O_YRAW))
#define YA ((bf16_t*)(ws + O_YA))
#define YB (YA + (size_t)TG * 512)
#define YC (YA + (size_t)2 * TG * 512)
#define YD (YA + (size_t)3 * TG * 512)
#define CS ((f32x2*)(ws + O_CS))
#define PB ((bf16_t*)(ws + O_PB))
#define MIXB ((bf16_t*)(ws + O_MIXB))
#define WIN ((const bf16_t*)(ws + O_WIN))
#define WGATE ((const bf16_t*)(ws + O_WGATE))
#define WBR ((const bf16_t*)(ws + O_WBR))
#define WOUT ((const bf16_t*)(ws + O_WOUT))
#define WQB ((const bf16_t*)(ws + O_WQB))
#define WKVB ((const bf16_t*)(ws + O_WKVB))
#define XNg (XN + (size_t)g * TG * 1024)
    int ph = 0;
#pragma unroll 1
    for (int l = 0; l < 4; ++l) {
#pragma unroll 1
        for (int f = 0; f < 2; ++f) {
            if (f == 0) {
                PH_BEGIN
                    convert_layer(p, l, (LAS float*)lds, wg, nwg);
                    if (l == 0) { rope_table(p, CS); init_rows(p.in[0], X, XN, SSQ0); }
                PH_END
            }
            PH_BEGIN
                EpiGU e{H, f == 0 ? SSQ0 : SSQ2};
#pragma unroll 1
                for (int rep = 0; rep < ((PROBE & 16) ? 2 : 1); ++rep) run_gemm(lds, XN, (const bf16_t*)(ws + (f == 0 ? O_WGU1 : O_WGU2)), T_ALL, 5632, 1024, e);
            PH_END
            PH_BEGIN
                EpiRes e{X, XN, f == 0 ? SSQ1 : SSQ0, 0.5f}; run_gemm(lds, H, (const bf16_t*)(ws + (f == 0 ? O_WD1 : O_WD2)), T_ALL, 1024, 2816, e);
            PH_END
            if (f == 0) {
#pragma unroll 1
                for (int g = 0; g < NGRP; ++g) {
                    PH_BEGIN
                        EpiStore e{PROJ, PLD, 0x7fffffff, SSQ1 + (size_t)g * TG * 16};
#pragma unroll 1
                        for (int rep = 0; rep < ((PROBE & 8) ? 2 : 1); ++rep) run_gemm(lds, XNg, WIN, TG, 4864, 1024, e);
                    PH_END
                    PH_BEGIN
                        prep1(p, l, PROJ, XBCC, DTB, AQ, AKV, YD);
                    PH_END
                    PH_BEGIN
                        { EpiStore e{QRAW, 768, 0x7fffffff, nullptr}; run_gemm(lds, AQ, WQB, TG, 768, 384, e); }
                        { EpiStore e{KVRAW, 1024, 0x7fffffff, nullptr}; run_gemm(lds, AKV, WKVB, TG, 1024, 256, e); }
#pragma unroll 1
                        for (int u = wg; u < 256; u += nwg) {
                            ssd_states_unit(XBCC, DTB, ST, ATOT, u >> 5, (u >> 1) & 15, u & 1, lds);
                        }
                    PH_END
                    PH_BEGIN
#pragma unroll 1
                        for (int u = wg; u < 256; u += nwg) prep2_unit(p, l, g, PROJ, QRAW, KVRAW, CS, QF, KF, VT, u >> 5, u & 31, lds);
                        ssd_scan(ST, ATOT);
                    PH_END
                    PH_BEGIN
#pragma unroll 1
                        for (int rep = 0; rep < ((PROBE & 2) ? 2 : 1); ++rep)
#pragma unroll 1
                        for (int slot = wg; slot < 256; slot += nwg) {
                            if (slot < 128) { const int bh = slot >> 2, pr = slot & 3;
                                attn_unit(QF, KF, VT, YC, bh, 7 - pr, lds); attn_unit(QF, KF, VT, YC, bh, pr, lds); }
                            else { const int sl = slot - 128;
#pragma unroll 1
                                for (int k = 0; k < 2; ++k) { const int u = sl * 2 + k; ssd_out_grp(p, l, PROJ, XBCC, DTB, ST, YRAW, YA, u >> 5, (u >> 1) & 15, u & 1, lds); }
                                gmlp_unit(p, l, PROJ, YB, sl >> 4, sl & 15, lds); }
                        }
                    PH_END
                    PH_BEGIN
                        EpiStore e{PB, 1024, 3, nullptr}; pg8::Gemm gm{YA, WBR, 4 * TG, 4096, 512}; BranchOrder S; S.G = nwg; S.c = wg;
                        pg8::gemm_phase<EpiStore, BranchOrder>(lds, gm, S, e);
                    PH_END
                    PH_BEGIN
                        EpiMerge e{PB, MIXB, SSQ1 + (size_t)g * TG * 16}; run_gemm(lds, XNg, WGATE, TG, 4096, 1024, e);
                    PH_END
                    PH_BEGIN
                        EpiRes e{X + (size_t)g * TG * 1024, XNg, SSQ2 + (size_t)g * TG * 16, 1.0f}; run_gemm(lds, MIXB, WOUT, TG, 1024, 1024, e);
                    PH_END
                }
            }
        }
    }
}

constexpr int N_PHASES = 4 * (1 + 2 + 4 * 8 + 2);

extern "C" void kernel_launch(void* const* d_in, const int* in_sizes, int n_in, void* d_out, int out_size, void* d_ws, size_t ws_size, hipStream_t stream) {
    static int grid_blocks = 0;
    if (!grid_blocks) {
        if (n_in != 28 || ws_size < WS_NEED) { fprintf(stderr, "kernel_launch: need 28 inputs and %zu bytes of workspace (got %d, %zu)\n", (size_t)WS_NEED, n_in, ws_size); grid_blocks = -1; return; }
        if (hipFuncSetAttribute((const void*)mega, hipFuncAttributeMaxDynamicSharedMemorySize, LDS_BYTES) != hipSuccess) { fprintf(stderr, "kernel_launch: hipFuncSetAttribute failed\n"); grid_blocks = -1; return; }
        int dev = 0, cus = 0, per_cu = 0;
        hipGetDevice(&dev); hipDeviceGetAttribute(&cus, hipDeviceAttributeMultiprocessorCount, dev);
        hipOccupancyMaxActiveBlocksPerMultiprocessor(&per_cu, mega, 512, LDS_BYTES);
        if (per_cu < 1) { fprintf(stderr, "kernel_launch: occupancy query returned %d\n", per_cu); per_cu = 1; }
        (void)hipGetLastError();
        grid_blocks = cus * per_cu;
    }
    if (grid_blocks < 0) return;
    Params p{};
    for (int i = 0; i < 28; ++i) p.in[i] = (const float*)d_in[i];
    p.out = (float*)d_out; p.ws = (unsigned char*)d_ws; p.only_phase = -1; p.pad = 0;
#if MULTI_LAUNCH
    for (int ph = 0; ph < N_PHASES; ++ph) { p.only_phase = ph; hipLaunchKernelGGL(mega, dim3(grid_blocks), dim3(512), LDS_BYTES, stream, p); }
#else
    if (hipMemsetAsync((unsigned char*)d_ws + O_BAR, 0, (size_t)XCD_BAR_WORDS * 4, stream) != hipSuccess) { fprintf(stderr, "kernel_launch: memset of barrier words failed\n"); return; }
    void* args[] = {&p};
    hipError_t e = hipLaunchCooperativeKernel((void*)mega, dim3(grid_blocks), dim3(512), args, LDS_BYTES, stream);
    if (e != hipSuccess) fprintf(stderr, "cooperative launch failed: %s (grid %d)\n", hipGetErrorString(e), grid_blocks);
#endif
}
```

```cpp
#include <hip/hip_runtime.h>
#include <hip/hip_cooperative_groups.h>
#include <cstdio>
namespace cg = cooperative_groups;

#ifndef PROBE
#define PROBE 0
#endif
#define REP(bit) _Pragma("unroll 1") for (int rep_ = 0; rep_ < ((PROBE & (bit)) ? 2 : 1); ++rep_)
#ifndef MULTI_LAUNCH
#define MULTI_LAUNCH 0
#endif

__device__ __forceinline__ int tid_now() { int t = threadIdx.x; asm volatile("" : "+v"(t)); return t; }
__device__ __forceinline__ int wg_now() { int t = blockIdx.x; asm volatile("" : "+s"(t)); return t; }
__device__ __forceinline__ int nwg_now() { int t = gridDim.x; asm volatile("" : "+s"(t)); return t; }
namespace pg8 {
#define PG8_LAS __attribute__((address_space(3)))
typedef unsigned short bf16_t;
typedef short bf16x8 __attribute__((ext_vector_type(8)));
typedef float f32x4 __attribute__((ext_vector_type(4)));
typedef unsigned u32x4 __attribute__((ext_vector_type(4)));
constexpr int BM = 256, BK = 64, HALF = 128, HTB = HALF * BK * 2  , STAGE_BYTES = 8 * HTB, NXCD = 8, WGM = 8;

__host__ __device__ __forceinline__ int lds_byte(int r, int c) { const int st = (r >> 4) * 2 + (c >> 5), rr = r & 15, cc = c & 31, ob = rr * 64 + cc * 2; return st * 1024 + (ob ^ (((ob >> 9) & 1) << 5)); }
__host__ __device__ __forceinline__ void stage_rc(int b, int& R, int& C) { const int st = b / 1024, sb = b % 1024, swz = sb ^ (((sb >> 9) & 1) << 5); R = (st >> 1) * 16 + swz / 64; C = (st & 1) * 32 + (swz % 64) / 2; }
__host__ __device__ __forceinline__ int perm32(int rho) { const int n = rho >> 4, i = rho & 15; return 8 * (i >> 2) + 4 * n + (i & 3); }

struct Unit { int pm, pn; };
struct Gemm { const bf16_t* A; const bf16_t* Bt; int M, N, K; };

struct StaticOrder {
    int nM, nN, nwg, G, c;
    __host__ __device__ void init(int M, int N, int G_, int c_) { nM = M / BM; nN = N / BM; nwg = nM * nN; G = G_; c = c_; }
    __host__ __device__ bool next(int i, Unit& u) const {
        const long L = (long)i * G + c; if (L >= nwg) return false;
        int wgid = (int)L; { const int q = nwg / NXCD, r = nwg % NXCD, xcd = wgid % NXCD, off = wgid / NXCD; wgid = (xcd < r ? xcd * (q + 1) : r * (q + 1) + (xcd - r) * q) + off; }
        const int nig = WGM * nN, gid = wgid / nig, fm = gid * WGM, gsz = (nM - fm) < WGM ? (nM - fm) : WGM;
        u.pm = fm + ((wgid % nig) % gsz); u.pn = (wgid % nig) / gsz; return true;
    }
    __device__ __forceinline__ void a_ready(const Unit&) const {}
    __device__ __forceinline__ void done(const Unit&) const {}
};

template <class Epi, class Sched>
__device__ __forceinline__ void gemm_phase(PG8_LAS unsigned char* lds, const Gemm g, const Sched& S, const Epi& E) {
    const int tid = tid_now(), wid = __builtin_amdgcn_readfirstlane(tid >> 6), lane = tid & 63, wr = wid >> 2, wc = wid & 3, fr = lane & 15, fq = lane >> 4;
    const int K = g.K, nt = K / BK;
    unsigned voffA[2], voffB[2];
#pragma unroll
    for (int i = 0; i < 2; ++i) { int R, C; stage_rc(tid * 16 + i * 8192, R, C); const int Rb = Epi::PERM ? ((R & ~31) + perm32(R & 31)) : R;
        voffA[i] = (unsigned)(R * K + C) * 2u; voffB[i] = (unsigned)(Rb * K + C) * 2u; }
    const size_t kstep = (size_t)(BK * 2);
    const size_t hstep = (size_t)HALF * K * 2;
    const size_t tstep = 2 * hstep;
    const unsigned ldsw = (unsigned)wid * 1024u;
    const int aoff = lds_byte(wr * 64 + fr, fq * 8), boff = lds_byte(wc * 32 + fr, fq * 8);
#define PG8_SA(b, h) (((b) * 2 + (h)) * HTB)
#define PG8_SB(b, h) ((4 + (b) * 2 + (h)) * HTB)
#define PG8_STAGE(bufoff, gbase, voff) do { _Pragma("unroll") for (int _i = 0; _i < 2; ++_i) \
        __builtin_amdgcn_global_load_lds((const unsigned*)((const char*)(gbase) + (voff)[_i]), (PG8_LAS unsigned*)(lds + (bufoff) + ldsw + _i * 8192), 16, 0, 0); } while (0)
#define PG8_LDA(dst, b, h) do { _Pragma("unroll") for (int m = 0; m < 4; ++m) _Pragma("unroll") for (int k = 0; k < 2; ++k) dst[m][k] = *(const PG8_LAS bf16x8*)(lds + PG8_SA(b, h) + aoff + m * 2048 + k * 1024); } while (0)
#define PG8_LDB(dst, b, h) do { _Pragma("unroll") for (int n = 0; n < 2; ++n) _Pragma("unroll") for (int k = 0; k < 2; ++k) dst[n][k] = *(const PG8_LAS bf16x8*)(lds + PG8_SB(b, h) + boff + n * 2048 + k * 1024); } while (0)
#define PG8_MMA(ai, bj, At, Bt) do { __builtin_amdgcn_s_setprio(1); _Pragma("unroll") for (int m = 0; m < 4; ++m) _Pragma("unroll") for (int n = 0; n < 2; ++n) _Pragma("unroll") for (int k = 0; k < 2; ++k) \
        acc[ai][bj][m][n] = __builtin_amdgcn_mfma_f32_16x16x32_bf16(Bt[n][k], At[m][k], acc[ai][bj][m][n], 0, 0, 0); __builtin_amdgcn_s_setprio(0); } while (0)
#define PG8_WAIT_V(n) asm volatile("s_waitcnt vmcnt(" #n ")" ::: "memory")
#define PG8_WAIT_L(n) asm volatile("s_waitcnt lgkmcnt(" #n ")" ::: "memory")
#define PG8_BAR __builtin_amdgcn_s_barrier()
#define PG8_SCHED __builtin_amdgcn_sched_barrier(0)
    Unit cur, nxt; int ui = 0;
    if (!S.next(0, cur)) return;
    f32x4 acc[2][2][4][2];
#pragma unroll
    for (int a = 0; a < 2; ++a)
#pragma unroll
        for (int b = 0; b < 2; ++b)
#pragma unroll
            for (int m = 0; m < 4; ++m)
#pragma unroll
                for (int n = 0; n < 2; ++n) acc[a][b][m][n] = (f32x4){0.f, 0.f, 0.f, 0.f};
    bf16x8 At[4][2], B0[2][2], B1[2][2];
    const char* cA = (const char*)g.A + (size_t)cur.pm * tstep; const char* cB = (const char*)g.Bt + (size_t)cur.pn * tstep;
    S.a_ready(cur);
    PG8_STAGE(PG8_SB(0, 0), cB, voffB); PG8_STAGE(PG8_SA(0, 0), cA, voffA); PG8_STAGE(PG8_SB(0, 1), cB + hstep, voffB); PG8_STAGE(PG8_SA(0, 1), cA + hstep, voffA);
    if (wr == 1) PG8_BAR;
    PG8_WAIT_V(4); PG8_BAR;
    PG8_STAGE(PG8_SB(1, 0), cB + kstep, voffB); PG8_STAGE(PG8_SA(1, 0), cA + kstep, voffA); PG8_STAGE(PG8_SB(1, 1), cB + hstep + kstep, voffB);
    PG8_WAIT_V(6); PG8_BAR;
    for (;;) {
        const bool has_next = S.next(ui + 1, nxt);
        const char* nA = has_next ? (const char*)g.A + (size_t)nxt.pm * tstep : cA; const char* nB = has_next ? (const char*)g.Bt + (size_t)nxt.pn * tstep : cB;
        for (int t = 0; t < nt; t += 2) {
            const bool last = (t == nt - 2);
            const char* a1 = cA + (size_t)(t + 1) * kstep;
            const char* a2 = last ? nA : cA + (size_t)(t + 2) * kstep; const char* b2 = last ? nB : cB + (size_t)(t + 2) * kstep;
            const char* a3 = a2 + kstep; const char* b3 = b2 + kstep;
            if (last && has_next) S.a_ready(nxt);
            PG8_LDB(B0, 0, 0); PG8_SCHED; PG8_LDA(At, 0, 0); PG8_STAGE(PG8_SA(1, 1), a1 + hstep, voffA);
            PG8_WAIT_L(8); PG8_BAR; PG8_WAIT_L(0); PG8_MMA(0, 0, At, B0); PG8_BAR; PG8_SCHED;
            PG8_LDB(B1, 0, 1); PG8_STAGE(PG8_SB(0, 0), b2, voffB);
            PG8_BAR; PG8_WAIT_L(0); PG8_MMA(0, 1, At, B1); PG8_BAR;
            PG8_LDA(At, 0, 1); PG8_STAGE(PG8_SA(0, 0), a2, voffA);
            PG8_BAR; PG8_WAIT_L(0); PG8_MMA(1, 0, At, B0); PG8_BAR; PG8_SCHED;
            PG8_STAGE(PG8_SB(0, 1), b2 + hstep, voffB);
            PG8_WAIT_V(6); PG8_BAR; PG8_MMA(1, 1, At, B1); PG8_BAR;
            PG8_LDB(B0, 1, 0); PG8_SCHED; PG8_LDA(At, 1, 0); PG8_STAGE(PG8_SA(0, 1), a2 + hstep, voffA);
            PG8_WAIT_L(8); PG8_BAR; PG8_WAIT_L(0); PG8_MMA(0, 0, At, B0); PG8_BAR; PG8_SCHED;
            PG8_LDB(B1, 1, 1); PG8_STAGE(PG8_SB(1, 0), b3, voffB);
            PG8_BAR; PG8_WAIT_L(0); PG8_MMA(0, 1, At, B1); PG8_BAR;
            PG8_LDA(At, 1, 1); PG8_STAGE(PG8_SA(1, 0), a3, voffA);
            PG8_BAR; PG8_WAIT_L(0); PG8_MMA(1, 0, At, B0); PG8_BAR; PG8_SCHED;
            PG8_STAGE(PG8_SB(1, 1), b3 + hstep, voffB);
            PG8_WAIT_V(6); PG8_BAR; PG8_MMA(1, 1, At, B1); PG8_BAR;
        }
        if constexpr (!Epi::AFTER_DRAIN) { E(acc, cur, wr, wc, fr, fq); S.done(cur); }
        if (!has_next) break;
#pragma unroll
        for (int a = 0; a < 2; ++a)
#pragma unroll
            for (int b = 0; b < 2; ++b)
#pragma unroll
                for (int m = 0; m < 4; ++m)
#pragma unroll
                    for (int n = 0; n < 2; ++n) acc[a][b][m][n] = (f32x4){0.f, 0.f, 0.f, 0.f};
        cur = nxt; cA = nA; cB = nB; ++ui;
    }
    PG8_WAIT_V(0);
    if (wr == 0) PG8_BAR;
    PG8_BAR;
    if constexpr (Epi::AFTER_DRAIN) { E.fused(acc, cur, wr, wc, fr, fq, lds, wid, lane); S.done(cur); }
#undef PG8_SA
#undef PG8_SB
#undef PG8_STAGE
#undef PG8_LDA
#undef PG8_LDB
#undef PG8_MMA
#undef PG8_WAIT_V
#undef PG8_WAIT_L
#undef PG8_BAR
#undef PG8_SCHED
}
}


using pg8::bf16_t; using pg8::bf16x8; using pg8::f32x4; using pg8::u32x4;
typedef short s16x4 __attribute__((ext_vector_type(4)));
typedef float f32x2 __attribute__((ext_vector_type(2)));
typedef float f32x16 __attribute__((ext_vector_type(16)));
typedef unsigned u32x2 __attribute__((ext_vector_type(2)));
typedef __bf16 bf16v2 __attribute__((ext_vector_type(2)));
#define LAS __attribute__((address_space(3)))
#define DI __device__ __forceinline__
#define XB_TMO      128
#define XB_XCNT(j)  (256  + 64 * (j))
#define XB_XSUB(j)  (1280 + 64 * (j))
#define XB_XGEN(j)  (2304 + 64 * (j))
#define XB_TOP      3328
#define XB_TOPGEN   3392
#define XCD_BAR_WORDS 3456
#define XB_SPIN_CAP (1u << 18)

__device__ __forceinline__ unsigned xb_ld(unsigned* p)              { return __hip_atomic_load(p, __ATOMIC_RELAXED, __HIP_MEMORY_SCOPE_AGENT); }
__device__ __forceinline__ unsigned xb_add(unsigned* p, unsigned v) { return __hip_atomic_fetch_add(p, v, __ATOMIC_RELAXED, __HIP_MEMORY_SCOPE_AGENT); }
__device__ __forceinline__ unsigned xb_xcc_id() { return (unsigned)__builtin_amdgcn_s_getreg((3 << 11) | 20) & 0xFu; }
#define XB_SPIN(cond, bar) do { unsigned _sp = 0; while (cond) { __builtin_amdgcn_s_sleep(1); \
    if ((++_sp & 255u) == 0u) { if (xb_ld(&(bar)[XB_TMO])) break; if (_sp > XB_SPIN_CAP) { atomicAdd(&(bar)[XB_TMO], 1u); break; } } } } while (0)

struct XcdBarrier {
    unsigned* bar; unsigned x;
    volatile LAS unsigned* st;
};

__device__ __forceinline__ XcdBarrier xcd_barrier_post(unsigned* bar, volatile LAS unsigned* st) {
    XcdBarrier b; b.bar = bar; b.x = xb_xcc_id(); b.st = st;
    if (threadIdx.x == 0) (void)xb_add(&bar[XB_XCNT(b.x)], 1u);
    return b;
}
__device__ __forceinline__ void xcd_barrier_complete(unsigned* bar, unsigned x, unsigned& nloc, unsigned& nx) {
    const unsigned G = (unsigned)nwg_now();
    unsigned sum, cnt, mine, sp = 0u;
    for (;;) {
        sum = 0u; cnt = 0u; mine = 0u;
#pragma unroll
        for (unsigned j = 0; j < 16; ++j) { const unsigned c = xb_ld(&bar[XB_XCNT(j)]); sum += c; cnt += (c > 0u) ? 1u : 0u; mine = (j == x) ? c : mine; }
        if (sum == G) break;
        __builtin_amdgcn_s_sleep(1);
        if ((++sp & 255u) == 0u) { if (xb_ld(&bar[XB_TMO])) break; if (sp > XB_SPIN_CAP) { atomicAdd(&bar[XB_TMO], 1u); break; } }
    }
    nloc = mine > 0u ? mine : 1u; nx = cnt > 0u ? cnt : 1u;
}

__device__ __forceinline__ void xcd_barrier(const XcdBarrier& b) {
    asm volatile("s_waitcnt vmcnt(0)" ::: "memory");
    __syncthreads();
    if (tid_now() == 0) {
        unsigned* bar = b.bar; unsigned bx = b.x; asm volatile("" : "+s"(bar), "+s"(bx));
        __builtin_amdgcn_s_waitcnt(0);
        unsigned nloc = b.st[0], nx = b.st[1];
        if (nloc == 0u) { xcd_barrier_complete(bar, bx, nloc, nx); b.st[0] = nloc; b.st[1] = nx; }
        const unsigned old = xb_add(&bar[XB_XSUB(bx)], 1u);
        const unsigned gen = old / nloc;
        if (old + 1u == (gen + 1u) * nloc) {
            __builtin_amdgcn_fence(__ATOMIC_RELEASE, "agent");
            asm volatile("s_waitcnt vmcnt(0)" ::: "memory");
            const unsigned og = xb_add(&bar[XB_TOP], 1u);
            const unsigned tg = og / nx;
            if (og + 1u == (tg + 1u) * nx) xb_add(&bar[XB_TOPGEN], 1u);
            else XB_SPIN(xb_ld(&bar[XB_TOPGEN]) == tg, bar);
            __builtin_amdgcn_fence(__ATOMIC_ACQUIRE, "agent");
            xb_add(&bar[XB_XGEN(bx)], 1u);
            asm volatile("s_waitcnt vmcnt(0)" ::: "memory");
        } else {
            XB_SPIN(xb_ld(&bar[XB_XGEN(bx)]) == gen, bar);
            __builtin_amdgcn_fence(__ATOMIC_ACQUIRE, "agent");
            asm volatile("s_waitcnt vmcnt(0)" ::: "memory");
        }
    }
    __syncthreads();
}


#define MFMA32(a, b, c) __builtin_amdgcn_mfma_f32_32x32x16_bf16((a), (b), (c), 0, 0, 0)

constexpr int T_ALL = 65536, SEQ = 2048, NGRP = 4, TG = 16384, BPG = 8, PLD = 4864;
constexpr float EPS = 1e-6f;
constexpr size_t SZ_GU = (size_t)5632 * 1024 * 2, SZ_D = (size_t)1024 * 2816 * 2;
constexpr size_t O_WGU1 = 0, O_WD1 = O_WGU1 + SZ_GU, O_WGU2 = O_WD1 + SZ_D, O_WD2 = O_WGU2 + SZ_GU, O_WIN = O_WD2 + SZ_D;
constexpr size_t O_WGATE = O_WIN + (size_t)4864 * 1024 * 2, O_WBR = O_WGATE + (size_t)4096 * 1024 * 2, O_WOUT = O_WBR + (size_t)4 * 1024 * 512 * 2;
constexpr size_t O_WQB = O_WOUT + (size_t)1024 * 1024 * 2, O_WKVB = O_WQB + (size_t)768 * 384 * 2, O_XN = O_WKVB + (size_t)1024 * 256 * 2;
constexpr size_t O_R0 = O_XN + (size_t)T_ALL * 1024 * 2;
constexpr size_t O_H = O_R0;
constexpr size_t O_PROJ = O_R0, O_XBCC = O_PROJ + (size_t)TG * PLD * 2, O_DTB = O_XBCC + (size_t)TG * 1024 * 2, O_AQ = O_DTB + (size_t)TG * 16 * 4;
constexpr size_t O_AKV = O_AQ + (size_t)TG * 384 * 2, O_QRAW = O_AKV + (size_t)TG * 256 * 2, O_KVRAW = O_QRAW + (size_t)TG * 768 * 2;
constexpr size_t O_QF = O_KVRAW + (size_t)TG * 1024 * 2, O_KF = O_QF + (size_t)TG * 768 * 2, O_VT = O_KF + (size_t)TG * 768 * 2;
constexpr size_t O_YRAW = O_VT + (size_t)TG * 512 * 2, O_YA = O_YRAW + (size_t)TG * 512 * 4;
constexpr size_t O_PB = O_YA + (size_t)4 * TG * 512 * 2, O_MIXB = O_PB + (size_t)4 * TG * 1024 * 2;
constexpr size_t O_ST = O_MIXB + (size_t)TG * 1024 * 2, O_ATOT = O_ST + (size_t)BPG * 16 * 8 * 8192 * 4;
constexpr size_t O_BAR = O_ATOT + 4096;
constexpr size_t O_CS = O_BAR + (size_t)XCD_BAR_WORDS * 4 + 256 - ((size_t)XCD_BAR_WORDS * 4) % 256;
constexpr size_t O_SSQ = O_CS + (size_t)T_ALL * 32 * 8;
constexpr size_t O_END = O_SSQ + (size_t)3 * T_ALL * 16 * 4;
constexpr size_t O_END_H = O_H + (size_t)T_ALL * 2816 * 2;
constexpr size_t WS_NEED = O_END > O_END_H ? O_END : O_END_H;
constexpr int LDS_BYTES = 147456;

struct Params { const float* in[28]; float* out; unsigned char* ws; int only_phase; int pad; };

DI unsigned pk2(float a, float b) { f32x2 v = {a, b}; return __builtin_bit_cast(unsigned, __builtin_convertvector(v, bf16v2)); }
DI bf16_t f2bf(float a) { return (bf16_t)(pk2(a, 0.f) & 0xffffu); }
DI float bf2f(bf16_t b) { return __uint_as_float(((unsigned)b) << 16); }
DI float bflo(unsigned u) { return __uint_as_float(u << 16); }
DI float bfhi(unsigned u) { return __uint_as_float(u & 0xffff0000u); }
#define UNPACK8(v, f) do { f[0] = bflo(v.x); f[1] = bfhi(v.x); f[2] = bflo(v.y); f[3] = bfhi(v.y); f[4] = bflo(v.z); f[5] = bfhi(v.z); f[6] = bflo(v.w); f[7] = bfhi(v.w); } while (0)
#define PACK8(f) ((u32x4){pk2(f[0], f[1]), pk2(f[2], f[3]), pk2(f[4], f[5]), pk2(f[6], f[7])})
DI float wave_sum(float v) {
#pragma unroll
    for (int o = 1; o < 64; o <<= 1) v += __shfl_xor(v, o);
    return v;
}
DI float silu_f(float x) { return x * __builtin_amdgcn_rcpf(1.f + __builtin_amdgcn_exp2f(-1.4426950408889634f * x)); }
DI float sigmoid_f(float x) { return __builtin_amdgcn_rcpf(1.f + __builtin_amdgcn_exp2f(-1.4426950408889634f * x)); }
DI float gelu_f(float x) { return 0.5f * x * (1.f + erff(x * 0.70710678118654752f)); }
DI int crow(int i, int h) { return (i & 3) + 8 * (i >> 2) + 4 * h; }
DI void rows_rstd(const float* ssq, int row0, int fq, float (&rs)[2][4]) {
    f32x4 q[2][4];
#pragma unroll
    for (int ai = 0; ai < 2; ++ai)
#pragma unroll
        for (int m = 0; m < 4; ++m) q[ai][m] = ((const f32x4*)(ssq + (size_t)(row0 + ai * 128 + m * 16) * 16))[fq];
#pragma unroll
    for (int ai = 0; ai < 2; ++ai)
#pragma unroll
        for (int m = 0; m < 4; ++m) { float t = (q[ai][m][0] + q[ai][m][1]) + (q[ai][m][2] + q[ai][m][3]); t += __shfl_xor(t, 16); t += __shfl_xor(t, 32);
            rs[ai][m] = rsqrtf(t * (1.f / 1024.f) + EPS); }
}
struct EpiStore {
    static constexpr bool PERM = true, AFTER_DRAIN = false;
    bf16_t* O; int ldc; int pnmask; const float* ssq;
    DI void operator()(const f32x4 (&acc)[2][2][4][2], const pg8::Unit& u, int wr, int wc, int fr, int fq) const {
        const int row0 = u.pm * 256 + wr * 64 + fr, col0 = (u.pn & pnmask) * 256 + wc * 32 + 8 * fq;
        float rsv[2][4];
        if (ssq) rows_rstd(ssq, row0, fq, rsv);
        else {
#pragma unroll
            for (int ai = 0; ai < 2; ++ai)
#pragma unroll
                for (int m = 0; m < 4; ++m) rsv[ai][m] = 1.f; }
#pragma unroll
        for (int ai = 0; ai < 2; ++ai)
#pragma unroll
            for (int m = 0; m < 4; ++m) { bf16_t* rowp = O + (size_t)(row0 + ai * 128 + m * 16) * ldc + col0;
                const float rs = rsv[ai][m];
#pragma unroll
                for (int bj = 0; bj < 2; ++bj) { const f32x4 v0 = acc[ai][bj][m][0] * rs, v1 = acc[ai][bj][m][1] * rs;
                    u32x4 w; w.x = pk2(v0[0], v0[1]); w.y = pk2(v0[2], v0[3]); w.z = pk2(v1[0], v1[1]); w.w = pk2(v1[2], v1[3]);
                    *(u32x4*)(rowp + bj * 128) = w; } }
    }
};
struct EpiGU {
    static constexpr bool PERM = true, AFTER_DRAIN = false;
    bf16_t* H; const float* ssq;
    DI void operator()(const f32x4 (&acc)[2][2][4][2], const pg8::Unit& u, int wr, int wc, int fr, int fq) const {
        const int row0 = u.pm * 256 + wr * 64 + fr, col0 = u.pn * 128 + wc * 32 + 8 * fq;
        float rsv[2][4]; rows_rstd(ssq, row0, fq, rsv);
#pragma unroll
        for (int ai = 0; ai < 2; ++ai)
#pragma unroll
            for (int m = 0; m < 4; ++m) { bf16_t* rowp = H + (size_t)(row0 + ai * 128 + m * 16) * 2816 + col0;
                const float rs = rsv[ai][m];
                float o[8];
#pragma unroll
                for (int n = 0; n < 2; ++n)
#pragma unroll
                    for (int j = 0; j < 4; ++j) o[4 * n + j] = silu_f(acc[ai][0][m][n][j] * rs) * (acc[ai][1][m][n][j] * rs);
                *(u32x4*)rowp = PACK8(o); }
    }
};
struct EpiRes {
    static constexpr bool PERM = false, AFTER_DRAIN = false;
    bf16_t* XB; float* SSQ; float* OUT; float sc;
    DI void operator()(const f32x4 (&acc)[2][2][4][2], const pg8::Unit& u, int wr, int wc, int fr, int fq) const {
        const int row0 = u.pm * 256 + wr * 64 + fr, col0 = u.pn * 256 + wc * 32 + 4 * fq;
#pragma unroll
        for (int ai = 0; ai < 2; ++ai) {
            u32x2 xv[4][2][2];
#pragma unroll
            for (int m = 0; m < 4; ++m)
#pragma unroll
                for (int bj = 0; bj < 2; ++bj)
#pragma unroll
                    for (int n = 0; n < 2; ++n) xv[m][bj][n] = *(const u32x2*)(XB + (size_t)(row0 + ai * 128 + m * 16) * 1024 + col0 + bj * 128 + n * 16);
#pragma unroll
            for (int m = 0; m < 4; ++m) { const int row = row0 + ai * 128 + m * 16; const size_t ro = (size_t)row * 1024 + col0;
                float ss = 0.f;
#pragma unroll
                for (int bj = 0; bj < 2; ++bj)
#pragma unroll
                    for (int n = 0; n < 2; ++n) { const u32x2 xo = xv[m][bj][n]; const f32x4 a = acc[ai][bj][m][n];
                        const f32x4 v = {bflo(xo.x) + a[0] * sc, bfhi(xo.x) + a[1] * sc, bflo(xo.y) + a[2] * sc, bfhi(xo.y) + a[3] * sc};
                        if (OUT) *(f32x4*)(OUT + ro + bj * 128 + n * 16) = v;
                        else *(u32x2*)(XB + ro + bj * 128 + n * 16) = (u32x2){pk2(v[0], v[1]), pk2(v[2], v[3])};
                        ss += v[0] * v[0] + v[1] * v[1] + v[2] * v[2] + v[3] * v[3]; }
                ss += __shfl_xor(ss, 16); ss += __shfl_xor(ss, 32);
                if (fq == 0) SSQ[(size_t)row * 16 + u.pn * 4 + wc] = ss; }
        }
    }
};
struct EpiMerge {
    static constexpr bool PERM = false, AFTER_DRAIN = false;
    const bf16_t* P; bf16_t* MIX; const float* ssq;
    DI void operator()(const f32x4 (&acc)[2][2][4][2], const pg8::Unit& u, int wr, int wc, int fr, int fq) const {
        const int row0 = u.pm * 256 + wr * 64 + fr, e0 = u.pn * 64 + wc * 16 + 4 * fq;
        float rsv[2][4]; rows_rstd(ssq, row0, fq, rsv);
#pragma unroll
        for (int ai = 0; ai < 2; ++ai) {
            u32x2 pv[4][4];
#pragma unroll
            for (int m = 0; m < 4; ++m)
#pragma unroll
                for (int b = 0; b < 4; ++b) pv[m][b] = *(const u32x2*)(P + (size_t)b * TG * 1024 + (size_t)(row0 + ai * 128 + m * 16) * 1024 + e0);
#pragma unroll
            for (int m = 0; m < 4; ++m) { const float rs = rsv[ai][m];
                float o[4] = {0.f, 0.f, 0.f, 0.f};
#pragma unroll
                for (int bj = 0; bj < 2; ++bj)
#pragma unroll
                    for (int n = 0; n < 2; ++n) { const u32x2 q = pv[m][2 * bj + n]; const f32x4 g = acc[ai][bj][m][n] * rs;
                        o[0] += sigmoid_f(g[0]) * bflo(q.x); o[1] += sigmoid_f(g[1]) * bfhi(q.x); o[2] += sigmoid_f(g[2]) * bflo(q.y); o[3] += sigmoid_f(g[3]) * bfhi(q.y); }
                *(u32x2*)(MIX + (size_t)(row0 + ai * 128 + m * 16) * 1024 + e0) = (u32x2){pk2(o[0], o[1]), pk2(o[2], o[3])}; }
        }
    }
};
struct BranchOrder {
    int G, c;
    DI bool next(int i, pg8::Unit& u) const { const int L = i * G + c; if (L >= 1024) return false; const int br = L >> 8, rem = L & 255; u.pm = br * 64 + (rem >> 2); u.pn = br * 4 + (rem & 3); return true; }
    DI void a_ready(const pg8::Unit&) const {}
    DI void done(const pg8::Unit&) const {}
};
template <class Epi> DI void run_gemm(LAS unsigned char* lds, const bf16_t* A, const bf16_t* Bt, int M, int N, int K, const Epi& E) {
    pg8::Gemm g{A, Bt, M, N, K}; pg8::StaticOrder S; S.init(M, N, nwg_now(), wg_now());
    pg8::gemm_phase<Epi, pg8::StaticOrder>(lds, g, S, E);
}

DI void conv_mat(const float* src, int ld, int c0, int nvalid, int kvalid, int mode, bf16_t* dst, int Nd, int Kd, LAS float* scr, int wg, int nwg, const float* ksc = nullptr) {
    const int tid = tid_now(); const int ntk = Kd >> 6, ntiles = (Nd >> 6) * ntk;
    for (int tile = wg; tile < ntiles; tile += nwg) {
        const int n0 = (tile / ntk) << 6, k0 = (tile % ntk) << 6;
        const int nn = tid & 63, kq = tid >> 6, n = n0 + nn;
        int col;
        if (mode == 1) { const int blk = n >> 7; col = ((blk & 1) ? 2816 : 0) + (blk >> 1) * 128 + (n & 127); }
        else if (mode == 2) { const int c = n & 255, br = 2 * (c >> 7) + ((c >> 4) & 1), e = 64 * (n >> 8) + 16 * ((c >> 5) & 3) + (c & 15); col = c0 + br * 1024 + e; }
        else col = c0 + n;
#pragma unroll
        for (int i = 0; i < 8; ++i) { const int kk = i * 8 + kq; float v = 0.f;
            if (k0 + kk < kvalid && n < nvalid) { v = src[(size_t)(k0 + kk) * ld + col]; if (ksc) v *= ksc[k0 + kk]; }
            scr[kk * 65 + nn] = v; }
        __syncthreads();
        { const int nr = tid >> 3, kc = tid & 7; const LAS float* sp = scr + (kc * 8) * 65 + nr;
          u32x4 o; o.x = pk2(sp[0], sp[65]); o.y = pk2(sp[130], sp[195]); o.z = pk2(sp[260], sp[325]); o.w = pk2(sp[390], sp[455]);
          *(u32x4*)(dst + (size_t)(n0 + nr) * Kd + k0 + kc * 8) = o; }
        __syncthreads();
    }
}
DI void convert_layer(const Params& p, int l, LAS float* scr, int wg, int nwg) {
    unsigned char* ws = p.ws;
    conv_mat(p.in[3] + (size_t)l * 1024 * 5632, 5632, 0, 5632, 1024, 1, (bf16_t*)(ws + O_WGU1), 5632, 1024, scr, wg, nwg, p.in[2] + l * 1024);
    conv_mat(p.in[26] + (size_t)l * 1024 * 5632, 5632, 0, 5632, 1024, 1, (bf16_t*)(ws + O_WGU2), 5632, 1024, scr, wg, nwg, p.in[25] + l * 1024);
    conv_mat(p.in[4] + (size_t)l * 2816 * 1024, 1024, 0, 1024, 2816, 0, (bf16_t*)(ws + O_WD1), 1024, 2816, scr, wg, nwg);
    conv_mat(p.in[27] + (size_t)l * 2816 * 1024, 1024, 0, 1024, 2816, 0, (bf16_t*)(ws + O_WD2), 1024, 2816, scr, wg, nwg);
    conv_mat(p.in[6] + (size_t)l * 1024 * 8776, 8776, 0, 4680, 1024, 0, (bf16_t*)(ws + O_WIN), 4864, 1024, scr, wg, nwg, p.in[5] + l * 1024);
    conv_mat(p.in[6] + (size_t)l * 1024 * 8776, 8776, 4680, 4096, 1024, 2, (bf16_t*)(ws + O_WGATE), 4096, 1024, scr, wg, nwg, p.in[5] + l * 1024);
#pragma unroll 1
    for (int i = 0; i < 4; ++i)
        conv_mat(p.in[23] + ((size_t)l * 4 + i) * 512 * 1024, 1024, 0, 1024, 512, 0, (bf16_t*)(ws + O_WBR) + (size_t)i * 1024 * 512, 1024, 512, scr, wg, nwg);
    conv_mat(p.in[24] + (size_t)l * 1024 * 1024, 1024, 0, 1024, 1024, 0, (bf16_t*)(ws + O_WOUT), 1024, 1024, scr, wg, nwg);
    conv_mat(p.in[17] + (size_t)l * 384 * 768, 768, 0, 768, 384, 0, (bf16_t*)(ws + O_WQB), 768, 384, scr, wg, nwg);
    conv_mat(p.in[19] + (size_t)l * 128 * 1024, 1024, 0, 1024, 128, 0, (bf16_t*)(ws + O_WKVB), 1024, 256, scr, wg, nwg);
}

DI void init_rows(const float* x, bf16_t* xb, float* ssq) {
    const int tidn = tid_now(); const int lane = tidn & 63, gwave = wg_now() * 8 + (tidn >> 6), ngw = nwg_now() * 8;
    for (int row = gwave; row < T_ALL; row += ngw) {
        const f32x4* xr = (const f32x4*)(x + (size_t)row * 1024);
        f32x4 v[4]; float ss = 0.f;
#pragma unroll
        for (int j = 0; j < 4; ++j) { v[j] = xr[lane + 64 * j]; ss += v[j][0] * v[j][0] + v[j][1] * v[j][1] + v[j][2] * v[j][2] + v[j][3] * v[j][3]; }
        ss = wave_sum(ss);
        u32x2* o = (u32x2*)(xb + (size_t)row * 1024);
#pragma unroll
        for (int j = 0; j < 4; ++j) o[lane + 64 * j] = (u32x2){pk2(v[j][0], v[j][1]), pk2(v[j][2], v[j][3])};
        if (lane < 16) ssq[(size_t)row * 16 + lane] = lane == 0 ? ss : 0.f;
    }
}
DI void zero_f32(float* q, int n) { const int tidn = tid_now(); for (int i = wg_now() * 512 + tidn; i < n; i += nwg_now() * 512) q[i] = 0.f; }

DI void prep1(const Params& p, int l, const bf16_t* proj, bf16_t* xbcc, float* dtb, bf16_t* aq, bf16_t* akv, bf16_t* yd) {
    const int tidn = tid_now(); const int gtid = wg_now() * 512 + tidn, gthreads = nwg_now() * 512;
    const float* cw = p.in[7] + l * 4096; const float* cb = p.in[8] + l * 1024;
    for (int idx = gtid; idx < (TG / 16) * 128; idx += gthreads) {
        const int c8 = (idx & 127) << 3, tl0 = (idx >> 7) << 4, s0 = tl0 & 2047;
        float w[4][8], bb[8], r0[8], r1[8], r2[8];
#pragma unroll
        for (int k = 0; k < 4; ++k) { const f32x4 a = *(const f32x4*)(cw + k * 1024 + c8), b = *(const f32x4*)(cw + k * 1024 + c8 + 4);
#pragma unroll
            for (int j = 0; j < 4; ++j) { w[k][j] = a[j]; w[k][4 + j] = b[j]; } }
        { const f32x4 a = *(const f32x4*)(cb + c8), b = *(const f32x4*)(cb + c8 + 4);
#pragma unroll
          for (int j = 0; j < 4; ++j) { bb[j] = a[j]; bb[4 + j] = b[j]; } }
        const bf16_t* src = proj + (size_t)tl0 * PLD + 512 + c8;
        if (s0 > 0) { const u32x4 v0 = *(const u32x4*)(src - 3 * PLD), v1 = *(const u32x4*)(src - 2 * PLD), v2 = *(const u32x4*)(src - PLD); UNPACK8(v0, r0); UNPACK8(v1, r1); UNPACK8(v2, r2); }
        else {
#pragma unroll
            for (int j = 0; j < 8; ++j) { r0[j] = 0.f; r1[j] = 0.f; r2[j] = 0.f; } }
#pragma unroll 4
        for (int tt = 0; tt < 16; ++tt) {
            const u32x4 v = *(const u32x4*)(src + (size_t)tt * PLD); float cur[8], o[8]; UNPACK8(v, cur);
#pragma unroll
            for (int j = 0; j < 8; ++j) { o[j] = silu_f(bb[j] + w[0][j] * r0[j] + w[1][j] * r1[j] + w[2][j] * r2[j] + w[3][j] * cur[j]); r0[j] = r1[j]; r1[j] = r2[j]; r2[j] = cur[j]; }
            *(u32x4*)(xbcc + (size_t)(tl0 + tt) * 1024 + c8) = PACK8(o);
        }
    }
    const float* sw = p.in[22] + l * 1536;
    for (int idx = gtid; idx < (TG / 16) * 64; idx += gthreads) {
        const int c8 = (idx & 63) << 3, tl0 = (idx >> 6) << 4, s0 = tl0 & 2047;
        float w[3][8], p1[8], p2[8];
#pragma unroll
        for (int k = 0; k < 3; ++k) { const f32x4 a = *(const f32x4*)(sw + k * 512 + c8), b = *(const f32x4*)(sw + k * 512 + c8 + 4);
#pragma unroll
            for (int j = 0; j < 4; ++j) { w[k][j] = a[j]; w[k][4 + j] = b[j]; } }
        const bf16_t* src = proj + (size_t)tl0 * PLD + c8;
        if (s0 > 0) { const u32x4 c1 = *(const u32x4*)(src - 2 * PLD + 3656), x1 = *(const u32x4*)(src - 2 * PLD + 4168), c2 = *(const u32x4*)(src - PLD + 3656), x2 = *(const u32x4*)(src - PLD + 4168);
            float a[8], b[8]; UNPACK8(c1, a); UNPACK8(x1, b);
#pragma unroll
            for (int j = 0; j < 8; ++j) p1[j] = a[j] * b[j];
            UNPACK8(c2, a); UNPACK8(x2, b);
#pragma unroll
            for (int j = 0; j < 8; ++j) p2[j] = a[j] * b[j]; }
        else {
#pragma unroll
            for (int j = 0; j < 8; ++j) { p1[j] = 0.f; p2[j] = 0.f; } }
#pragma unroll 4
        for (int tt = 0; tt < 16; ++tt) {
            const bf16_t* pr = src + (size_t)tt * PLD;
            const u32x4 vc = *(const u32x4*)(pr + 3656), vx = *(const u32x4*)(pr + 4168), vb = *(const u32x4*)(pr + 3144);
            float fc[8], fx[8], fb[8], o[8]; UNPACK8(vc, fc); UNPACK8(vx, fx); UNPACK8(vb, fb);
#pragma unroll
            for (int j = 0; j < 8; ++j) { const float cur = fc[j] * fx[j]; o[j] = fb[j] * (w[0][j] * p1[j] + w[1][j] * p2[j] + w[2][j] * cur); p1[j] = p2[j]; p2[j] = cur; }
            *(u32x4*)(yd + (size_t)(tl0 + tt) * 512 + c8) = PACK8(o);
        }
    }
    const int gwave = gtid >> 6, ngw = gthreads >> 6, lane = tidn & 63;
    const float* qn = p.in[16] + l * 384; const float* kn = p.in[18] + l * 128;
    for (int tl = gwave; tl < TG; tl += ngw) {
        const bf16_t* pr = proj + (size_t)tl * PLD;
        const u32x4 v = *(const u32x4*)(pr + 2568 + lane * 8); float f[8]; UNPACK8(v, f);
        float ss = 0.f;
#pragma unroll
        for (int j = 0; j < 8; ++j) ss += f[j] * f[j];
        const float ssq = wave_sum(lane < 48 ? ss : 0.f), ssk = wave_sum(lane >= 48 ? ss : 0.f);
        if (lane < 48) {
            const float rstd = rsqrtf(ssq * (1.f / 384.f) + EPS);
#pragma unroll
            for (int j = 0; j < 8; ++j) f[j] *= rstd * qn[lane * 8 + j];
            *(u32x4*)(aq + (size_t)tl * 384 + lane * 8) = PACK8(f);
        } else {
            const float rstd = rsqrtf(ssk * (1.f / 128.f) + EPS);
#pragma unroll
            for (int j = 0; j < 8; ++j) f[j] *= rstd * kn[(lane - 48) * 8 + j];
            *(u32x4*)(akv + (size_t)tl * 256 + (lane - 48) * 8) = PACK8(f);
            *(u32x4*)(akv + (size_t)tl * 256 + 128 + (lane - 48) * 8) = (u32x4){0u, 0u, 0u, 0u};
        }
        if (lane < 8) {
            const float xr = bf2f(pr[1536 + lane]) + p.in[9][l * 8 + lane];
            const float dt = xr > 20.f ? xr : log1pf(expf(xr));
            const float A = -expf(p.in[10][l * 8 + lane]);
            dtb[(size_t)tl * 16 + lane] = dt; dtb[(size_t)tl * 16 + 8 + lane] = dt * A;
        }
    }
}

DI void rope_table(const Params& p, f32x2* CS) {
    const int* pos = (const int*)p.in[1];
    const int tidn = tid_now();
    for (int idx = wg_now() * 512 + tidn; idx < T_ALL * 32; idx += nwg_now() * 512) {
        const float invf = exp2f(-(float)(idx & 31) * (13.287712379549449f / 32.f));
        const float ang = (float)pos[idx >> 5] * invf;
        CS[idx] = (f32x2){cosf(ang), sinf(ang)};
    }
}
DI void prep2_unit(const Params& p, int l, int g, const bf16_t* proj, const bf16_t* qraw, const bf16_t* kvraw, const f32x2* CS, bf16_t* Qf, bf16_t* Kf, bf16_t* Vt, int bl, int tile, LAS unsigned char* lds) {
    const int tid = tid_now(), wave = tid >> 6, lane = tid & 63;
    const float* wq = p.in[20] + l * 192; const float* wk = p.in[21] + l * 192;
    const float qscale = 0.07216878364870322f * 1.4426950408889634f;
    const float wq0 = wq[lane], wq1 = wq[64 + lane], wq2 = wq[128 + lane], wk0 = wk[lane], wk1 = wk[64 + lane], wk2 = wk[128 + lane];
    LAS bf16_t* img = (LAS bf16_t*)lds;
    const int t0 = tile * 64;
#pragma unroll 1
    for (int tt = 0; tt < 8; ++tt) {
        const int tloc = wave * 8 + tt, s = t0 + tloc; const size_t tl = (size_t)bl * SEQ + s;
        const f32x2 cssn = CS[((size_t)(g * BPG + bl) * SEQ + s) * 32 + (lane & 31)];
        const float cs = cssn[0], sn = cssn[1];
        const float kpe = bf2f(proj[tl * PLD + 3080 + lane]);
#pragma unroll
        for (int h = 0; h < 4; ++h) {
            const size_t ob = ((size_t)(bl * 4 + h) * SEQ + s) * 192;
            {
                const bf16_t* qr = qraw + tl * 768 + h * 192;
                float q0 = bf2f(qr[lane]), q1 = bf2f(qr[64 + lane]), q2 = bf2f(qr[128 + lane]);
                const float r = rsqrtf(wave_sum(q0 * q0 + q1 * q1 + q2 * q2) * (1.f / 192.f) + EPS);
                q0 *= r * wq0; q1 *= r * wq1; q2 *= r * wq2;
                const float qp = __shfl_xor(q2, 32);
                q2 = (lane < 32) ? q2 * cs - qp * sn : q2 * cs + qp * sn;
                bf16_t* qo = Qf + ob;
                qo[lane] = f2bf(q0 * qscale); qo[64 + lane] = f2bf(q1 * qscale); qo[128 + lane] = f2bf(q2 * qscale);
            }
            const bf16_t* kr = kvraw + tl * 1024 + h * 256;
            {
                float k0 = bf2f(kr[lane]), k1 = bf2f(kr[64 + lane]), k2 = kpe;
                const float r = rsqrtf(wave_sum(k0 * k0 + k1 * k1 + k2 * k2) * (1.f / 192.f) + EPS);
                k0 *= r * wk0; k1 *= r * wk1; k2 *= r * wk2;
                const float kp = __shfl_xor(k2, 32);
                k2 = (lane < 32) ? k2 * cs - kp * sn : k2 * cs + kp * sn;
                bf16_t* ko = Kf + ob;
                ko[lane] = f2bf(k0); ko[64 + lane] = f2bf(k1); ko[128 + lane] = f2bf(k2);
            }
            img[(h * 128 + lane) * 72 + tloc] = kr[128 + lane]; img[(h * 128 + 64 + lane) * 72 + tloc] = kr[192 + lane];
        }
    }
    __syncthreads();
#pragma unroll
    for (int i = 0; i < 8; ++i) {
        const int ch = tid + 512 * i, row = ch >> 3, cc = ch & 7;
        *(u32x4*)(Vt + ((size_t)(bl * 4 + (row >> 7)) * 128 + (row & 127)) * SEQ + t0 + cc * 8) = *(const LAS u32x4*)(lds + row * 144 + cc * 16);
    }
    __syncthreads();
}

constexpr int KP = 400, VP = 136, KBYTES = 64 * KP, VBYTES = 128 * VP, ASTAGE = KBYTES + VBYTES;
DI void attn_unit(const bf16_t* Qf, const bf16_t* Kf, const bf16_t* Vt, bf16_t* yc, int bh, int qb, LAS unsigned char* lds) {
    const int tid = tid_now(), wave = tid >> 6, lane = tid & 63, r31 = lane & 31, hh = lane >> 5;
    const int q0 = qb * 256, qrow = q0 + wave * 32 + r31;
    const bf16_t* Qp = Qf + ((size_t)bh * SEQ + qrow) * 192 + 8 * hh;
    bf16x8 qf[12];
#pragma unroll
    for (int kk = 0; kk < 12; ++kk) qf[kk] = *(const bf16x8*)(Qp + kk * 16);
    f32x16 o[4];
#pragma unroll
    for (int d = 0; d < 4; ++d)
#pragma unroll
        for (int i = 0; i < 16; ++i) o[d][i] = 0.f;
    float m = -1e30f, l = 0.f;
    const int ntiles = qb * 4 + 4;
    const bf16_t* Kb = Kf + (size_t)bh * SEQ * 192; const bf16_t* Vb = Vt + (size_t)bh * 128 * SEQ;
    int krow[3], kcc[3], vd[2], vcc[2];
#pragma unroll
    for (int i = 0; i < 3; ++i) { const int c = tid + 512 * i; krow[i] = c / 24; kcc[i] = c % 24; }
#pragma unroll
    for (int i = 0; i < 2; ++i) { const int c = tid + 512 * i; vd[i] = c >> 3; vcc[i] = c & 7; }
    u32x4 kreg[3], vreg[2];
#define ATT_GLOAD(j) do { _Pragma("unroll") for (int i = 0; i < 3; ++i) kreg[i] = *(const u32x4*)(Kb + (size_t)((j) * 64 + krow[i]) * 192 + kcc[i] * 8); \
        _Pragma("unroll") for (int i = 0; i < 2; ++i) vreg[i] = *(const u32x4*)(Vb + (size_t)vd[i] * SEQ + (j) * 64 + vcc[i] * 8); } while (0)
#define ATT_LSTORE(st) do { LAS unsigned char* b_ = lds + (st) * ASTAGE; \
        _Pragma("unroll") for (int i = 0; i < 3; ++i) *(LAS u32x4*)(b_ + krow[i] * KP + kcc[i] * 16) = kreg[i]; \
        _Pragma("unroll") for (int i = 0; i < 2; ++i) { LAS u32x2* d_ = (LAS u32x2*)(b_ + KBYTES + vd[i] * VP + vcc[i] * 16); d_[0] = (u32x2){vreg[i].x, vreg[i].y}; d_[1] = (u32x2){vreg[i].z, vreg[i].w}; } } while (0)
    ATT_GLOAD(0); ATT_LSTORE(0);
    __syncthreads();
    for (int j = 0; j < ntiles; ++j) {
        const int cur = j & 1;
        if (j + 1 < ntiles) ATT_GLOAD(j + 1);
        if (j * 64 <= q0 + wave * 32 + 31) {
            const LAS unsigned char* Kl = lds + cur * ASTAGE; const LAS unsigned char* Vl = Kl + KBYTES;
            f32x16 s0, s1;
#pragma unroll
            for (int i = 0; i < 16; ++i) { s0[i] = 0.f; s1[i] = 0.f; }
#pragma unroll
            for (int kk = 0; kk < 12; ++kk) {
                const bf16x8 a0 = *(const LAS bf16x8*)(Kl + r31 * KP + (kk * 16 + 8 * hh) * 2);
                const bf16x8 a1 = *(const LAS bf16x8*)(Kl + (32 + r31) * KP + (kk * 16 + 8 * hh) * 2);
                s0 = MFMA32(a0, qf[kk], s0); s1 = MFMA32(a1, qf[kk], s1);
            }
            if (j * 64 + 63 > q0 + wave * 32) {
#pragma unroll
                for (int i = 0; i < 16; ++i) { const int key = j * 64 + crow(i, hh); if (key > qrow) s0[i] = -1e30f; if (key + 32 > qrow) s1[i] = -1e30f; }
            }
            float mx = s0[0];
#pragma unroll
            for (int i = 1; i < 16; ++i) mx = fmaxf(mx, s0[i]);
#pragma unroll
            for (int i = 0; i < 16; ++i) mx = fmaxf(mx, s1[i]);
            mx = fmaxf(mx, __shfl_xor(mx, 32));
            const float mn = fmaxf(m, mx), alpha = __builtin_amdgcn_exp2f(m - mn);
            m = mn;
            float ls = 0.f;
#pragma unroll
            for (int i = 0; i < 16; ++i) { s0[i] = __builtin_amdgcn_exp2f(s0[i] - mn); s1[i] = __builtin_amdgcn_exp2f(s1[i] - mn); ls += s0[i] + s1[i]; }
            l = l * alpha + ls;
#pragma unroll
            for (int d = 0; d < 4; ++d)
#pragma unroll
                for (int i = 0; i < 16; ++i) o[d][i] *= alpha;
            bf16x8 pf[2][2];
#pragma unroll
            for (int s = 0; s < 2; ++s) {
                u32x4 w0, w1;
                w0.x = pk2(s0[8 * s], s0[8 * s + 1]); w0.y = pk2(s0[8 * s + 2], s0[8 * s + 3]); w0.z = pk2(s0[8 * s + 4], s0[8 * s + 5]); w0.w = pk2(s0[8 * s + 6], s0[8 * s + 7]);
                w1.x = pk2(s1[8 * s], s1[8 * s + 1]); w1.y = pk2(s1[8 * s + 2], s1[8 * s + 3]); w1.z = pk2(s1[8 * s + 4], s1[8 * s + 5]); w1.w = pk2(s1[8 * s + 6], s1[8 * s + 7]);
                pf[0][s] = __builtin_bit_cast(bf16x8, w0); pf[1][s] = __builtin_bit_cast(bf16x8, w1);
            }
#pragma unroll
            for (int d = 0; d < 4; ++d)
#pragma unroll
                for (int kb = 0; kb < 2; ++kb)
#pragma unroll
                    for (int s = 0; s < 2; ++s) {
                        const LAS unsigned char* vp = Vl + (d * 32 + r31) * VP + (kb * 32 + 16 * s + 4 * hh) * 2;
                        const s16x4 lo = *(const LAS s16x4*)vp, hi = *(const LAS s16x4*)(vp + 16);
                        const bf16x8 a = __builtin_shufflevector(lo, hi, 0, 1, 2, 3, 4, 5, 6, 7);
                        o[d] = MFMA32(a, pf[kb][s], o[d]);
                    }
        }
        if (j + 1 < ntiles) ATT_LSTORE(cur ^ 1);
        __syncthreads();
    }
#undef ATT_GLOAD
#undef ATT_LSTORE
    l += __shfl_xor(l, 32);
    const float inv = 1.f / l;
    const int bl = bh >> 2, h = bh & 3;
    bf16_t* op = yc + ((size_t)bl * SEQ + qrow) * 512 + h * 128 + 4 * hh;
#pragma unroll
    for (int d = 0; d < 4; ++d)
#pragma unroll
        for (int i4 = 0; i4 < 4; ++i4)
            *(u32x2*)(op + d * 32 + 8 * i4) = (u32x2){pk2(o[d][4 * i4] * inv, o[d][4 * i4 + 1] * inv), pk2(o[d][4 * i4 + 2] * inv, o[d][4 * i4 + 3] * inv)};
}

DI void gmlp_unit(const Params& p, int l, const bf16_t* proj, bf16_t* yb, int bl, int c, LAS unsigned char* lds) {
    const int tid = tid_now(), wave = tid >> 6, lane = tid & 63, r31 = lane & 31, hh = lane >> 5;
    const float* wsp = p.in[14] + (size_t)l * 4 * 128 * 128; const float* bs = p.in[15] + l * 512; const float* vn = p.in[13] + l * 512;
    const size_t tl0 = (size_t)bl * SEQ + c * 128;
    float w8[8];
#pragma unroll
    for (int j = 0; j < 8; ++j) w8[j] = vn[lane + 64 * j];
    LAS bf16_t* vt = (LAS bf16_t*)lds;
#pragma unroll 2
    for (int rr = 0; rr < 16; ++rr) {
        const int row = wave * 16 + rr;
        const bf16_t* vr = proj + (tl0 + row) * PLD + 2056 + lane;
        float f[8]; float ss = 0.f;
#pragma unroll
        for (int j = 0; j < 8; ++j) { f[j] = gelu_f(bf2f(vr[64 * j])); ss += f[j] * f[j]; }
        const float rstd = rsqrtf(wave_sum(ss) * (1.f / 512.f) + EPS);
#pragma unroll
        for (int j = 0; j < 8; ++j) vt[(lane + 64 * j) * 136 + row] = f2bf(f[j] * rstd * w8[j]);
    }
    __syncthreads();
    const int mb = wave & 3, nh = wave >> 2, trow = mb * 32 + r31;
#pragma unroll 1
    for (int g = 0; g < 4; ++g) {
        f32x16 a0, a1;
#pragma unroll
        for (int i = 0; i < 16; ++i) { a0[i] = 0.f; a1[i] = 0.f; }
        const float* wrow = wsp + ((size_t)g * 128 + trow) * 128 + 8 * hh;
#pragma unroll
        for (int kk = 0; kk < 8; ++kk) if (kk * 16 <= mb * 32 + 31) {
            const f32x4 x0 = *(const f32x4*)(wrow + kk * 16), x1 = *(const f32x4*)(wrow + kk * 16 + 4);
            const int sb = kk * 16 + 8 * hh;
            float f[8];
#pragma unroll
            for (int j = 0; j < 4; ++j) { f[j] = (sb + j <= trow) ? x0[j] : 0.f; f[4 + j] = (sb + 4 + j <= trow) ? x1[j] : 0.f; }
            const bf16x8 a = __builtin_bit_cast(bf16x8, PACK8(f));
            const bf16x8 b0 = *(const LAS bf16x8*)(vt + (g * 128 + nh * 64 + r31) * 136 + kk * 16 + 8 * hh);
            const bf16x8 b1 = *(const LAS bf16x8*)(vt + (g * 128 + nh * 64 + 32 + r31) * 136 + kk * 16 + 8 * hh);
            a0 = MFMA32(a, b0, a0); a1 = MFMA32(a, b1, a1);
        }
#pragma unroll
        for (int i = 0; i < 16; ++i) {
            const int t = mb * 32 + crow(i, hh); const float bias = bs[g * 128 + t];
            const bf16_t* ur = proj + (tl0 + t) * PLD + 1544 + g * 128 + nh * 64 + r31;
            bf16_t* orow = yb + (tl0 + t) * 512 + g * 128 + nh * 64 + r31;
            orow[0] = f2bf(gelu_f(bf2f(ur[0])) * (a0[i] + bias));
            orow[32] = f2bf(gelu_f(bf2f(ur[32])) * (a1[i] + bias));
        }
    }
    __syncthreads();
}

constexpr int SP = 136;
DI void scan128(float& v0, float& v1, int lane) {
#pragma unroll
    for (int o = 1; o < 64; o <<= 1) { const float n0 = __shfl_up(v0, o), n1 = __shfl_up(v1, o); if (lane >= o) { v0 += n0; v1 += n1; } }
    v1 += __shfl(v0, 63);
}
DI void ssd_states_unit(const bf16_t* xbcc, const float* dtb, float* ST, float* ATOT, int bl, int c, int grp, LAS unsigned char* lds) {
    const int tid = tid_now(), wave = tid >> 6, lane = tid & 63, r31 = lane & 31, hh = lane >> 5;
    LAS bf16_t* BT = (LAS bf16_t*)lds; LAS bf16_t* XT = (LAS bf16_t*)(lds + 34816); LAS float* WS = (LAS float*)(lds + 104448);
    const size_t row0 = (size_t)bl * SEQ + c * 128;
    if (wave < 4) {
        const int h = grp * 4 + wave;
        const float d0 = dtb[(row0 + lane) * 16 + h], d1 = dtb[(row0 + 64 + lane) * 16 + h];
        float v0 = dtb[(row0 + lane) * 16 + 8 + h], v1 = dtb[(row0 + 64 + lane) * 16 + 8 + h];
        scan128(v0, v1, lane);
        const float tot = __shfl(v1, 63);
        WS[wave * 128 + lane] = d0 * __expf(tot - v0); WS[wave * 128 + 64 + lane] = d1 * __expf(tot - v1);
        if (lane == 0) ATOT[(bl * 16 + c) * 8 + h] = tot;
    }
    __syncthreads();
#pragma unroll
    for (int i = 0; i < 4; ++i) {
        const int ch = tid + 512 * i, s = ch >> 4, n8 = (ch & 15) * 8;
        const u32x4 v = *(const u32x4*)(xbcc + (row0 + s) * 1024 + 512 + grp * 128 + n8);
        LAS bf16_t* d = BT + n8 * SP + s;
        d[0] = (bf16_t)(v.x & 0xffffu); d[SP] = (bf16_t)(v.x >> 16); d[2 * SP] = (bf16_t)(v.y & 0xffffu); d[3 * SP] = (bf16_t)(v.y >> 16);
        d[4 * SP] = (bf16_t)(v.z & 0xffffu); d[5 * SP] = (bf16_t)(v.z >> 16); d[6 * SP] = (bf16_t)(v.w & 0xffffu); d[7 * SP] = (bf16_t)(v.w >> 16);
    }
#pragma unroll
    for (int i = 0; i < 8; ++i) {
        const int ch = tid + 512 * i, s = ch >> 5, c8 = (ch & 31) * 8;
        const u32x4 v = *(const u32x4*)(xbcc + (row0 + s) * 1024 + grp * 256 + c8); float f[8]; UNPACK8(v, f);
        const float w = WS[(c8 >> 6) * 128 + s];
        LAS bf16_t* d = XT + c8 * SP + s;
#pragma unroll
        for (int j = 0; j < 8; ++j) d[j * SP] = f2bf(f[j] * w);
    }
    __syncthreads();
    const int hl = wave >> 1, pb = wave & 1;
    f32x16 acc[4];
#pragma unroll
    for (int nb = 0; nb < 4; ++nb)
#pragma unroll
        for (int i = 0; i < 16; ++i) acc[nb][i] = 0.f;
#pragma unroll
    for (int k = 0; k < 8; ++k) {
        const bf16x8 a = *(const LAS bf16x8*)(XT + (hl * 64 + pb * 32 + r31) * SP + k * 16 + 8 * hh);
#pragma unroll
        for (int nb = 0; nb < 4; ++nb) { const bf16x8 b = *(const LAS bf16x8*)(BT + (nb * 32 + r31) * SP + k * 16 + 8 * hh); acc[nb] = MFMA32(a, b, acc[nb]); }
    }
    float* so = ST + (((size_t)bl * 16 + c) * 8 + grp * 4 + hl) * 8192;
#pragma unroll
    for (int nb = 0; nb < 4; ++nb)
#pragma unroll
        for (int i = 0; i < 16; ++i) so[(pb * 32 + crow(i, hh)) * 128 + nb * 32 + r31] = acc[nb][i];
    __syncthreads();
}
DI void ssd_scan(float* ST, const float* ATOT) {
    const int tidn = tid_now();
    for (int idx = wg_now() * 512 + tidn; idx < 64 * 2048; idx += nwg_now() * 512) {
        const int bh = idx >> 11, e4 = idx & 2047, bl = bh >> 3, head = bh & 7;
        float* base = ST + ((size_t)bl * 16 * 8 + head) * 8192 + e4 * 4;
        f32x4 s[16];
#pragma unroll
        for (int c = 0; c < 16; ++c) s[c] = *(const f32x4*)(base + (size_t)c * 8 * 8192);
        f32x4 run = {0.f, 0.f, 0.f, 0.f};
#pragma unroll
        for (int c = 0; c < 16; ++c) { const float ea = __expf(ATOT[(bl * 16 + c) * 8 + head]); *(f32x4*)(base + (size_t)c * 8 * 8192) = run; run = run * ea + s[c]; }
    }
}
DI void ssd_out_unit(const Params& p, int l, const bf16_t* proj, const bf16_t* xbcc, const float* dtb, const float* ST, float* yraw, int bl, int c, int pair, LAS unsigned char* lds, LAS float* RS, int first) {
    const int tid = tid_now(), wave = tid >> 6, lane = tid & 63, r31 = lane & 31, hh = lane >> 5;
    LAS bf16_t* CL = (LAS bf16_t*)lds; LAS bf16_t* BL = (LAS bf16_t*)(lds + 34816); LAS bf16_t* XT = (LAS bf16_t*)(lds + 69632); LAS bf16_t* PV = (LAS bf16_t*)(lds + 104448);
    LAS float* ACS = (LAS float*)(lds + 139264); LAS float* DTL = (LAS float*)(lds + 140288); LAS float* OUT = (LAS float*)lds;
    const int grp = pair >> 1; const size_t row0 = (size_t)bl * SEQ + c * 128;
    if (wave < 2) {
        const int h = pair * 2 + wave;
        const float d0 = dtb[(row0 + lane) * 16 + h], d1 = dtb[(row0 + 64 + lane) * 16 + h];
        float v0 = dtb[(row0 + lane) * 16 + 8 + h], v1 = dtb[(row0 + 64 + lane) * 16 + 8 + h];
        scan128(v0, v1, lane);
        ACS[wave * 128 + lane] = v0; ACS[wave * 128 + 64 + lane] = v1; DTL[wave * 128 + lane] = d0; DTL[wave * 128 + 64 + lane] = d1;
    }
    __syncthreads();
#pragma unroll
    for (int i = 0; i < 4; ++i) {
        const int ch = tid + 512 * i, s = ch >> 4, n8 = (ch & 15) * 8;
        const bf16_t* xr = xbcc + (row0 + s) * 1024;
        *(LAS u32x4*)(CL + s * SP + n8) = *(const u32x4*)(xr + 768 + grp * 128 + n8);
        *(LAS u32x4*)(BL + s * SP + n8) = *(const u32x4*)(xr + 512 + grp * 128 + n8);
        const u32x4 v = *(const u32x4*)(xr + pair * 128 + n8); float f[8]; UNPACK8(v, f);
        const float w = DTL[(n8 >> 6) * 128 + s];
        LAS bf16_t* d = XT + n8 * SP + s;
#pragma unroll
        for (int j = 0; j < 8; ++j) d[j * SP] = f2bf(f[j] * w);
        const float* sp = ST + (((size_t)bl * 16 + c) * 8 + pair * 2) * 8192 + (size_t)s * 128 + n8;
        const f32x4 a = *(const f32x4*)sp, b = *(const f32x4*)(sp + 4);
        *(LAS u32x4*)(PV + s * SP + n8) = (u32x4){pk2(a[0], a[1]), pk2(a[2], a[3]), pk2(b[0], b[1]), pk2(b[2], b[3])};
    }
    __syncthreads();
    const int tb = wave >> 1, hl = wave & 1;
    f32x16 acc[2];
#pragma unroll
    for (int pb = 0; pb < 2; ++pb)
#pragma unroll
        for (int i = 0; i < 16; ++i) acc[pb][i] = 0.f;
    const LAS bf16_t* crw = CL + (tb * 32 + r31) * SP + 8 * hh;
#pragma unroll
    for (int k = 0; k < 8; ++k) {
        const bf16x8 b = *(const LAS bf16x8*)(crw + k * 16);
#pragma unroll
        for (int pb = 0; pb < 2; ++pb) { const bf16x8 a = *(const LAS bf16x8*)(PV + (hl * 64 + pb * 32 + r31) * SP + k * 16 + 8 * hh); acc[pb] = MFMA32(a, b, acc[pb]); }
    }
    const float at = ACS[hl * 128 + tb * 32 + r31], eat = __expf(at);
#pragma unroll
    for (int pb = 0; pb < 2; ++pb)
#pragma unroll
        for (int i = 0; i < 16; ++i) acc[pb][i] *= eat;
#pragma unroll 1
    for (int sb = 0; sb <= tb; ++sb) {
        f32x16 cbt;
#pragma unroll
        for (int i = 0; i < 16; ++i) cbt[i] = 0.f;
#pragma unroll
        for (int k = 0; k < 8; ++k) {
            const bf16x8 a = *(const LAS bf16x8*)(BL + (sb * 32 + r31) * SP + k * 16 + 8 * hh);
            const bf16x8 b = *(const LAS bf16x8*)(crw + k * 16);
            cbt = MFMA32(a, b, cbt);
        }
#pragma unroll
        for (int i = 0; i < 16; ++i) {
            const int sl = crow(i, hh); const float as = ACS[hl * 128 + sb * 32 + sl];
            const float mv = cbt[i] * __expf(fminf(at - as, 0.f));
            cbt[i] = (sb == tb && sl > r31) ? 0.f : mv;
        }
#pragma unroll
        for (int ks = 0; ks < 2; ++ks) {
            u32x4 w; w.x = pk2(cbt[8 * ks], cbt[8 * ks + 1]); w.y = pk2(cbt[8 * ks + 2], cbt[8 * ks + 3]); w.z = pk2(cbt[8 * ks + 4], cbt[8 * ks + 5]); w.w = pk2(cbt[8 * ks + 6], cbt[8 * ks + 7]);
            const bf16x8 pfr = __builtin_bit_cast(bf16x8, w);
#pragma unroll
            for (int pb = 0; pb < 2; ++pb) {
                const LAS bf16_t* vp = XT + (hl * 64 + pb * 32 + r31) * SP + sb * 32 + 16 * ks + 4 * hh;
                const s16x4 lo = *(const LAS s16x4*)vp, hi = *(const LAS s16x4*)(vp + 8);
                const bf16x8 a = __builtin_shufflevector(lo, hi, 0, 1, 2, 3, 4, 5, 6, 7);
                acc[pb] = MFMA32(a, pfr, acc[pb]);
            }
        }
    }
    __syncthreads();
#pragma unroll
    for (int pb = 0; pb < 2; ++pb)
#pragma unroll
        for (int i = 0; i < 16; ++i) OUT[(tb * 32 + r31) * 132 + hl * 64 + pb * 32 + crow(i, hh)] = acc[pb][i];
    __syncthreads();
#pragma unroll
    for (int i = 0; i < 4; ++i) {
        const int it = tid + 512 * i, t = it >> 4, c8 = (it & 15) * 8;
        const f32x4 y0 = *(const LAS f32x4*)(OUT + t * 132 + c8), y1 = *(const LAS f32x4*)(OUT + t * 132 + c8 + 4);
        const u32x4 xv = *(const u32x4*)(xbcc + (row0 + t) * 1024 + pair * 128 + c8), zv = *(const u32x4*)(proj + (row0 + t) * PLD + pair * 128 + c8);
        float fx[8], fz[8]; UNPACK8(xv, fx); UNPACK8(zv, fz);
        const float Dh = p.in[11][l * 8 + pair * 2 + (c8 >> 6)];
        f32x4 o0, o1;
#pragma unroll
        for (int j = 0; j < 4; ++j) { o0[j] = (y0[j] + Dh * fx[j]) * silu_f(fz[j]); o1[j] = (y1[j] + Dh * fx[4 + j]) * silu_f(fz[4 + j]); }
        float* op = yraw + (row0 + t) * 512 + pair * 128 + c8; *(f32x4*)op = o0; *(f32x4*)(op + 4) = o1;
        float ss = 0.f;
#pragma unroll
        for (int j = 0; j < 4; ++j) ss += o0[j] * o0[j] + o1[j] * o1[j];
        ss += __shfl_xor(ss, 1); ss += __shfl_xor(ss, 2); ss += __shfl_xor(ss, 4); ss += __shfl_xor(ss, 8);
        if ((tid & 15) == 0) RS[t] = first ? ss : RS[t] + ss;
    }
    __syncthreads();
}
DI void ssd_out_grp(const Params& p, int l, const bf16_t* proj, const bf16_t* xbcc, const float* dtb, const float* ST, float* yraw, bf16_t* ya, int bl, int c, int grp, LAS unsigned char* lds) {
    LAS float* RS = (LAS float*)(lds + 141312);
    ssd_out_unit(p, l, proj, xbcc, dtb, ST, yraw, bl, c, grp * 2, lds, RS, 1);
    ssd_out_unit(p, l, proj, xbcc, dtb, ST, yraw, bl, c, grp * 2 + 1, lds, RS, 0);
    const int tid = tid_now(); const size_t row0 = (size_t)bl * SEQ + c * 128;
    const float* nw = p.in[12] + l * 512 + grp * 256;
#pragma unroll
    for (int i = 0; i < 8; ++i) {
        const int it = tid + 512 * i, t = it >> 5, c8 = (it & 31) * 8;
        const float* yr = yraw + (row0 + t) * 512 + grp * 256 + c8;
        const f32x4 a = *(const f32x4*)yr, b = *(const f32x4*)(yr + 4), w0 = *(const f32x4*)(nw + c8), w1 = *(const f32x4*)(nw + c8 + 4);
        const float rstd = rsqrtf(RS[t] * (1.f / 256.f) + EPS);
        *(u32x4*)(ya + (row0 + t) * 512 + grp * 256 + c8) = (u32x4){pk2(a[0] * rstd * w0[0], a[1] * rstd * w0[1]), pk2(a[2] * rstd * w0[2], a[3] * rstd * w0[3]),
                                                                      pk2(b[0] * rstd * w1[0], b[1] * rstd * w1[1]), pk2(b[2] * rstd * w1[2], b[3] * rstd * w1[3])};
    }
    __syncthreads();
}
#if MULTI_LAUNCH
#define RUNPH(x) ((x) == p.only_phase)
#define GSYNC() do {} while (0)
#else
#define RUNPH(x) true
#define GSYNC() do { xcd_barrier(xb); if (PROBE & 1) xcd_barrier(xb); } while (0)
#endif
#define PH_BEGIN if (RUNPH(ph)) { unsigned char* ws = p.ws; float* X = p.out; asm volatile("" : "+s"(ws), "+s"(X)); const int wg = wg_now(), nwg = nwg_now();
#define PH_END } ++ph; GSYNC();
__global__ void __launch_bounds__(512) mega(Params p) {
    extern __shared__ __attribute__((aligned(16))) unsigned char smem[];
    LAS unsigned char* lds = (LAS unsigned char*)smem;
#if !MULTI_LAUNCH
    cg::grid_group grid = cg::this_grid();
    volatile LAS unsigned* xst = (volatile LAS unsigned*)(lds + LDS_BYTES - 16);
    if (threadIdx.x == 0) { xst[0] = 0u; xst[1] = 0u; }
    __syncthreads();
    const XcdBarrier xb = xcd_barrier_post((unsigned*)(p.ws + O_BAR), xst);
    grid.sync();
#endif
#define XN ((bf16_t*)(ws + O_XN))
#define SSQ0 ((float*)(ws + O_SSQ))
#define SSQ1 (SSQ0 + (size_t)T_ALL * 16)
#define SSQ2 (SSQ0 + (size_t)2 * T_ALL * 16)
#define H ((bf16_t*)(ws + O_H))
#define PROJ ((bf16_t*)(ws + O_PROJ))
#define XBCC ((bf16_t*)(ws + O_XBCC))
#define ST ((float*)(ws + O_ST))
#define ATOT ((float*)(ws + O_ATOT))
#define DTB ((float*)(ws + O_DTB))
#define AQ ((bf16_t*)(ws + O_AQ))
#define AKV ((bf16_t*)(ws + O_AKV))
#define QRAW ((bf16_t*)(ws + O_QRAW))
#define KVRAW ((bf16_t*)(ws + O_KVRAW))
#define QF ((bf16_t*)(ws + O_QF))
#define KF ((bf16_t*)(ws + O_KF))
#define VT ((bf16_t*)(ws + O_VT))
#define YRAW ((float*)(ws + O_YRAW))
#define YA ((bf16_t*)(ws + O_YA))
#define YB (YA + (size_t)TG * 512)
#define YC (YA + (size_t)2 * TG * 512)
#define YD (YA + (size_t)3 * TG * 512)
#define CS ((f32x2*)(ws + O_CS))
#define PB ((bf16_t*)(ws + O_PB))
#define MIXB ((bf16_t*)(ws + O_MIXB))
#define WIN ((const bf16_t*)(ws + O_WIN))
#define WGATE ((const bf16_t*)(ws + O_WGATE))
#define WBR ((const bf16_t*)(ws + O_WBR))
#define WOUT ((const bf16_t*)(ws + O_WOUT))
#define WQB ((const bf16_t*)(ws + O_WQB))
#define WKVB ((const bf16_t*)(ws + O_WKVB))
#define XNg (XN + (size_t)g * TG * 1024)
    int ph = 0;
#pragma unroll 1
    for (int l = 0; l < 4; ++l) {
#pragma unroll 1
        for (int f = 0; f < 2; ++f) {
            if (f == 0) {
                PH_BEGIN
                    REP(32) convert_layer(p, l, (LAS float*)lds, wg, nwg);
                    if (l == 0) { rope_table(p, CS); init_rows(p.in[0], XN, SSQ0); }
                PH_END
            }
            PH_BEGIN
                EpiGU e{H, f == 0 ? SSQ0 : SSQ2};
#pragma unroll 1
                for (int rep = 0; rep < ((PROBE & 16) ? 2 : 1); ++rep) run_gemm(lds, XN, (const bf16_t*)(ws + (f == 0 ? O_WGU1 : O_WGU2)), T_ALL, 5632, 1024, e);
            PH_END
            PH_BEGIN
                EpiRes e{XN, f == 0 ? SSQ1 : SSQ0, (l == 3 && f == 1) ? X : nullptr, 0.5f}; run_gemm(lds, H, (const bf16_t*)(ws + (f == 0 ? O_WD1 : O_WD2)), T_ALL, 1024, 2816, e);
            PH_END
            if (f == 0) {
#pragma unroll 1
                for (int g = 0; g < NGRP; ++g) {
                    PH_BEGIN
                        EpiStore e{PROJ, PLD, 0x7fffffff, SSQ1 + (size_t)g * TG * 16};
#pragma unroll 1
                        for (int rep = 0; rep < ((PROBE & 8) ? 2 : 1); ++rep) run_gemm(lds, XNg, WIN, TG, 4864, 1024, e);
                    PH_END
                    PH_BEGIN
                        REP(4) prep1(p, l, PROJ, XBCC, DTB, AQ, AKV, YD);
                    PH_END
                    PH_BEGIN
                        REP(64) {
                        { EpiStore e{QRAW, 768, 0x7fffffff, nullptr}; run_gemm(lds, AQ, WQB, TG, 768, 384, e); }
                        { EpiStore e{KVRAW, 1024, 0x7fffffff, nullptr}; run_gemm(lds, AKV, WKVB, TG, 1024, 256, e); }
#pragma unroll 1
                        for (int u = wg; u < 256; u += nwg) {
                            ssd_states_unit(XBCC, DTB, ST, ATOT, u >> 5, (u >> 1) & 15, u & 1, lds);
                        }
                        }
                    PH_END
                    PH_BEGIN
                        REP(4) for (int u = wg; u < 256; u += nwg) prep2_unit(p, l, g, PROJ, QRAW, KVRAW, CS, QF, KF, VT, u >> 5, u & 31, lds);
                        ssd_scan(ST, ATOT);
                    PH_END
                    PH_BEGIN
#pragma unroll 1
                        for (int rep = 0; rep < ((PROBE & 2) ? 2 : 1); ++rep)
#pragma unroll 1
                        for (int slot = wg; slot < 256; slot += nwg) {
                            if (slot < 128) { const int bh = slot >> 2, pr = slot & 3;
                                attn_unit(QF, KF, VT, YC, bh, 7 - pr, lds); attn_unit(QF, KF, VT, YC, bh, pr, lds); }
                            else { const int sl = slot - 128;
#pragma unroll 1
                                for (int k = 0; k < 2; ++k) { const int u = sl * 2 + k; ssd_out_grp(p, l, PROJ, XBCC, DTB, ST, YRAW, YA, u >> 5, (u >> 1) & 15, u & 1, lds); }
                                gmlp_unit(p, l, PROJ, YB, sl >> 4, sl & 15, lds); }
                        }
                    PH_END
                    PH_BEGIN
                        EpiStore e{PB, 1024, 3, nullptr}; pg8::Gemm gm{YA, WBR, 4 * TG, 4096, 512}; BranchOrder S; S.G = nwg; S.c = wg;
                        REP(128) pg8::gemm_phase<EpiStore, BranchOrder>(lds, gm, S, e);
                    PH_END
                    PH_BEGIN
                        EpiMerge e{PB, MIXB, SSQ1 + (size_t)g * TG * 16}; REP(128) run_gemm(lds, XNg, WGATE, TG, 4096, 1024, e);
                    PH_END
                    PH_BEGIN
                        EpiRes e{XNg, SSQ2 + (size_t)g * TG * 16, nullptr, 1.0f}; run_gemm(lds, MIXB, WOUT, TG, 1024, 1024, e);
                    PH_END
                }
            }
        }
    }
}

constexpr int N_PHASES = 4 * (1 + 2 + 4 * 8 + 2);

extern "C" void kernel_launch(void* const* d_in, const int* in_sizes, int n_in, void* d_out, int out_size, void* d_ws, size_t ws_size, hipStream_t stream) {
    static int grid_blocks = 0;
    if (!grid_blocks) {
        if (n_in != 28 || ws_size < WS_NEED) { fprintf(stderr, "kernel_launch: need 28 inputs and %zu bytes of workspace (got %d, %zu)\n", (size_t)WS_NEED, n_in, ws_size); grid_blocks = -1; return; }
        if (hipFuncSetAttribute((const void*)mega, hipFuncAttributeMaxDynamicSharedMemorySize, LDS_BYTES) != hipSuccess) { fprintf(stderr, "kernel_launch: hipFuncSetAttribute failed\n"); grid_blocks = -1; return; }
        int dev = 0, cus = 0, per_cu = 0;
        hipGetDevice(&dev); hipDeviceGetAttribute(&cus, hipDeviceAttributeMultiprocessorCount, dev);
        hipOccupancyMaxActiveBlocksPerMultiprocessor(&per_cu, mega, 512, LDS_BYTES);
        if (per_cu < 1) { fprintf(stderr, "kernel_launch: occupancy query returned %d\n", per_cu); per_cu = 1; }
        (void)hipGetLastError();
        grid_blocks = cus * per_cu;
    }
    if (grid_blocks < 0) return;
    Params p{};
    for (int i = 0; i < 28; ++i) p.in[i] = (const float*)d_in[i];
    p.out = (float*)d_out; p.ws = (unsigned char*)d_ws; p.only_phase = -1; p.pad = 0;
#if MULTI_LAUNCH
    for (int ph = 0; ph < N_PHASES; ++ph) { p.only_phase = ph; hipLaunchKernelGGL(mega, dim3(grid_blocks), dim3(512), LDS_BYTES, stream, p); }
#else
    if (hipMemsetAsync((unsigned char*)d_ws + O_BAR, 0, (size_t)XCD_BAR_WORDS * 4, stream) != hipSuccess) { fprintf(stderr, "kernel_launch: memset of barrier words failed\n"); return; }
    void* args[] = {&p};
    hipError_t e = hipLaunchCooperativeKernel((void*)mega, dim3(grid_blocks), dim3(512), args, LDS_BYTES, stream);
    if (e != hipSuccess) fprintf(stderr, "cooperative launch failed: %s (grid %d)\n", hipGetErrorString(e), grid_blocks);
#endif
}
```

```cpp
#include <hip/hip_runtime.h>
#include <hip/hip_cooperative_groups.h>
#include <cstdio>
namespace cg = cooperative_groups;

#ifndef PROBE
#define PROBE 0
#endif
#define REP(bit) _Pragma("unroll 1") for (int rep_ = 0; rep_ < ((PROBE & (bit)) ? 2 : 1); ++rep_)
#ifndef MULTI_LAUNCH
#define MULTI_LAUNCH 0
#endif

__device__ __forceinline__ int tid_now() { int t = threadIdx.x; asm volatile("" : "+v"(t)); return t; }
__device__ __forceinline__ int wg_now() { int t = blockIdx.x; asm volatile("" : "+s"(t)); return t; }
__device__ __forceinline__ int nwg_now() { int t = gridDim.x; asm volatile("" : "+s"(t)); return t; }
namespace pg8 {
#define PG8_LAS __attribute__((address_space(3)))
typedef unsigned short bf16_t;
typedef short bf16x8 __attribute__((ext_vector_type(8)));
typedef float f32x4 __attribute__((ext_vector_type(4)));
typedef unsigned u32x4 __attribute__((ext_vector_type(4)));
constexpr int BM = 256, BK = 64, HALF = 128, HTB = HALF * BK * 2  , STAGE_BYTES = 8 * HTB, NXCD = 8, WGM = 8;

__host__ __device__ __forceinline__ int lds_byte(int r, int c) { const int st = (r >> 4) * 2 + (c >> 5), rr = r & 15, cc = c & 31, ob = rr * 64 + cc * 2; return st * 1024 + (ob ^ (((ob >> 9) & 1) << 5)); }
__host__ __device__ __forceinline__ void stage_rc(int b, int& R, int& C) { const int st = b / 1024, sb = b % 1024, swz = sb ^ (((sb >> 9) & 1) << 5); R = (st >> 1) * 16 + swz / 64; C = (st & 1) * 32 + (swz % 64) / 2; }
__host__ __device__ __forceinline__ int perm32(int rho) { const int n = rho >> 4, i = rho & 15; return 8 * (i >> 2) + 4 * n + (i & 3); }

struct Unit { int pm, pn; };
struct Gemm { const bf16_t* A; const bf16_t* Bt; int M, N, K; };

struct StaticOrder {
    int nM, nN, nwg, G, c;
    __host__ __device__ void init(int M, int N, int G_, int c_) { nM = M / BM; nN = N / BM; nwg = nM * nN; G = G_; c = c_; }
    __host__ __device__ bool next(int i, Unit& u) const {
        const long L = (long)i * G + c; if (L >= nwg) return false;
        int wgid = (int)L; { const int q = nwg / NXCD, r = nwg % NXCD, xcd = wgid % NXCD, off = wgid / NXCD; wgid = (xcd < r ? xcd * (q + 1) : r * (q + 1) + (xcd - r) * q) + off; }
        const int nig = WGM * nN, gid = wgid / nig, fm = gid * WGM, gsz = (nM - fm) < WGM ? (nM - fm) : WGM;
        u.pm = fm + ((wgid % nig) % gsz); u.pn = (wgid % nig) / gsz; return true;
    }
    __device__ __forceinline__ void a_ready(const Unit&) const {}
    __device__ __forceinline__ void done(const Unit&) const {}
};

template <class Epi, class Sched>
__device__ __forceinline__ void gemm_phase(PG8_LAS unsigned char* lds, const Gemm g, const Sched& S, const Epi& E) {
    const int tid = tid_now(), wid = __builtin_amdgcn_readfirstlane(tid >> 6), lane = tid & 63, wr = wid >> 2, wc = wid & 3, fr = lane & 15, fq = lane >> 4;
    const int K = g.K, nt = K / BK;
    unsigned voffA[2], voffB[2];
#pragma unroll
    for (int i = 0; i < 2; ++i) { int R, C; stage_rc(tid * 16 + i * 8192, R, C); const int Rb = Epi::PERM ? ((R & ~31) + perm32(R & 31)) : R;
        voffA[i] = (unsigned)(R * K + C) * 2u; voffB[i] = (unsigned)(Rb * K + C) * 2u; }
    const size_t kstep = (size_t)(BK * 2);
    const size_t hstep = (size_t)HALF * K * 2;
    const size_t tstep = 2 * hstep;
    const unsigned ldsw = (unsigned)wid * 1024u;
    const int aoff = lds_byte(wr * 64 + fr, fq * 8), boff = lds_byte(wc * 32 + fr, fq * 8);
#define PG8_SA(b, h) (((b) * 2 + (h)) * HTB)
#define PG8_SB(b, h) ((4 + (b) * 2 + (h)) * HTB)
#define PG8_STAGE(bufoff, gbase, voff) do { _Pragma("unroll") for (int _i = 0; _i < 2; ++_i) \
        __builtin_amdgcn_global_load_lds((const unsigned*)((const char*)(gbase) + (voff)[_i]), (PG8_LAS unsigned*)(lds + (bufoff) + ldsw + _i * 8192), 16, 0, 0); } while (0)
#define PG8_LDA(dst, b, h) do { _Pragma("unroll") for (int m = 0; m < 4; ++m) _Pragma("unroll") for (int k = 0; k < 2; ++k) dst[m][k] = *(const PG8_LAS bf16x8*)(lds + PG8_SA(b, h) + aoff + m * 2048 + k * 1024); } while (0)
#define PG8_LDB(dst, b, h) do { _Pragma("unroll") for (int n = 0; n < 2; ++n) _Pragma("unroll") for (int k = 0; k < 2; ++k) dst[n][k] = *(const PG8_LAS bf16x8*)(lds + PG8_SB(b, h) + boff + n * 2048 + k * 1024); } while (0)
#define PG8_MMA(ai, bj, At, Bt) do { __builtin_amdgcn_s_setprio(1); _Pragma("unroll") for (int m = 0; m < 4; ++m) _Pragma("unroll") for (int n = 0; n < 2; ++n) _Pragma("unroll") for (int k = 0; k < 2; ++k) \
        acc[ai][bj][m][n] = __builtin_amdgcn_mfma_f32_16x16x32_bf16(Bt[n][k], At[m][k], acc[ai][bj][m][n], 0, 0, 0); __builtin_amdgcn_s_setprio(0); } while (0)
#define PG8_WAIT_V(n) asm volatile("s_waitcnt vmcnt(" #n ")" ::: "memory")
#define PG8_WAIT_L(n) asm volatile("s_waitcnt lgkmcnt(" #n ")" ::: "memory")
#define PG8_BAR __builtin_amdgcn_s_barrier()
#define PG8_SCHED __builtin_amdgcn_sched_barrier(0)
    Unit cur, nxt; int ui = 0;
    if (!S.next(0, cur)) return;
    f32x4 acc[2][2][4][2];
#pragma unroll
    for (int a = 0; a < 2; ++a)
#pragma unroll
        for (int b = 0; b < 2; ++b)
#pragma unroll
            for (int m = 0; m < 4; ++m)
#pragma unroll
                for (int n = 0; n < 2; ++n) acc[a][b][m][n] = (f32x4){0.f, 0.f, 0.f, 0.f};
    bf16x8 At[4][2], B0[2][2], B1[2][2];
    const char* cA = (const char*)g.A + (size_t)cur.pm * tstep; const char* cB = (const char*)g.Bt + (size_t)cur.pn * tstep;
    S.a_ready(cur);
    PG8_STAGE(PG8_SB(0, 0), cB, voffB); PG8_STAGE(PG8_SA(0, 0), cA, voffA); PG8_STAGE(PG8_SB(0, 1), cB + hstep, voffB); PG8_STAGE(PG8_SA(0, 1), cA + hstep, voffA);
    if (wr == 1) PG8_BAR;
    PG8_WAIT_V(4); PG8_BAR;
    PG8_STAGE(PG8_SB(1, 0), cB + kstep, voffB); PG8_STAGE(PG8_SA(1, 0), cA + kstep, voffA); PG8_STAGE(PG8_SB(1, 1), cB + hstep + kstep, voffB);
    PG8_WAIT_V(6); PG8_BAR;
    for (;;) {
        const bool has_next = S.next(ui + 1, nxt);
        const char* nA = has_next ? (const char*)g.A + (size_t)nxt.pm * tstep : cA; const char* nB = has_next ? (const char*)g.Bt + (size_t)nxt.pn * tstep : cB;
        for (int t = 0; t < nt; t += 2) {
            const bool last = (t == nt - 2);
            const char* a1 = cA + (size_t)(t + 1) * kstep;
            const char* a2 = last ? nA : cA + (size_t)(t + 2) * kstep; const char* b2 = last ? nB : cB + (size_t)(t + 2) * kstep;
            const char* a3 = a2 + kstep; const char* b3 = b2 + kstep;
            if (last && has_next) S.a_ready(nxt);
            PG8_LDB(B0, 0, 0); PG8_SCHED; PG8_LDA(At, 0, 0); PG8_STAGE(PG8_SA(1, 1), a1 + hstep, voffA);
            PG8_WAIT_L(8); PG8_BAR; PG8_WAIT_L(0); PG8_MMA(0, 0, At, B0); PG8_BAR; PG8_SCHED;
            PG8_LDB(B1, 0, 1); PG8_STAGE(PG8_SB(0, 0), b2, voffB);
            PG8_BAR; PG8_WAIT_L(0); PG8_MMA(0, 1, At, B1); PG8_BAR;
            PG8_LDA(At, 0, 1); PG8_STAGE(PG8_SA(0, 0), a2, voffA);
            PG8_BAR; PG8_WAIT_L(0); PG8_MMA(1, 0, At, B0); PG8_BAR; PG8_SCHED;
            PG8_STAGE(PG8_SB(0, 1), b2 + hstep, voffB);
            PG8_WAIT_V(6); PG8_BAR; PG8_MMA(1, 1, At, B1); PG8_BAR;
            PG8_LDB(B0, 1, 0); PG8_SCHED; PG8_LDA(At, 1, 0); PG8_STAGE(PG8_SA(0, 1), a2 + hstep, voffA);
            PG8_WAIT_L(8); PG8_BAR; PG8_WAIT_L(0); PG8_MMA(0, 0, At, B0); PG8_BAR; PG8_SCHED;
            PG8_LDB(B1, 1, 1); PG8_STAGE(PG8_SB(1, 0), b3, voffB);
            PG8_BAR; PG8_WAIT_L(0); PG8_MMA(0, 1, At, B1); PG8_BAR;
            PG8_LDA(At, 1, 1); PG8_STAGE(PG8_SA(1, 0), a3, voffA);
            PG8_BAR; PG8_WAIT_L(0); PG8_MMA(1, 0, At, B0); PG8_BAR; PG8_SCHED;
            PG8_STAGE(PG8_SB(1, 1), b3 + hstep, voffB);
            PG8_WAIT_V(6); PG8_BAR; PG8_MMA(1, 1, At, B1); PG8_BAR;
        }
        if constexpr (!Epi::AFTER_DRAIN) { E(acc, cur, wr, wc, fr, fq); S.done(cur); }
        if (!has_next) break;
#pragma unroll
        for (int a = 0; a < 2; ++a)
#pragma unroll
            for (int b = 0; b < 2; ++b)
#pragma unroll
                for (int m = 0; m < 4; ++m)
#pragma unroll
                    for (int n = 0; n < 2; ++n) acc[a][b][m][n] = (f32x4){0.f, 0.f, 0.f, 0.f};
        cur = nxt; cA = nA; cB = nB; ++ui;
    }
    PG8_WAIT_V(0);
    if (wr == 0) PG8_BAR;
    PG8_BAR;
    if constexpr (Epi::AFTER_DRAIN) { E.fused(acc, cur, wr, wc, fr, fq, lds, wid, lane); S.done(cur); }
#undef PG8_SA
#undef PG8_SB
#undef PG8_STAGE
#undef PG8_LDA
#undef PG8_LDB
#undef PG8_MMA
#undef PG8_WAIT_V
#undef PG8_WAIT_L
#undef PG8_BAR
#undef PG8_SCHED
}
}


using pg8::bf16_t; using pg8::bf16x8; using pg8::f32x4; using pg8::u32x4;
typedef short s16x4 __attribute__((ext_vector_type(4)));
typedef float f32x2 __attribute__((ext_vector_type(2)));
typedef float f32x16 __attribute__((ext_vector_type(16)));
typedef unsigned u32x2 __attribute__((ext_vector_type(2)));
typedef __bf16 bf16v2 __attribute__((ext_vector_type(2)));
#define LAS __attribute__((address_space(3)))
#define DI __device__ __forceinline__
#define XB_TMO      128
#define XB_XCNT(j)  (256  + 64 * (j))
#define XB_XSUB(j)  (1280 + 64 * (j))
#define XB_XGEN(j)  (2304 + 64 * (j))
#define XB_TOP      3328
#define XB_TOPGEN   3392
#define XCD_BAR_WORDS 3456
#define XB_SPIN_CAP (1u << 18)

__device__ __forceinline__ unsigned xb_ld(unsigned* p)              { return __hip_atomic_load(p, __ATOMIC_RELAXED, __HIP_MEMORY_SCOPE_AGENT); }
__device__ __forceinline__ unsigned xb_add(unsigned* p, unsigned v) { return __hip_atomic_fetch_add(p, v, __ATOMIC_RELAXED, __HIP_MEMORY_SCOPE_AGENT); }
__device__ __forceinline__ unsigned xb_xcc_id() { return (unsigned)__builtin_amdgcn_s_getreg((3 << 11) | 20) & 0xFu; }
#define XB_SPIN(cond, bar) do { unsigned _sp = 0; while (cond) { __builtin_amdgcn_s_sleep(1); \
    if ((++_sp & 255u) == 0u) { if (xb_ld(&(bar)[XB_TMO])) break; if (_sp > XB_SPIN_CAP) { atomicAdd(&(bar)[XB_TMO], 1u); break; } } } } while (0)

struct XcdBarrier {
    unsigned* bar; unsigned x;
    volatile LAS unsigned* st;
};

__device__ __forceinline__ XcdBarrier xcd_barrier_post(unsigned* bar, volatile LAS unsigned* st) {
    XcdBarrier b; b.bar = bar; b.x = xb_xcc_id(); b.st = st;
    if (threadIdx.x == 0) (void)xb_add(&bar[XB_XCNT(b.x)], 1u);
    return b;
}
__device__ __forceinline__ void xcd_barrier_complete(unsigned* bar, unsigned x, unsigned& nloc, unsigned& nx) {
    const unsigned G = (unsigned)nwg_now();
    unsigned sum, cnt, mine, sp = 0u;
    for (;;) {
        sum = 0u; cnt = 0u; mine = 0u;
#pragma unroll
        for (unsigned j = 0; j < 16; ++j) { const unsigned c = xb_ld(&bar[XB_XCNT(j)]); sum += c; cnt += (c > 0u) ? 1u : 0u; mine = (j == x) ? c : mine; }
        if (sum == G) break;
        __builtin_amdgcn_s_sleep(1);
        if ((++sp & 255u) == 0u) { if (xb_ld(&bar[XB_TMO])) break; if (sp > XB_SPIN_CAP) { atomicAdd(&bar[XB_TMO], 1u); break; } }
    }
    nloc = mine > 0u ? mine : 1u; nx = cnt > 0u ? cnt : 1u;
}

__device__ __forceinline__ void xcd_barrier(const XcdBarrier& b) {
    asm volatile("s_waitcnt vmcnt(0)" ::: "memory");
    __syncthreads();
    if (tid_now() == 0) {
        unsigned* bar = b.bar; unsigned bx = b.x; asm volatile("" : "+s"(bar), "+s"(bx));
        __builtin_amdgcn_s_waitcnt(0);
        unsigned nloc = b.st[0], nx = b.st[1];
        if (nloc == 0u) { xcd_barrier_complete(bar, bx, nloc, nx); b.st[0] = nloc; b.st[1] = nx; }
        const unsigned old = xb_add(&bar[XB_XSUB(bx)], 1u);
        const unsigned gen = old / nloc;
        if (old + 1u == (gen + 1u) * nloc) {
            __builtin_amdgcn_fence(__ATOMIC_RELEASE, "agent");
            asm volatile("s_waitcnt vmcnt(0)" ::: "memory");
            const unsigned og = xb_add(&bar[XB_TOP], 1u);
            const unsigned tg = og / nx;
            if (og + 1u == (tg + 1u) * nx) xb_add(&bar[XB_TOPGEN], 1u);
            else XB_SPIN(xb_ld(&bar[XB_TOPGEN]) == tg, bar);
            __builtin_amdgcn_fence(__ATOMIC_ACQUIRE, "agent");
            xb_add(&bar[XB_XGEN(bx)], 1u);
            asm volatile("s_waitcnt vmcnt(0)" ::: "memory");
        } else {
            XB_SPIN(xb_ld(&bar[XB_XGEN(bx)]) == gen, bar);
            __builtin_amdgcn_fence(__ATOMIC_ACQUIRE, "agent");
            asm volatile("s_waitcnt vmcnt(0)" ::: "memory");
        }
    }
    __syncthreads();
}


#define MFMA32(a, b, c) __builtin_amdgcn_mfma_f32_32x32x16_bf16((a), (b), (c), 0, 0, 0)

constexpr int T_ALL = 65536, SEQ = 2048, NGRP = 4, TG = 16384, BPG = 8, PLD = 4864;
constexpr float EPS = 1e-6f;
constexpr size_t SZ_GU = (size_t)5632 * 1024 * 2, SZ_D = (size_t)1024 * 2816 * 2;
constexpr size_t O_WGU1 = 0, O_WD1 = O_WGU1 + SZ_GU, O_WGU2 = O_WD1 + SZ_D, O_WD2 = O_WGU2 + SZ_GU, O_WIN = O_WD2 + SZ_D;
constexpr size_t O_WGATE = O_WIN + (size_t)4864 * 1024 * 2, O_WBR = O_WGATE + (size_t)4096 * 1024 * 2, O_WOUT = O_WBR + (size_t)4 * 1024 * 512 * 2;
constexpr size_t O_WQB = O_WOUT + (size_t)1024 * 1024 * 2, O_WKVB = O_WQB + (size_t)768 * 384 * 2, O_XN = O_WKVB + (size_t)1024 * 256 * 2;
constexpr size_t O_R0 = O_XN + (size_t)T_ALL * 1024 * 2;
constexpr size_t O_H = O_R0;
constexpr size_t O_PROJ = O_R0, O_XBCC = O_PROJ + (size_t)TG * PLD * 2, O_DTB = O_XBCC + (size_t)TG * 1024 * 2, O_AQ = O_DTB + (size_t)TG * 16 * 4;
constexpr size_t O_AKV = O_AQ + (size_t)TG * 384 * 2, O_QRAW = O_AKV + (size_t)TG * 256 * 2, O_KVRAW = O_QRAW + (size_t)TG * 768 * 2;
constexpr size_t O_QF = O_KVRAW + (size_t)TG * 1024 * 2, O_KF = O_QF + (size_t)TG * 768 * 2, O_VT = O_KF + (size_t)TG * 768 * 2;
constexpr size_t O_YRAW = O_VT + (size_t)TG * 512 * 2, O_YA = O_YRAW + (size_t)TG * 512 * 4;
constexpr size_t O_PB = O_YA + (size_t)4 * TG * 512 * 2, O_MIXB = O_PB + (size_t)4 * TG * 1024 * 2;
constexpr size_t O_ST = O_MIXB + (size_t)TG * 1024 * 2, O_ATOT = O_ST + (size_t)BPG * 16 * 8 * 8192 * 4;
constexpr size_t O_STB = O_ATOT + 4096;
constexpr size_t O_BAR = O_STB + (size_t)BPG * 16 * 8 * 8192 * 2;
constexpr size_t O_WQ = O_BAR + (size_t)XCD_BAR_WORDS * 4;
constexpr size_t ZERO_BYTES = (size_t)XCD_BAR_WORDS * 4 + 256;
constexpr size_t O_CS = O_WQ + 256 + 256 - ((size_t)XCD_BAR_WORDS * 4) % 256;
constexpr size_t O_SSQ = O_CS + (size_t)T_ALL * 32 * 8;
constexpr size_t O_END = O_SSQ + (size_t)3 * T_ALL * 16 * 4;
constexpr size_t O_END_H = O_H + (size_t)T_ALL * 2816 * 2;
constexpr size_t WS_NEED = O_END > O_END_H ? O_END : O_END_H;
constexpr int LDS_BYTES = 147456;

struct Params { const float* in[28]; float* out; unsigned char* ws; int only_phase; int pad; };

DI unsigned pk2(float a, float b) { f32x2 v = {a, b}; return __builtin_bit_cast(unsigned, __builtin_convertvector(v, bf16v2)); }
DI bf16_t f2bf(float a) { return (bf16_t)(pk2(a, 0.f) & 0xffffu); }
DI float bf2f(bf16_t b) { return __uint_as_float(((unsigned)b) << 16); }
DI float bflo(unsigned u) { return __uint_as_float(u << 16); }
DI float bfhi(unsigned u) { return __uint_as_float(u & 0xffff0000u); }
#define UNPACK8(v, f) do { f[0] = bflo(v.x); f[1] = bfhi(v.x); f[2] = bflo(v.y); f[3] = bfhi(v.y); f[4] = bflo(v.z); f[5] = bfhi(v.z); f[6] = bflo(v.w); f[7] = bfhi(v.w); } while (0)
#define PACK8(f) ((u32x4){pk2(f[0], f[1]), pk2(f[2], f[3]), pk2(f[4], f[5]), pk2(f[6], f[7])})
DI float wave_sum(float v) {
#pragma unroll
    for (int o = 1; o < 64; o <<= 1) v += __shfl_xor(v, o);
    return v;
}
DI float silu_f(float x) { return x * __builtin_amdgcn_rcpf(1.f + __builtin_amdgcn_exp2f(-1.4426950408889634f * x)); }
DI float sigmoid_f(float x) { return __builtin_amdgcn_rcpf(1.f + __builtin_amdgcn_exp2f(-1.4426950408889634f * x)); }
DI float gelu_f(float v) {
    const float t = __builtin_amdgcn_rcpf(fabsf(v) * 0.2316418882f + 1.0f);
    float q = t * 0.5307027145f + (-0.7265760135f); q = q * t + 0.7107068705f; q = q * t + (-0.142248368f); q = q * t + 0.127414796f; q = q * t;
    const float m = v * (q * __builtin_amdgcn_exp2f(v * v * (-0.72134752044f)));
    return v < 0.f ? m : v - m;
}
DI int crow(int i, int h) { return (i & 3) + 8 * (i >> 2) + 4 * h; }
DI void rows_rstd(const float* ssq, int row0, int fq, float (&rs)[2][4]) {
    f32x4 q[2][4];
#pragma unroll
    for (int ai = 0; ai < 2; ++ai)
#pragma unroll
        for (int m = 0; m < 4; ++m) q[ai][m] = ((const f32x4*)(ssq + (size_t)(row0 + ai * 128 + m * 16) * 16))[fq];
#pragma unroll
    for (int ai = 0; ai < 2; ++ai)
#pragma unroll
        for (int m = 0; m < 4; ++m) { float t = (q[ai][m][0] + q[ai][m][1]) + (q[ai][m][2] + q[ai][m][3]); t += __shfl_xor(t, 16); t += __shfl_xor(t, 32);
            rs[ai][m] = rsqrtf(t * (1.f / 1024.f) + EPS); }
}
struct EpiStore {
    static constexpr bool PERM = true, AFTER_DRAIN = false;
    bf16_t* O; int ldc; int pnmask; const float* ssq;
    DI void operator()(const f32x4 (&acc)[2][2][4][2], const pg8::Unit& u, int wr, int wc, int fr, int fq) const {
        const int row0 = u.pm * 256 + wr * 64 + fr, col0 = (u.pn & pnmask) * 256 + wc * 32 + 8 * fq;
        float rsv[2][4];
        if (ssq) rows_rstd(ssq, row0, fq, rsv);
        else {
#pragma unroll
            for (int ai = 0; ai < 2; ++ai)
#pragma unroll
                for (int m = 0; m < 4; ++m) rsv[ai][m] = 1.f; }
#pragma unroll
        for (int ai = 0; ai < 2; ++ai)
#pragma unroll
            for (int m = 0; m < 4; ++m) { bf16_t* rowp = O + (size_t)(row0 + ai * 128 + m * 16) * ldc + col0;
                const float rs = rsv[ai][m];
#pragma unroll
                for (int bj = 0; bj < 2; ++bj) { const f32x4 v0 = acc[ai][bj][m][0] * rs, v1 = acc[ai][bj][m][1] * rs;
                    u32x4 w; w.x = pk2(v0[0], v0[1]); w.y = pk2(v0[2], v0[3]); w.z = pk2(v1[0], v1[1]); w.w = pk2(v1[2], v1[3]);
                    *(u32x4*)(rowp + bj * 128) = w; } }
    }
};
struct EpiGU {
    static constexpr bool PERM = true, AFTER_DRAIN = false;
    bf16_t* H; const float* ssq;
    DI void operator()(const f32x4 (&acc)[2][2][4][2], const pg8::Unit& u, int wr, int wc, int fr, int fq) const {
        const int row0 = u.pm * 256 + wr * 64 + fr, col0 = u.pn * 128 + wc * 32 + 8 * fq;
        float rsv[2][4]; rows_rstd(ssq, row0, fq, rsv);
#pragma unroll
        for (int ai = 0; ai < 2; ++ai)
#pragma unroll
            for (int m = 0; m < 4; ++m) { bf16_t* rowp = H + (size_t)(row0 + ai * 128 + m * 16) * 2816 + col0;
                const float rs = rsv[ai][m];
                float o[8];
#pragma unroll
                for (int n = 0; n < 2; ++n)
#pragma unroll
                    for (int j = 0; j < 4; ++j) o[4 * n + j] = silu_f(acc[ai][0][m][n][j] * rs) * (acc[ai][1][m][n][j] * rs);
                *(u32x4*)rowp = PACK8(o); }
    }
};
struct EpiRes {
    static constexpr bool PERM = false, AFTER_DRAIN = false;
    bf16_t* XB; float* SSQ; float* OUT; float sc;
    DI void operator()(const f32x4 (&acc)[2][2][4][2], const pg8::Unit& u, int wr, int wc, int fr, int fq) const {
        const int row0 = u.pm * 256 + wr * 64 + fr, col0 = u.pn * 256 + wc * 32 + 4 * fq;
#pragma unroll
        for (int ai = 0; ai < 2; ++ai) {
            u32x2 xv[4][2][2];
#pragma unroll
            for (int m = 0; m < 4; ++m)
#pragma unroll
                for (int bj = 0; bj < 2; ++bj)
#pragma unroll
                    for (int n = 0; n < 2; ++n) xv[m][bj][n] = *(const u32x2*)(XB + (size_t)(row0 + ai * 128 + m * 16) * 1024 + col0 + bj * 128 + n * 16);
#pragma unroll
            for (int m = 0; m < 4; ++m) { const int row = row0 + ai * 128 + m * 16; const size_t ro = (size_t)row * 1024 + col0;
                float ss = 0.f;
#pragma unroll
                for (int bj = 0; bj < 2; ++bj)
#pragma unroll
                    for (int n = 0; n < 2; ++n) { const u32x2 xo = xv[m][bj][n]; const f32x4 a = acc[ai][bj][m][n];
                        const f32x4 v = {bflo(xo.x) + a[0] * sc, bfhi(xo.x) + a[1] * sc, bflo(xo.y) + a[2] * sc, bfhi(xo.y) + a[3] * sc};
                        if (OUT) *(f32x4*)(OUT + ro + bj * 128 + n * 16) = v;
                        else *(u32x2*)(XB + ro + bj * 128 + n * 16) = (u32x2){pk2(v[0], v[1]), pk2(v[2], v[3])};
                        ss += v[0] * v[0] + v[1] * v[1] + v[2] * v[2] + v[3] * v[3]; }
                ss += __shfl_xor(ss, 16); ss += __shfl_xor(ss, 32);
                if (fq == 0) SSQ[(size_t)row * 16 + u.pn * 4 + wc] = ss; }
        }
    }
};
struct EpiMerge {
    static constexpr bool PERM = false, AFTER_DRAIN = false;
    const bf16_t* P; bf16_t* MIX; const float* ssq;
    DI void operator()(const f32x4 (&acc)[2][2][4][2], const pg8::Unit& u, int wr, int wc, int fr, int fq) const {
        const int row0 = u.pm * 256 + wr * 64 + fr, e0 = u.pn * 64 + wc * 16 + 4 * fq;
        float rsv[2][4]; rows_rstd(ssq, row0, fq, rsv);
#pragma unroll
        for (int ai = 0; ai < 2; ++ai) {
            u32x2 pv[4][4];
#pragma unroll
            for (int m = 0; m < 4; ++m)
#pragma unroll
                for (int b = 0; b < 4; ++b) pv[m][b] = *(const u32x2*)(P + (size_t)b * TG * 1024 + (size_t)(row0 + ai * 128 + m * 16) * 1024 + e0);
#pragma unroll
            for (int m = 0; m < 4; ++m) { const float rs = rsv[ai][m];
                float o[4] = {0.f, 0.f, 0.f, 0.f};
#pragma unroll
                for (int bj = 0; bj < 2; ++bj)
#pragma unroll
                    for (int n = 0; n < 2; ++n) { const u32x2 q = pv[m][2 * bj + n]; const f32x4 g = acc[ai][bj][m][n] * rs;
                        o[0] += sigmoid_f(g[0]) * bflo(q.x); o[1] += sigmoid_f(g[1]) * bfhi(q.x); o[2] += sigmoid_f(g[2]) * bflo(q.y); o[3] += sigmoid_f(g[3]) * bfhi(q.y); }
                *(u32x2*)(MIX + (size_t)(row0 + ai * 128 + m * 16) * 1024 + e0) = (u32x2){pk2(o[0], o[1]), pk2(o[2], o[3])}; }
        }
    }
};
struct BranchOrder {
    int G, c;
    DI bool next(int i, pg8::Unit& u) const { const int L = i * G + c; if (L >= 1024) return false; const int br = L >> 8, rem = L & 255; u.pm = br * 64 + (rem >> 2); u.pn = br * 4 + (rem & 3); return true; }
    DI void a_ready(const pg8::Unit&) const {}
    DI void done(const pg8::Unit&) const {}
};
template <class Epi> DI void run_gemm(LAS unsigned char* lds, const bf16_t* A, const bf16_t* Bt, int M, int N, int K, const Epi& E) {
    pg8::Gemm g{A, Bt, M, N, K}; pg8::StaticOrder S; S.init(M, N, nwg_now(), wg_now());
    pg8::gemm_phase<Epi, pg8::StaticOrder>(lds, g, S, E);
}

DI void conv_mat(const float* src, int ld, int c0, int nvalid, int kvalid, int mode, bf16_t* dst, int Nd, int Kd, LAS float* scr, int wg, int nwg, const float* ksc = nullptr) {
    const int tid = tid_now(); const int ntk = Kd >> 6, ntiles = (Nd >> 6) * ntk;
    for (int tile = wg; tile < ntiles; tile += nwg) {
        const int n0 = (tile / ntk) << 6, k0 = (tile % ntk) << 6;
        const int nn = tid & 63, kq = tid >> 6, n = n0 + nn;
        int col;
        if (mode == 1) { const int blk = n >> 7; col = ((blk & 1) ? 2816 : 0) + (blk >> 1) * 128 + (n & 127); }
        else if (mode == 2) { const int c = n & 255, br = 2 * (c >> 7) + ((c >> 4) & 1), e = 64 * (n >> 8) + 16 * ((c >> 5) & 3) + (c & 15); col = c0 + br * 1024 + e; }
        else col = c0 + n;
#pragma unroll
        for (int i = 0; i < 8; ++i) { const int kk = i * 8 + kq; float v = 0.f;
            if (k0 + kk < kvalid && n < nvalid) { v = src[(size_t)(k0 + kk) * ld + col]; if (ksc) v *= ksc[k0 + kk]; }
            scr[kk * 65 + nn] = v; }
        __syncthreads();
        { const int nr = tid >> 3, kc = tid & 7; const LAS float* sp = scr + (kc * 8) * 65 + nr;
          u32x4 o; o.x = pk2(sp[0], sp[65]); o.y = pk2(sp[130], sp[195]); o.z = pk2(sp[260], sp[325]); o.w = pk2(sp[390], sp[455]);
          *(u32x4*)(dst + (size_t)(n0 + nr) * Kd + k0 + kc * 8) = o; }
        __syncthreads();
    }
}
DI void convert_layer(const Params& p, int l, LAS float* scr, int wg, int nwg) {
    unsigned char* ws = p.ws;
    conv_mat(p.in[3] + (size_t)l * 1024 * 5632, 5632, 0, 5632, 1024, 1, (bf16_t*)(ws + O_WGU1), 5632, 1024, scr, wg, nwg, p.in[2] + l * 1024);
    conv_mat(p.in[26] + (size_t)l * 1024 * 5632, 5632, 0, 5632, 1024, 1, (bf16_t*)(ws + O_WGU2), 5632, 1024, scr, wg, nwg, p.in[25] + l * 1024);
    conv_mat(p.in[4] + (size_t)l * 2816 * 1024, 1024, 0, 1024, 2816, 0, (bf16_t*)(ws + O_WD1), 1024, 2816, scr, wg, nwg);
    conv_mat(p.in[27] + (size_t)l * 2816 * 1024, 1024, 0, 1024, 2816, 0, (bf16_t*)(ws + O_WD2), 1024, 2816, scr, wg, nwg);
    conv_mat(p.in[6] + (size_t)l * 1024 * 8776, 8776, 0, 4680, 1024, 0, (bf16_t*)(ws + O_WIN), 4864, 1024, scr, wg, nwg, p.in[5] + l * 1024);
    conv_mat(p.in[6] + (size_t)l * 1024 * 8776, 8776, 4680, 4096, 1024, 2, (bf16_t*)(ws + O_WGATE), 4096, 1024, scr, wg, nwg, p.in[5] + l * 1024);
#pragma unroll 1
    for (int i = 0; i < 4; ++i)
        conv_mat(p.in[23] + ((size_t)l * 4 + i) * 512 * 1024, 1024, 0, 1024, 512, 0, (bf16_t*)(ws + O_WBR) + (size_t)i * 1024 * 512, 1024, 512, scr, wg, nwg);
    conv_mat(p.in[24] + (size_t)l * 1024 * 1024, 1024, 0, 1024, 1024, 0, (bf16_t*)(ws + O_WOUT), 1024, 1024, scr, wg, nwg);
    conv_mat(p.in[17] + (size_t)l * 384 * 768, 768, 0, 768, 384, 0, (bf16_t*)(ws + O_WQB), 768, 384, scr, wg, nwg);
    conv_mat(p.in[19] + (size_t)l * 128 * 1024, 1024, 0, 1024, 128, 0, (bf16_t*)(ws + O_WKVB), 1024, 256, scr, wg, nwg);
}

DI void init_rows(const float* x, bf16_t* xb, float* ssq) {
    const int tidn = tid_now(); const int lane = tidn & 63, gwave = wg_now() * 8 + (tidn >> 6), ngw = nwg_now() * 8;
    for (int row = gwave; row < T_ALL; row += ngw) {
        const f32x4* xr = (const f32x4*)(x + (size_t)row * 1024);
        f32x4 v[4]; float ss = 0.f;
#pragma unroll
        for (int j = 0; j < 4; ++j) { v[j] = xr[lane + 64 * j]; ss += v[j][0] * v[j][0] + v[j][1] * v[j][1] + v[j][2] * v[j][2] + v[j][3] * v[j][3]; }
        ss = wave_sum(ss);
        u32x2* o = (u32x2*)(xb + (size_t)row * 1024);
#pragma unroll
        for (int j = 0; j < 4; ++j) o[lane + 64 * j] = (u32x2){pk2(v[j][0], v[j][1]), pk2(v[j][2], v[j][3])};
        if (lane < 16) ssq[(size_t)row * 16 + lane] = lane == 0 ? ss : 0.f;
    }
}
DI void zero_f32(float* q, int n) { const int tidn = tid_now(); for (int i = wg_now() * 512 + tidn; i < n; i += nwg_now() * 512) q[i] = 0.f; }

DI void prep1(const Params& p, int l, const bf16_t* proj, bf16_t* xbcc, float* dtb, bf16_t* aq, bf16_t* akv, bf16_t* yd) {
    const int tidn = tid_now(); const int gtid = wg_now() * 512 + tidn, gthreads = nwg_now() * 512;
    const float* cw = p.in[7] + l * 4096; const float* cb = p.in[8] + l * 1024;
    for (int idx = gtid; idx < (TG / 16) * 128; idx += gthreads) {
        const int c8 = (idx & 127) << 3, tl0 = (idx >> 7) << 4, s0 = tl0 & 2047;
        float w[4][8], bb[8], r0[8], r1[8], r2[8];
#pragma unroll
        for (int k = 0; k < 4; ++k) { const f32x4 a = *(const f32x4*)(cw + k * 1024 + c8), b = *(const f32x4*)(cw + k * 1024 + c8 + 4);
#pragma unroll
            for (int j = 0; j < 4; ++j) { w[k][j] = a[j]; w[k][4 + j] = b[j]; } }
        { const f32x4 a = *(const f32x4*)(cb + c8), b = *(const f32x4*)(cb + c8 + 4);
#pragma unroll
          for (int j = 0; j < 4; ++j) { bb[j] = a[j]; bb[4 + j] = b[j]; } }
        const bf16_t* src = proj + (size_t)tl0 * PLD + 512 + c8;
        if (s0 > 0) { const u32x4 v0 = *(const u32x4*)(src - 3 * PLD), v1 = *(const u32x4*)(src - 2 * PLD), v2 = *(const u32x4*)(src - PLD); UNPACK8(v0, r0); UNPACK8(v1, r1); UNPACK8(v2, r2); }
        else {
#pragma unroll
            for (int j = 0; j < 8; ++j) { r0[j] = 0.f; r1[j] = 0.f; r2[j] = 0.f; } }
#pragma unroll 4
        for (int tt = 0; tt < 16; ++tt) {
            const u32x4 v = *(const u32x4*)(src + (size_t)tt * PLD); float cur[8], o[8]; UNPACK8(v, cur);
#pragma unroll
            for (int j = 0; j < 8; ++j) { o[j] = silu_f(bb[j] + w[0][j] * r0[j] + w[1][j] * r1[j] + w[2][j] * r2[j] + w[3][j] * cur[j]); r0[j] = r1[j]; r1[j] = r2[j]; r2[j] = cur[j]; }
            *(u32x4*)(xbcc + (size_t)(tl0 + tt) * 1024 + c8) = PACK8(o);
        }
    }
    const float* sw = p.in[22] + l * 1536;
    for (int idx = gtid; idx < (TG / 16) * 64; idx += gthreads) {
        const int c8 = (idx & 63) << 3, tl0 = (idx >> 6) << 4, s0 = tl0 & 2047;
        float w[3][8], p1[8], p2[8];
#pragma unroll
        for (int k = 0; k < 3; ++k) { const f32x4 a = *(const f32x4*)(sw + k * 512 + c8), b = *(const f32x4*)(sw + k * 512 + c8 + 4);
#pragma unroll
            for (int j = 0; j < 4; ++j) { w[k][j] = a[j]; w[k][4 + j] = b[j]; } }
        const bf16_t* src = proj + (size_t)tl0 * PLD + c8;
        if (s0 > 0) { const u32x4 c1 = *(const u32x4*)(src - 2 * PLD + 3656), x1 = *(const u32x4*)(src - 2 * PLD + 4168), c2 = *(const u32x4*)(src - PLD + 3656), x2 = *(const u32x4*)(src - PLD + 4168);
            float a[8], b[8]; UNPACK8(c1, a); UNPACK8(x1, b);
#pragma unroll
            for (int j = 0; j < 8; ++j) p1[j] = a[j] * b[j];
            UNPACK8(c2, a); UNPACK8(x2, b);
#pragma unroll
            for (int j = 0; j < 8; ++j) p2[j] = a[j] * b[j]; }
        else {
#pragma unroll
            for (int j = 0; j < 8; ++j) { p1[j] = 0.f; p2[j] = 0.f; } }
#pragma unroll 4
        for (int tt = 0; tt < 16; ++tt) {
            const bf16_t* pr = src + (size_t)tt * PLD;
            const u32x4 vc = *(const u32x4*)(pr + 3656), vx = *(const u32x4*)(pr + 4168), vb = *(const u32x4*)(pr + 3144);
            float fc[8], fx[8], fb[8], o[8]; UNPACK8(vc, fc); UNPACK8(vx, fx); UNPACK8(vb, fb);
#pragma unroll
            for (int j = 0; j < 8; ++j) { const float cur = fc[j] * fx[j]; o[j] = fb[j] * (w[0][j] * p1[j] + w[1][j] * p2[j] + w[2][j] * cur); p1[j] = p2[j]; p2[j] = cur; }
            *(u32x4*)(yd + (size_t)(tl0 + tt) * 512 + c8) = PACK8(o);
        }
    }
    const int gwave = gtid >> 6, ngw = gthreads >> 6, lane = tidn & 63;
    const float* qn = p.in[16] + l * 384; const float* kn = p.in[18] + l * 128;
    for (int tl = gwave; tl < TG; tl += ngw) {
        const bf16_t* pr = proj + (size_t)tl * PLD;
        const u32x4 v = *(const u32x4*)(pr + 2568 + lane * 8); float f[8]; UNPACK8(v, f);
        float ss = 0.f;
#pragma unroll
        for (int j = 0; j < 8; ++j) ss += f[j] * f[j];
        const float ssq = wave_sum(lane < 48 ? ss : 0.f), ssk = wave_sum(lane >= 48 ? ss : 0.f);
        if (lane < 48) {
            const float rstd = rsqrtf(ssq * (1.f / 384.f) + EPS);
#pragma unroll
            for (int j = 0; j < 8; ++j) f[j] *= rstd * qn[lane * 8 + j];
            *(u32x4*)(aq + (size_t)tl * 384 + lane * 8) = PACK8(f);
        } else {
            const float rstd = rsqrtf(ssk * (1.f / 128.f) + EPS);
#pragma unroll
            for (int j = 0; j < 8; ++j) f[j] *= rstd * kn[(lane - 48) * 8 + j];
            *(u32x4*)(akv + (size_t)tl * 256 + (lane - 48) * 8) = PACK8(f);
            { unsigned z = 0u; asm volatile("" : "+v"(z)); *(u32x4*)(akv + (size_t)tl * 256 + 128 + (lane - 48) * 8) = (u32x4){z, z, z, z}; }
        }
        if (lane < 8) {
            const float xr = bf2f(pr[1536 + lane]) + p.in[9][l * 8 + lane];
            const float dt = xr > 20.f ? xr : log1pf(expf(xr));
            const float A = -expf(p.in[10][l * 8 + lane]);
            dtb[(size_t)tl * 16 + lane] = dt; dtb[(size_t)tl * 16 + 8 + lane] = dt * A;
        }
    }
}

DI void rope_table(const Params& p, f32x2* CS) {
    const int* pos = (const int*)p.in[1];
    const int tidn = tid_now();
    for (int idx = wg_now() * 512 + tidn; idx < T_ALL * 32; idx += nwg_now() * 512) {
        const float invf = exp2f(-(float)(idx & 31) * (13.287712379549449f / 32.f));
        const float ang = (float)pos[idx >> 5] * invf;
        CS[idx] = (f32x2){cosf(ang), sinf(ang)};
    }
}
DI void prep2_unit(const Params& p, int l, int g, const bf16_t* proj, const bf16_t* qraw, const bf16_t* kvraw, const f32x2* CS, bf16_t* Qf, bf16_t* Kf, bf16_t* Vt, int bl, int tile, LAS unsigned char* lds) {
    const int tid = tid_now(), wave = tid >> 6, lane = tid & 63;
    const float* wq = p.in[20] + l * 192; const float* wk = p.in[21] + l * 192;
    const float qscale = 0.07216878364870322f * 1.4426950408889634f;
    const float wq0 = wq[lane], wq1 = wq[64 + lane], wq2 = wq[128 + lane], wk0 = wk[lane], wk1 = wk[64 + lane], wk2 = wk[128 + lane];
    LAS bf16_t* img = (LAS bf16_t*)lds;
    const int t0 = tile * 64;
#pragma unroll 1
    for (int tt = 0; tt < 8; ++tt) {
        const int tloc = wave * 8 + tt, s = t0 + tloc; const size_t tl = (size_t)bl * SEQ + s;
        const f32x2 cssn = CS[((size_t)(g * BPG + bl) * SEQ + s) * 32 + (lane & 31)];
        const float cs = cssn[0], sn = cssn[1];
        const float kpe = bf2f(proj[tl * PLD + 3080 + lane]);
#pragma unroll
        for (int h = 0; h < 4; ++h) {
            const size_t ob = ((size_t)(bl * 4 + h) * SEQ + s) * 192;
            {
                const bf16_t* qr = qraw + tl * 768 + h * 192;
                float q0 = bf2f(qr[lane]), q1 = bf2f(qr[64 + lane]), q2 = bf2f(qr[128 + lane]);
                const float r = rsqrtf(wave_sum(q0 * q0 + q1 * q1 + q2 * q2) * (1.f / 192.f) + EPS);
                q0 *= r * wq0; q1 *= r * wq1; q2 *= r * wq2;
                const float qp = __shfl_xor(q2, 32);
                q2 = (lane < 32) ? q2 * cs - qp * sn : q2 * cs + qp * sn;
                bf16_t* qo = Qf + ob;
                qo[lane] = f2bf(q0 * qscale); qo[64 + lane] = f2bf(q1 * qscale); qo[128 + lane] = f2bf(q2 * qscale);
            }
            const bf16_t* kr = kvraw + tl * 1024 + h * 256;
            {
                float k0 = bf2f(kr[lane]), k1 = bf2f(kr[64 + lane]), k2 = kpe;
                const float r = rsqrtf(wave_sum(k0 * k0 + k1 * k1 + k2 * k2) * (1.f / 192.f) + EPS);
                k0 *= r * wk0; k1 *= r * wk1; k2 *= r * wk2;
                const float kp = __shfl_xor(k2, 32);
                k2 = (lane < 32) ? k2 * cs - kp * sn : k2 * cs + kp * sn;
                bf16_t* ko = Kf + ob;
                ko[lane] = f2bf(k0); ko[64 + lane] = f2bf(k1); ko[128 + lane] = f2bf(k2);
            }
            img[(h * 128 + lane) * 72 + tloc] = kr[128 + lane]; img[(h * 128 + 64 + lane) * 72 + tloc] = kr[192 + lane];
        }
    }
    __syncthreads();
#pragma unroll
    for (int i = 0; i < 8; ++i) {
        const int ch = tid + 512 * i, row = ch >> 3, cc = ch & 7;
        *(u32x4*)(Vt + ((size_t)(bl * 4 + (row >> 7)) * 128 + (row & 127)) * SEQ + t0 + cc * 8) = *(const LAS u32x4*)(lds + row * 144 + cc * 16);
    }
    __syncthreads();
}

constexpr int KP = 400, VP = 136, KBYTES = 64 * KP, VBYTES = 128 * VP, ASTAGE = KBYTES + VBYTES;
DI void attn_unit(const bf16_t* Qf, const bf16_t* Kf, const bf16_t* Vt, bf16_t* yc, int bh, int qb, LAS unsigned char* lds) {
    const int tid = tid_now(), wave = tid >> 6, lane = tid & 63, r31 = lane & 31, hh = lane >> 5;
    const int q0 = qb * 256, qrow = q0 + wave * 32 + r31;
    const bf16_t* Qp = Qf + ((size_t)bh * SEQ + qrow) * 192 + 8 * hh;
    bf16x8 qf[12];
#pragma unroll
    for (int kk = 0; kk < 12; ++kk) qf[kk] = *(const bf16x8*)(Qp + kk * 16);
    f32x16 o[4];
#pragma unroll
    for (int d = 0; d < 4; ++d)
#pragma unroll
        for (int i = 0; i < 16; ++i) o[d][i] = 0.f;
    float m = -1e30f, l = 0.f;
    const int ntiles = qb * 4 + 4;
    const bf16_t* Kb = Kf + (size_t)bh * SEQ * 192; const bf16_t* Vb = Vt + (size_t)bh * 128 * SEQ;
    int krow[3], kcc[3], vd[2], vcc[2];
#pragma unroll
    for (int i = 0; i < 3; ++i) { const int c = tid + 512 * i; krow[i] = c / 24; kcc[i] = c % 24; }
#pragma unroll
    for (int i = 0; i < 2; ++i) { const int c = tid + 512 * i; vd[i] = c >> 3; vcc[i] = c & 7; }
    u32x4 kreg[3], vreg[2];
#define ATT_GLOAD(j) do { _Pragma("unroll") for (int i = 0; i < 3; ++i) kreg[i] = *(const u32x4*)(Kb + (size_t)((j) * 64 + krow[i]) * 192 + kcc[i] * 8); \
        _Pragma("unroll") for (int i = 0; i < 2; ++i) vreg[i] = *(const u32x4*)(Vb + (size_t)vd[i] * SEQ + (j) * 64 + vcc[i] * 8); } while (0)
#define ATT_LSTORE(st) do { LAS unsigned char* b_ = lds + (st) * ASTAGE; \
        _Pragma("unroll") for (int i = 0; i < 3; ++i) *(LAS u32x4*)(b_ + krow[i] * KP + kcc[i] * 16) = kreg[i]; \
        _Pragma("unroll") for (int i = 0; i < 2; ++i) { LAS u32x2* d_ = (LAS u32x2*)(b_ + KBYTES + vd[i] * VP + vcc[i] * 16); d_[0] = (u32x2){vreg[i].x, vreg[i].y}; d_[1] = (u32x2){vreg[i].z, vreg[i].w}; } } while (0)
    ATT_GLOAD(0); ATT_LSTORE(0);
    __syncthreads();
    for (int j = 0; j < ntiles; ++j) {
        const int cur = j & 1;
        if (j + 1 < ntiles) ATT_GLOAD(j + 1);
        if (j * 64 <= q0 + wave * 32 + 31) {
            const LAS unsigned char* Kl = lds + cur * ASTAGE; const LAS unsigned char* Vl = Kl + KBYTES;
            f32x16 s0, s1;
#pragma unroll
            for (int i = 0; i < 16; ++i) { s0[i] = 0.f; s1[i] = 0.f; }
#pragma unroll
            for (int kk = 0; kk < 12; ++kk) {
                const bf16x8 a0 = *(const LAS bf16x8*)(Kl + r31 * KP + (kk * 16 + 8 * hh) * 2);
                const bf16x8 a1 = *(const LAS bf16x8*)(Kl + (32 + r31) * KP + (kk * 16 + 8 * hh) * 2);
                s0 = MFMA32(a0, qf[kk], s0); s1 = MFMA32(a1, qf[kk], s1);
            }
            if (j * 64 + 63 > q0 + wave * 32) {
#pragma unroll
                for (int i = 0; i < 16; ++i) { const int key = j * 64 + crow(i, hh); if (key > qrow) s0[i] = -1e30f; if (key + 32 > qrow) s1[i] = -1e30f; }
            }
            float mx = s0[0];
#pragma unroll
            for (int i = 1; i < 16; ++i) mx = fmaxf(mx, s0[i]);
#pragma unroll
            for (int i = 0; i < 16; ++i) mx = fmaxf(mx, s1[i]);
            mx = fmaxf(mx, __shfl_xor(mx, 32));
            const float mn = fmaxf(m, mx), alpha = __builtin_amdgcn_exp2f(m - mn);
            m = mn;
            float ls = 0.f;
#pragma unroll
            for (int i = 0; i < 16; ++i) { s0[i] = __builtin_amdgcn_exp2f(s0[i] - mn); s1[i] = __builtin_amdgcn_exp2f(s1[i] - mn); ls += s0[i] + s1[i]; }
            l = l * alpha + ls;
#pragma unroll
            for (int d = 0; d < 4; ++d)
#pragma unroll
                for (int i = 0; i < 16; ++i) o[d][i] *= alpha;
            bf16x8 pf[2][2];
#pragma unroll
            for (int s = 0; s < 2; ++s) {
                u32x4 w0, w1;
                w0.x = pk2(s0[8 * s], s0[8 * s + 1]); w0.y = pk2(s0[8 * s + 2], s0[8 * s + 3]); w0.z = pk2(s0[8 * s + 4], s0[8 * s + 5]); w0.w = pk2(s0[8 * s + 6], s0[8 * s + 7]);
                w1.x = pk2(s1[8 * s], s1[8 * s + 1]); w1.y = pk2(s1[8 * s + 2], s1[8 * s + 3]); w1.z = pk2(s1[8 * s + 4], s1[8 * s + 5]); w1.w = pk2(s1[8 * s + 6], s1[8 * s + 7]);
                pf[0][s] = __builtin_bit_cast(bf16x8, w0); pf[1][s] = __builtin_bit_cast(bf16x8, w1);
            }
#pragma unroll
            for (int d = 0; d < 4; ++d)
#pragma unroll
                for (int kb = 0; kb < 2; ++kb)
#pragma unroll
                    for (int s = 0; s < 2; ++s) {
                        const LAS unsigned char* vp = Vl + (d * 32 + r31) * VP + (kb * 32 + 16 * s + 4 * hh) * 2;
                        const s16x4 lo = *(const LAS s16x4*)vp, hi = *(const LAS s16x4*)(vp + 16);
                        const bf16x8 a = __builtin_shufflevector(lo, hi, 0, 1, 2, 3, 4, 5, 6, 7);
                        o[d] = MFMA32(a, pf[kb][s], o[d]);
                    }
        }
        if (j + 1 < ntiles) ATT_LSTORE(cur ^ 1);
        __syncthreads();
    }
#undef ATT_GLOAD
#undef ATT_LSTORE
    l += __shfl_xor(l, 32);
    const float inv = 1.f / l;
    const int bl = bh >> 2, h = bh & 3;
    bf16_t* op = yc + ((size_t)bl * SEQ + qrow) * 512 + h * 128 + 4 * hh;
#pragma unroll
    for (int d = 0; d < 4; ++d)
#pragma unroll
        for (int i4 = 0; i4 < 4; ++i4)
            *(u32x2*)(op + d * 32 + 8 * i4) = (u32x2){pk2(o[d][4 * i4] * inv, o[d][4 * i4 + 1] * inv), pk2(o[d][4 * i4 + 2] * inv, o[d][4 * i4 + 3] * inv)};
}

DI void gmlp_unit(const Params& p, int l, const bf16_t* proj, bf16_t* yb, int bl, int c, LAS unsigned char* lds) {
    const int tid = tid_now(), wave = tid >> 6, lane = tid & 63, r31 = lane & 31, hh = lane >> 5;
    const float* wsp = p.in[14] + (size_t)l * 4 * 128 * 128; const float* bs = p.in[15] + l * 512; const float* vn = p.in[13] + l * 512;
    const size_t tl0 = (size_t)bl * SEQ + c * 128;
    float w8[8];
#pragma unroll
    for (int j = 0; j < 8; ++j) w8[j] = vn[lane + 64 * j];
    LAS bf16_t* vt = (LAS bf16_t*)lds;
#pragma unroll 2
    for (int rr = 0; rr < 16; ++rr) {
        const int row = wave * 16 + rr;
        const bf16_t* vr = proj + (tl0 + row) * PLD + 2056 + lane;
        float f[8]; float ss = 0.f;
#pragma unroll
        for (int j = 0; j < 8; ++j) { f[j] = gelu_f(bf2f(vr[64 * j])); ss += f[j] * f[j]; }
        const float rstd = rsqrtf(wave_sum(ss) * (1.f / 512.f) + EPS);
#pragma unroll
        for (int j = 0; j < 8; ++j) vt[(lane + 64 * j) * 136 + row] = f2bf(f[j] * rstd * w8[j]);
    }
    __syncthreads();
    const int mb = wave & 3, nh = wave >> 2, trow = mb * 32 + r31;
#pragma unroll 1
    for (int g = 0; g < 4; ++g) {
        f32x16 a0, a1;
#pragma unroll
        for (int i = 0; i < 16; ++i) { a0[i] = 0.f; a1[i] = 0.f; }
        const float* wrow = wsp + ((size_t)g * 128 + trow) * 128 + 8 * hh;
#pragma unroll
        for (int kk = 0; kk < 8; ++kk) if (kk * 16 <= mb * 32 + 31) {
            const f32x4 x0 = *(const f32x4*)(wrow + kk * 16), x1 = *(const f32x4*)(wrow + kk * 16 + 4);
            const int sb = kk * 16 + 8 * hh;
            float f[8];
#pragma unroll
            for (int j = 0; j < 4; ++j) { f[j] = (sb + j <= trow) ? x0[j] : 0.f; f[4 + j] = (sb + 4 + j <= trow) ? x1[j] : 0.f; }
            const bf16x8 a = __builtin_bit_cast(bf16x8, PACK8(f));
            const bf16x8 b0 = *(const LAS bf16x8*)(vt + (g * 128 + nh * 64 + r31) * 136 + kk * 16 + 8 * hh);
            const bf16x8 b1 = *(const LAS bf16x8*)(vt + (g * 128 + nh * 64 + 32 + r31) * 136 + kk * 16 + 8 * hh);
            a0 = MFMA32(a, b0, a0); a1 = MFMA32(a, b1, a1);
        }
#pragma unroll
        for (int i = 0; i < 16; ++i) {
            const int t = mb * 32 + crow(i, hh); const float bias = bs[g * 128 + t];
            const bf16_t* ur = proj + (tl0 + t) * PLD + 1544 + g * 128 + nh * 64 + r31;
            bf16_t* orow = yb + (tl0 + t) * 512 + g * 128 + nh * 64 + r31;
            orow[0] = f2bf(gelu_f(bf2f(ur[0])) * (a0[i] + bias));
            orow[32] = f2bf(gelu_f(bf2f(ur[32])) * (a1[i] + bias));
        }
    }
    __syncthreads();
}

constexpr int SP = 136;
DI void scan128(float& v0, float& v1, int lane) {
#pragma unroll
    for (int o = 1; o < 64; o <<= 1) { const float n0 = __shfl_up(v0, o), n1 = __shfl_up(v1, o); if (lane >= o) { v0 += n0; v1 += n1; } }
    v1 += __shfl(v0, 63);
}
DI void ssd_states_unit(const bf16_t* xbcc, const float* dtb, float* ST, float* ATOT, int bl, int c, int grp, LAS unsigned char* lds) {
    const int tid = tid_now(), wave = tid >> 6, lane = tid & 63, r31 = lane & 31, hh = lane >> 5;
    LAS bf16_t* BT = (LAS bf16_t*)lds; LAS bf16_t* XT = (LAS bf16_t*)(lds + 34816); LAS float* WS = (LAS float*)(lds + 104448);
    const size_t row0 = (size_t)bl * SEQ + c * 128;
    if (wave < 4) {
        const int h = grp * 4 + wave;
        const float d0 = dtb[(row0 + lane) * 16 + h], d1 = dtb[(row0 + 64 + lane) * 16 + h];
        float v0 = dtb[(row0 + lane) * 16 + 8 + h], v1 = dtb[(row0 + 64 + lane) * 16 + 8 + h];
        scan128(v0, v1, lane);
        const float tot = __shfl(v1, 63);
        WS[wave * 128 + lane] = d0 * __expf(tot - v0); WS[wave * 128 + 64 + lane] = d1 * __expf(tot - v1);
        if (lane == 0) ATOT[(bl * 16 + c) * 8 + h] = tot;
    }
    __syncthreads();
#pragma unroll
    for (int i = 0; i < 4; ++i) {
        const int ch = tid + 512 * i, s = ch >> 4, n8 = (ch & 15) * 8;
        const u32x4 v = *(const u32x4*)(xbcc + (row0 + s) * 1024 + 512 + grp * 128 + n8);
        LAS bf16_t* d = BT + n8 * SP + s;
        d[0] = (bf16_t)(v.x & 0xffffu); d[SP] = (bf16_t)(v.x >> 16); d[2 * SP] = (bf16_t)(v.y & 0xffffu); d[3 * SP] = (bf16_t)(v.y >> 16);
        d[4 * SP] = (bf16_t)(v.z & 0xffffu); d[5 * SP] = (bf16_t)(v.z >> 16); d[6 * SP] = (bf16_t)(v.w & 0xffffu); d[7 * SP] = (bf16_t)(v.w >> 16);
    }
#pragma unroll
    for (int i = 0; i < 8; ++i) {
        const int ch = tid + 512 * i, s = ch >> 5, c8 = (ch & 31) * 8;
        const u32x4 v = *(const u32x4*)(xbcc + (row0 + s) * 1024 + grp * 256 + c8); float f[8]; UNPACK8(v, f);
        const float w = WS[(c8 >> 6) * 128 + s];
        LAS bf16_t* d = XT + c8 * SP + s;
#pragma unroll
        for (int j = 0; j < 8; ++j) d[j * SP] = f2bf(f[j] * w);
    }
    __syncthreads();
    const int hl = wave >> 1, pb = wave & 1;
    f32x16 acc[4];
#pragma unroll
    for (int nb = 0; nb < 4; ++nb)
#pragma unroll
        for (int i = 0; i < 16; ++i) acc[nb][i] = 0.f;
#pragma unroll
    for (int k = 0; k < 8; ++k) {
        const bf16x8 a = *(const LAS bf16x8*)(XT + (hl * 64 + pb * 32 + r31) * SP + k * 16 + 8 * hh);
#pragma unroll
        for (int nb = 0; nb < 4; ++nb) { const bf16x8 b = *(const LAS bf16x8*)(BT + (nb * 32 + r31) * SP + k * 16 + 8 * hh); acc[nb] = MFMA32(a, b, acc[nb]); }
    }
    float* so = ST + (((size_t)bl * 16 + c) * 8 + grp * 4 + hl) * 8192;
#pragma unroll
    for (int nb = 0; nb < 4; ++nb)
#pragma unroll
        for (int i = 0; i < 16; ++i) so[(pb * 32 + crow(i, hh)) * 128 + nb * 32 + r31] = acc[nb][i];
    __syncthreads();
}
DI void ssd_scan(const float* ST, bf16_t* STB, const float* ATOT) {
    const int tidn = tid_now();
    for (int idx = wg_now() * 512 + tidn; idx < 64 * 2048; idx += nwg_now() * 512) {
        const int bh = idx >> 11, e4 = idx & 2047, bl = bh >> 3, head = bh & 7;
        const size_t off = ((size_t)bl * 16 * 8 + head) * 8192 + e4 * 4;
        f32x4 sv[16];
#pragma unroll
        for (int c = 0; c < 16; ++c) sv[c] = *(const f32x4*)(ST + off + (size_t)c * 8 * 8192);
        f32x4 run = {0.f, 0.f, 0.f, 0.f};
#pragma unroll
        for (int c = 0; c < 16; ++c) { const float ea = __expf(ATOT[(bl * 16 + c) * 8 + head]);
            *(u32x2*)(STB + off + (size_t)c * 8 * 8192) = (u32x2){pk2(run[0], run[1]), pk2(run[2], run[3])}; run = run * ea + sv[c]; }
    }
}
DI void ssd_out_grp(const Params& p, int l, const bf16_t* proj, const bf16_t* xbcc, const float* dtb, const bf16_t* STB, float* yraw, bf16_t* ya, int bl, int c, int grp, LAS unsigned char* lds) {
    const int tid = tid_now(), wave = tid >> 6, lane = tid & 63, r31 = lane & 31, hh = lane >> 5;
    LAS bf16_t* CL = (LAS bf16_t*)lds; LAS bf16_t* BL = (LAS bf16_t*)(lds + 34816); LAS bf16_t* XT = (LAS bf16_t*)(lds + 69632); LAS bf16_t* PV = (LAS bf16_t*)(lds + 104448);
    LAS float* ACS = (LAS float*)(lds + 139264); LAS float* DTL = (LAS float*)(lds + 140288); LAS float* RS = (LAS float*)(lds + 141312); LAS float* OUT = (LAS float*)(lds + 69632);
    const size_t row0 = (size_t)bl * SEQ + c * 128;
#pragma unroll
    for (int i = 0; i < 4; ++i) {
        const int ch = tid + 512 * i, s = ch >> 4, n8 = (ch & 15) * 8;
        const bf16_t* xr = xbcc + (row0 + s) * 1024;
        *(LAS u32x4*)(CL + s * SP + n8) = *(const u32x4*)(xr + 768 + grp * 128 + n8);
        *(LAS u32x4*)(BL + s * SP + n8) = *(const u32x4*)(xr + 512 + grp * 128 + n8);
    }
#pragma unroll 1
    for (int pi = 0; pi < 2; ++pi) {
        const int pair = grp * 2 + pi;
        if (wave < 2) {
            const int h = pair * 2 + wave;
            const float d0 = dtb[(row0 + lane) * 16 + h], d1 = dtb[(row0 + 64 + lane) * 16 + h];
            float v0 = dtb[(row0 + lane) * 16 + 8 + h], v1 = dtb[(row0 + 64 + lane) * 16 + 8 + h];
            scan128(v0, v1, lane);
            ACS[wave * 128 + lane] = v0; ACS[wave * 128 + 64 + lane] = v1; DTL[wave * 128 + lane] = d0; DTL[wave * 128 + 64 + lane] = d1;
        }
        __syncthreads();
#pragma unroll
        for (int i = 0; i < 4; ++i) {
            const int ch = tid + 512 * i, s = ch >> 4, n8 = (ch & 15) * 8;
            const u32x4 v = *(const u32x4*)(xbcc + (row0 + s) * 1024 + pair * 128 + n8); float f[8]; UNPACK8(v, f);
            const float w = DTL[(n8 >> 6) * 128 + s];
            LAS bf16_t* d = XT + n8 * SP + s;
#pragma unroll
            for (int j = 0; j < 8; ++j) d[j * SP] = f2bf(f[j] * w);
            *(LAS u32x4*)(PV + s * SP + n8) = *(const u32x4*)(STB + (((size_t)bl * 16 + c) * 8 + pair * 2) * 8192 + (size_t)s * 128 + n8);
        }
        __syncthreads();
        const int tb = wave >> 1, hl = wave & 1;
        f32x16 acc[2];
#pragma unroll
        for (int pb = 0; pb < 2; ++pb)
#pragma unroll
            for (int i = 0; i < 16; ++i) acc[pb][i] = 0.f;
        const LAS bf16_t* crw = CL + (tb * 32 + r31) * SP + 8 * hh;
#pragma unroll
        for (int k = 0; k < 8; ++k) {
            const bf16x8 b = *(const LAS bf16x8*)(crw + k * 16);
#pragma unroll
            for (int pb = 0; pb < 2; ++pb) { const bf16x8 a = *(const LAS bf16x8*)(PV + (hl * 64 + pb * 32 + r31) * SP + k * 16 + 8 * hh); acc[pb] = MFMA32(a, b, acc[pb]); }
        }
        const float at = ACS[hl * 128 + tb * 32 + r31], eat = __expf(at);
#pragma unroll
        for (int pb = 0; pb < 2; ++pb)
#pragma unroll
            for (int i = 0; i < 16; ++i) acc[pb][i] *= eat;
#pragma unroll 1
        for (int sb = 0; sb <= tb; ++sb) {
            f32x16 cbt;
#pragma unroll
            for (int i = 0; i < 16; ++i) cbt[i] = 0.f;
#pragma unroll
            for (int k = 0; k < 8; ++k) {
                const bf16x8 a = *(const LAS bf16x8*)(BL + (sb * 32 + r31) * SP + k * 16 + 8 * hh);
                const bf16x8 b = *(const LAS bf16x8*)(crw + k * 16);
                cbt = MFMA32(a, b, cbt);
            }
#pragma unroll
            for (int i = 0; i < 16; ++i) {
                const int sl = crow(i, hh); const float as = ACS[hl * 128 + sb * 32 + sl];
                const float mv = cbt[i] * __expf(fminf(at - as, 0.f));
                cbt[i] = (sb == tb && sl > r31) ? 0.f : mv;
            }
#pragma unroll
            for (int ks = 0; ks < 2; ++ks) {
                u32x4 w; w.x = pk2(cbt[8 * ks], cbt[8 * ks + 1]); w.y = pk2(cbt[8 * ks + 2], cbt[8 * ks + 3]); w.z = pk2(cbt[8 * ks + 4], cbt[8 * ks + 5]); w.w = pk2(cbt[8 * ks + 6], cbt[8 * ks + 7]);
                const bf16x8 pfr = __builtin_bit_cast(bf16x8, w);
#pragma unroll
                for (int pb = 0; pb < 2; ++pb) {
                    const LAS bf16_t* vp = XT + (hl * 64 + pb * 32 + r31) * SP + sb * 32 + 16 * ks + 4 * hh;
                    const s16x4 lo = *(const LAS s16x4*)vp, hi = *(const LAS s16x4*)(vp + 8);
                    const bf16x8 a = __builtin_shufflevector(lo, hi, 0, 1, 2, 3, 4, 5, 6, 7);
                    acc[pb] = MFMA32(a, pfr, acc[pb]);
                }
            }
        }
        __syncthreads();
#pragma unroll
        for (int pb = 0; pb < 2; ++pb)
#pragma unroll
            for (int i = 0; i < 16; ++i) OUT[(tb * 32 + r31) * 132 + hl * 64 + pb * 32 + crow(i, hh)] = acc[pb][i];
        __syncthreads();
#pragma unroll
        for (int i = 0; i < 4; ++i) {
            const int it = tid + 512 * i, t = it >> 4, c8 = (it & 15) * 8;
            const f32x4 y0 = *(const LAS f32x4*)(OUT + t * 132 + c8), y1 = *(const LAS f32x4*)(OUT + t * 132 + c8 + 4);
            const u32x4 xv = *(const u32x4*)(xbcc + (row0 + t) * 1024 + pair * 128 + c8), zv = *(const u32x4*)(proj + (row0 + t) * PLD + pair * 128 + c8);
            float fx[8], fz[8]; UNPACK8(xv, fx); UNPACK8(zv, fz);
            const float Dh = p.in[11][l * 8 + pair * 2 + (c8 >> 6)];
            f32x4 o0, o1;
#pragma unroll
            for (int j = 0; j < 4; ++j) { o0[j] = (y0[j] + Dh * fx[j]) * silu_f(fz[j]); o1[j] = (y1[j] + Dh * fx[4 + j]) * silu_f(fz[4 + j]); }
            float* op = yraw + (row0 + t) * 512 + pair * 128 + c8; *(f32x4*)op = o0; *(f32x4*)(op + 4) = o1;
            float ss = 0.f;
#pragma unroll
            for (int j = 0; j < 4; ++j) ss += o0[j] * o0[j] + o1[j] * o1[j];
            ss += __shfl_xor(ss, 1); ss += __shfl_xor(ss, 2); ss += __shfl_xor(ss, 4); ss += __shfl_xor(ss, 8);
            if ((tid & 15) == 0) RS[t] = pi == 0 ? ss : RS[t] + ss;
        }
        __syncthreads();
    }
    const float* nw = p.in[12] + l * 512 + grp * 256;
#pragma unroll
    for (int i = 0; i < 8; ++i) {
        const int it = tid + 512 * i, t = it >> 5, c8 = (it & 31) * 8;
        const float* yr = yraw + (row0 + t) * 512 + grp * 256 + c8;
        const f32x4 a = *(const f32x4*)yr, b = *(const f32x4*)(yr + 4), w0 = *(const f32x4*)(nw + c8), w1 = *(const f32x4*)(nw + c8 + 4);
        const float rstd = rsqrtf(RS[t] * (1.f / 256.f) + EPS);
        *(u32x4*)(ya + (row0 + t) * 512 + grp * 256 + c8) = (u32x4){pk2(a[0] * rstd * w0[0], a[1] * rstd * w0[1]), pk2(a[2] * rstd * w0[2], a[3] * rstd * w0[3]),
                                                                      pk2(b[0] * rstd * w1[0], b[1] * rstd * w1[1]), pk2(b[2] * rstd * w1[2], b[3] * rstd * w1[3])};
    }
    __syncthreads();
}

#if MULTI_LAUNCH
#define RUNPH(x) ((x) == p.only_phase)
#define GSYNC() do {} while (0)
#else
#define RUNPH(x) true
#define GSYNC() do { XcdBarrier xb_; xb_.bar = (unsigned*)(p.ws + O_BAR); xb_.x = xb_xcc_id(); xb_.st = (volatile LAS unsigned*)(lds + LDS_BYTES - 16); xcd_barrier(xb_); if (PROBE & 1) xcd_barrier(xb_); } while (0)
#endif
#define PH_BEGIN if (RUNPH(ph)) { unsigned char* ws = p.ws; float* X = p.out; asm volatile("" : "+s"(ws), "+s"(X)); const int wg = wg_now(), nwg = nwg_now();
#define PH_END } ++ph; GSYNC();
__global__ void __launch_bounds__(512) mega(Params p) {
    extern __shared__ __attribute__((aligned(16))) unsigned char smem[];
    LAS unsigned char* lds = (LAS unsigned char*)smem;
#if !MULTI_LAUNCH
    cg::grid_group grid = cg::this_grid();
    volatile LAS unsigned* xst = (volatile LAS unsigned*)(lds + LDS_BYTES - 16);
    if (threadIdx.x == 0) { xst[0] = 0u; xst[1] = 0u; }
    __syncthreads();
    (void)xcd_barrier_post((unsigned*)(p.ws + O_BAR), xst);
    grid.sync();
#endif
#define XN ((bf16_t*)(ws + O_XN))
#define SSQ0 ((float*)(ws + O_SSQ))
#define SSQ1 (SSQ0 + (size_t)T_ALL * 16)
#define SSQ2 (SSQ0 + (size_t)2 * T_ALL * 16)
#define H ((bf16_t*)(ws + O_H))
#define PROJ ((bf16_t*)(ws + O_PROJ))
#define XBCC ((bf16_t*)(ws + O_XBCC))
#define ST ((float*)(ws + O_ST))
#define ATOT ((float*)(ws + O_ATOT))
#define STB ((bf16_t*)(ws + O_STB))
#define DTB ((float*)(ws + O_DTB))
#define AQ ((bf16_t*)(ws + O_AQ))
#define AKV ((bf16_t*)(ws + O_AKV))
#define QRAW ((bf16_t*)(ws + O_QRAW))
#define KVRAW ((bf16_t*)(ws + O_KVRAW))
#define QF ((bf16_t*)(ws + O_QF))
#define KF ((bf16_t*)(ws + O_KF))
#define VT ((bf16_t*)(ws + O_VT))
#define YRAW ((float*)(ws + O_YRAW))
#define YA ((bf16_t*)(ws + O_YA))
#define YB (YA + (size_t)TG * 512)
#define YC (YA + (size_t)2 * TG * 512)
#define YD (YA + (size_t)3 * TG * 512)
#define CS ((f32x2*)(ws + O_CS))
#define PB ((bf16_t*)(ws + O_PB))
#define MIXB ((bf16_t*)(ws + O_MIXB))
#define WIN ((const bf16_t*)(ws + O_WIN))
#define WGATE ((const bf16_t*)(ws + O_WGATE))
#define WBR ((const bf16_t*)(ws + O_WBR))
#define WOUT ((const bf16_t*)(ws + O_WOUT))
#define WQB ((const bf16_t*)(ws + O_WQB))
#define WKVB ((const bf16_t*)(ws + O_WKVB))
#define XNg (XN + (size_t)g * TG * 1024)
    int ph = 0;
#pragma unroll 1
    for (int l = 0; l < 4; ++l) {
#pragma unroll 1
        for (int f = 0; f < 2; ++f) {
            if (f == 0) {
                PH_BEGIN
                    REP(32) convert_layer(p, l, (LAS float*)lds, wg, nwg);
                    if (l == 0) { rope_table(p, CS); init_rows(p.in[0], XN, SSQ0); }
                PH_END
            }
            PH_BEGIN
                EpiGU e{H, f == 0 ? SSQ0 : SSQ2};
#pragma unroll 1
                for (int rep = 0; rep < ((PROBE & 16) ? 2 : 1); ++rep) run_gemm(lds, XN, (const bf16_t*)(ws + (f == 0 ? O_WGU1 : O_WGU2)), T_ALL, 5632, 1024, e);
            PH_END
            PH_BEGIN
                EpiRes e{XN, f == 0 ? SSQ1 : SSQ0, (l == 3 && f == 1) ? X : nullptr, 0.5f}; run_gemm(lds, H, (const bf16_t*)(ws + (f == 0 ? O_WD1 : O_WD2)), T_ALL, 1024, 2816, e);
            PH_END
            if (f == 0) {
#pragma unroll 1
                for (int g = 0; g < NGRP; ++g) {
                    PH_BEGIN
                        EpiStore e{PROJ, PLD, 0x7fffffff, SSQ1 + (size_t)g * TG * 16};
#pragma unroll 1
                        for (int rep = 0; rep < ((PROBE & 8) ? 2 : 1); ++rep) run_gemm(lds, XNg, WIN, TG, 4864, 1024, e);
                    PH_END
                    PH_BEGIN
                        REP(4) prep1(p, l, PROJ, XBCC, DTB, AQ, AKV, YD);
                    PH_END
                    PH_BEGIN
                        REP(64) {
                        { EpiStore e{QRAW, 768, 0x7fffffff, nullptr}; run_gemm(lds, AQ, WQB, TG, 768, 384, e); }
                        { EpiStore e{KVRAW, 1024, 0x7fffffff, nullptr}; run_gemm(lds, AKV, WKVB, TG, 1024, 256, e); }
#pragma unroll 1
                        for (int u = wg; u < 256; u += nwg) {
                            ssd_states_unit(XBCC, DTB, ST, ATOT, u >> 5, (u >> 1) & 15, u & 1, lds);
                        }
                        }
                    PH_END
                    PH_BEGIN
                        REP(4) for (int u = wg; u < 256; u += nwg) prep2_unit(p, l, g, PROJ, QRAW, KVRAW, CS, QF, KF, VT, u >> 5, u & 31, lds);
                        ssd_scan(ST, STB, ATOT);
                    PH_END
                    PH_BEGIN
                        {
                            unsigned* ctr = (unsigned*)(ws + O_WQ) + (l * 4 + g);
                            volatile LAS unsigned* wq = (volatile LAS unsigned*)(lds + LDS_BYTES - 32);
#pragma unroll 1
                            for (;;) {
                                __syncthreads();
                                if (tid_now() == 0) *wq = atomicAdd(ctr, 1u);
                                __syncthreads();
                                const int u = (int)*wq;
                                if (u >= 640) break;
                                if (u < 64) attn_unit(QF, KF, VT, YC, u & 31, 7 - (u >> 5), lds);
                                else if (u < 320) { const int k = u - 64; ssd_out_grp(p, l, PROJ, XBCC, DTB, STB, YRAW, YA, k >> 5, (k >> 1) & 15, k & 1, lds); }
                                else if (u < 512) { const int k = u - 320; attn_unit(QF, KF, VT, YC, k & 31, 5 - (k >> 5), lds); }
                                else { const int k = u - 512; gmlp_unit(p, l, PROJ, YB, k >> 4, k & 15, lds); }
                            }
                        }
                    PH_END
                    PH_BEGIN
                        EpiStore e{PB, 1024, 3, nullptr}; pg8::Gemm gm{YA, WBR, 4 * TG, 4096, 512}; BranchOrder S; S.G = nwg; S.c = wg;
                        REP(128) pg8::gemm_phase<EpiStore, BranchOrder>(lds, gm, S, e);
                    PH_END
                    PH_BEGIN
                        EpiMerge e{PB, MIXB, SSQ1 + (size_t)g * TG * 16}; REP(128) run_gemm(lds, XNg, WGATE, TG, 4096, 1024, e);
                    PH_END
                    PH_BEGIN
                        EpiRes e{XNg, SSQ2 + (size_t)g * TG * 16, nullptr, 1.0f}; run_gemm(lds, MIXB, WOUT, TG, 1024, 1024, e);
                    PH_END
                }
            }
        }
    }
}

constexpr int N_PHASES = 4 * (1 + 2 + 4 * 8 + 2);

extern "C" void kernel_launch(void* const* d_in, const int* in_sizes, int n_in, void* d_out, int out_size, void* d_ws, size_t ws_size, hipStream_t stream) {
    static int grid_blocks = 0;
    if (!grid_blocks) {
        if (n_in != 28 || ws_size < WS_NEED) { fprintf(stderr, "kernel_launch: need 28 inputs and %zu bytes of workspace (got %d, %zu)\n", (size_t)WS_NEED, n_in, ws_size); grid_blocks = -1; return; }
        if (hipFuncSetAttribute((const void*)mega, hipFuncAttributeMaxDynamicSharedMemorySize, LDS_BYTES) != hipSuccess) { fprintf(stderr, "kernel_launch: hipFuncSetAttribute failed\n"); grid_blocks = -1; return; }
        int dev = 0, cus = 0, per_cu = 0;
        hipGetDevice(&dev); hipDeviceGetAttribute(&cus, hipDeviceAttributeMultiprocessorCount, dev);
        hipOccupancyMaxActiveBlocksPerMultiprocessor(&per_cu, mega, 512, LDS_BYTES);
        if (per_cu < 1) { fprintf(stderr, "kernel_launch: occupancy query returned %d\n", per_cu); per_cu = 1; }
        (void)hipGetLastError();
        grid_blocks = cus * per_cu;
    }
    if (grid_blocks < 0) return;
    Params p{};
    for (int i = 0; i < 28; ++i) p.in[i] = (const float*)d_in[i];
    p.out = (float*)d_out; p.ws = (unsigned char*)d_ws; p.only_phase = -1; p.pad = 0;
#if MULTI_LAUNCH
    for (int ph = 0; ph < N_PHASES; ++ph) { p.only_phase = ph; hipLaunchKernelGGL(mega, dim3(grid_blocks), dim3(512), LDS_BYTES, stream, p); }
#else
    if (hipMemsetAsync((unsigned char*)d_ws + O_BAR, 0, ZERO_BYTES, stream) != hipSuccess) { fprintf(stderr, "kernel_launch: memset of barrier words failed\n"); return; }
    void* args[] = {&p};
    hipError_t e = hipLaunchCooperativeKernel((void*)mega, dim3(grid_blocks), dim3(512), args, LDS_BYTES, stream);
    if (e != hipSuccess) fprintf(stderr, "cooperative launch failed: %s (grid %d)\n", hipGetErrorString(e), grid_blocks);
#endif
}
```

```cpp
#include <hip/hip_runtime.h>
#include <hip/hip_cooperative_groups.h>
#include <cstdio>
namespace cg = cooperative_groups;

#ifndef PROBE
#define PROBE 0
#endif
#define REP(bit) _Pragma("unroll 1") for (int rep_ = 0; rep_ < ((PROBE & (bit)) ? 2 : 1); ++rep_)
#ifndef MULTI_LAUNCH
#define MULTI_LAUNCH 0
#endif

__device__ __forceinline__ int tid_now() { int t = threadIdx.x; asm volatile("" : "+v"(t)); return t; }
__device__ __forceinline__ int wg_now() { int t = blockIdx.x; asm volatile("" : "+s"(t)); return t; }
__device__ __forceinline__ int nwg_now() { int t = gridDim.x; asm volatile("" : "+s"(t)); return t; }
namespace pg8 {
#define PG8_LAS __attribute__((address_space(3)))
typedef unsigned short bf16_t;
typedef short bf16x8 __attribute__((ext_vector_type(8)));
typedef float f32x4 __attribute__((ext_vector_type(4)));
typedef unsigned u32x4 __attribute__((ext_vector_type(4)));
constexpr int BM = 256, BK = 64, HALF = 128, HTB = HALF * BK * 2  , STAGE_BYTES = 8 * HTB, NXCD = 8, WGM = 8;

__host__ __device__ __forceinline__ int lds_byte(int r, int c) { const int st = (r >> 4) * 2 + (c >> 5), rr = r & 15, cc = c & 31, ob = rr * 64 + cc * 2; return st * 1024 + (ob ^ (((ob >> 9) & 1) << 5)); }
__host__ __device__ __forceinline__ void stage_rc(int b, int& R, int& C) { const int st = b / 1024, sb = b % 1024, swz = sb ^ (((sb >> 9) & 1) << 5); R = (st >> 1) * 16 + swz / 64; C = (st & 1) * 32 + (swz % 64) / 2; }
__host__ __device__ __forceinline__ int perm32(int rho) { const int n = rho >> 4, i = rho & 15; return 8 * (i >> 2) + 4 * n + (i & 3); }

struct Unit { int pm, pn; };
struct Gemm { const bf16_t* A; const bf16_t* Bt; int M, N, K; };

struct StaticOrder {
    int nM, nN, nwg, G, c;
    __host__ __device__ void init(int M, int N, int G_, int c_) { nM = M / BM; nN = N / BM; nwg = nM * nN; G = G_; c = c_; }
    __host__ __device__ bool next(int i, Unit& u) const {
        const long L = (long)i * G + c; if (L >= nwg) return false;
        int wgid = (int)L; { const int q = nwg / NXCD, r = nwg % NXCD, xcd = wgid % NXCD, off = wgid / NXCD; wgid = (xcd < r ? xcd * (q + 1) : r * (q + 1) + (xcd - r) * q) + off; }
        const int nig = WGM * nN, gid = wgid / nig, fm = gid * WGM, gsz = (nM - fm) < WGM ? (nM - fm) : WGM;
        u.pm = fm + ((wgid % nig) % gsz); u.pn = (wgid % nig) / gsz; return true;
    }
    __device__ __forceinline__ void a_ready(const Unit&) const {}
    __device__ __forceinline__ void done(const Unit&) const {}
};

template <class Epi, class Sched>
__device__ __forceinline__ void gemm_phase(PG8_LAS unsigned char* lds, const Gemm g, const Sched& S, const Epi& E) {
    const int tid = tid_now(), wid = __builtin_amdgcn_readfirstlane(tid >> 6), lane = tid & 63, wr = wid >> 2, wc = wid & 3, fr = lane & 15, fq = lane >> 4;
    const int K = g.K, nt = K / BK;
    unsigned voffA[2], voffB[2];
#pragma unroll
    for (int i = 0; i < 2; ++i) { int R, C; stage_rc(tid * 16 + i * 8192, R, C); const int Rb = Epi::PERM ? ((R & ~31) + perm32(R & 31)) : R;
        voffA[i] = (unsigned)(R * K + C) * 2u; voffB[i] = (unsigned)(Rb * K + C) * 2u; }
    const size_t kstep = (size_t)(BK * 2);
    const size_t hstep = (size_t)HALF * K * 2;
    const size_t tstep = 2 * hstep;
    const unsigned ldsw = (unsigned)wid * 1024u;
    const int aoff = lds_byte(wr * 64 + fr, fq * 8), boff = lds_byte(wc * 32 + fr, fq * 8);
#define PG8_SA(b, h) (((b) * 2 + (h)) * HTB)
#define PG8_SB(b, h) ((4 + (b) * 2 + (h)) * HTB)
#define PG8_STAGE(bufoff, gbase, voff) do { _Pragma("unroll") for (int _i = 0; _i < 2; ++_i) \
        __builtin_amdgcn_global_load_lds((const unsigned*)((const char*)(gbase) + (voff)[_i]), (PG8_LAS unsigned*)(lds + (bufoff) + ldsw + _i * 8192), 16, 0, 0); } while (0)
#define PG8_LDA(dst, b, h) do { _Pragma("unroll") for (int m = 0; m < 4; ++m) _Pragma("unroll") for (int k = 0; k < 2; ++k) dst[m][k] = *(const PG8_LAS bf16x8*)(lds + PG8_SA(b, h) + aoff + m * 2048 + k * 1024); } while (0)
#define PG8_LDB(dst, b, h) do { _Pragma("unroll") for (int n = 0; n < 2; ++n) _Pragma("unroll") for (int k = 0; k < 2; ++k) dst[n][k] = *(const PG8_LAS bf16x8*)(lds + PG8_SB(b, h) + boff + n * 2048 + k * 1024); } while (0)
#define PG8_MMA(ai, bj, At, Bt) do { __builtin_amdgcn_s_setprio(1); _Pragma("unroll") for (int m = 0; m < 4; ++m) _Pragma("unroll") for (int n = 0; n < 2; ++n) _Pragma("unroll") for (int k = 0; k < 2; ++k) \
        acc[ai][bj][m][n] = __builtin_amdgcn_mfma_f32_16x16x32_bf16(Bt[n][k], At[m][k], acc[ai][bj][m][n], 0, 0, 0); __builtin_amdgcn_s_setprio(0); } while (0)
#define PG8_WAIT_V(n) asm volatile("s_waitcnt vmcnt(" #n ")" ::: "memory")
#define PG8_WAIT_L(n) asm volatile("s_waitcnt lgkmcnt(" #n ")" ::: "memory")
#define PG8_BAR __builtin_amdgcn_s_barrier()
#define PG8_SCHED __builtin_amdgcn_sched_barrier(0)
    Unit cur, nxt; int ui = 0;
    if (!S.next(0, cur)) return;
    f32x4 acc[2][2][4][2];
#pragma unroll
    for (int a = 0; a < 2; ++a)
#pragma unroll
        for (int b = 0; b < 2; ++b)
#pragma unroll
            for (int m = 0; m < 4; ++m)
#pragma unroll
                for (int n = 0; n < 2; ++n) acc[a][b][m][n] = (f32x4){0.f, 0.f, 0.f, 0.f};
    bf16x8 At[4][2], B0[2][2], B1[2][2];
    const char* cA = (const char*)g.A + (size_t)cur.pm * tstep; const char* cB = (const char*)g.Bt + (size_t)cur.pn * tstep;
    S.a_ready(cur);
    PG8_STAGE(PG8_SB(0, 0), cB, voffB); PG8_STAGE(PG8_SA(0, 0), cA, voffA); PG8_STAGE(PG8_SB(0, 1), cB + hstep, voffB); PG8_STAGE(PG8_SA(0, 1), cA + hstep, voffA);
    if (wr == 1) PG8_BAR;
    PG8_WAIT_V(4); PG8_BAR;
    PG8_STAGE(PG8_SB(1, 0), cB + kstep, voffB); PG8_STAGE(PG8_SA(1, 0), cA + kstep, voffA); PG8_STAGE(PG8_SB(1, 1), cB + hstep + kstep, voffB);
    PG8_WAIT_V(6); PG8_BAR;
    for (;;) {
        const bool has_next = S.next(ui + 1, nxt);
        const char* nA = has_next ? (const char*)g.A + (size_t)nxt.pm * tstep : cA; const char* nB = has_next ? (const char*)g.Bt + (size_t)nxt.pn * tstep : cB;
        for (int t = 0; t < nt; t += 2) {
            const bool last = (t == nt - 2);
            const char* a1 = cA + (size_t)(t + 1) * kstep;
            const char* a2 = last ? nA : cA + (size_t)(t + 2) * kstep; const char* b2 = last ? nB : cB + (size_t)(t + 2) * kstep;
            const char* a3 = a2 + kstep; const char* b3 = b2 + kstep;
            if (last && has_next) S.a_ready(nxt);
            PG8_LDB(B0, 0, 0); PG8_SCHED; PG8_LDA(At, 0, 0); PG8_STAGE(PG8_SA(1, 1), a1 + hstep, voffA);
            PG8_WAIT_L(8); PG8_BAR; PG8_WAIT_L(0); PG8_MMA(0, 0, At, B0); PG8_BAR; PG8_SCHED;
            PG8_LDB(B1, 0, 1); PG8_STAGE(PG8_SB(0, 0), b2, voffB);
            PG8_BAR; PG8_WAIT_L(0); PG8_MMA(0, 1, At, B1); PG8_BAR;
            PG8_LDA(At, 0, 1); PG8_STAGE(PG8_SA(0, 0), a2, voffA);
            PG8_BAR; PG8_WAIT_L(0); PG8_MMA(1, 0, At, B0); PG8_BAR; PG8_SCHED;
            PG8_STAGE(PG8_SB(0, 1), b2 + hstep, voffB);
            PG8_WAIT_V(6); PG8_BAR; PG8_MMA(1, 1, At, B1); PG8_BAR;
            PG8_LDB(B0, 1, 0); PG8_SCHED; PG8_LDA(At, 1, 0); PG8_STAGE(PG8_SA(0, 1), a2 + hstep, voffA);
            PG8_WAIT_L(8); PG8_BAR; PG8_WAIT_L(0); PG8_MMA(0, 0, At, B0); PG8_BAR; PG8_SCHED;
            PG8_LDB(B1, 1, 1); PG8_STAGE(PG8_SB(1, 0), b3, voffB);
            PG8_BAR; PG8_WAIT_L(0); PG8_MMA(0, 1, At, B1); PG8_BAR;
            PG8_LDA(At, 1, 1); PG8_STAGE(PG8_SA(1, 0), a3, voffA);
            PG8_BAR; PG8_WAIT_L(0); PG8_MMA(1, 0, At, B0); PG8_BAR; PG8_SCHED;
            PG8_STAGE(PG8_SB(1, 1), b3 + hstep, voffB);
            PG8_WAIT_V(6); PG8_BAR; PG8_MMA(1, 1, At, B1); PG8_BAR;
        }
        if constexpr (!Epi::AFTER_DRAIN) { E(acc, cur, wr, wc, fr, fq); S.done(cur); }
        if (!has_next) break;
#pragma unroll
        for (int a = 0; a < 2; ++a)
#pragma unroll
            for (int b = 0; b < 2; ++b)
#pragma unroll
                for (int m = 0; m < 4; ++m)
#pragma unroll
                    for (int n = 0; n < 2; ++n) acc[a][b][m][n] = (f32x4){0.f, 0.f, 0.f, 0.f};
        cur = nxt; cA = nA; cB = nB; ++ui;
    }
    PG8_WAIT_V(0);
    if (wr == 0) PG8_BAR;
    PG8_BAR;
    if constexpr (Epi::AFTER_DRAIN) { E.fused(acc, cur, wr, wc, fr, fq, lds, wid, lane); S.done(cur); }
#undef PG8_SA
#undef PG8_SB
#undef PG8_STAGE
#undef PG8_LDA
#undef PG8_LDB
#undef PG8_MMA
#undef PG8_WAIT_V
#undef PG8_WAIT_L
#undef PG8_BAR
#undef PG8_SCHED
}
}


using pg8::bf16_t; using pg8::bf16x8; using pg8::f32x4; using pg8::u32x4;
typedef short s16x4 __attribute__((ext_vector_type(4)));
typedef float f32x2 __attribute__((ext_vector_type(2)));
typedef float f32x16 __attribute__((ext_vector_type(16)));
typedef unsigned u32x2 __attribute__((ext_vector_type(2)));
typedef __bf16 bf16v2 __attribute__((ext_vector_type(2)));
#define LAS __attribute__((address_space(3)))
#define DI __device__ __forceinline__
#define XB_TMO      128
#define XB_XCNT(j)  (256  + 64 * (j))
#define XB_XSUB(j)  (1280 + 64 * (j))
#define XB_XGEN(j)  (2304 + 64 * (j))
#define XB_TOP      3328
#define XB_TOPGEN   3392
#define XCD_BAR_WORDS 3456
#define XB_SPIN_CAP (1u << 18)

__device__ __forceinline__ unsigned xb_ld(unsigned* p)              { return __hip_atomic_load(p, __ATOMIC_RELAXED, __HIP_MEMORY_SCOPE_AGENT); }
__device__ __forceinline__ unsigned xb_add(unsigned* p, unsigned v) { return __hip_atomic_fetch_add(p, v, __ATOMIC_RELAXED, __HIP_MEMORY_SCOPE_AGENT); }
__device__ __forceinline__ unsigned xb_xcc_id() { return (unsigned)__builtin_amdgcn_s_getreg((3 << 11) | 20) & 0xFu; }
#define XB_SPIN(cond, bar) do { unsigned _sp = 0; while (cond) { __builtin_amdgcn_s_sleep(1); \
    if ((++_sp & 255u) == 0u) { if (xb_ld(&(bar)[XB_TMO])) break; if (_sp > XB_SPIN_CAP) { atomicAdd(&(bar)[XB_TMO], 1u); break; } } } } while (0)

struct XcdBarrier {
    unsigned* bar; unsigned x;
    volatile LAS unsigned* st;
};

__device__ __forceinline__ XcdBarrier xcd_barrier_post(unsigned* bar, volatile LAS unsigned* st) {
    XcdBarrier b; b.bar = bar; b.x = xb_xcc_id(); b.st = st;
    if (threadIdx.x == 0) (void)xb_add(&bar[XB_XCNT(b.x)], 1u);
    return b;
}
__device__ __forceinline__ void xcd_barrier_complete(unsigned* bar, unsigned x, unsigned& nloc, unsigned& nx) {
    const unsigned G = (unsigned)nwg_now();
    unsigned sum, cnt, mine, sp = 0u;
    for (;;) {
        sum = 0u; cnt = 0u; mine = 0u;
#pragma unroll
        for (unsigned j = 0; j < 16; ++j) { const unsigned c = xb_ld(&bar[XB_XCNT(j)]); sum += c; cnt += (c > 0u) ? 1u : 0u; mine = (j == x) ? c : mine; }
        if (sum == G) break;
        __builtin_amdgcn_s_sleep(1);
        if ((++sp & 255u) == 0u) { if (xb_ld(&bar[XB_TMO])) break; if (sp > XB_SPIN_CAP) { atomicAdd(&bar[XB_TMO], 1u); break; } }
    }
    nloc = mine > 0u ? mine : 1u; nx = cnt > 0u ? cnt : 1u;
}

__device__ __forceinline__ void xcd_barrier(const XcdBarrier& b) {
    asm volatile("s_waitcnt vmcnt(0)" ::: "memory");
    __syncthreads();
    if (tid_now() == 0) {
        unsigned* bar = b.bar; unsigned bx = b.x; asm volatile("" : "+s"(bar), "+s"(bx));
        __builtin_amdgcn_s_waitcnt(0);
        unsigned nloc = b.st[0], nx = b.st[1];
        if (nloc == 0u) { xcd_barrier_complete(bar, bx, nloc, nx); b.st[0] = nloc; b.st[1] = nx; }
        const unsigned old = xb_add(&bar[XB_XSUB(bx)], 1u);
        const unsigned gen = old / nloc;
        if (old + 1u == (gen + 1u) * nloc) {
            __builtin_amdgcn_fence(__ATOMIC_RELEASE, "agent");
            asm volatile("s_waitcnt vmcnt(0)" ::: "memory");
            const unsigned og = xb_add(&bar[XB_TOP], 1u);
            const unsigned tg = og / nx;
            if (og + 1u == (tg + 1u) * nx) xb_add(&bar[XB_TOPGEN], 1u);
            else XB_SPIN(xb_ld(&bar[XB_TOPGEN]) == tg, bar);
            __builtin_amdgcn_fence(__ATOMIC_ACQUIRE, "agent");
            xb_add(&bar[XB_XGEN(bx)], 1u);
            asm volatile("s_waitcnt vmcnt(0)" ::: "memory");
        } else {
            XB_SPIN(xb_ld(&bar[XB_XGEN(bx)]) == gen, bar);
            __builtin_amdgcn_fence(__ATOMIC_ACQUIRE, "agent");
            asm volatile("s_waitcnt vmcnt(0)" ::: "memory");
        }
    }
    __syncthreads();
}


#define MFMA32(a, b, c) __builtin_amdgcn_mfma_f32_32x32x16_bf16((a), (b), (c), 0, 0, 0)

constexpr int T_ALL = 65536, SEQ = 2048, NGRP = 4, TG = 16384, BPG = 8, PLD = 4864;
constexpr float EPS = 1e-6f;
constexpr size_t SZ_GU = (size_t)5632 * 1024 * 2, SZ_D = (size_t)1024 * 2816 * 2;
constexpr size_t O_WGU1 = 0, O_WD1 = O_WGU1 + SZ_GU, O_WGU2 = O_WD1 + SZ_D, O_WD2 = O_WGU2 + SZ_GU, O_WIN = O_WD2 + SZ_D;
constexpr size_t O_WGATE = O_WIN + (size_t)4864 * 1024 * 2, O_WBR = O_WGATE + (size_t)4096 * 1024 * 2, O_WOUT = O_WBR + (size_t)4 * 1024 * 512 * 2;
constexpr size_t O_WQB = O_WOUT + (size_t)1024 * 1024 * 2, O_WKVB = O_WQB + (size_t)768 * 384 * 2, O_XN = O_WKVB + (size_t)1024 * 256 * 2;
constexpr size_t O_R0 = O_XN + (size_t)T_ALL * 1024 * 2;
constexpr size_t O_H = O_R0;
constexpr size_t O_PROJ = O_R0, O_XBCC = O_PROJ + (size_t)TG * PLD * 2, O_DTB = O_XBCC + (size_t)TG * 1024 * 2, O_AQ = O_DTB + (size_t)TG * 16 * 4;
constexpr size_t O_AKV = O_AQ + (size_t)TG * 384 * 2, O_QRAW = O_AKV + (size_t)TG * 256 * 2, O_KVRAW = O_QRAW + (size_t)TG * 768 * 2;
constexpr size_t O_QF = O_KVRAW + (size_t)TG * 1024 * 2, O_KF = O_QF + (size_t)TG * 768 * 2, O_VT = O_KF + (size_t)TG * 768 * 2;
constexpr size_t O_YRAW = O_VT + (size_t)TG * 512 * 2, O_YA = O_YRAW + (size_t)TG * 512 * 4;
constexpr size_t O_PB = O_YA + (size_t)4 * TG * 512 * 2, O_MIXB = O_PB + (size_t)4 * TG * 1024 * 2;
constexpr size_t O_ST = O_MIXB + (size_t)TG * 1024 * 2, O_ATOT = O_ST + (size_t)BPG * 16 * 8 * 8192 * 4;
constexpr size_t O_STB = O_ATOT + 4096;
constexpr size_t O_BAR = O_STB + (size_t)BPG * 16 * 8 * 8192 * 2;
constexpr size_t O_WQ = O_BAR + (size_t)XCD_BAR_WORDS * 4;
constexpr size_t ZERO_BYTES = (size_t)XCD_BAR_WORDS * 4 + 256;
constexpr size_t O_CS = O_WQ + 256 + 256 - ((size_t)XCD_BAR_WORDS * 4) % 256;
constexpr size_t O_SSQ = O_CS + (size_t)T_ALL * 32 * 8;
constexpr size_t O_END = O_SSQ + (size_t)3 * T_ALL * 16 * 4;
constexpr size_t O_END_H = O_H + (size_t)T_ALL * 2816 * 2;
constexpr size_t WS_NEED = O_END > O_END_H ? O_END : O_END_H;
constexpr int LDS_BYTES = 147456;

struct Params { const float* in[28]; float* out; unsigned char* ws; int only_phase; int pad; };

DI unsigned pk2(float a, float b) { f32x2 v = {a, b}; return __builtin_bit_cast(unsigned, __builtin_convertvector(v, bf16v2)); }
DI bf16_t f2bf(float a) { return (bf16_t)(pk2(a, 0.f) & 0xffffu); }
DI float bf2f(bf16_t b) { return __uint_as_float(((unsigned)b) << 16); }
DI float bflo(unsigned u) { return __uint_as_float(u << 16); }
DI float bfhi(unsigned u) { return __uint_as_float(u & 0xffff0000u); }
#define UNPACK8(v, f) do { f[0] = bflo(v.x); f[1] = bfhi(v.x); f[2] = bflo(v.y); f[3] = bfhi(v.y); f[4] = bflo(v.z); f[5] = bfhi(v.z); f[6] = bflo(v.w); f[7] = bfhi(v.w); } while (0)
#define PACK8(f) ((u32x4){pk2(f[0], f[1]), pk2(f[2], f[3]), pk2(f[4], f[5]), pk2(f[6], f[7])})
DI float wave_sum(float v) {
#pragma unroll
    for (int o = 1; o < 64; o <<= 1) v += __shfl_xor(v, o);
    return v;
}
DI float silu_f(float x) { return x * __builtin_amdgcn_rcpf(1.f + __builtin_amdgcn_exp2f(-1.4426950408889634f * x)); }
DI float sigmoid_f(float x) { return __builtin_amdgcn_rcpf(1.f + __builtin_amdgcn_exp2f(-1.4426950408889634f * x)); }
DI float gelu_f(float v) {
    const float t = __builtin_amdgcn_rcpf(fabsf(v) * 0.2316418882f + 1.0f);
    float q = t * 0.5307027145f + (-0.7265760135f); q = q * t + 0.7107068705f; q = q * t + (-0.142248368f); q = q * t + 0.127414796f; q = q * t;
    const float m = v * (q * __builtin_amdgcn_exp2f(v * v * (-0.72134752044f)));
    return v < 0.f ? m : v - m;
}
DI int crow(int i, int h) { return (i & 3) + 8 * (i >> 2) + 4 * h; }
DI void rows_rstd(const float* ssq, int row0, int fq, float (&rs)[2][4]) {
    f32x4 q[2][4];
#pragma unroll
    for (int ai = 0; ai < 2; ++ai)
#pragma unroll
        for (int m = 0; m < 4; ++m) q[ai][m] = ((const f32x4*)(ssq + (size_t)(row0 + ai * 128 + m * 16) * 16))[fq];
#pragma unroll
    for (int ai = 0; ai < 2; ++ai)
#pragma unroll
        for (int m = 0; m < 4; ++m) { float t = (q[ai][m][0] + q[ai][m][1]) + (q[ai][m][2] + q[ai][m][3]); t += __shfl_xor(t, 16); t += __shfl_xor(t, 32);
            rs[ai][m] = rsqrtf(t * (1.f / 1024.f) + EPS); }
}
struct EpiStore {
    static constexpr bool PERM = true, AFTER_DRAIN = false;
    bf16_t* O; int ldc; int pnmask; const float* ssq;
    DI void operator()(const f32x4 (&acc)[2][2][4][2], const pg8::Unit& u, int wr, int wc, int fr, int fq) const {
        const int row0 = u.pm * 256 + wr * 64 + fr, col0 = (u.pn & pnmask) * 256 + wc * 32 + 8 * fq;
        float rsv[2][4];
        if (ssq) rows_rstd(ssq, row0, fq, rsv);
        else {
#pragma unroll
            for (int ai = 0; ai < 2; ++ai)
#pragma unroll
                for (int m = 0; m < 4; ++m) rsv[ai][m] = 1.f; }
#pragma unroll
        for (int ai = 0; ai < 2; ++ai)
#pragma unroll
            for (int m = 0; m < 4; ++m) { bf16_t* rowp = O + (size_t)(row0 + ai * 128 + m * 16) * ldc + col0;
                const float rs = rsv[ai][m];
#pragma unroll
                for (int bj = 0; bj < 2; ++bj) { const f32x4 v0 = acc[ai][bj][m][0] * rs, v1 = acc[ai][bj][m][1] * rs;
                    u32x4 w; w.x = pk2(v0[0], v0[1]); w.y = pk2(v0[2], v0[3]); w.z = pk2(v1[0], v1[1]); w.w = pk2(v1[2], v1[3]);
                    *(u32x4*)(rowp + bj * 128) = w; } }
    }
};
struct EpiGU {
    static constexpr bool PERM = true, AFTER_DRAIN = false;
    bf16_t* H; const float* ssq;
    DI void operator()(const f32x4 (&acc)[2][2][4][2], const pg8::Unit& u, int wr, int wc, int fr, int fq) const {
        const int row0 = u.pm * 256 + wr * 64 + fr, col0 = u.pn * 128 + wc * 32 + 8 * fq;
        float rsv[2][4]; rows_rstd(ssq, row0, fq, rsv);
#pragma unroll
        for (int ai = 0; ai < 2; ++ai)
#pragma unroll
            for (int m = 0; m < 4; ++m) { bf16_t* rowp = H + (size_t)(row0 + ai * 128 + m * 16) * 2816 + col0;
                const float rs = rsv[ai][m];
                float o[8];
#pragma unroll
                for (int n = 0; n < 2; ++n)
#pragma unroll
                    for (int j = 0; j < 4; ++j) o[4 * n + j] = silu_f(acc[ai][0][m][n][j] * rs) * (acc[ai][1][m][n][j] * rs);
                *(u32x4*)rowp = PACK8(o); }
    }
};
struct EpiRes {
    static constexpr bool PERM = false, AFTER_DRAIN = false;
    bf16_t* XB; float* SSQ; float* OUT; float sc;
    DI void operator()(const f32x4 (&acc)[2][2][4][2], const pg8::Unit& u, int wr, int wc, int fr, int fq) const {
        const int row0 = u.pm * 256 + wr * 64 + fr, col0 = u.pn * 256 + wc * 32 + 4 * fq;
#pragma unroll
        for (int ai = 0; ai < 2; ++ai) {
            u32x2 xv[4][2][2];
#pragma unroll
            for (int m = 0; m < 4; ++m)
#pragma unroll
                for (int bj = 0; bj < 2; ++bj)
#pragma unroll
                    for (int n = 0; n < 2; ++n) xv[m][bj][n] = *(const u32x2*)(XB + (size_t)(row0 + ai * 128 + m * 16) * 1024 + col0 + bj * 128 + n * 16);
#pragma unroll
            for (int m = 0; m < 4; ++m) { const int row = row0 + ai * 128 + m * 16; const size_t ro = (size_t)row * 1024 + col0;
                float ss = 0.f;
#pragma unroll
                for (int bj = 0; bj < 2; ++bj)
#pragma unroll
                    for (int n = 0; n < 2; ++n) { const u32x2 xo = xv[m][bj][n]; const f32x4 a = acc[ai][bj][m][n];
                        const f32x4 v = {bflo(xo.x) + a[0] * sc, bfhi(xo.x) + a[1] * sc, bflo(xo.y) + a[2] * sc, bfhi(xo.y) + a[3] * sc};
                        if (OUT) *(f32x4*)(OUT + ro + bj * 128 + n * 16) = v;
                        else *(u32x2*)(XB + ro + bj * 128 + n * 16) = (u32x2){pk2(v[0], v[1]), pk2(v[2], v[3])};
                        ss += v[0] * v[0] + v[1] * v[1] + v[2] * v[2] + v[3] * v[3]; }
                ss += __shfl_xor(ss, 16); ss += __shfl_xor(ss, 32);
                if (fq == 0) SSQ[(size_t)row * 16 + u.pn * 4 + wc] = ss; }
        }
    }
};
struct EpiMerge {
    static constexpr bool PERM = false, AFTER_DRAIN = false;
    const bf16_t* P; bf16_t* MIX; const float* ssq;
    DI void operator()(const f32x4 (&acc)[2][2][4][2], const pg8::Unit& u, int wr, int wc, int fr, int fq) const {
        const int row0 = u.pm * 256 + wr * 64 + fr, e0 = u.pn * 64 + wc * 16 + 4 * fq;
        float rsv[2][4]; rows_rstd(ssq, row0, fq, rsv);
#pragma unroll
        for (int ai = 0; ai < 2; ++ai) {
            u32x2 pv[4][4];
#pragma unroll
            for (int m = 0; m < 4; ++m)
#pragma unroll
                for (int b = 0; b < 4; ++b) pv[m][b] = *(const u32x2*)(P + (size_t)b * TG * 1024 + (size_t)(row0 + ai * 128 + m * 16) * 1024 + e0);
#pragma unroll
            for (int m = 0; m < 4; ++m) { const float rs = rsv[ai][m];
                float o[4] = {0.f, 0.f, 0.f, 0.f};
#pragma unroll
                for (int bj = 0; bj < 2; ++bj)
#pragma unroll
                    for (int n = 0; n < 2; ++n) { const u32x2 q = pv[m][2 * bj + n]; const f32x4 g = acc[ai][bj][m][n] * rs;
                        o[0] += sigmoid_f(g[0]) * bflo(q.x); o[1] += sigmoid_f(g[1]) * bfhi(q.x); o[2] += sigmoid_f(g[2]) * bflo(q.y); o[3] += sigmoid_f(g[3]) * bfhi(q.y); }
                *(u32x2*)(MIX + (size_t)(row0 + ai * 128 + m * 16) * 1024 + e0) = (u32x2){pk2(o[0], o[1]), pk2(o[2], o[3])}; }
        }
    }
};
struct BranchOrder {
    int G, c;
    DI bool next(int i, pg8::Unit& u) const { const int L = i * G + c; if (L >= 1024) return false; const int br = L >> 8, rem = L & 255; u.pm = br * 64 + (rem >> 2); u.pn = br * 4 + (rem & 3); return true; }
    DI void a_ready(const pg8::Unit&) const {}
    DI void done(const pg8::Unit&) const {}
};
template <class Epi> DI void run_gemm(LAS unsigned char* lds, const bf16_t* A, const bf16_t* Bt, int M, int N, int K, const Epi& E) {
    pg8::Gemm g{A, Bt, M, N, K}; pg8::StaticOrder S; S.init(M, N, nwg_now(), wg_now());
    pg8::gemm_phase<Epi, pg8::StaticOrder>(lds, g, S, E);
}

DI void conv_mat(const float* src, int ld, int c0, int nvalid, int kvalid, int mode, bf16_t* dst, int Nd, int Kd, LAS float* scr, int wg, int nwg, const float* ksc = nullptr) {
    const int tid = tid_now(); const int ntk = Kd >> 6, ntiles = (Nd >> 6) * ntk;
    for (int tile = wg; tile < ntiles; tile += nwg) {
        const int n0 = (tile / ntk) << 6, k0 = (tile % ntk) << 6;
        const int nn = tid & 63, kq = tid >> 6, n = n0 + nn;
        int col;
        if (mode == 1) { const int blk = n >> 7; col = ((blk & 1) ? 2816 : 0) + (blk >> 1) * 128 + (n & 127); }
        else if (mode == 2) { const int c = n & 255, br = 2 * (c >> 7) + ((c >> 4) & 1), e = 64 * (n >> 8) + 16 * ((c >> 5) & 3) + (c & 15); col = c0 + br * 1024 + e; }
        else col = c0 + n;
#pragma unroll
        for (int i = 0; i < 8; ++i) { const int kk = i * 8 + kq; float v = 0.f;
            if (k0 + kk < kvalid && n < nvalid) { v = src[(size_t)(k0 + kk) * ld + col]; if (ksc) v *= ksc[k0 + kk]; }
            scr[kk * 65 + nn] = v; }
        __syncthreads();
        { const int nr = tid >> 3, kc = tid & 7; const LAS float* sp = scr + (kc * 8) * 65 + nr;
          u32x4 o; o.x = pk2(sp[0], sp[65]); o.y = pk2(sp[130], sp[195]); o.z = pk2(sp[260], sp[325]); o.w = pk2(sp[390], sp[455]);
          *(u32x4*)(dst + (size_t)(n0 + nr) * Kd + k0 + kc * 8) = o; }
        __syncthreads();
    }
}
DI void convert_layer(const Params& p, int l, LAS float* scr, int wg, int nwg) {
    unsigned char* ws = p.ws;
    conv_mat(p.in[3] + (size_t)l * 1024 * 5632, 5632, 0, 5632, 1024, 1, (bf16_t*)(ws + O_WGU1), 5632, 1024, scr, wg, nwg, p.in[2] + l * 1024);
    conv_mat(p.in[26] + (size_t)l * 1024 * 5632, 5632, 0, 5632, 1024, 1, (bf16_t*)(ws + O_WGU2), 5632, 1024, scr, wg, nwg, p.in[25] + l * 1024);
    conv_mat(p.in[4] + (size_t)l * 2816 * 1024, 1024, 0, 1024, 2816, 0, (bf16_t*)(ws + O_WD1), 1024, 2816, scr, wg, nwg);
    conv_mat(p.in[27] + (size_t)l * 2816 * 1024, 1024, 0, 1024, 2816, 0, (bf16_t*)(ws + O_WD2), 1024, 2816, scr, wg, nwg);
    conv_mat(p.in[6] + (size_t)l * 1024 * 8776, 8776, 0, 4680, 1024, 0, (bf16_t*)(ws + O_WIN), 4864, 1024, scr, wg, nwg, p.in[5] + l * 1024);
    conv_mat(p.in[6] + (size_t)l * 1024 * 8776, 8776, 4680, 4096, 1024, 2, (bf16_t*)(ws + O_WGATE), 4096, 1024, scr, wg, nwg, p.in[5] + l * 1024);
#pragma unroll 1
    for (int i = 0; i < 4; ++i)
        conv_mat(p.in[23] + ((size_t)l * 4 + i) * 512 * 1024, 1024, 0, 1024, 512, 0, (bf16_t*)(ws + O_WBR) + (size_t)i * 1024 * 512, 1024, 512, scr, wg, nwg);
    conv_mat(p.in[24] + (size_t)l * 1024 * 1024, 1024, 0, 1024, 1024, 0, (bf16_t*)(ws + O_WOUT), 1024, 1024, scr, wg, nwg);
    conv_mat(p.in[17] + (size_t)l * 384 * 768, 768, 0, 768, 384, 0, (bf16_t*)(ws + O_WQB), 768, 384, scr, wg, nwg);
    conv_mat(p.in[19] + (size_t)l * 128 * 1024, 1024, 0, 1024, 128, 0, (bf16_t*)(ws + O_WKVB), 1024, 256, scr, wg, nwg);
}

DI void init_rows(const float* x, bf16_t* xb, float* ssq) {
    const int tidn = tid_now(); const int lane = tidn & 63, gwave = wg_now() * 8 + (tidn >> 6), ngw = nwg_now() * 8;
    for (int row = gwave; row < T_ALL; row += ngw) {
        const f32x4* xr = (const f32x4*)(x + (size_t)row * 1024);
        f32x4 v[4]; float ss = 0.f;
#pragma unroll
        for (int j = 0; j < 4; ++j) { v[j] = xr[lane + 64 * j]; ss += v[j][0] * v[j][0] + v[j][1] * v[j][1] + v[j][2] * v[j][2] + v[j][3] * v[j][3]; }
        ss = wave_sum(ss);
        u32x2* o = (u32x2*)(xb + (size_t)row * 1024);
#pragma unroll
        for (int j = 0; j < 4; ++j) o[lane + 64 * j] = (u32x2){pk2(v[j][0], v[j][1]), pk2(v[j][2], v[j][3])};
        if (lane < 16) ssq[(size_t)row * 16 + lane] = lane == 0 ? ss : 0.f;
    }
}
DI void zero_f32(float* q, int n) { const int tidn = tid_now(); for (int i = wg_now() * 512 + tidn; i < n; i += nwg_now() * 512) q[i] = 0.f; }

DI void prep1(const Params& p, int l, const bf16_t* proj, bf16_t* xbcc, float* dtb, bf16_t* aq, bf16_t* akv, bf16_t* yd) {
    const int tidn = tid_now(); const int gtid = wg_now() * 512 + tidn, gthreads = nwg_now() * 512;
    const float* cw = p.in[7] + l * 4096; const float* cb = p.in[8] + l * 1024;
    for (int idx = gtid; idx < (TG / 16) * 128; idx += gthreads) {
        const int c8 = (idx & 127) << 3, tl0 = (idx >> 7) << 4, s0 = tl0 & 2047;
        float w[4][8], bb[8], r0[8], r1[8], r2[8];
#pragma unroll
        for (int k = 0; k < 4; ++k) { const f32x4 a = *(const f32x4*)(cw + k * 1024 + c8), b = *(const f32x4*)(cw + k * 1024 + c8 + 4);
#pragma unroll
            for (int j = 0; j < 4; ++j) { w[k][j] = a[j]; w[k][4 + j] = b[j]; } }
        { const f32x4 a = *(const f32x4*)(cb + c8), b = *(const f32x4*)(cb + c8 + 4);
#pragma unroll
          for (int j = 0; j < 4; ++j) { bb[j] = a[j]; bb[4 + j] = b[j]; } }
        const bf16_t* src = proj + (size_t)tl0 * PLD + 512 + c8;
        if (s0 > 0) { const u32x4 v0 = *(const u32x4*)(src - 3 * PLD), v1 = *(const u32x4*)(src - 2 * PLD), v2 = *(const u32x4*)(src - PLD); UNPACK8(v0, r0); UNPACK8(v1, r1); UNPACK8(v2, r2); }
        else {
#pragma unroll
            for (int j = 0; j < 8; ++j) { r0[j] = 0.f; r1[j] = 0.f; r2[j] = 0.f; } }
#pragma unroll 4
        for (int tt = 0; tt < 16; ++tt) {
            const u32x4 v = *(const u32x4*)(src + (size_t)tt * PLD); float cur[8], o[8]; UNPACK8(v, cur);
#pragma unroll
            for (int j = 0; j < 8; ++j) { o[j] = silu_f(bb[j] + w[0][j] * r0[j] + w[1][j] * r1[j] + w[2][j] * r2[j] + w[3][j] * cur[j]); r0[j] = r1[j]; r1[j] = r2[j]; r2[j] = cur[j]; }
            *(u32x4*)(xbcc + (size_t)(tl0 + tt) * 1024 + c8) = PACK8(o);
        }
    }
    const float* sw = p.in[22] + l * 1536;
    for (int idx = gtid; idx < (TG / 16) * 64; idx += gthreads) {
        const int c8 = (idx & 63) << 3, tl0 = (idx >> 6) << 4, s0 = tl0 & 2047;
        float w[3][8], p1[8], p2[8];
#pragma unroll
        for (int k = 0; k < 3; ++k) { const f32x4 a = *(const f32x4*)(sw + k * 512 + c8), b = *(const f32x4*)(sw + k * 512 + c8 + 4);
#pragma unroll
            for (int j = 0; j < 4; ++j) { w[k][j] = a[j]; w[k][4 + j] = b[j]; } }
        const bf16_t* src = proj + (size_t)tl0 * PLD + c8;
        if (s0 > 0) { const u32x4 c1 = *(const u32x4*)(src - 2 * PLD + 3656), x1 = *(const u32x4*)(src - 2 * PLD + 4168), c2 = *(const u32x4*)(src - PLD + 3656), x2 = *(const u32x4*)(src - PLD + 4168);
            float a[8], b[8]; UNPACK8(c1, a); UNPACK8(x1, b);
#pragma unroll
            for (int j = 0; j < 8; ++j) p1[j] = a[j] * b[j];
            UNPACK8(c2, a); UNPACK8(x2, b);
#pragma unroll
            for (int j = 0; j < 8; ++j) p2[j] = a[j] * b[j]; }
        else {
#pragma unroll
            for (int j = 0; j < 8; ++j) { p1[j] = 0.f; p2[j] = 0.f; } }
#pragma unroll 4
        for (int tt = 0; tt < 16; ++tt) {
            const bf16_t* pr = src + (size_t)tt * PLD;
            const u32x4 vc = *(const u32x4*)(pr + 3656), vx = *(const u32x4*)(pr + 4168), vb = *(const u32x4*)(pr + 3144);
            float fc[8], fx[8], fb[8], o[8]; UNPACK8(vc, fc); UNPACK8(vx, fx); UNPACK8(vb, fb);
#pragma unroll
            for (int j = 0; j < 8; ++j) { const float cur = fc[j] * fx[j]; o[j] = fb[j] * (w[0][j] * p1[j] + w[1][j] * p2[j] + w[2][j] * cur); p1[j] = p2[j]; p2[j] = cur; }
            *(u32x4*)(yd + (size_t)(tl0 + tt) * 512 + c8) = PACK8(o);
        }
    }
    const int gwave = gtid >> 6, ngw = gthreads >> 6, lane = tidn & 63;
    const float* qn = p.in[16] + l * 384; const float* kn = p.in[18] + l * 128;
    for (int tl = gwave; tl < TG; tl += ngw) {
        const bf16_t* pr = proj + (size_t)tl * PLD;
        const u32x4 v = *(const u32x4*)(pr + 2568 + lane * 8); float f[8]; UNPACK8(v, f);
        float ss = 0.f;
#pragma unroll
        for (int j = 0; j < 8; ++j) ss += f[j] * f[j];
        const float ssq = wave_sum(lane < 48 ? ss : 0.f), ssk = wave_sum(lane >= 48 ? ss : 0.f);
        if (lane < 48) {
            const float rstd = rsqrtf(ssq * (1.f / 384.f) + EPS);
#pragma unroll
            for (int j = 0; j < 8; ++j) f[j] *= rstd * qn[lane * 8 + j];
            *(u32x4*)(aq + (size_t)tl * 384 + lane * 8) = PACK8(f);
        } else {
            const float rstd = rsqrtf(ssk * (1.f / 128.f) + EPS);
#pragma unroll
            for (int j = 0; j < 8; ++j) f[j] *= rstd * kn[(lane - 48) * 8 + j];
            *(u32x4*)(akv + (size_t)tl * 256 + (lane - 48) * 8) = PACK8(f);
            { unsigned z = 0u; asm volatile("" : "+v"(z)); *(u32x4*)(akv + (size_t)tl * 256 + 128 + (lane - 48) * 8) = (u32x4){z, z, z, z}; }
        }
        if (lane < 8) {
            const float xr = bf2f(pr[1536 + lane]) + p.in[9][l * 8 + lane];
            const float dt = xr > 20.f ? xr : log1pf(expf(xr));
            const float A = -expf(p.in[10][l * 8 + lane]);
            dtb[(size_t)tl * 16 + lane] = dt; dtb[(size_t)tl * 16 + 8 + lane] = dt * A;
        }
    }
}

DI void rope_table(const Params& p, f32x2* CS) {
    const int* pos = (const int*)p.in[1];
    const int tidn = tid_now();
    for (int idx = wg_now() * 512 + tidn; idx < T_ALL * 32; idx += nwg_now() * 512) {
        const float invf = exp2f(-(float)(idx & 31) * (13.287712379549449f / 32.f));
        const float ang = (float)pos[idx >> 5] * invf;
        CS[idx] = (f32x2){cosf(ang), sinf(ang)};
    }
}
DI void prep2_unit(const Params& p, int l, int g, const bf16_t* proj, const bf16_t* qraw, const bf16_t* kvraw, const f32x2* CS, bf16_t* Qf, bf16_t* Kf, bf16_t* Vt, int bl, int tile, LAS unsigned char* lds) {
    const int tid = tid_now(), wave = tid >> 6, lane = tid & 63;
    const float* wq = p.in[20] + l * 192; const float* wk = p.in[21] + l * 192;
    const float qscale = 0.07216878364870322f * 1.4426950408889634f;
    const float wq0 = wq[lane], wq1 = wq[64 + lane], wq2 = wq[128 + lane], wk0 = wk[lane], wk1 = wk[64 + lane], wk2 = wk[128 + lane];
    LAS bf16_t* img = (LAS bf16_t*)lds;
    const int t0 = tile * 64;
#pragma unroll 1
    for (int tt = 0; tt < 8; ++tt) {
        const int tloc = wave * 8 + tt, s = t0 + tloc; const size_t tl = (size_t)bl * SEQ + s;
        const f32x2 cssn = CS[((size_t)(g * BPG + bl) * SEQ + s) * 32 + (lane & 31)];
        const float cs = cssn[0], sn = cssn[1];
        const float kpe = bf2f(proj[tl * PLD + 3080 + lane]);
#pragma unroll
        for (int h = 0; h < 4; ++h) {
            const size_t ob = ((size_t)(bl * 4 + h) * SEQ + s) * 192;
            {
                const bf16_t* qr = qraw + tl * 768 + h * 192;
                float q0 = bf2f(qr[lane]), q1 = bf2f(qr[64 + lane]), q2 = bf2f(qr[128 + lane]);
                const float r = rsqrtf(wave_sum(q0 * q0 + q1 * q1 + q2 * q2) * (1.f / 192.f) + EPS);
                q0 *= r * wq0; q1 *= r * wq1; q2 *= r * wq2;
                const float qp = __shfl_xor(q2, 32);
                q2 = (lane < 32) ? q2 * cs - qp * sn : q2 * cs + qp * sn;
                bf16_t* qo = Qf + ob;
                qo[lane] = f2bf(q0 * qscale); qo[64 + lane] = f2bf(q1 * qscale); qo[128 + lane] = f2bf(q2 * qscale);
            }
            const bf16_t* kr = kvraw + tl * 1024 + h * 256;
            {
                float k0 = bf2f(kr[lane]), k1 = bf2f(kr[64 + lane]), k2 = kpe;
                const float r = rsqrtf(wave_sum(k0 * k0 + k1 * k1 + k2 * k2) * (1.f / 192.f) + EPS);
                k0 *= r * wk0; k1 *= r * wk1; k2 *= r * wk2;
                const float kp = __shfl_xor(k2, 32);
                k2 = (lane < 32) ? k2 * cs - kp * sn : k2 * cs + kp * sn;
                bf16_t* ko = Kf + ob;
                ko[lane] = f2bf(k0); ko[64 + lane] = f2bf(k1); ko[128 + lane] = f2bf(k2);
            }
            img[(h * 128 + lane) * 72 + tloc] = kr[128 + lane]; img[(h * 128 + 64 + lane) * 72 + tloc] = kr[192 + lane];
        }
    }
    __syncthreads();
#pragma unroll
    for (int i = 0; i < 8; ++i) {
        const int ch = tid + 512 * i, row = ch >> 3, cc = ch & 7;
        *(u32x4*)(Vt + ((size_t)(bl * 4 + (row >> 7)) * 128 + (row & 127)) * SEQ + t0 + cc * 8) = *(const LAS u32x4*)(lds + row * 144 + cc * 16);
    }
    __syncthreads();
}

constexpr int KP = 400, VP = 136, KBYTES = 64 * KP, VBYTES = 128 * VP, ASTAGE = KBYTES + VBYTES;
DI void attn_unit(const bf16_t* Qf, const bf16_t* Kf, const bf16_t* Vt, bf16_t* yc, int bh, int qb, LAS unsigned char* lds) {
    const int tid = tid_now(), wave = tid >> 6, lane = tid & 63, r31 = lane & 31, hh = lane >> 5;
    const int q0 = qb * 256, qrow = q0 + wave * 32 + r31;
    const bf16_t* Qp = Qf + ((size_t)bh * SEQ + qrow) * 192 + 8 * hh;
    bf16x8 qf[12];
#pragma unroll
    for (int kk = 0; kk < 12; ++kk) qf[kk] = *(const bf16x8*)(Qp + kk * 16);
    f32x16 o[4];
#pragma unroll
    for (int d = 0; d < 4; ++d)
#pragma unroll
        for (int i = 0; i < 16; ++i) o[d][i] = 0.f;
    float m = -1e30f, l = 0.f;
    const int ntiles = qb * 4 + 4;
    const bf16_t* Kb = Kf + (size_t)bh * SEQ * 192; const bf16_t* Vb = Vt + (size_t)bh * 128 * SEQ;
    int krow[3], kcc[3], vd[2], vcc[2];
#pragma unroll
    for (int i = 0; i < 3; ++i) { const int c = tid + 512 * i; krow[i] = c / 24; kcc[i] = c % 24; }
#pragma unroll
    for (int i = 0; i < 2; ++i) { const int c = tid + 512 * i; vd[i] = c >> 3; vcc[i] = c & 7; }
    u32x4 kreg[3], vreg[2];
#define ATT_GLOAD(j) do { _Pragma("unroll") for (int i = 0; i < 3; ++i) kreg[i] = *(const u32x4*)(Kb + (size_t)((j) * 64 + krow[i]) * 192 + kcc[i] * 8); \
        _Pragma("unroll") for (int i = 0; i < 2; ++i) vreg[i] = *(const u32x4*)(Vb + (size_t)vd[i] * SEQ + (j) * 64 + vcc[i] * 8); } while (0)
#define ATT_LSTORE(st) do { LAS unsigned char* b_ = lds + (st) * ASTAGE; \
        _Pragma("unroll") for (int i = 0; i < 3; ++i) *(LAS u32x4*)(b_ + krow[i] * KP + kcc[i] * 16) = kreg[i]; \
        _Pragma("unroll") for (int i = 0; i < 2; ++i) { LAS u32x2* d_ = (LAS u32x2*)(b_ + KBYTES + vd[i] * VP + vcc[i] * 16); d_[0] = (u32x2){vreg[i].x, vreg[i].y}; d_[1] = (u32x2){vreg[i].z, vreg[i].w}; } } while (0)
    ATT_GLOAD(0); ATT_LSTORE(0);
    __syncthreads();
    for (int j = 0; j < ntiles; ++j) {
        const int cur = j & 1;
        if (j + 1 < ntiles) ATT_GLOAD(j + 1);
        if (j * 64 <= q0 + wave * 32 + 31) {
            const LAS unsigned char* Kl = lds + cur * ASTAGE; const LAS unsigned char* Vl = Kl + KBYTES;
            f32x16 s0, s1;
#pragma unroll
            for (int i = 0; i < 16; ++i) { s0[i] = 0.f; s1[i] = 0.f; }
#pragma unroll
            for (int kk = 0; kk < 12; ++kk) {
                const bf16x8 a0 = *(const LAS bf16x8*)(Kl + r31 * KP + (kk * 16 + 8 * hh) * 2);
                const bf16x8 a1 = *(const LAS bf16x8*)(Kl + (32 + r31) * KP + (kk * 16 + 8 * hh) * 2);
                s0 = MFMA32(a0, qf[kk], s0); s1 = MFMA32(a1, qf[kk], s1);
            }
            if (j * 64 + 63 > q0 + wave * 32) {
#pragma unroll
                for (int i = 0; i < 16; ++i) { const int key = j * 64 + crow(i, hh); if (key > qrow) s0[i] = -1e30f; if (key + 32 > qrow) s1[i] = -1e30f; }
            }
            float mx = s0[0];
#pragma unroll
            for (int i = 1; i < 16; ++i) mx = fmaxf(mx, s0[i]);
#pragma unroll
            for (int i = 0; i < 16; ++i) mx = fmaxf(mx, s1[i]);
            mx = fmaxf(mx, __shfl_xor(mx, 32));
            const float mn = fmaxf(m, mx), alpha = __builtin_amdgcn_exp2f(m - mn);
            m = mn;
            float ls = 0.f;
#pragma unroll
            for (int i = 0; i < 16; ++i) { s0[i] = __builtin_amdgcn_exp2f(s0[i] - mn); s1[i] = __builtin_amdgcn_exp2f(s1[i] - mn); ls += s0[i] + s1[i]; }
            l = l * alpha + ls;
#pragma unroll
            for (int d = 0; d < 4; ++d)
#pragma unroll
                for (int i = 0; i < 16; ++i) o[d][i] *= alpha;
            bf16x8 pf[2][2];
#pragma unroll
            for (int s = 0; s < 2; ++s) {
                u32x4 w0, w1;
                w0.x = pk2(s0[8 * s], s0[8 * s + 1]); w0.y = pk2(s0[8 * s + 2], s0[8 * s + 3]); w0.z = pk2(s0[8 * s + 4], s0[8 * s + 5]); w0.w = pk2(s0[8 * s + 6], s0[8 * s + 7]);
                w1.x = pk2(s1[8 * s], s1[8 * s + 1]); w1.y = pk2(s1[8 * s + 2], s1[8 * s + 3]); w1.z = pk2(s1[8 * s + 4], s1[8 * s + 5]); w1.w = pk2(s1[8 * s + 6], s1[8 * s + 7]);
                pf[0][s] = __builtin_bit_cast(bf16x8, w0); pf[1][s] = __builtin_bit_cast(bf16x8, w1);
            }
#pragma unroll
            for (int d = 0; d < 4; ++d)
#pragma unroll
                for (int kb = 0; kb < 2; ++kb)
#pragma unroll
                    for (int s = 0; s < 2; ++s) {
                        const LAS unsigned char* vp = Vl + (d * 32 + r31) * VP + (kb * 32 + 16 * s + 4 * hh) * 2;
                        const s16x4 lo = *(const LAS s16x4*)vp, hi = *(const LAS s16x4*)(vp + 16);
                        const bf16x8 a = __builtin_shufflevector(lo, hi, 0, 1, 2, 3, 4, 5, 6, 7);
                        o[d] = MFMA32(a, pf[kb][s], o[d]);
                    }
        }
        if (j + 1 < ntiles) ATT_LSTORE(cur ^ 1);
        __syncthreads();
    }
#undef ATT_GLOAD
#undef ATT_LSTORE
    l += __shfl_xor(l, 32);
    const float inv = 1.f / l;
    const int bl = bh >> 2, h = bh & 3;
    bf16_t* op = yc + ((size_t)bl * SEQ + qrow) * 512 + h * 128 + 4 * hh;
#pragma unroll
    for (int d = 0; d < 4; ++d)
#pragma unroll
        for (int i4 = 0; i4 < 4; ++i4)
            *(u32x2*)(op + d * 32 + 8 * i4) = (u32x2){pk2(o[d][4 * i4] * inv, o[d][4 * i4 + 1] * inv), pk2(o[d][4 * i4 + 2] * inv, o[d][4 * i4 + 3] * inv)};
}

DI void gmlp_unit(const Params& p, int l, const bf16_t* proj, bf16_t* yb, int bl, int c, LAS unsigned char* lds) {
    const int tid = tid_now(), wave = tid >> 6, lane = tid & 63, r31 = lane & 31, hh = lane >> 5;
    const float* wsp = p.in[14] + (size_t)l * 4 * 128 * 128; const float* bs = p.in[15] + l * 512; const float* vn = p.in[13] + l * 512;
    const size_t tl0 = (size_t)bl * SEQ + c * 128;
    float w8[8];
#pragma unroll
    for (int j = 0; j < 8; ++j) w8[j] = vn[lane + 64 * j];
    LAS bf16_t* vt = (LAS bf16_t*)lds;
#pragma unroll 2
    for (int rr = 0; rr < 16; ++rr) {
        const int row = wave * 16 + rr;
        const bf16_t* vr = proj + (tl0 + row) * PLD + 2056 + lane;
        float f[8]; float ss = 0.f;
#pragma unroll
        for (int j = 0; j < 8; ++j) { f[j] = gelu_f(bf2f(vr[64 * j])); ss += f[j] * f[j]; }
        const float rstd = rsqrtf(wave_sum(ss) * (1.f / 512.f) + EPS);
#pragma unroll
        for (int j = 0; j < 8; ++j) vt[(lane + 64 * j) * 136 + row] = f2bf(f[j] * rstd * w8[j]);
    }
    __syncthreads();
    const int mb = wave & 3, nh = wave >> 2, trow = mb * 32 + r31;
#pragma unroll 1
    for (int g = 0; g < 4; ++g) {
        f32x16 a0, a1;
#pragma unroll
        for (int i = 0; i < 16; ++i) { a0[i] = 0.f; a1[i] = 0.f; }
        const float* wrow = wsp + ((size_t)g * 128 + trow) * 128 + 8 * hh;
#pragma unroll
        for (int kk = 0; kk < 8; ++kk) if (kk * 16 <= mb * 32 + 31) {
            const f32x4 x0 = *(const f32x4*)(wrow + kk * 16), x1 = *(const f32x4*)(wrow + kk * 16 + 4);
            const int sb = kk * 16 + 8 * hh;
            float f[8];
#pragma unroll
            for (int j = 0; j < 4; ++j) { f[j] = (sb + j <= trow) ? x0[j] : 0.f; f[4 + j] = (sb + 4 + j <= trow) ? x1[j] : 0.f; }
            const bf16x8 a = __builtin_bit_cast(bf16x8, PACK8(f));
            const bf16x8 b0 = *(const LAS bf16x8*)(vt + (g * 128 + nh * 64 + r31) * 136 + kk * 16 + 8 * hh);
            const bf16x8 b1 = *(const LAS bf16x8*)(vt + (g * 128 + nh * 64 + 32 + r31) * 136 + kk * 16 + 8 * hh);
            a0 = MFMA32(a, b0, a0); a1 = MFMA32(a, b1, a1);
        }
#pragma unroll
        for (int i = 0; i < 16; ++i) {
            const int t = mb * 32 + crow(i, hh); const float bias = bs[g * 128 + t];
            const bf16_t* ur = proj + (tl0 + t) * PLD + 1544 + g * 128 + nh * 64 + r31;
            bf16_t* orow = yb + (tl0 + t) * 512 + g * 128 + nh * 64 + r31;
            orow[0] = f2bf(gelu_f(bf2f(ur[0])) * (a0[i] + bias));
            orow[32] = f2bf(gelu_f(bf2f(ur[32])) * (a1[i] + bias));
        }
    }
    __syncthreads();
}

constexpr int SP = 136;
DI void scan128(float& v0, float& v1, int lane) {
#pragma unroll
    for (int o = 1; o < 64; o <<= 1) { const float n0 = __shfl_up(v0, o), n1 = __shfl_up(v1, o); if (lane >= o) { v0 += n0; v1 += n1; } }
    v1 += __shfl(v0, 63);
}
DI void ssd_states_unit(const bf16_t* xbcc, const float* dtb, float* ST, float* ATOT, int bl, int c, int grp, LAS unsigned char* lds) {
    const int tid = tid_now(), wave = tid >> 6, lane = tid & 63, r31 = lane & 31, hh = lane >> 5;
    LAS bf16_t* BT = (LAS bf16_t*)lds; LAS bf16_t* XT = (LAS bf16_t*)(lds + 34816); LAS float* WS = (LAS float*)(lds + 104448);
    const size_t row0 = (size_t)bl * SEQ + c * 128;
    if (wave < 4) {
        const int h = grp * 4 + wave;
        const float d0 = dtb[(row0 + lane) * 16 + h], d1 = dtb[(row0 + 64 + lane) * 16 + h];
        float v0 = dtb[(row0 + lane) * 16 + 8 + h], v1 = dtb[(row0 + 64 + lane) * 16 + 8 + h];
        scan128(v0, v1, lane);
        const float tot = __shfl(v1, 63);
        WS[wave * 128 + lane] = d0 * __expf(tot - v0); WS[wave * 128 + 64 + lane] = d1 * __expf(tot - v1);
        if (lane == 0) ATOT[(bl * 16 + c) * 8 + h] = tot;
    }
    __syncthreads();
#pragma unroll
    for (int i = 0; i < 4; ++i) {
        const int ch = tid + 512 * i, s = ch >> 4, n8 = (ch & 15) * 8;
        const u32x4 v = *(const u32x4*)(xbcc + (row0 + s) * 1024 + 512 + grp * 128 + n8);
        LAS bf16_t* d = BT + n8 * SP + s;
        d[0] = (bf16_t)(v.x & 0xffffu); d[SP] = (bf16_t)(v.x >> 16); d[2 * SP] = (bf16_t)(v.y & 0xffffu); d[3 * SP] = (bf16_t)(v.y >> 16);
        d[4 * SP] = (bf16_t)(v.z & 0xffffu); d[5 * SP] = (bf16_t)(v.z >> 16); d[6 * SP] = (bf16_t)(v.w & 0xffffu); d[7 * SP] = (bf16_t)(v.w >> 16);
    }
#pragma unroll
    for (int i = 0; i < 8; ++i) {
        const int ch = tid + 512 * i, s = ch >> 5, c8 = (ch & 31) * 8;
        const u32x4 v = *(const u32x4*)(xbcc + (row0 + s) * 1024 + grp * 256 + c8); float f[8]; UNPACK8(v, f);
        const float w = WS[(c8 >> 6) * 128 + s];
        LAS bf16_t* d = XT + c8 * SP + s;
#pragma unroll
        for (int j = 0; j < 8; ++j) d[j * SP] = f2bf(f[j] * w);
    }
    __syncthreads();
    const int hl = wave >> 1, pb = wave & 1;
    f32x16 acc[4];
#pragma unroll
    for (int nb = 0; nb < 4; ++nb)
#pragma unroll
        for (int i = 0; i < 16; ++i) acc[nb][i] = 0.f;
#pragma unroll
    for (int k = 0; k < 8; ++k) {
        const bf16x8 a = *(const LAS bf16x8*)(XT + (hl * 64 + pb * 32 + r31) * SP + k * 16 + 8 * hh);
#pragma unroll
        for (int nb = 0; nb < 4; ++nb) { const bf16x8 b = *(const LAS bf16x8*)(BT + (nb * 32 + r31) * SP + k * 16 + 8 * hh); acc[nb] = MFMA32(a, b, acc[nb]); }
    }
    float* so = ST + (((size_t)bl * 16 + c) * 8 + grp * 4 + hl) * 8192;
#pragma unroll
    for (int nb = 0; nb < 4; ++nb)
#pragma unroll
        for (int i = 0; i < 16; ++i) so[(pb * 32 + crow(i, hh)) * 128 + nb * 32 + r31] = acc[nb][i];
    __syncthreads();
}
DI void ssd_scan(const float* ST, bf16_t* STB, const float* ATOT) {
    const int tidn = tid_now();
    for (int idx = wg_now() * 512 + tidn; idx < 64 * 2048; idx += nwg_now() * 512) {
        const int bh = idx >> 11, e4 = idx & 2047, bl = bh >> 3, head = bh & 7;
        const size_t off = ((size_t)bl * 16 * 8 + head) * 8192 + e4 * 4;
        f32x4 sv[16];
#pragma unroll
        for (int c = 0; c < 16; ++c) sv[c] = *(const f32x4*)(ST + off + (size_t)c * 8 * 8192);
        f32x4 run = {0.f, 0.f, 0.f, 0.f};
#pragma unroll
        for (int c = 0; c < 16; ++c) { const float ea = __expf(ATOT[(bl * 16 + c) * 8 + head]);
            *(u32x2*)(STB + off + (size_t)c * 8 * 8192) = (u32x2){pk2(run[0], run[1]), pk2(run[2], run[3])}; run = run * ea + sv[c]; }
    }
}
DI void ssd_out_grp(const Params& p, int l, const bf16_t* proj, const bf16_t* xbcc, const float* dtb, const bf16_t* STB, float* yraw, bf16_t* ya, int bl, int c, int grp, LAS unsigned char* lds) {
    const int tid = tid_now(), wave = tid >> 6, lane = tid & 63, r31 = lane & 31, hh = lane >> 5;
    LAS bf16_t* CL = (LAS bf16_t*)lds; LAS bf16_t* BL = (LAS bf16_t*)(lds + 34816); LAS bf16_t* XT = (LAS bf16_t*)(lds + 69632); LAS bf16_t* PV = (LAS bf16_t*)(lds + 104448);
    LAS float* ACS = (LAS float*)(lds + 139264); LAS float* DTL = (LAS float*)(lds + 140288); LAS float* RS = (LAS float*)(lds + 141312); LAS float* OUT = (LAS float*)(lds + 69632);
    const size_t row0 = (size_t)bl * SEQ + c * 128;
#pragma unroll
    for (int i = 0; i < 4; ++i) {
        const int ch = tid + 512 * i, s = ch >> 4, n8 = (ch & 15) * 8;
        const bf16_t* xr = xbcc + (row0 + s) * 1024;
        *(LAS u32x4*)(CL + s * SP + n8) = *(const u32x4*)(xr + 768 + grp * 128 + n8);
        *(LAS u32x4*)(BL + s * SP + n8) = *(const u32x4*)(xr + 512 + grp * 128 + n8);
    }
#pragma unroll 1
    for (int pi = 0; pi < 2; ++pi) {
        const int pair = grp * 2 + pi;
        if (wave < 2) {
            const int h = pair * 2 + wave;
            const float d0 = dtb[(row0 + lane) * 16 + h], d1 = dtb[(row0 + 64 + lane) * 16 + h];
            float v0 = dtb[(row0 + lane) * 16 + 8 + h], v1 = dtb[(row0 + 64 + lane) * 16 + 8 + h];
            scan128(v0, v1, lane);
            ACS[wave * 128 + lane] = v0; ACS[wave * 128 + 64 + lane] = v1; DTL[wave * 128 + lane] = d0; DTL[wave * 128 + 64 + lane] = d1;
        }
        __syncthreads();
#pragma unroll
        for (int i = 0; i < 4; ++i) {
            const int ch = tid + 512 * i, s = ch >> 4, n8 = (ch & 15) * 8;
            const u32x4 v = *(const u32x4*)(xbcc + (row0 + s) * 1024 + pair * 128 + n8); float f[8]; UNPACK8(v, f);
            const float w = DTL[(n8 >> 6) * 128 + s];
            LAS bf16_t* d = XT + n8 * SP + s;
#pragma unroll
            for (int j = 0; j < 8; ++j) d[j * SP] = f2bf(f[j] * w);
            *(LAS u32x4*)(PV + s * SP + n8) = *(const u32x4*)(STB + (((size_t)bl * 16 + c) * 8 + pair * 2) * 8192 + (size_t)s * 128 + n8);
        }
        __syncthreads();
        const int tb = wave >> 1, hl = wave & 1;
        f32x16 acc[2];
#pragma unroll
        for (int pb = 0; pb < 2; ++pb)
#pragma unroll
            for (int i = 0; i < 16; ++i) acc[pb][i] = 0.f;
        const LAS bf16_t* crw = CL + (tb * 32 + r31) * SP + 8 * hh;
#pragma unroll
        for (int k = 0; k < 8; ++k) {
            const bf16x8 b = *(const LAS bf16x8*)(crw + k * 16);
#pragma unroll
            for (int pb = 0; pb < 2; ++pb) { const bf16x8 a = *(const LAS bf16x8*)(PV + (hl * 64 + pb * 32 + r31) * SP + k * 16 + 8 * hh); acc[pb] = MFMA32(a, b, acc[pb]); }
        }
        const float at = ACS[hl * 128 + tb * 32 + r31], eat = __expf(at);
#pragma unroll
        for (int pb = 0; pb < 2; ++pb)
#pragma unroll
            for (int i = 0; i < 16; ++i) acc[pb][i] *= eat;
#pragma unroll 1
        for (int sb = 0; sb <= tb; ++sb) {
            f32x16 cbt;
#pragma unroll
            for (int i = 0; i < 16; ++i) cbt[i] = 0.f;
#pragma unroll
            for (int k = 0; k < 8; ++k) {
                const bf16x8 a = *(const LAS bf16x8*)(BL + (sb * 32 + r31) * SP + k * 16 + 8 * hh);
                const bf16x8 b = *(const LAS bf16x8*)(crw + k * 16);
                cbt = MFMA32(a, b, cbt);
            }
#pragma unroll
            for (int i = 0; i < 16; ++i) {
                const int sl = crow(i, hh); const float as = ACS[hl * 128 + sb * 32 + sl];
                const float mv = cbt[i] * __expf(fminf(at - as, 0.f));
                cbt[i] = (sb == tb && sl > r31) ? 0.f : mv;
            }
#pragma unroll
            for (int ks = 0; ks < 2; ++ks) {
                u32x4 w; w.x = pk2(cbt[8 * ks], cbt[8 * ks + 1]); w.y = pk2(cbt[8 * ks + 2], cbt[8 * ks + 3]); w.z = pk2(cbt[8 * ks + 4], cbt[8 * ks + 5]); w.w = pk2(cbt[8 * ks + 6], cbt[8 * ks + 7]);
                const bf16x8 pfr = __builtin_bit_cast(bf16x8, w);
#pragma unroll
                for (int pb = 0; pb < 2; ++pb) {
                    const LAS bf16_t* vp = XT + (hl * 64 + pb * 32 + r31) * SP + sb * 32 + 16 * ks + 4 * hh;
                    const s16x4 lo = *(const LAS s16x4*)vp, hi = *(const LAS s16x4*)(vp + 8);
                    const bf16x8 a = __builtin_shufflevector(lo, hi, 0, 1, 2, 3, 4, 5, 6, 7);
                    acc[pb] = MFMA32(a, pfr, acc[pb]);
                }
            }
        }
        __syncthreads();
#pragma unroll
        for (int pb = 0; pb < 2; ++pb)
#pragma unroll
            for (int i = 0; i < 16; ++i) OUT[(tb * 32 + r31) * 132 + hl * 64 + pb * 32 + crow(i, hh)] = acc[pb][i];
        __syncthreads();
#pragma unroll
        for (int i = 0; i < 4; ++i) {
            const int it = tid + 512 * i, t = it >> 4, c8 = (it & 15) * 8;
            const f32x4 y0 = *(const LAS f32x4*)(OUT + t * 132 + c8), y1 = *(const LAS f32x4*)(OUT + t * 132 + c8 + 4);
            const u32x4 xv = *(const u32x4*)(xbcc + (row0 + t) * 1024 + pair * 128 + c8), zv = *(const u32x4*)(proj + (row0 + t) * PLD + pair * 128 + c8);
            float fx[8], fz[8]; UNPACK8(xv, fx); UNPACK8(zv, fz);
            const float Dh = p.in[11][l * 8 + pair * 2 + (c8 >> 6)];
            f32x4 o0, o1;
#pragma unroll
            for (int j = 0; j < 4; ++j) { o0[j] = (y0[j] + Dh * fx[j]) * silu_f(fz[j]); o1[j] = (y1[j] + Dh * fx[4 + j]) * silu_f(fz[4 + j]); }
            float* op = yraw + (row0 + t) * 512 + pair * 128 + c8; *(f32x4*)op = o0; *(f32x4*)(op + 4) = o1;
            float ss = 0.f;
#pragma unroll
            for (int j = 0; j < 4; ++j) ss += o0[j] * o0[j] + o1[j] * o1[j];
            ss += __shfl_xor(ss, 1); ss += __shfl_xor(ss, 2); ss += __shfl_xor(ss, 4); ss += __shfl_xor(ss, 8);
            if ((tid & 15) == 0) RS[t] = pi == 0 ? ss : RS[t] + ss;
        }
        __syncthreads();
    }
    const float* nw = p.in[12] + l * 512 + grp * 256;
#pragma unroll
    for (int i = 0; i < 8; ++i) {
        const int it = tid + 512 * i, t = it >> 5, c8 = (it & 31) * 8;
        const float* yr = yraw + (row0 + t) * 512 + grp * 256 + c8;
        const f32x4 a = *(const f32x4*)yr, b = *(const f32x4*)(yr + 4), w0 = *(const f32x4*)(nw + c8), w1 = *(const f32x4*)(nw + c8 + 4);
        const float rstd = rsqrtf(RS[t] * (1.f / 256.f) + EPS);
        *(u32x4*)(ya + (row0 + t) * 512 + grp * 256 + c8) = (u32x4){pk2(a[0] * rstd * w0[0], a[1] * rstd * w0[1]), pk2(a[2] * rstd * w0[2], a[3] * rstd * w0[3]),
                                                                      pk2(b[0] * rstd * w1[0], b[1] * rstd * w1[1]), pk2(b[2] * rstd * w1[2], b[3] * rstd * w1[3])};
    }
    __syncthreads();
}

#if MULTI_LAUNCH
#define RUNPH(x) ((x) == p.only_phase)
#define GSYNC() do {} while (0)
#else
#define RUNPH(x) true
#define GSYNC() do { XcdBarrier xb_; xb_.bar = (unsigned*)(p.ws + O_BAR); xb_.x = xb_xcc_id(); xb_.st = (volatile LAS unsigned*)(lds + LDS_BYTES - 16); xcd_barrier(xb_); if (PROBE & 1) xcd_barrier(xb_); } while (0)
#endif
#define PH_BEGIN if (RUNPH(ph)) { unsigned char* ws = p.ws; float* X = p.out; asm volatile("" : "+s"(ws), "+s"(X)); const int wg = wg_now(), nwg = nwg_now();
#define PH_END } ++ph; GSYNC();
__global__ void __launch_bounds__(512) mega(Params p) {
    extern __shared__ __attribute__((aligned(16))) unsigned char smem[];
    LAS unsigned char* lds = (LAS unsigned char*)smem;
#if !MULTI_LAUNCH
    cg::grid_group grid = cg::this_grid();
    volatile LAS unsigned* xst = (volatile LAS unsigned*)(lds + LDS_BYTES - 16);
    if (threadIdx.x == 0) { xst[0] = 0u; xst[1] = 0u; }
    __syncthreads();
    (void)xcd_barrier_post((unsigned*)(p.ws + O_BAR), xst);
    grid.sync();
#endif
#define XN ((bf16_t*)(ws + O_XN))
#define SSQ0 ((float*)(ws + O_SSQ))
#define SSQ1 (SSQ0 + (size_t)T_ALL * 16)
#define SSQ2 (SSQ0 + (size_t)2 * T_ALL * 16)
#define H ((bf16_t*)(ws + O_H))
#define PROJ ((bf16_t*)(ws + O_PROJ))
#define XBCC ((bf16_t*)(ws + O_XBCC))
#define ST ((float*)(ws + O_ST))
#define ATOT ((float*)(ws + O_ATOT))
#define STB ((bf16_t*)(ws + O_STB))
#define DTB ((float*)(ws + O_DTB))
#define AQ ((bf16_t*)(ws + O_AQ))
#define AKV ((bf16_t*)(ws + O_AKV))
#define QRAW ((bf16_t*)(ws + O_QRAW))
#define KVRAW ((bf16_t*)(ws + O_KVRAW))
#define QF ((bf16_t*)(ws + O_QF))
#define KF ((bf16_t*)(ws + O_KF))
#define VT ((bf16_t*)(ws + O_VT))
#define YRAW ((float*)(ws + O_YRAW))
#define YA ((bf16_t*)(ws + O_YA))
#define YB (YA + (size_t)TG * 512)
#define YC (YA + (size_t)2 * TG * 512)
#define YD (YA + (size_t)3 * TG * 512)
#define CS ((f32x2*)(ws + O_CS))
#define PB ((bf16_t*)(ws + O_PB))
#define MIXB ((bf16_t*)(ws + O_MIXB))
#define WIN ((const bf16_t*)(ws + O_WIN))
#define WGATE ((const bf16_t*)(ws + O_WGATE))
#define WBR ((const bf16_t*)(ws + O_WBR))
#define WOUT ((const bf16_t*)(ws + O_WOUT))
#define WQB ((const bf16_t*)(ws + O_WQB))
#define WKVB ((const bf16_t*)(ws + O_WKVB))
#define XNg (XN + (size_t)g * TG * 1024)
    int ph = 0;
#pragma unroll 1
    for (int l = 0; l < 4; ++l) {
#pragma unroll 1
        for (int f = 0; f < 2; ++f) {
            if (f == 0) {
                PH_BEGIN
                    REP(32) convert_layer(p, l, (LAS float*)lds, wg, nwg);
                    if (l == 0) { rope_table(p, CS); init_rows(p.in[0], XN, SSQ0); }
                PH_END
            }
            PH_BEGIN
                EpiGU e{H, f == 0 ? SSQ0 : SSQ2};
#pragma unroll 1
                for (int rep = 0; rep < ((PROBE & 16) ? 2 : 1); ++rep) run_gemm(lds, XN, (const bf16_t*)(ws + (f == 0 ? O_WGU1 : O_WGU2)), T_ALL, 5632, 1024, e);
            PH_END
            PH_BEGIN
                if (PROBE & 256) { EpiRes e0{XN, f == 0 ? SSQ1 : SSQ0, (l == 3 && f == 1) ? X : nullptr, 0.0f}; run_gemm(lds, H, (const bf16_t*)(ws + (f == 0 ? O_WD1 : O_WD2)), T_ALL, 1024, 2816, e0); }
                EpiRes e{XN, f == 0 ? SSQ1 : SSQ0, (l == 3 && f == 1) ? X : nullptr, 0.5f}; run_gemm(lds, H, (const bf16_t*)(ws + (f == 0 ? O_WD1 : O_WD2)), T_ALL, 1024, 2816, e);
            PH_END
            if (f == 0) {
#pragma unroll 1
                for (int g = 0; g < NGRP; ++g) {
                    if (g == 0) {
                        PH_BEGIN
                            EpiStore e{PROJ, PLD, 0x7fffffff, SSQ1}; run_gemm(lds, XN, WIN, TG, 4864, 1024, e);
                        PH_END
                    }
                    PH_BEGIN
                        REP(4) prep1(p, l, PROJ, XBCC, DTB, AQ, AKV, YD);
                    PH_END
                    PH_BEGIN
                        REP(64) {
                        { EpiStore e{QRAW, 768, 0x7fffffff, nullptr}; run_gemm(lds, AQ, WQB, TG, 768, 384, e); }
                        { EpiStore e{KVRAW, 1024, 0x7fffffff, nullptr}; run_gemm(lds, AKV, WKVB, TG, 1024, 256, e); }
#pragma unroll 1
                        for (int u = wg; u < 256; u += nwg) {
                            ssd_states_unit(XBCC, DTB, ST, ATOT, u >> 5, (u >> 1) & 15, u & 1, lds);
                        }
                        }
                    PH_END
                    PH_BEGIN
                        REP(4) for (int u = wg; u < 256; u += nwg) prep2_unit(p, l, g, PROJ, QRAW, KVRAW, CS, QF, KF, VT, u >> 5, u & 31, lds);
                        ssd_scan(ST, STB, ATOT);
                    PH_END
                    PH_BEGIN
                        {
                            unsigned* ctr = (unsigned*)(ws + O_WQ) + (l * 4 + g);
                            volatile LAS unsigned* wq = (volatile LAS unsigned*)(lds + LDS_BYTES - 32);
#pragma unroll 1
                            for (;;) {
                                __syncthreads();
                                if (tid_now() == 0) *wq = atomicAdd(ctr, 1u);
                                __syncthreads();
                                const int u = (int)*wq;
                                if (u >= 640) break;
                                if (u < 64) { REP(2048) attn_unit(QF, KF, VT, YC, u & 31, 7 - (u >> 5), lds); }
                                else if (u < 320) { const int k = u - 64; REP(1024) ssd_out_grp(p, l, PROJ, XBCC, DTB, STB, YRAW, YA, k >> 5, (k >> 1) & 15, k & 1, lds); }
                                else if (u < 512) { const int k = u - 320; REP(2048) attn_unit(QF, KF, VT, YC, k & 31, 5 - (k >> 5), lds); }
                                else { const int k = u - 512; gmlp_unit(p, l, PROJ, YB, k >> 4, k & 15, lds); }
                            }
                        }
                    PH_END
                    PH_BEGIN
                        EpiStore e{PB, 1024, 3, nullptr}; pg8::Gemm gm{YA, WBR, 4 * TG, 4096, 512}; BranchOrder S; S.G = nwg; S.c = wg;
                        REP(128) pg8::gemm_phase<EpiStore, BranchOrder>(lds, gm, S, e);
                    PH_END
                    PH_BEGIN
                        EpiMerge e{PB, MIXB, SSQ1 + (size_t)g * TG * 16}; REP(128) run_gemm(lds, XNg, WGATE, TG, 4096, 1024, e);
                    PH_END
                    PH_BEGIN
                        { EpiRes e{XNg, SSQ2 + (size_t)g * TG * 16, nullptr, 1.0f}; run_gemm(lds, MIXB, WOUT, TG, 1024, 1024, e); }
                        if (g < NGRP - 1) {
                            EpiStore e{PROJ, PLD, 0x7fffffff, SSQ1 + (size_t)(g + 1) * TG * 16}; run_gemm(lds, XN + (size_t)(g + 1) * TG * 1024, WIN, TG, 4864, 1024, e); }
                    PH_END
                }
            }
        }
    }
}

constexpr int N_PHASES = 4 * (1 + 2 + 1 + 4 * 7 + 2);

extern "C" void kernel_launch(void* const* d_in, const int* in_sizes, int n_in, void* d_out, int out_size, void* d_ws, size_t ws_size, hipStream_t stream) {
    static int grid_blocks = 0;
    if (!grid_blocks) {
        if (n_in != 28 || ws_size < WS_NEED) { fprintf(stderr, "kernel_launch: need 28 inputs and %zu bytes of workspace (got %d, %zu)\n", (size_t)WS_NEED, n_in, ws_size); grid_blocks = -1; return; }
        if (hipFuncSetAttribute((const void*)mega, hipFuncAttributeMaxDynamicSharedMemorySize, LDS_BYTES) != hipSuccess) { fprintf(stderr, "kernel_launch: hipFuncSetAttribute failed\n"); grid_blocks = -1; return; }
        int dev = 0, cus = 0, per_cu = 0;
        hipGetDevice(&dev); hipDeviceGetAttribute(&cus, hipDeviceAttributeMultiprocessorCount, dev);
        hipOccupancyMaxActiveBlocksPerMultiprocessor(&per_cu, mega, 512, LDS_BYTES);
        if (per_cu < 1) { fprintf(stderr, "kernel_launch: occupancy query returned %d\n", per_cu); per_cu = 1; }
        (void)hipGetLastError();
        grid_blocks = cus * per_cu;
    }
    if (grid_blocks < 0) return;
    Params p{};
    for (int i = 0; i < 28; ++i) p.in[i] = (const float*)d_in[i];
    p.out = (float*)d_out; p.ws = (unsigned char*)d_ws; p.only_phase = -1; p.pad = 0;
#if MULTI_LAUNCH
    for (int ph = 0; ph < N_PHASES; ++ph) { p.only_phase = ph; hipLaunchKernelGGL(mega, dim3(grid_blocks), dim3(512), LDS_BYTES, stream, p); }
#else
    if (hipMemsetAsync((unsigned char*)d_ws + O_BAR, 0, ZERO_BYTES, stream) != hipSuccess) { fprintf(stderr, "kernel_launch: memset of barrier words failed\n"); return; }
    void* args[] = {&p};
    hipError_t e = hipLaunchCooperativeKernel((void*)mega, dim3(grid_blocks), dim3(512), args, LDS_BYTES, stream);
    if (e != hipSuccess) fprintf(stderr, "cooperative launch failed: %s (grid %d)\n", hipGetErrorString(e), grid_blocks);
#endif
}
```

```cpp
#include <hip/hip_runtime.h>
#include <hip/hip_cooperative_groups.h>
#include <cstdio>
namespace cg = cooperative_groups;

#ifndef PROBE
#define PROBE 0
#endif
#define REP(bit) _Pragma("unroll 1") for (int rep_ = 0; rep_ < ((PROBE & (bit)) ? 2 : 1); ++rep_)
#ifndef MULTI_LAUNCH
#define MULTI_LAUNCH 0
#endif

__device__ __forceinline__ int tid_now() { int t = threadIdx.x; asm volatile("" : "+v"(t)); return t; }
__device__ __forceinline__ int wg_now() { int t = blockIdx.x; asm volatile("" : "+s"(t)); return t; }
__device__ __forceinline__ int nwg_now() { int t = gridDim.x; asm volatile("" : "+s"(t)); return t; }
namespace pg8 {
#define PG8_LAS __attribute__((address_space(3)))
typedef unsigned short bf16_t;
typedef short bf16x8 __attribute__((ext_vector_type(8)));
typedef float f32x4 __attribute__((ext_vector_type(4)));
typedef unsigned u32x4 __attribute__((ext_vector_type(4)));
constexpr int BM = 256, BK = 64, HALF = 128, HTB = HALF * BK * 2  , STAGE_BYTES = 8 * HTB, NXCD = 8, WGM = 8;

__host__ __device__ __forceinline__ int lds_byte(int r, int c) { const int st = (r >> 4) * 2 + (c >> 5), rr = r & 15, cc = c & 31, ob = rr * 64 + cc * 2; return st * 1024 + (ob ^ (((ob >> 9) & 1) << 5)); }
__host__ __device__ __forceinline__ void stage_rc(int b, int& R, int& C) { const int st = b / 1024, sb = b % 1024, swz = sb ^ (((sb >> 9) & 1) << 5); R = (st >> 1) * 16 + swz / 64; C = (st & 1) * 32 + (swz % 64) / 2; }
__host__ __device__ __forceinline__ int perm32(int rho) { const int n = rho >> 4, i = rho & 15; return 8 * (i >> 2) + 4 * n + (i & 3); }

struct Unit { int pm, pn; };
struct Gemm { const bf16_t* A; const bf16_t* Bt; int M, N, K; };

struct StaticOrder {
    int nM, nN, nwg, G, c;
    __host__ __device__ void init(int M, int N, int G_, int c_) { nM = M / BM; nN = N / BM; nwg = nM * nN; G = G_; c = c_; }
    __host__ __device__ bool next(int i, Unit& u) const {
        const long L = (long)i * G + c; if (L >= nwg) return false;
        int wgid = (int)L; { const int q = nwg / NXCD, r = nwg % NXCD, xcd = wgid % NXCD, off = wgid / NXCD; wgid = (xcd < r ? xcd * (q + 1) : r * (q + 1) + (xcd - r) * q) + off; }
        const int nig = WGM * nN, gid = wgid / nig, fm = gid * WGM, gsz = (nM - fm) < WGM ? (nM - fm) : WGM;
        u.pm = fm + ((wgid % nig) % gsz); u.pn = (wgid % nig) / gsz; return true;
    }
    __device__ __forceinline__ void a_ready(const Unit&) const {}
    __device__ __forceinline__ void done(const Unit&) const {}
};

template <class Epi, class Sched>
__device__ __forceinline__ void gemm_phase(PG8_LAS unsigned char* lds, const Gemm g, const Sched& S, const Epi& E) {
    const int tid = tid_now(), wid = __builtin_amdgcn_readfirstlane(tid >> 6), lane = tid & 63, wr = wid >> 2, wc = wid & 3, fr = lane & 15, fq = lane >> 4;
    const int K = g.K, nt = K / BK;
    unsigned voffA[2], voffB[2];
#pragma unroll
    for (int i = 0; i < 2; ++i) { int R, C; stage_rc(tid * 16 + i * 8192, R, C); const int Rb = Epi::PERM ? ((R & ~31) + perm32(R & 31)) : R;
        voffA[i] = (unsigned)(R * K + C) * 2u; voffB[i] = (unsigned)(Rb * K + C) * 2u; }
    const size_t kstep = (size_t)(BK * 2);
    const size_t hstep = (size_t)HALF * K * 2;
    const size_t tstep = 2 * hstep;
    const unsigned ldsw = (unsigned)wid * 1024u;
    const int aoff = lds_byte(wr * 64 + fr, fq * 8), boff = lds_byte(wc * 32 + fr, fq * 8);
#define PG8_SA(b, h) (((b) * 2 + (h)) * HTB)
#define PG8_SB(b, h) ((4 + (b) * 2 + (h)) * HTB)
#define PG8_STAGE(bufoff, gbase, voff) do { _Pragma("unroll") for (int _i = 0; _i < 2; ++_i) \
        __builtin_amdgcn_global_load_lds((const unsigned*)((const char*)(gbase) + (voff)[_i]), (PG8_LAS unsigned*)(lds + (bufoff) + ldsw + _i * 8192), 16, 0, 0); } while (0)
#define PG8_LDA(dst, b, h) do { _Pragma("unroll") for (int m = 0; m < 4; ++m) _Pragma("unroll") for (int k = 0; k < 2; ++k) dst[m][k] = *(const PG8_LAS bf16x8*)(lds + PG8_SA(b, h) + aoff + m * 2048 + k * 1024); } while (0)
#define PG8_LDB(dst, b, h) do { _Pragma("unroll") for (int n = 0; n < 2; ++n) _Pragma("unroll") for (int k = 0; k < 2; ++k) dst[n][k] = *(const PG8_LAS bf16x8*)(lds + PG8_SB(b, h) + boff + n * 2048 + k * 1024); } while (0)
#define PG8_MMA(ai, bj, At, Bt) do { __builtin_amdgcn_s_setprio(1); _Pragma("unroll") for (int m = 0; m < 4; ++m) _Pragma("unroll") for (int n = 0; n < 2; ++n) _Pragma("unroll") for (int k = 0; k < 2; ++k) \
        acc[ai][bj][m][n] = __builtin_amdgcn_mfma_f32_16x16x32_bf16(Bt[n][k], At[m][k], acc[ai][bj][m][n], 0, 0, 0); __builtin_amdgcn_s_setprio(0); } while (0)
#define PG8_WAIT_V(n) asm volatile("s_waitcnt vmcnt(" #n ")" ::: "memory")
#define PG8_WAIT_L(n) asm volatile("s_waitcnt lgkmcnt(" #n ")" ::: "memory")
#define PG8_BAR __builtin_amdgcn_s_barrier()
#define PG8_SCHED __builtin_amdgcn_sched_barrier(0)
    Unit cur, nxt; int ui = 0;
    if (!S.next(0, cur)) return;
    f32x4 acc[2][2][4][2];
#pragma unroll
    for (int a = 0; a < 2; ++a)
#pragma unroll
        for (int b = 0; b < 2; ++b)
#pragma unroll
            for (int m = 0; m < 4; ++m)
#pragma unroll
                for (int n = 0; n < 2; ++n) acc[a][b][m][n] = (f32x4){0.f, 0.f, 0.f, 0.f};
    bf16x8 At[4][2], B0[2][2], B1[2][2];
    const char* cA = (const char*)g.A + (size_t)cur.pm * tstep; const char* cB = (const char*)g.Bt + (size_t)cur.pn * tstep;
    S.a_ready(cur);
    PG8_STAGE(PG8_SB(0, 0), cB, voffB); PG8_STAGE(PG8_SA(0, 0), cA, voffA); PG8_STAGE(PG8_SB(0, 1), cB + hstep, voffB); PG8_STAGE(PG8_SA(0, 1), cA + hstep, voffA);
    if (wr == 1) PG8_BAR;
    PG8_WAIT_V(4); PG8_BAR;
    PG8_STAGE(PG8_SB(1, 0), cB + kstep, voffB); PG8_STAGE(PG8_SA(1, 0), cA + kstep, voffA); PG8_STAGE(PG8_SB(1, 1), cB + hstep + kstep, voffB);
    PG8_WAIT_V(6); PG8_BAR;
    for (;;) {
        const bool has_next = S.next(ui + 1, nxt);
        const char* nA = has_next ? (const char*)g.A + (size_t)nxt.pm * tstep : cA; const char* nB = has_next ? (const char*)g.Bt + (size_t)nxt.pn * tstep : cB;
        for (int t = 0; t < nt; t += 2) {
            const bool last = (t == nt - 2);
            const char* a1 = cA + (size_t)(t + 1) * kstep;
            const char* a2 = last ? nA : cA + (size_t)(t + 2) * kstep; const char* b2 = last ? nB : cB + (size_t)(t + 2) * kstep;
            const char* a3 = a2 + kstep; const char* b3 = b2 + kstep;
            if (last && has_next) S.a_ready(nxt);
            PG8_LDB(B0, 0, 0); PG8_SCHED; PG8_LDA(At, 0, 0); PG8_STAGE(PG8_SA(1, 1), a1 + hstep, voffA);
            PG8_WAIT_L(8); PG8_BAR; PG8_WAIT_L(0); PG8_MMA(0, 0, At, B0); PG8_BAR; PG8_SCHED;
            PG8_LDB(B1, 0, 1); PG8_STAGE(PG8_SB(0, 0), b2, voffB);
            PG8_BAR; PG8_WAIT_L(0); PG8_MMA(0, 1, At, B1); PG8_BAR;
            PG8_LDA(At, 0, 1); PG8_STAGE(PG8_SA(0, 0), a2, voffA);
            PG8_BAR; PG8_WAIT_L(0); PG8_MMA(1, 0, At, B0); PG8_BAR; PG8_SCHED;
            PG8_STAGE(PG8_SB(0, 1), b2 + hstep, voffB);
            PG8_WAIT_V(6); PG8_BAR; PG8_MMA(1, 1, At, B1); PG8_BAR;
            PG8_LDB(B0, 1, 0); PG8_SCHED; PG8_LDA(At, 1, 0); PG8_STAGE(PG8_SA(0, 1), a2 + hstep, voffA);
            PG8_WAIT_L(8); PG8_BAR; PG8_WAIT_L(0); PG8_MMA(0, 0, At, B0); PG8_BAR; PG8_SCHED;
            PG8_LDB(B1, 1, 1); PG8_STAGE(PG8_SB(1, 0), b3, voffB);
            PG8_BAR; PG8_WAIT_L(0); PG8_MMA(0, 1, At, B1); PG8_BAR;
            PG8_LDA(At, 1, 1); PG8_STAGE(PG8_SA(1, 0), a3, voffA);
            PG8_BAR; PG8_WAIT_L(0); PG8_MMA(1, 0, At, B0); PG8_BAR; PG8_SCHED;
            PG8_STAGE(PG8_SB(1, 1), b3 + hstep, voffB);
            PG8_WAIT_V(6); PG8_BAR; PG8_MMA(1, 1, At, B1); PG8_BAR;
        }
        if constexpr (!Epi::AFTER_DRAIN) { E(acc, cur, wr, wc, fr, fq); S.done(cur); }
        if (!has_next) break;
#pragma unroll
        for (int a = 0; a < 2; ++a)
#pragma unroll
            for (int b = 0; b < 2; ++b)
#pragma unroll
                for (int m = 0; m < 4; ++m)
#pragma unroll
                    for (int n = 0; n < 2; ++n) acc[a][b][m][n] = (f32x4){0.f, 0.f, 0.f, 0.f};
        cur = nxt; cA = nA; cB = nB; ++ui;
    }
    PG8_WAIT_V(0);
    if (wr == 0) PG8_BAR;
    PG8_BAR;
    if constexpr (Epi::AFTER_DRAIN) { E.fused(acc, cur, wr, wc, fr, fq, lds, wid, lane); S.done(cur); }
#undef PG8_SA
#undef PG8_SB
#undef PG8_STAGE
#undef PG8_LDA
#undef PG8_LDB
#undef PG8_MMA
#undef PG8_WAIT_V
#undef PG8_WAIT_L
#undef PG8_BAR
#undef PG8_SCHED
}
}


using pg8::bf16_t; using pg8::bf16x8; using pg8::f32x4; using pg8::u32x4;
typedef short s16x4 __attribute__((ext_vector_type(4)));
typedef float f32x2 __attribute__((ext_vector_type(2)));
typedef float f32x16 __attribute__((ext_vector_type(16)));
typedef unsigned u32x2 __attribute__((ext_vector_type(2)));
typedef __bf16 bf16v2 __attribute__((ext_vector_type(2)));
#define LAS __attribute__((address_space(3)))
#define DI __device__ __forceinline__
#define XB_TMO      128
#define XB_XCNT(j)  (256  + 64 * (j))
#define XB_XSUB(j)  (1280 + 64 * (j))
#define XB_XGEN(j)  (2304 + 64 * (j))
#define XB_TOP      3328
#define XB_TOPGEN   3392
#define XCD_BAR_WORDS 3456
#define XB_SPIN_CAP (1u << 18)

__device__ __forceinline__ unsigned xb_ld(unsigned* p)              { return __hip_atomic_load(p, __ATOMIC_RELAXED, __HIP_MEMORY_SCOPE_AGENT); }
__device__ __forceinline__ unsigned xb_add(unsigned* p, unsigned v) { return __hip_atomic_fetch_add(p, v, __ATOMIC_RELAXED, __HIP_MEMORY_SCOPE_AGENT); }
__device__ __forceinline__ unsigned xb_xcc_id() { return (unsigned)__builtin_amdgcn_s_getreg((3 << 11) | 20) & 0xFu; }
#define XB_SPIN(cond, bar) do { unsigned _sp = 0; while (cond) { __builtin_amdgcn_s_sleep(1); \
    if ((++_sp & 255u) == 0u) { if (xb_ld(&(bar)[XB_TMO])) break; if (_sp > XB_SPIN_CAP) { atomicAdd(&(bar)[XB_TMO], 1u); break; } } } } while (0)

struct XcdBarrier {
    unsigned* bar; unsigned x;
    volatile LAS unsigned* st;
};

__device__ __forceinline__ XcdBarrier xcd_barrier_post(unsigned* bar, volatile LAS unsigned* st) {
    XcdBarrier b; b.bar = bar; b.x = xb_xcc_id(); b.st = st;
    if (threadIdx.x == 0) (void)xb_add(&bar[XB_XCNT(b.x)], 1u);
    return b;
}
__device__ __forceinline__ void xcd_barrier_complete(unsigned* bar, unsigned x, unsigned& nloc, unsigned& nx) {
    const unsigned G = (unsigned)nwg_now();
    unsigned sum, cnt, mine, sp = 0u;
    for (;;) {
        sum = 0u; cnt = 0u; mine = 0u;
#pragma unroll
        for (unsigned j = 0; j < 16; ++j) { const unsigned c = xb_ld(&bar[XB_XCNT(j)]); sum += c; cnt += (c > 0u) ? 1u : 0u; mine = (j == x) ? c : mine; }
        if (sum == G) break;
        __builtin_amdgcn_s_sleep(1);
        if ((++sp & 255u) == 0u) { if (xb_ld(&bar[XB_TMO])) break; if (sp > XB_SPIN_CAP) { atomicAdd(&bar[XB_TMO], 1u); break; } }
    }
    nloc = mine > 0u ? mine : 1u; nx = cnt > 0u ? cnt : 1u;
}

__device__ __forceinline__ void xcd_barrier(const XcdBarrier& b) {
    asm volatile("s_waitcnt vmcnt(0)" ::: "memory");
    __syncthreads();
    if (tid_now() == 0) {
        unsigned* bar = b.bar; unsigned bx = b.x; asm volatile("" : "+s"(bar), "+s"(bx));
        __builtin_amdgcn_s_waitcnt(0);
        unsigned nloc = b.st[0], nx = b.st[1];
        if (nloc == 0u) { xcd_barrier_complete(bar, bx, nloc, nx); b.st[0] = nloc; b.st[1] = nx; }
        const unsigned old = xb_add(&bar[XB_XSUB(bx)], 1u);
        const unsigned gen = old / nloc;
        if (old + 1u == (gen + 1u) * nloc) {
            __builtin_amdgcn_fence(__ATOMIC_RELEASE, "agent");
            asm volatile("s_waitcnt vmcnt(0)" ::: "memory");
            const unsigned og = xb_add(&bar[XB_TOP], 1u);
            const unsigned tg = og / nx;
            if (og + 1u == (tg + 1u) * nx) xb_add(&bar[XB_TOPGEN], 1u);
            else XB_SPIN(xb_ld(&bar[XB_TOPGEN]) == tg, bar);
            __builtin_amdgcn_fence(__ATOMIC_ACQUIRE, "agent");
            xb_add(&bar[XB_XGEN(bx)], 1u);
            asm volatile("s_waitcnt vmcnt(0)" ::: "memory");
        } else {
            XB_SPIN(xb_ld(&bar[XB_XGEN(bx)]) == gen, bar);
            __builtin_amdgcn_fence(__ATOMIC_ACQUIRE, "agent");
            asm volatile("s_waitcnt vmcnt(0)" ::: "memory");
        }
    }
    __syncthreads();
}


#define MFMA32(a, b, c) __builtin_amdgcn_mfma_f32_32x32x16_bf16((a), (b), (c), 0, 0, 0)

constexpr int T_ALL = 65536, SEQ = 2048, NGRP = 4, TG = 16384, BPG = 8, PLD = 4864;
constexpr float EPS = 1e-6f;
constexpr size_t SZ_GU = (size_t)5632 * 1024 * 2, SZ_D = (size_t)1024 * 2816 * 2;
constexpr size_t O_WGU1 = 0, O_WD1 = O_WGU1 + SZ_GU, O_WGU2 = O_WD1 + SZ_D, O_WD2 = O_WGU2 + SZ_GU, O_WIN = O_WD2 + SZ_D;
constexpr size_t O_WGATE = O_WIN + (size_t)4864 * 1024 * 2, O_WBR = O_WGATE + (size_t)4096 * 1024 * 2, O_WOUT = O_WBR + (size_t)4 * 1024 * 512 * 2;
constexpr size_t O_WQB = O_WOUT + (size_t)1024 * 1024 * 2, O_WKVB = O_WQB + (size_t)768 * 384 * 2, O_XN = O_WKVB + (size_t)1024 * 256 * 2;
constexpr size_t O_R0 = O_XN + (size_t)T_ALL * 1024 * 2;
constexpr size_t O_H = O_R0;
constexpr size_t O_PROJ = O_R0, O_XBCC = O_PROJ + (size_t)TG * PLD * 2, O_DTB = O_XBCC + (size_t)TG * 1024 * 2, O_AQ = O_DTB + (size_t)TG * 16 * 4;
constexpr size_t O_AKV = O_AQ + (size_t)TG * 384 * 2, O_QRAW = O_AKV + (size_t)TG * 256 * 2, O_KVRAW = O_QRAW + (size_t)TG * 768 * 2;
constexpr size_t O_QF = O_KVRAW + (size_t)TG * 1024 * 2, O_KF = O_QF + (size_t)TG * 768 * 2, O_VT = O_KF + (size_t)TG * 768 * 2;
constexpr size_t O_YRAW = O_VT + (size_t)TG * 512 * 2, O_YA = O_YRAW + (size_t)TG * 512 * 4;
constexpr size_t O_PB = O_YA + (size_t)4 * TG * 512 * 2, O_MIXB = O_PB + (size_t)4 * TG * 1024 * 2;
constexpr size_t O_ST = O_MIXB + (size_t)TG * 1024 * 2, O_ATOT = O_ST + (size_t)BPG * 16 * 8 * 8192 * 4;
constexpr size_t O_STB = O_ATOT + 4096;
constexpr size_t O_BAR = O_STB + (size_t)BPG * 16 * 8 * 8192 * 2;
constexpr size_t O_WQ = O_BAR + (size_t)XCD_BAR_WORDS * 4;
constexpr size_t ZERO_BYTES = (size_t)XCD_BAR_WORDS * 4 + 256;
constexpr size_t O_CS = O_WQ + 256 + 256 - ((size_t)XCD_BAR_WORDS * 4) % 256;
constexpr size_t O_SSQ = O_CS + (size_t)T_ALL * 32 * 8;
constexpr size_t O_END = O_SSQ + (size_t)3 * T_ALL * 16 * 4;
constexpr size_t O_END_H = O_H + (size_t)T_ALL * 2816 * 2;
constexpr size_t WS_NEED = O_END > O_END_H ? O_END : O_END_H;
constexpr int LDS_BYTES = 147456;

struct Params { const float* in[28]; float* out; unsigned char* ws; int only_phase; int pad; };

DI unsigned pk2(float a, float b) { f32x2 v = {a, b}; return __builtin_bit_cast(unsigned, __builtin_convertvector(v, bf16v2)); }
DI bf16_t f2bf(float a) { return (bf16_t)(pk2(a, 0.f) & 0xffffu); }
DI float bf2f(bf16_t b) { return __uint_as_float(((unsigned)b) << 16); }
DI float bflo(unsigned u) { return __uint_as_float(u << 16); }
DI float bfhi(unsigned u) { return __uint_as_float(u & 0xffff0000u); }
#define UNPACK8(v, f) do { f[0] = bflo(v.x); f[1] = bfhi(v.x); f[2] = bflo(v.y); f[3] = bfhi(v.y); f[4] = bflo(v.z); f[5] = bfhi(v.z); f[6] = bflo(v.w); f[7] = bfhi(v.w); } while (0)
#define PACK8(f) ((u32x4){pk2(f[0], f[1]), pk2(f[2], f[3]), pk2(f[4], f[5]), pk2(f[6], f[7])})
DI float wave_sum(float v) {
#pragma unroll
    for (int o = 1; o < 64; o <<= 1) v += __shfl_xor(v, o);
    return v;
}
DI float silu_f(float x) { return x * __builtin_amdgcn_rcpf(1.f + __builtin_amdgcn_exp2f(-1.4426950408889634f * x)); }
DI float sigmoid_f(float x) { return __builtin_amdgcn_rcpf(1.f + __builtin_amdgcn_exp2f(-1.4426950408889634f * x)); }
DI float gelu_f(float v) {
    const float t = __builtin_amdgcn_rcpf(fabsf(v) * 0.2316418882f + 1.0f);
    float q = t * 0.5307027145f + (-0.7265760135f); q = q * t + 0.7107068705f; q = q * t + (-0.142248368f); q = q * t + 0.127414796f; q = q * t;
    const float m = v * (q * __builtin_amdgcn_exp2f(v * v * (-0.72134752044f)));
    return v < 0.f ? m : v - m;
}
DI int crow(int i, int h) { return (i & 3) + 8 * (i >> 2) + 4 * h; }
DI void rows_rstd(const float* ssq, int row0, int fq, float (&rs)[2][4]) {
    f32x4 q[2][4];
#pragma unroll
    for (int ai = 0; ai < 2; ++ai)
#pragma unroll
        for (int m = 0; m < 4; ++m) q[ai][m] = ((const f32x4*)(ssq + (size_t)(row0 + ai * 128 + m * 16) * 16))[fq];
#pragma unroll
    for (int ai = 0; ai < 2; ++ai)
#pragma unroll
        for (int m = 0; m < 4; ++m) { float t = (q[ai][m][0] + q[ai][m][1]) + (q[ai][m][2] + q[ai][m][3]); t += __shfl_xor(t, 16); t += __shfl_xor(t, 32);
            rs[ai][m] = rsqrtf(t * (1.f / 1024.f) + EPS); }
}
struct EpiStore {
    static constexpr bool PERM = true, AFTER_DRAIN = false;
    bf16_t* O; int ldc; int pnmask; const float* ssq;
    DI void operator()(const f32x4 (&acc)[2][2][4][2], const pg8::Unit& u, int wr, int wc, int fr, int fq) const {
        const int row0 = u.pm * 256 + wr * 64 + fr, col0 = (u.pn & pnmask) * 256 + wc * 32 + 8 * fq;
        float rsv[2][4];
        if (ssq) rows_rstd(ssq, row0, fq, rsv);
        else {
#pragma unroll
            for (int ai = 0; ai < 2; ++ai)
#pragma unroll
                for (int m = 0; m < 4; ++m) rsv[ai][m] = 1.f; }
#pragma unroll
        for (int ai = 0; ai < 2; ++ai)
#pragma unroll
            for (int m = 0; m < 4; ++m) { bf16_t* rowp = O + (size_t)(row0 + ai * 128 + m * 16) * ldc + col0;
                const float rs = rsv[ai][m];
#pragma unroll
                for (int bj = 0; bj < 2; ++bj) { const f32x4 v0 = acc[ai][bj][m][0] * rs, v1 = acc[ai][bj][m][1] * rs;
                    u32x4 w; w.x = pk2(v0[0], v0[1]); w.y = pk2(v0[2], v0[3]); w.z = pk2(v1[0], v1[1]); w.w = pk2(v1[2], v1[3]);
                    *(u32x4*)(rowp + bj * 128) = w; } }
    }
};
struct EpiGU {
    static constexpr bool PERM = true, AFTER_DRAIN = false;
    bf16_t* H; const float* ssq;
    DI void operator()(const f32x4 (&acc)[2][2][4][2], const pg8::Unit& u, int wr, int wc, int fr, int fq) const {
        const int row0 = u.pm * 256 + wr * 64 + fr, col0 = u.pn * 128 + wc * 32 + 8 * fq;
        float rsv[2][4]; rows_rstd(ssq, row0, fq, rsv);
#pragma unroll
        for (int ai = 0; ai < 2; ++ai)
#pragma unroll
            for (int m = 0; m < 4; ++m) { bf16_t* rowp = H + (size_t)(row0 + ai * 128 + m * 16) * 2816 + col0;
                const float rs = rsv[ai][m];
                float o[8];
#pragma unroll
                for (int n = 0; n < 2; ++n)
#pragma unroll
                    for (int j = 0; j < 4; ++j) o[4 * n + j] = silu_f(acc[ai][0][m][n][j] * rs) * (acc[ai][1][m][n][j] * rs);
                *(u32x4*)rowp = PACK8(o); }
    }
};
struct EpiRes {
    static constexpr bool PERM = false, AFTER_DRAIN = false;
    bf16_t* XB; float* SSQ; float* OUT; float sc;
    DI void operator()(const f32x4 (&acc)[2][2][4][2], const pg8::Unit& u, int wr, int wc, int fr, int fq) const {
        const int row0 = u.pm * 256 + wr * 64 + fr, col0 = u.pn * 256 + wc * 32 + 4 * fq;
#pragma unroll
        for (int ai = 0; ai < 2; ++ai) {
            u32x2 xv[4][2][2];
#pragma unroll
            for (int m = 0; m < 4; ++m)
#pragma unroll
                for (int bj = 0; bj < 2; ++bj)
#pragma unroll
                    for (int n = 0; n < 2; ++n) xv[m][bj][n] = *(const u32x2*)(XB + (size_t)(row0 + ai * 128 + m * 16) * 1024 + col0 + bj * 128 + n * 16);
#pragma unroll
            for (int m = 0; m < 4; ++m) { const int row = row0 + ai * 128 + m * 16; const size_t ro = (size_t)row * 1024 + col0;
                float ss = 0.f;
#pragma unroll
                for (int bj = 0; bj < 2; ++bj)
#pragma unroll
                    for (int n = 0; n < 2; ++n) { const u32x2 xo = xv[m][bj][n]; const f32x4 a = acc[ai][bj][m][n];
                        const f32x4 v = {bflo(xo.x) + a[0] * sc, bfhi(xo.x) + a[1] * sc, bflo(xo.y) + a[2] * sc, bfhi(xo.y) + a[3] * sc};
                        if (OUT) *(f32x4*)(OUT + ro + bj * 128 + n * 16) = v;
                        else *(u32x2*)(XB + ro + bj * 128 + n * 16) = (u32x2){pk2(v[0], v[1]), pk2(v[2], v[3])};
                        ss += v[0] * v[0] + v[1] * v[1] + v[2] * v[2] + v[3] * v[3]; }
                ss += __shfl_xor(ss, 16); ss += __shfl_xor(ss, 32);
                if (fq == 0) SSQ[(size_t)row * 16 + u.pn * 4 + wc] = ss; }
        }
    }
};
struct EpiMerge {
    static constexpr bool PERM = false, AFTER_DRAIN = false;
    const bf16_t* P; bf16_t* MIX; const float* ssq;
    DI void operator()(const f32x4 (&acc)[2][2][4][2], const pg8::Unit& u, int wr, int wc, int fr, int fq) const {
        const int row0 = u.pm * 256 + wr * 64 + fr, e0 = u.pn * 64 + wc * 16 + 4 * fq;
        float rsv[2][4]; rows_rstd(ssq, row0, fq, rsv);
#pragma unroll
        for (int ai = 0; ai < 2; ++ai) {
            u32x2 pv[4][4];
#pragma unroll
            for (int m = 0; m < 4; ++m)
#pragma unroll
                for (int b = 0; b < 4; ++b) pv[m][b] = *(const u32x2*)(P + (size_t)b * TG * 1024 + (size_t)(row0 + ai * 128 + m * 16) * 1024 + e0);
#pragma unroll
            for (int m = 0; m < 4; ++m) { const float rs = rsv[ai][m];
                float o[4] = {0.f, 0.f, 0.f, 0.f};
#pragma unroll
                for (int bj = 0; bj < 2; ++bj)
#pragma unroll
                    for (int n = 0; n < 2; ++n) { const u32x2 q = pv[m][2 * bj + n]; const f32x4 g = acc[ai][bj][m][n] * rs;
                        o[0] += sigmoid_f(g[0]) * bflo(q.x); o[1] += sigmoid_f(g[1]) * bfhi(q.x); o[2] += sigmoid_f(g[2]) * bflo(q.y); o[3] += sigmoid_f(g[3]) * bfhi(q.y); }
                *(u32x2*)(MIX + (size_t)(row0 + ai * 128 + m * 16) * 1024 + e0) = (u32x2){pk2(o[0], o[1]), pk2(o[2], o[3])}; }
        }
    }
};
struct BranchOrder {
    int G, c;
    DI bool next(int i, pg8::Unit& u) const { const int L = i * G + c; if (L >= 1024) return false; const int br = L >> 8, rem = L & 255; u.pm = br * 64 + (rem >> 2); u.pn = br * 4 + (rem & 3); return true; }
    DI void a_ready(const pg8::Unit&) const {}
    DI void done(const pg8::Unit&) const {}
};
template <class Epi> DI void run_gemm(LAS unsigned char* lds, const bf16_t* A, const bf16_t* Bt, int M, int N, int K, const Epi& E) {
    pg8::Gemm g{A, Bt, M, N, K}; pg8::StaticOrder S; S.init(M, N, nwg_now(), wg_now());
    pg8::gemm_phase<Epi, pg8::StaticOrder>(lds, g, S, E);
}

DI void conv_mat(const float* src, int ld, int c0, int nvalid, int kvalid, int mode, bf16_t* dst, int Nd, int Kd, LAS float* scr, int wg, int nwg, const float* ksc = nullptr) {
    const int tid = tid_now(); const int ntk = Kd >> 6, ntiles = (Nd >> 6) * ntk;
    for (int tile = wg; tile < ntiles; tile += nwg) {
        const int n0 = (tile / ntk) << 6, k0 = (tile % ntk) << 6;
        const int nn = tid & 63, kq = tid >> 6, n = n0 + nn;
        int col;
        if (mode == 1) { const int blk = n >> 7; col = ((blk & 1) ? 2816 : 0) + (blk >> 1) * 128 + (n & 127); }
        else if (mode == 2) { const int c = n & 255, br = 2 * (c >> 7) + ((c >> 4) & 1), e = 64 * (n >> 8) + 16 * ((c >> 5) & 3) + (c & 15); col = c0 + br * 1024 + e; }
        else col = c0 + n;
#pragma unroll
        for (int i = 0; i < 8; ++i) { const int kk = i * 8 + kq; float v = 0.f;
            if (k0 + kk < kvalid && n < nvalid) { v = src[(size_t)(k0 + kk) * ld + col]; if (ksc) v *= ksc[k0 + kk]; }
            scr[kk * 65 + nn] = v; }
        __syncthreads();
        { const int nr = tid >> 3, kc = tid & 7; const LAS float* sp = scr + (kc * 8) * 65 + nr;
          u32x4 o; o.x = pk2(sp[0], sp[65]); o.y = pk2(sp[130], sp[195]); o.z = pk2(sp[260], sp[325]); o.w = pk2(sp[390], sp[455]);
          *(u32x4*)(dst + (size_t)(n0 + nr) * Kd + k0 + kc * 8) = o; }
        __syncthreads();
    }
}
DI void convert_layer(const Params& p, int l, LAS float* scr, int wg, int nwg) {
    unsigned char* ws = p.ws;
    conv_mat(p.in[3] + (size_t)l * 1024 * 5632, 5632, 0, 5632, 1024, 1, (bf16_t*)(ws + O_WGU1), 5632, 1024, scr, wg, nwg, p.in[2] + l * 1024);
    conv_mat(p.in[26] + (size_t)l * 1024 * 5632, 5632, 0, 5632, 1024, 1, (bf16_t*)(ws + O_WGU2), 5632, 1024, scr, wg, nwg, p.in[25] + l * 1024);
    conv_mat(p.in[4] + (size_t)l * 2816 * 1024, 1024, 0, 1024, 2816, 0, (bf16_t*)(ws + O_WD1), 1024, 2816, scr, wg, nwg);
    conv_mat(p.in[27] + (size_t)l * 2816 * 1024, 1024, 0, 1024, 2816, 0, (bf16_t*)(ws + O_WD2), 1024, 2816, scr, wg, nwg);
    conv_mat(p.in[6] + (size_t)l * 1024 * 8776, 8776, 0, 4680, 1024, 0, (bf16_t*)(ws + O_WIN), 4864, 1024, scr, wg, nwg, p.in[5] + l * 1024);
    conv_mat(p.in[6] + (size_t)l * 1024 * 8776, 8776, 4680, 4096, 1024, 2, (bf16_t*)(ws + O_WGATE), 4096, 1024, scr, wg, nwg, p.in[5] + l * 1024);
#pragma unroll 1
    for (int i = 0; i < 4; ++i)
        conv_mat(p.in[23] + ((size_t)l * 4 + i) * 512 * 1024, 1024, 0, 1024, 512, 0, (bf16_t*)(ws + O_WBR) + (size_t)i * 1024 * 512, 1024, 512, scr, wg, nwg);
    conv_mat(p.in[24] + (size_t)l * 1024 * 1024, 1024, 0, 1024, 1024, 0, (bf16_t*)(ws + O_WOUT), 1024, 1024, scr, wg, nwg);
    conv_mat(p.in[17] + (size_t)l * 384 * 768, 768, 0, 768, 384, 0, (bf16_t*)(ws + O_WQB), 768, 384, scr, wg, nwg);
    conv_mat(p.in[19] + (size_t)l * 128 * 1024, 1024, 0, 1024, 128, 0, (bf16_t*)(ws + O_WKVB), 1024, 256, scr, wg, nwg);
}

DI void init_rows(const float* x, bf16_t* xb, float* ssq) {
    const int tidn = tid_now(); const int lane = tidn & 63, gwave = wg_now() * 8 + (tidn >> 6), ngw = nwg_now() * 8;
    for (int row = gwave; row < T_ALL; row += ngw) {
        const f32x4* xr = (const f32x4*)(x + (size_t)row * 1024);
        f32x4 v[4]; float ss = 0.f;
#pragma unroll
        for (int j = 0; j < 4; ++j) { v[j] = xr[lane + 64 * j]; ss += v[j][0] * v[j][0] + v[j][1] * v[j][1] + v[j][2] * v[j][2] + v[j][3] * v[j][3]; }
        ss = wave_sum(ss);
        u32x2* o = (u32x2*)(xb + (size_t)row * 1024);
#pragma unroll
        for (int j = 0; j < 4; ++j) o[lane + 64 * j] = (u32x2){pk2(v[j][0], v[j][1]), pk2(v[j][2], v[j][3])};
        if (lane < 16) ssq[(size_t)row * 16 + lane] = lane == 0 ? ss : 0.f;
    }
}
DI void zero_f32(float* q, int n) { const int tidn = tid_now(); for (int i = wg_now() * 512 + tidn; i < n; i += nwg_now() * 512) q[i] = 0.f; }

DI void prep1(const Params& p, int l, const bf16_t* __restrict__ proj, bf16_t* __restrict__ xbcc, float* __restrict__ dtb, bf16_t* __restrict__ aq, bf16_t* __restrict__ akv, bf16_t* __restrict__ yd) {
    const int tidn = tid_now(); const int gtid = wg_now() * 512 + tidn, gthreads = nwg_now() * 512;
    const float* cw = p.in[7] + l * 4096; const float* cb = p.in[8] + l * 1024;
    for (int idx = gtid; idx < (TG / 16) * 128; idx += gthreads) {
        const int c8 = (idx & 127) << 3, tl0 = (idx >> 7) << 4, s0 = tl0 & 2047;
        float w[4][8], bb[8], r0[8], r1[8], r2[8];
#pragma unroll
        for (int k = 0; k < 4; ++k) { const f32x4 a = *(const f32x4*)(cw + k * 1024 + c8), b = *(const f32x4*)(cw + k * 1024 + c8 + 4);
#pragma unroll
            for (int j = 0; j < 4; ++j) { w[k][j] = a[j]; w[k][4 + j] = b[j]; } }
        { const f32x4 a = *(const f32x4*)(cb + c8), b = *(const f32x4*)(cb + c8 + 4);
#pragma unroll
          for (int j = 0; j < 4; ++j) { bb[j] = a[j]; bb[4 + j] = b[j]; } }
        const bf16_t* src = proj + (size_t)tl0 * PLD + 512 + c8;
        if (s0 > 0) { const u32x4 v0 = *(const u32x4*)(src - 3 * PLD), v1 = *(const u32x4*)(src - 2 * PLD), v2 = *(const u32x4*)(src - PLD); UNPACK8(v0, r0); UNPACK8(v1, r1); UNPACK8(v2, r2); }
        else {
#pragma unroll
            for (int j = 0; j < 8; ++j) { r0[j] = 0.f; r1[j] = 0.f; r2[j] = 0.f; } }
#pragma unroll 8
        for (int tt = 0; tt < 16; ++tt) {
            const u32x4 v = *(const u32x4*)(src + (size_t)tt * PLD); float cur[8], o[8]; UNPACK8(v, cur);
#pragma unroll
            for (int j = 0; j < 8; ++j) { o[j] = silu_f(bb[j] + w[0][j] * r0[j] + w[1][j] * r1[j] + w[2][j] * r2[j] + w[3][j] * cur[j]); r0[j] = r1[j]; r1[j] = r2[j]; r2[j] = cur[j]; }
            *(u32x4*)(xbcc + (size_t)(tl0 + tt) * 1024 + c8) = PACK8(o);
        }
    }
    const float* sw = p.in[22] + l * 1536;
    for (int idx = gtid; idx < (TG / 16) * 64; idx += gthreads) {
        const int c8 = (idx & 63) << 3, tl0 = (idx >> 6) << 4, s0 = tl0 & 2047;
        float w[3][8], p1[8], p2[8];
#pragma unroll
        for (int k = 0; k < 3; ++k) { const f32x4 a = *(const f32x4*)(sw + k * 512 + c8), b = *(const f32x4*)(sw + k * 512 + c8 + 4);
#pragma unroll
            for (int j = 0; j < 4; ++j) { w[k][j] = a[j]; w[k][4 + j] = b[j]; } }
        const bf16_t* src = proj + (size_t)tl0 * PLD + c8;
        if (s0 > 0) { const u32x4 c1 = *(const u32x4*)(src - 2 * PLD + 3656), x1 = *(const u32x4*)(src - 2 * PLD + 4168), c2 = *(const u32x4*)(src - PLD + 3656), x2 = *(const u32x4*)(src - PLD + 4168);
            float a[8], b[8]; UNPACK8(c1, a); UNPACK8(x1, b);
#pragma unroll
            for (int j = 0; j < 8; ++j) p1[j] = a[j] * b[j];
            UNPACK8(c2, a); UNPACK8(x2, b);
#pragma unroll
            for (int j = 0; j < 8; ++j) p2[j] = a[j] * b[j]; }
        else {
#pragma unroll
            for (int j = 0; j < 8; ++j) { p1[j] = 0.f; p2[j] = 0.f; } }
#pragma unroll 8
        for (int tt = 0; tt < 16; ++tt) {
            const bf16_t* pr = src + (size_t)tt * PLD;
            const u32x4 vc = *(const u32x4*)(pr + 3656), vx = *(const u32x4*)(pr + 4168), vb = *(const u32x4*)(pr + 3144);
            float fc[8], fx[8], fb[8], o[8]; UNPACK8(vc, fc); UNPACK8(vx, fx); UNPACK8(vb, fb);
#pragma unroll
            for (int j = 0; j < 8; ++j) { const float cur = fc[j] * fx[j]; o[j] = fb[j] * (w[0][j] * p1[j] + w[1][j] * p2[j] + w[2][j] * cur); p1[j] = p2[j]; p2[j] = cur; }
            *(u32x4*)(yd + (size_t)(tl0 + tt) * 512 + c8) = PACK8(o);
        }
    }
    const int gwave = gtid >> 6, ngw = gthreads >> 6, lane = tidn & 63;
    const float* qn = p.in[16] + l * 384; const float* kn = p.in[18] + l * 128;
#pragma unroll 4
    for (int tl = gwave; tl < TG; tl += ngw) {
        const bf16_t* pr = proj + (size_t)tl * PLD;
        const u32x4 v = *(const u32x4*)(pr + 2568 + lane * 8); float f[8]; UNPACK8(v, f);
        float ss = 0.f;
#pragma unroll
        for (int j = 0; j < 8; ++j) ss += f[j] * f[j];
        const float ssq = wave_sum(lane < 48 ? ss : 0.f), ssk = wave_sum(lane >= 48 ? ss : 0.f);
        if (lane < 48) {
            const float rstd = rsqrtf(ssq * (1.f / 384.f) + EPS);
#pragma unroll
            for (int j = 0; j < 8; ++j) f[j] *= rstd * qn[lane * 8 + j];
            *(u32x4*)(aq + (size_t)tl * 384 + lane * 8) = PACK8(f);
        } else {
            const float rstd = rsqrtf(ssk * (1.f / 128.f) + EPS);
#pragma unroll
            for (int j = 0; j < 8; ++j) f[j] *= rstd * kn[(lane - 48) * 8 + j];
            *(u32x4*)(akv + (size_t)tl * 256 + (lane - 48) * 8) = PACK8(f);
            { unsigned z = 0u; asm volatile("" : "+v"(z)); *(u32x4*)(akv + (size_t)tl * 256 + 128 + (lane - 48) * 8) = (u32x4){z, z, z, z}; }
        }
        if (lane < 8) {
            const float xr = bf2f(pr[1536 + lane]) + p.in[9][l * 8 + lane];
            const float dt = xr > 20.f ? xr : log1pf(expf(xr));
            const float A = -expf(p.in[10][l * 8 + lane]);
            dtb[(size_t)tl * 16 + lane] = dt; dtb[(size_t)tl * 16 + 8 + lane] = dt * A;
        }
    }
}

DI void rope_table(const Params& p, f32x2* CS) {
    const int* pos = (const int*)p.in[1];
    const int tidn = tid_now();
    for (int idx = wg_now() * 512 + tidn; idx < T_ALL * 32; idx += nwg_now() * 512) {
        const float invf = exp2f(-(float)(idx & 31) * (13.287712379549449f / 32.f));
        const float ang = (float)pos[idx >> 5] * invf;
        CS[idx] = (f32x2){cosf(ang), sinf(ang)};
    }
}
DI void prep2_unit(const Params& p, int l, int g, const bf16_t* __restrict__ proj, const bf16_t* __restrict__ qraw, const bf16_t* __restrict__ kvraw, const f32x2* __restrict__ CSt, bf16_t* __restrict__ Qf, bf16_t* __restrict__ Kf, bf16_t* __restrict__ Vt, int bl, int tile, LAS unsigned char* lds) {
    const int tid = tid_now(), wave = tid >> 6, lane = tid & 63;
    const float* wq = p.in[20] + l * 192; const float* wk = p.in[21] + l * 192;
    const float qscale = 0.07216878364870322f * 1.4426950408889634f;
    const float wq0 = wq[lane], wq1 = wq[64 + lane], wq2 = wq[128 + lane], wk0 = wk[lane], wk1 = wk[64 + lane], wk2 = wk[128 + lane];
    LAS bf16_t* img = (LAS bf16_t*)lds;
    const int t0 = tile * 64;
#pragma unroll 2
    for (int tt = 0; tt < 8; ++tt) {
        const int tloc = wave * 8 + tt, s = t0 + tloc; const size_t tl = (size_t)bl * SEQ + s;
        const f32x2 cssn = CSt[((size_t)(g * BPG + bl) * SEQ + s) * 32 + (lane & 31)];
        const float cs = cssn[0], sn = cssn[1];
        const float kpe = bf2f(proj[tl * PLD + 3080 + lane]);
#pragma unroll
        for (int h = 0; h < 4; ++h) {
            const size_t ob = ((size_t)(bl * 4 + h) * SEQ + s) * 192;
            {
                const bf16_t* qr = qraw + tl * 768 + h * 192;
                float q0 = bf2f(qr[lane]), q1 = bf2f(qr[64 + lane]), q2 = bf2f(qr[128 + lane]);
                const float r = rsqrtf(wave_sum(q0 * q0 + q1 * q1 + q2 * q2) * (1.f / 192.f) + EPS);
                q0 *= r * wq0; q1 *= r * wq1; q2 *= r * wq2;
                const float qp = __shfl_xor(q2, 32);
                q2 = (lane < 32) ? q2 * cs - qp * sn : q2 * cs + qp * sn;
                bf16_t* qo = Qf + ob;
                qo[lane] = f2bf(q0 * qscale); qo[64 + lane] = f2bf(q1 * qscale); qo[128 + lane] = f2bf(q2 * qscale);
            }
            const bf16_t* kr = kvraw + tl * 1024 + h * 256;
            {
                float k0 = bf2f(kr[lane]), k1 = bf2f(kr[64 + lane]), k2 = kpe;
                const float r = rsqrtf(wave_sum(k0 * k0 + k1 * k1 + k2 * k2) * (1.f / 192.f) + EPS);
                k0 *= r * wk0; k1 *= r * wk1; k2 *= r * wk2;
                const float kp = __shfl_xor(k2, 32);
                k2 = (lane < 32) ? k2 * cs - kp * sn : k2 * cs + kp * sn;
                bf16_t* ko = Kf + ob;
                ko[lane] = f2bf(k0); ko[64 + lane] = f2bf(k1); ko[128 + lane] = f2bf(k2);
            }
            img[(h * 128 + lane) * 72 + tloc] = kr[128 + lane]; img[(h * 128 + 64 + lane) * 72 + tloc] = kr[192 + lane];
        }
    }
    __syncthreads();
#pragma unroll
    for (int i = 0; i < 8; ++i) {
        const int ch = tid + 512 * i, row = ch >> 3, cc = ch & 7;
        *(u32x4*)(Vt + ((size_t)(bl * 4 + (row >> 7)) * 128 + (row & 127)) * SEQ + t0 + cc * 8) = *(const LAS u32x4*)(lds + row * 144 + cc * 16);
    }
    __syncthreads();
}

constexpr int KP = 400, VP = 136, KBYTES = 64 * KP, VBYTES = 128 * VP, ASTAGE = KBYTES + VBYTES;
DI void attn_unit(const bf16_t* Qf, const bf16_t* Kf, const bf16_t* Vt, bf16_t* yc, int bh, int qb, LAS unsigned char* lds) {
    const int tid = tid_now(), wave = tid >> 6, lane = tid & 63, r31 = lane & 31, hh = lane >> 5;
    const int q0 = qb * 256, qrow = q0 + wave * 32 + r31;
    const bf16_t* Qp = Qf + ((size_t)bh * SEQ + qrow) * 192 + 8 * hh;
    bf16x8 qf[12];
#pragma unroll
    for (int kk = 0; kk < 12; ++kk) qf[kk] = *(const bf16x8*)(Qp + kk * 16);
    f32x16 o[4];
#pragma unroll
    for (int d = 0; d < 4; ++d)
#pragma unroll
        for (int i = 0; i < 16; ++i) o[d][i] = 0.f;
    float m = -1e30f, l = 0.f;
    const int ntiles = qb * 4 + 4;
    const bf16_t* Kb = Kf + (size_t)bh * SEQ * 192; const bf16_t* Vb = Vt + (size_t)bh * 128 * SEQ;
    int krow[3], kcc[3], vd[2], vcc[2];
#pragma unroll
    for (int i = 0; i < 3; ++i) { const int c = tid + 512 * i; krow[i] = c / 24; kcc[i] = c % 24; }
#pragma unroll
    for (int i = 0; i < 2; ++i) { const int c = tid + 512 * i; vd[i] = c >> 3; vcc[i] = c & 7; }
    u32x4 kreg[3], vreg[2];
#define ATT_GLOAD(j) do { _Pragma("unroll") for (int i = 0; i < 3; ++i) kreg[i] = *(const u32x4*)(Kb + (size_t)((j) * 64 + krow[i]) * 192 + kcc[i] * 8); \
        _Pragma("unroll") for (int i = 0; i < 2; ++i) vreg[i] = *(const u32x4*)(Vb + (size_t)vd[i] * SEQ + (j) * 64 + vcc[i] * 8); } while (0)
#define ATT_LSTORE(st) do { LAS unsigned char* b_ = lds + (st) * ASTAGE; \
        _Pragma("unroll") for (int i = 0; i < 3; ++i) *(LAS u32x4*)(b_ + krow[i] * KP + kcc[i] * 16) = kreg[i]; \
        _Pragma("unroll") for (int i = 0; i < 2; ++i) { LAS u32x2* d_ = (LAS u32x2*)(b_ + KBYTES + vd[i] * VP + vcc[i] * 16); d_[0] = (u32x2){vreg[i].x, vreg[i].y}; d_[1] = (u32x2){vreg[i].z, vreg[i].w}; } } while (0)
    ATT_GLOAD(0); ATT_LSTORE(0);
    __syncthreads();
    for (int j = 0; j < ntiles; ++j) {
        const int cur = j & 1;
        if (j + 1 < ntiles) ATT_GLOAD(j + 1);
        if (j * 64 <= q0 + wave * 32 + 31) {
            const LAS unsigned char* Kl = lds + cur * ASTAGE; const LAS unsigned char* Vl = Kl + KBYTES;
            f32x16 s0, s1;
#pragma unroll
            for (int i = 0; i < 16; ++i) { s0[i] = 0.f; s1[i] = 0.f; }
#pragma unroll
            for (int kk = 0; kk < 12; ++kk) {
                const bf16x8 a0 = *(const LAS bf16x8*)(Kl + r31 * KP + (kk * 16 + 8 * hh) * 2);
                const bf16x8 a1 = *(const LAS bf16x8*)(Kl + (32 + r31) * KP + (kk * 16 + 8 * hh) * 2);
                s0 = MFMA32(a0, qf[kk], s0); s1 = MFMA32(a1, qf[kk], s1);
            }
            if (j * 64 + 63 > q0 + wave * 32) {
#pragma unroll
                for (int i = 0; i < 16; ++i) { const int key = j * 64 + crow(i, hh); if (key > qrow) s0[i] = -1e30f; if (key + 32 > qrow) s1[i] = -1e30f; }
            }
            float mx = s0[0];
#pragma unroll
            for (int i = 1; i < 16; ++i) mx = fmaxf(mx, s0[i]);
#pragma unroll
            for (int i = 0; i < 16; ++i) mx = fmaxf(mx, s1[i]);
            mx = fmaxf(mx, __shfl_xor(mx, 32));
            const float mn = fmaxf(m, mx), alpha = __builtin_amdgcn_exp2f(m - mn);
            m = mn;
            float ls = 0.f;
#pragma unroll
            for (int i = 0; i < 16; ++i) { s0[i] = __builtin_amdgcn_exp2f(s0[i] - mn); s1[i] = __builtin_amdgcn_exp2f(s1[i] - mn); ls += s0[i] + s1[i]; }
            l = l * alpha + ls;
#pragma unroll
            for (int d = 0; d < 4; ++d)
#pragma unroll
                for (int i = 0; i < 16; ++i) o[d][i] *= alpha;
            bf16x8 pf[2][2];
#pragma unroll
            for (int s = 0; s < 2; ++s) {
                u32x4 w0, w1;
                w0.x = pk2(s0[8 * s], s0[8 * s + 1]); w0.y = pk2(s0[8 * s + 2], s0[8 * s + 3]); w0.z = pk2(s0[8 * s + 4], s0[8 * s + 5]); w0.w = pk2(s0[8 * s + 6], s0[8 * s + 7]);
                w1.x = pk2(s1[8 * s], s1[8 * s + 1]); w1.y = pk2(s1[8 * s + 2], s1[8 * s + 3]); w1.z = pk2(s1[8 * s + 4], s1[8 * s + 5]); w1.w = pk2(s1[8 * s + 6], s1[8 * s + 7]);
                pf[0][s] = __builtin_bit_cast(bf16x8, w0); pf[1][s] = __builtin_bit_cast(bf16x8, w1);
            }
#pragma unroll
            for (int d = 0; d < 4; ++d)
#pragma unroll
                for (int kb = 0; kb < 2; ++kb)
#pragma unroll
                    for (int s = 0; s < 2; ++s) {
                        const LAS unsigned char* vp = Vl + (d * 32 + r31) * VP + (kb * 32 + 16 * s + 4 * hh) * 2;
                        const s16x4 lo = *(const LAS s16x4*)vp, hi = *(const LAS s16x4*)(vp + 16);
                        const bf16x8 a = __builtin_shufflevector(lo, hi, 0, 1, 2, 3, 4, 5, 6, 7);
                        o[d] = MFMA32(a, pf[kb][s], o[d]);
                    }
        }
        if (j + 1 < ntiles) ATT_LSTORE(cur ^ 1);
        __syncthreads();
    }
#undef ATT_GLOAD
#undef ATT_LSTORE
    l += __shfl_xor(l, 32);
    const float inv = 1.f / l;
    const int bl = bh >> 2, h = bh & 3;
    bf16_t* op = yc + ((size_t)bl * SEQ + qrow) * 512 + h * 128 + 4 * hh;
#pragma unroll
    for (int d = 0; d < 4; ++d)
#pragma unroll
        for (int i4 = 0; i4 < 4; ++i4)
            *(u32x2*)(op + d * 32 + 8 * i4) = (u32x2){pk2(o[d][4 * i4] * inv, o[d][4 * i4 + 1] * inv), pk2(o[d][4 * i4 + 2] * inv, o[d][4 * i4 + 3] * inv)};
}

DI void gmlp_unit(const Params& p, int l, const bf16_t* proj, bf16_t* yb, int bl, int c, LAS unsigned char* lds) {
    const int tid = tid_now(), wave = tid >> 6, lane = tid & 63, r31 = lane & 31, hh = lane >> 5;
    const float* wsp = p.in[14] + (size_t)l * 4 * 128 * 128; const float* bs = p.in[15] + l * 512; const float* vn = p.in[13] + l * 512;
    const size_t tl0 = (size_t)bl * SEQ + c * 128;
    float w8[8];
#pragma unroll
    for (int j = 0; j < 8; ++j) w8[j] = vn[lane + 64 * j];
    LAS bf16_t* vt = (LAS bf16_t*)lds;
#pragma unroll 2
    for (int rr = 0; rr < 16; ++rr) {
        const int row = wave * 16 + rr;
        const bf16_t* vr = proj + (tl0 + row) * PLD + 2056 + lane;
        float f[8]; float ss = 0.f;
#pragma unroll
        for (int j = 0; j < 8; ++j) { f[j] = gelu_f(bf2f(vr[64 * j])); ss += f[j] * f[j]; }
        const float rstd = rsqrtf(wave_sum(ss) * (1.f / 512.f) + EPS);
#pragma unroll
        for (int j = 0; j < 8; ++j) vt[(lane + 64 * j) * 136 + row] = f2bf(f[j] * rstd * w8[j]);
    }
    __syncthreads();
    const int mb = wave & 3, nh = wave >> 2, trow = mb * 32 + r31;
#pragma unroll 1
    for (int g = 0; g < 4; ++g) {
        f32x16 a0, a1;
#pragma unroll
        for (int i = 0; i < 16; ++i) { a0[i] = 0.f; a1[i] = 0.f; }
        const float* wrow = wsp + ((size_t)g * 128 + trow) * 128 + 8 * hh;
#pragma unroll
        for (int kk = 0; kk < 8; ++kk) if (kk * 16 <= mb * 32 + 31) {
            const f32x4 x0 = *(const f32x4*)(wrow + kk * 16), x1 = *(const f32x4*)(wrow + kk * 16 + 4);
            const int sb = kk * 16 + 8 * hh;
            float f[8];
#pragma unroll
            for (int j = 0; j < 4; ++j) { f[j] = (sb + j <= trow) ? x0[j] : 0.f; f[4 + j] = (sb + 4 + j <= trow) ? x1[j] : 0.f; }
            const bf16x8 a = __builtin_bit_cast(bf16x8, PACK8(f));
            const bf16x8 b0 = *(const LAS bf16x8*)(vt + (g * 128 + nh * 64 + r31) * 136 + kk * 16 + 8 * hh);
            const bf16x8 b1 = *(const LAS bf16x8*)(vt + (g * 128 + nh * 64 + 32 + r31) * 136 + kk * 16 + 8 * hh);
            a0 = MFMA32(a, b0, a0); a1 = MFMA32(a, b1, a1);
        }
#pragma unroll
        for (int i = 0; i < 16; ++i) {
            const int t = mb * 32 + crow(i, hh); const float bias = bs[g * 128 + t];
            const bf16_t* ur = proj + (tl0 + t) * PLD + 1544 + g * 128 + nh * 64 + r31;
            bf16_t* orow = yb + (tl0 + t) * 512 + g * 128 + nh * 64 + r31;
            orow[0] = f2bf(gelu_f(bf2f(ur[0])) * (a0[i] + bias));
            orow[32] = f2bf(gelu_f(bf2f(ur[32])) * (a1[i] + bias));
        }
    }
    __syncthreads();
}

constexpr int SP = 136;
DI void scan128(float& v0, float& v1, int lane) {
#pragma unroll
    for (int o = 1; o < 64; o <<= 1) { const float n0 = __shfl_up(v0, o), n1 = __shfl_up(v1, o); if (lane >= o) { v0 += n0; v1 += n1; } }
    v1 += __shfl(v0, 63);
}
DI void ssd_states_unit(const bf16_t* xbcc, const float* dtb, float* ST, float* ATOT, int bl, int c, int grp, LAS unsigned char* lds) {
    const int tid = tid_now(), wave = tid >> 6, lane = tid & 63, r31 = lane & 31, hh = lane >> 5;
    LAS bf16_t* BT = (LAS bf16_t*)lds; LAS bf16_t* XT = (LAS bf16_t*)(lds + 34816); LAS float* WS = (LAS float*)(lds + 104448);
    const size_t row0 = (size_t)bl * SEQ + c * 128;
    if (wave < 4) {
        const int h = grp * 4 + wave;
        const float d0 = dtb[(row0 + lane) * 16 + h], d1 = dtb[(row0 + 64 + lane) * 16 + h];
        float v0 = dtb[(row0 + lane) * 16 + 8 + h], v1 = dtb[(row0 + 64 + lane) * 16 + 8 + h];
        scan128(v0, v1, lane);
        const float tot = __shfl(v1, 63);
        WS[wave * 128 + lane] = d0 * __expf(tot - v0); WS[wave * 128 + 64 + lane] = d1 * __expf(tot - v1);
        if (lane == 0) ATOT[(bl * 16 + c) * 8 + h] = tot;
    }
    __syncthreads();
#pragma unroll
    for (int i = 0; i < 4; ++i) {
        const int ch = tid + 512 * i, s = ch >> 4, n8 = (ch & 15) * 8;
        const u32x4 v = *(const u32x4*)(xbcc + (row0 + s) * 1024 + 512 + grp * 128 + n8);
        LAS bf16_t* d = BT + n8 * SP + s;
        d[0] = (bf16_t)(v.x & 0xffffu); d[SP] = (bf16_t)(v.x >> 16); d[2 * SP] = (bf16_t)(v.y & 0xffffu); d[3 * SP] = (bf16_t)(v.y >> 16);
        d[4 * SP] = (bf16_t)(v.z & 0xffffu); d[5 * SP] = (bf16_t)(v.z >> 16); d[6 * SP] = (bf16_t)(v.w & 0xffffu); d[7 * SP] = (bf16_t)(v.w >> 16);
    }
#pragma unroll
    for (int i = 0; i < 8; ++i) {
        const int ch = tid + 512 * i, s = ch >> 5, c8 = (ch & 31) * 8;
        const u32x4 v = *(const u32x4*)(xbcc + (row0 + s) * 1024 + grp * 256 + c8); float f[8]; UNPACK8(v, f);
        const float w = WS[(c8 >> 6) * 128 + s];
        LAS bf16_t* d = XT + c8 * SP + s;
#pragma unroll
        for (int j = 0; j < 8; ++j) d[j * SP] = f2bf(f[j] * w);
    }
    __syncthreads();
    const int hl = wave >> 1, pb = wave & 1;
    f32x16 acc[4];
#pragma unroll
    for (int nb = 0; nb < 4; ++nb)
#pragma unroll
        for (int i = 0; i < 16; ++i) acc[nb][i] = 0.f;
#pragma unroll
    for (int k = 0; k < 8; ++k) {
        const bf16x8 a = *(const LAS bf16x8*)(XT + (hl * 64 + pb * 32 + r31) * SP + k * 16 + 8 * hh);
#pragma unroll
        for (int nb = 0; nb < 4; ++nb) { const bf16x8 b = *(const LAS bf16x8*)(BT + (nb * 32 + r31) * SP + k * 16 + 8 * hh); acc[nb] = MFMA32(a, b, acc[nb]); }
    }
    float* so = ST + (((size_t)bl * 16 + c) * 8 + grp * 4 + hl) * 8192;
#pragma unroll
    for (int nb = 0; nb < 4; ++nb)
#pragma unroll
        for (int i = 0; i < 16; ++i) so[(pb * 32 + crow(i, hh)) * 128 + nb * 32 + r31] = acc[nb][i];
    __syncthreads();
}
DI void ssd_scan(const float* ST, bf16_t* STB, const float* ATOT) {
    const int tidn = tid_now();
    for (int idx = wg_now() * 512 + tidn; idx < 64 * 2048; idx += nwg_now() * 512) {
        const int bh = idx >> 11, e4 = idx & 2047, bl = bh >> 3, head = bh & 7;
        const size_t off = ((size_t)bl * 16 * 8 + head) * 8192 + e4 * 4;
        f32x4 sv[16];
#pragma unroll
        for (int c = 0; c < 16; ++c) sv[c] = *(const f32x4*)(ST + off + (size_t)c * 8 * 8192);
        f32x4 run = {0.f, 0.f, 0.f, 0.f};
#pragma unroll
        for (int c = 0; c < 16; ++c) { const float ea = __expf(ATOT[(bl * 16 + c) * 8 + head]);
            *(u32x2*)(STB + off + (size_t)c * 8 * 8192) = (u32x2){pk2(run[0], run[1]), pk2(run[2], run[3])}; run = run * ea + sv[c]; }
    }
}
DI void ssd_out_grp(const Params& p, int l, const bf16_t* proj, const bf16_t* xbcc, const float* dtb, const bf16_t* STB, float* yraw, bf16_t* ya, int bl, int c, int grp, LAS unsigned char* lds) {
    const int tid = tid_now(), wave = tid >> 6, lane = tid & 63, r31 = lane & 31, hh = lane >> 5;
    LAS bf16_t* CL = (LAS bf16_t*)lds; LAS bf16_t* BL = (LAS bf16_t*)(lds + 34816); LAS bf16_t* XT = (LAS bf16_t*)(lds + 69632); LAS bf16_t* PV = (LAS bf16_t*)(lds + 104448);
    LAS float* ACS = (LAS float*)(lds + 139264); LAS float* DTL = (LAS float*)(lds + 140288); LAS float* RS = (LAS float*)(lds + 141312); LAS float* OUT = (LAS float*)(lds + 69632);
    const size_t row0 = (size_t)bl * SEQ + c * 128;
#pragma unroll
    for (int i = 0; i < 4; ++i) {
        const int ch = tid + 512 * i, s = ch >> 4, n8 = (ch & 15) * 8;
        const bf16_t* xr = xbcc + (row0 + s) * 1024;
        *(LAS u32x4*)(CL + s * SP + n8) = *(const u32x4*)(xr + 768 + grp * 128 + n8);
        *(LAS u32x4*)(BL + s * SP + n8) = *(const u32x4*)(xr + 512 + grp * 128 + n8);
    }
#pragma unroll 1
    for (int pi = 0; pi < 2; ++pi) {
        const int pair = grp * 2 + pi;
        if (wave < 2) {
            const int h = pair * 2 + wave;
            const float d0 = dtb[(row0 + lane) * 16 + h], d1 = dtb[(row0 + 64 + lane) * 16 + h];
            float v0 = dtb[(row0 + lane) * 16 + 8 + h], v1 = dtb[(row0 + 64 + lane) * 16 + 8 + h];
            scan128(v0, v1, lane);
            ACS[wave * 128 + lane] = v0; ACS[wave * 128 + 64 + lane] = v1; DTL[wave * 128 + lane] = d0; DTL[wave * 128 + 64 + lane] = d1;
        }
        __syncthreads();
#pragma unroll
        for (int i = 0; i < 4; ++i) {
            const int ch = tid + 512 * i, s = ch >> 4, n8 = (ch & 15) * 8;
            const u32x4 v = *(const u32x4*)(xbcc + (row0 + s) * 1024 + pair * 128 + n8); float f[8]; UNPACK8(v, f);
            const float w = DTL[(n8 >> 6) * 128 + s];
            LAS bf16_t* d = XT + n8 * SP + s;
#pragma unroll
            for (int j = 0; j < 8; ++j) d[j * SP] = f2bf(f[j] * w);
            *(LAS u32x4*)(PV + s * SP + n8) = *(const u32x4*)(STB + (((size_t)bl * 16 + c) * 8 + pair * 2) * 8192 + (size_t)s * 128 + n8);
        }
        __syncthreads();
        const int tb = wave >> 1, hl = wave & 1;
        f32x16 acc[2];
#pragma unroll
        for (int pb = 0; pb < 2; ++pb)
#pragma unroll
            for (int i = 0; i < 16; ++i) acc[pb][i] = 0.f;
        const LAS bf16_t* crw = CL + (tb * 32 + r31) * SP + 8 * hh;
#pragma unroll
        for (int k = 0; k < 8; ++k) {
            const bf16x8 b = *(const LAS bf16x8*)(crw + k * 16);
#pragma unroll
            for (int pb = 0; pb < 2; ++pb) { const bf16x8 a = *(const LAS bf16x8*)(PV + (hl * 64 + pb * 32 + r31) * SP + k * 16 + 8 * hh); acc[pb] = MFMA32(a, b, acc[pb]); }
        }
        const float at = ACS[hl * 128 + tb * 32 + r31], eat = __expf(at);
#pragma unroll
        for (int pb = 0; pb < 2; ++pb)
#pragma unroll
            for (int i = 0; i < 16; ++i) acc[pb][i] *= eat;
#pragma unroll 1
        for (int sb = 0; sb <= tb; ++sb) {
            f32x16 cbt;
#pragma unroll
            for (int i = 0; i < 16; ++i) cbt[i] = 0.f;
#pragma unroll
            for (int k = 0; k < 8; ++k) {
                const bf16x8 a = *(const LAS bf16x8*)(BL + (sb * 32 + r31) * SP + k * 16 + 8 * hh);
                const bf16x8 b = *(const LAS bf16x8*)(crw + k * 16);
                cbt = MFMA32(a, b, cbt);
            }
#pragma unroll
            for (int i = 0; i < 16; ++i) {
                const int sl = crow(i, hh); const float as = ACS[hl * 128 + sb * 32 + sl];
                const float mv = cbt[i] * __expf(fminf(at - as, 0.f));
                cbt[i] = (sb == tb && sl > r31) ? 0.f : mv;
            }
#pragma unroll
            for (int ks = 0; ks < 2; ++ks) {
                u32x4 w; w.x = pk2(cbt[8 * ks], cbt[8 * ks + 1]); w.y = pk2(cbt[8 * ks + 2], cbt[8 * ks + 3]); w.z = pk2(cbt[8 * ks + 4], cbt[8 * ks + 5]); w.w = pk2(cbt[8 * ks + 6], cbt[8 * ks + 7]);
                const bf16x8 pfr = __builtin_bit_cast(bf16x8, w);
#pragma unroll
                for (int pb = 0; pb < 2; ++pb) {
                    const LAS bf16_t* vp = XT + (hl * 64 + pb * 32 + r31) * SP + sb * 32 + 16 * ks + 4 * hh;
                    const s16x4 lo = *(const LAS s16x4*)vp, hi = *(const LAS s16x4*)(vp + 8);
                    const bf16x8 a = __builtin_shufflevector(lo, hi, 0, 1, 2, 3, 4, 5, 6, 7);
                    acc[pb] = MFMA32(a, pfr, acc[pb]);
                }
            }
        }
        __syncthreads();
#pragma unroll
        for (int pb = 0; pb < 2; ++pb)
#pragma unroll
            for (int i = 0; i < 16; ++i) OUT[(tb * 32 + r31) * 132 + hl * 64 + pb * 32 + crow(i, hh)] = acc[pb][i];
        __syncthreads();
#pragma unroll
        for (int i = 0; i < 4; ++i) {
            const int it = tid + 512 * i, t = it >> 4, c8 = (it & 15) * 8;
            const f32x4 y0 = *(const LAS f32x4*)(OUT + t * 132 + c8), y1 = *(const LAS f32x4*)(OUT + t * 132 + c8 + 4);
            const u32x4 xv = *(const u32x4*)(xbcc + (row0 + t) * 1024 + pair * 128 + c8), zv = *(const u32x4*)(proj + (row0 + t) * PLD + pair * 128 + c8);
            float fx[8], fz[8]; UNPACK8(xv, fx); UNPACK8(zv, fz);
            const float Dh = p.in[11][l * 8 + pair * 2 + (c8 >> 6)];
            f32x4 o0, o1;
#pragma unroll
            for (int j = 0; j < 4; ++j) { o0[j] = (y0[j] + Dh * fx[j]) * silu_f(fz[j]); o1[j] = (y1[j] + Dh * fx[4 + j]) * silu_f(fz[4 + j]); }
            float* op = yraw + (row0 + t) * 512 + pair * 128 + c8; *(f32x4*)op = o0; *(f32x4*)(op + 4) = o1;
            float ss = 0.f;
#pragma unroll
            for (int j = 0; j < 4; ++j) ss += o0[j] * o0[j] + o1[j] * o1[j];
            ss += __shfl_xor(ss, 1); ss += __shfl_xor(ss, 2); ss += __shfl_xor(ss, 4); ss += __shfl_xor(ss, 8);
            if ((tid & 15) == 0) RS[t] = pi == 0 ? ss : RS[t] + ss;
        }
        __syncthreads();
    }
    const float* nw = p.in[12] + l * 512 + grp * 256;
#pragma unroll
    for (int i = 0; i < 8; ++i) {
        const int it = tid + 512 * i, t = it >> 5, c8 = (it & 31) * 8;
        const float* yr = yraw + (row0 + t) * 512 + grp * 256 + c8;
        const f32x4 a = *(const f32x4*)yr, b = *(const f32x4*)(yr + 4), w0 = *(const f32x4*)(nw + c8), w1 = *(const f32x4*)(nw + c8 + 4);
        const float rstd = rsqrtf(RS[t] * (1.f / 256.f) + EPS);
        *(u32x4*)(ya + (row0 + t) * 512 + grp * 256 + c8) = (u32x4){pk2(a[0] * rstd * w0[0], a[1] * rstd * w0[1]), pk2(a[2] * rstd * w0[2], a[3] * rstd * w0[3]),
                                                                      pk2(b[0] * rstd * w1[0], b[1] * rstd * w1[1]), pk2(b[2] * rstd * w1[2], b[3] * rstd * w1[3])};
    }
    __syncthreads();
}

#if MULTI_LAUNCH
#define RUNPH(x) ((x) == p.only_phase)
#define GSYNC() do {} while (0)
#else
#define RUNPH(x) true
#define GSYNC() do { XcdBarrier xb_; xb_.bar = (unsigned*)(p.ws + O_BAR); xb_.x = xb_xcc_id(); xb_.st = (volatile LAS unsigned*)(lds + LDS_BYTES - 16); xcd_barrier(xb_); if (PROBE & 1) xcd_barrier(xb_); } while (0)
#endif
#define PH_BEGIN if (RUNPH(ph)) { unsigned char* ws = p.ws; float* X = p.out; asm volatile("" : "+s"(ws), "+s"(X)); const int wg = wg_now(), nwg = nwg_now();
#define PH_END } ++ph; GSYNC();
__global__ void __launch_bounds__(512) mega(Params p) {
    extern __shared__ __attribute__((aligned(16))) unsigned char smem[];
    LAS unsigned char* lds = (LAS unsigned char*)smem;
#if !MULTI_LAUNCH
    cg::grid_group grid = cg::this_grid();
    volatile LAS unsigned* xst = (volatile LAS unsigned*)(lds + LDS_BYTES - 16);
    if (threadIdx.x == 0) { xst[0] = 0u; xst[1] = 0u; }
    __syncthreads();
    (void)xcd_barrier_post((unsigned*)(p.ws + O_BAR), xst);
    grid.sync();
#endif
#define XN ((bf16_t*)(ws + O_XN))
#define SSQ0 ((float*)(ws + O_SSQ))
#define SSQ1 (SSQ0 + (size_t)T_ALL * 16)
#define SSQ2 (SSQ0 + (size_t)2 * T_ALL * 16)
#define H ((bf16_t*)(ws + O_H))
#define PROJ ((bf16_t*)(ws + O_PROJ))
#define XBCC ((bf16_t*)(ws + O_XBCC))
#define ST ((float*)(ws + O_ST))
#define ATOT ((float*)(ws + O_ATOT))
#define STB ((bf16_t*)(ws + O_STB))
#define DTB ((float*)(ws + O_DTB))
#define AQ ((bf16_t*)(ws + O_AQ))
#define AKV ((bf16_t*)(ws + O_AKV))
#define QRAW ((bf16_t*)(ws + O_QRAW))
#define KVRAW ((bf16_t*)(ws + O_KVRAW))
#define QF ((bf16_t*)(ws + O_QF))
#define KF ((bf16_t*)(ws + O_KF))
#define VT ((bf16_t*)(ws + O_VT))
#define YRAW ((float*)(ws + O_YRAW))
#define YA ((bf16_t*)(ws + O_YA))
#define YB (YA + (size_t)TG * 512)
#define YC (YA + (size_t)2 * TG * 512)
#define YD (YA + (size_t)3 * TG * 512)
#define CS ((f32x2*)(ws + O_CS))
#define PB ((bf16_t*)(ws + O_PB))
#define MIXB ((bf16_t*)(ws + O_MIXB))
#define WIN ((const bf16_t*)(ws + O_WIN))
#define WGATE ((const bf16_t*)(ws + O_WGATE))
#define WBR ((const bf16_t*)(ws + O_WBR))
#define WOUT ((const bf16_t*)(ws + O_WOUT))
#define WQB ((const bf16_t*)(ws + O_WQB))
#define WKVB ((const bf16_t*)(ws + O_WKVB))
#define XNg (XN + (size_t)g * TG * 1024)
    int ph = 0;
#pragma unroll 1
    for (int l = 0; l < 4; ++l) {
#pragma unroll 1
        for (int f = 0; f < 2; ++f) {
            if (f == 0) {
                PH_BEGIN
                    REP(32) convert_layer(p, l, (LAS float*)lds, wg, nwg);
                    if (l == 0) { rope_table(p, CS); init_rows(p.in[0], XN, SSQ0); }
                PH_END
            }
            PH_BEGIN
                EpiGU e{H, f == 0 ? SSQ0 : SSQ2};
#pragma unroll 1
                for (int rep = 0; rep < ((PROBE & 16) ? 2 : 1); ++rep) run_gemm(lds, XN, (const bf16_t*)(ws + (f == 0 ? O_WGU1 : O_WGU2)), T_ALL, 5632, 1024, e);
            PH_END
            PH_BEGIN
                if (PROBE & 256) { EpiRes e0{XN, f == 0 ? SSQ1 : SSQ0, (l == 3 && f == 1) ? X : nullptr, 0.0f}; run_gemm(lds, H, (const bf16_t*)(ws + (f == 0 ? O_WD1 : O_WD2)), T_ALL, 1024, 2816, e0); }
                EpiRes e{XN, f == 0 ? SSQ1 : SSQ0, (l == 3 && f == 1) ? X : nullptr, 0.5f}; run_gemm(lds, H, (const bf16_t*)(ws + (f == 0 ? O_WD1 : O_WD2)), T_ALL, 1024, 2816, e);
            PH_END
            if (f == 0) {
#pragma unroll 1
                for (int g = 0; g < NGRP; ++g) {
                    if (g == 0) {
                        PH_BEGIN
                            EpiStore e{PROJ, PLD, 0x7fffffff, SSQ1}; run_gemm(lds, XN, WIN, TG, 4864, 1024, e);
                        PH_END
                    }
                    PH_BEGIN
                        REP(4) prep1(p, l, PROJ, XBCC, DTB, AQ, AKV, YD);
                    PH_END
                    PH_BEGIN
                        REP(64) {
                        { EpiStore e{QRAW, 768, 0x7fffffff, nullptr}; run_gemm(lds, AQ, WQB, TG, 768, 384, e); }
                        { EpiStore e{KVRAW, 1024, 0x7fffffff, nullptr}; run_gemm(lds, AKV, WKVB, TG, 1024, 256, e); }
#pragma unroll 1
                        for (int u = wg; u < 256; u += nwg) {
                            ssd_states_unit(XBCC, DTB, ST, ATOT, u >> 5, (u >> 1) & 15, u & 1, lds);
                        }
                        }
                    PH_END
                    PH_BEGIN
                        REP(4) for (int u = wg; u < 256; u += nwg) prep2_unit(p, l, g, PROJ, QRAW, KVRAW, CS, QF, KF, VT, u >> 5, u & 31, lds);
                        ssd_scan(ST, STB, ATOT);
                    PH_END
                    PH_BEGIN
                        {
                            unsigned* ctr = (unsigned*)(ws + O_WQ) + (l * 4 + g);
                            volatile LAS unsigned* wq = (volatile LAS unsigned*)(lds + LDS_BYTES - 32);
#pragma unroll 1
                            for (;;) {
                                __syncthreads();
                                if (tid_now() == 0) *wq = atomicAdd(ctr, 1u);
                                __syncthreads();
                                const int u = (int)*wq;
                                if (u >= 640) break;
                                if (u < 64) { REP(2048) attn_unit(QF, KF, VT, YC, u & 31, 7 - (u >> 5), lds); }
                                else if (u < 320) { const int k = u - 64; REP(1024) ssd_out_grp(p, l, PROJ, XBCC, DTB, STB, YRAW, YA, k >> 5, (k >> 1) & 15, k & 1, lds); }
                                else if (u < 512) { const int k = u - 320; REP(2048) attn_unit(QF, KF, VT, YC, k & 31, 5 - (k >> 5), lds); }
                                else { const int k = u - 512; gmlp_unit(p, l, PROJ, YB, k >> 4, k & 15, lds); }
                            }
                        }
                    PH_END
                    PH_BEGIN
                        EpiStore e{PB, 1024, 3, nullptr}; pg8::Gemm gm{YA, WBR, 4 * TG, 4096, 512}; BranchOrder S; S.G = nwg; S.c = wg;
                        REP(128) pg8::gemm_phase<EpiStore, BranchOrder>(lds, gm, S, e);
                    PH_END
                    PH_BEGIN
                        EpiMerge e{PB, MIXB, SSQ1 + (size_t)g * TG * 16}; REP(128) run_gemm(lds, XNg, WGATE, TG, 4096, 1024, e);
                    PH_END
                    PH_BEGIN
                        { EpiRes e{XNg, SSQ2 + (size_t)g * TG * 16, nullptr, 1.0f}; run_gemm(lds, MIXB, WOUT, TG, 1024, 1024, e); }
                        if (g < NGRP - 1) {
                            EpiStore e{PROJ, PLD, 0x7fffffff, SSQ1 + (size_t)(g + 1) * TG * 16}; run_gemm(lds, XN + (size_t)(g + 1) * TG * 1024, WIN, TG, 4864, 1024, e); }
                    PH_END
                }
            }
        }
    }
}

constexpr int N_PHASES = 4 * (1 + 2 + 1 + 4 * 7 + 2);

extern "C" void kernel_launch(void* const* d_in, const int* in_sizes, int n_in, void* d_out, int out_size, void* d_ws, size_t ws_size, hipStream_t stream) {
    static int grid_blocks = 0;
    if (!grid_blocks) {
        if (n_in != 28 || ws_size < WS_NEED) { fprintf(stderr, "kernel_launch: need 28 inputs and %zu bytes of workspace (got %d, %zu)\n", (size_t)WS_NEED, n_in, ws_size); grid_blocks = -1; return; }
        if (hipFuncSetAttribute((const void*)mega, hipFuncAttributeMaxDynamicSharedMemorySize, LDS_BYTES) != hipSuccess) { fprintf(stderr, "kernel_launch: hipFuncSetAttribute failed\n"); grid_blocks = -1; return; }
        int dev = 0, cus = 0, per_cu = 0;
        hipGetDevice(&dev); hipDeviceGetAttribute(&cus, hipDeviceAttributeMultiprocessorCount, dev);
        hipOccupancyMaxActiveBlocksPerMultiprocessor(&per_cu, mega, 512, LDS_BYTES);
        if (per_cu < 1) { fprintf(stderr, "kernel_launch: occupancy query returned %d\n", per_cu); per_cu = 1; }
        (void)hipGetLastError();
        grid_blocks = cus * per_cu;
    }
    if (grid_blocks < 0) return;
    Params p{};
    for (int i = 0; i < 28; ++i) p.in[i] = (const float*)d_in[i];
    p.out = (float*)d_out; p.ws = (unsigned char*)d_ws; p.only_phase = -1; p.pad = 0;
#if MULTI_LAUNCH
    for (int ph = 0; ph < N_PHASES; ++ph) { p.only_phase = ph; hipLaunchKernelGGL(mega, dim3(grid_blocks), dim3(512), LDS_BYTES, stream, p); }
#else
    if (hipMemsetAsync((unsigned char*)d_ws + O_BAR, 0, ZERO_BYTES, stream) != hipSuccess) { fprintf(stderr, "kernel_launch: memset of barrier words failed\n"); return; }
    void* args[] = {&p};
    hipError_t e = hipLaunchCooperativeKernel((void*)mega, dim3(grid_blocks), dim3(512), args, LDS_BYTES, stream);
    if (e != hipSuccess) fprintf(stderr, "cooperative launch failed: %s (grid %d)\n", hipGetErrorString(e), grid_blocks);
#endif
}
```

```cpp
#include <hip/hip_runtime.h>
#include <hip/hip_cooperative_groups.h>
#include <cstdio>
namespace cg = cooperative_groups;

#ifndef PROBE
#define PROBE 0
#endif
#define REP(bit) _Pragma("unroll 1") for (int rep_ = 0; rep_ < ((PROBE & (bit)) ? 2 : 1); ++rep_)
#ifndef MULTI_LAUNCH
#define MULTI_LAUNCH 0
#endif

__device__ __forceinline__ int tid_now() { int t = threadIdx.x; asm volatile("" : "+v"(t)); return t; }
__device__ __forceinline__ int wg_now() { int t = blockIdx.x; asm volatile("" : "+s"(t)); return t; }
__device__ __forceinline__ int nwg_now() { int t = gridDim.x; asm volatile("" : "+s"(t)); return t; }
namespace pg8 {
#define PG8_LAS __attribute__((address_space(3)))
typedef unsigned short bf16_t;
typedef short bf16x8 __attribute__((ext_vector_type(8)));
typedef float f32x4 __attribute__((ext_vector_type(4)));
typedef unsigned u32x4 __attribute__((ext_vector_type(4)));
constexpr int BM = 256, BK = 64, HALF = 128, HTB = HALF * BK * 2  , STAGE_BYTES = 8 * HTB, NXCD = 8, WGM = 8;

__host__ __device__ __forceinline__ int lds_byte(int r, int c) { const int st = (r >> 4) * 2 + (c >> 5), rr = r & 15, cc = c & 31, ob = rr * 64 + cc * 2; return st * 1024 + (ob ^ (((ob >> 9) & 1) << 5)); }
__host__ __device__ __forceinline__ void stage_rc(int b, int& R, int& C) { const int st = b / 1024, sb = b % 1024, swz = sb ^ (((sb >> 9) & 1) << 5); R = (st >> 1) * 16 + swz / 64; C = (st & 1) * 32 + (swz % 64) / 2; }
__host__ __device__ __forceinline__ int perm32(int rho) { const int n = rho >> 4, i = rho & 15; return 8 * (i >> 2) + 4 * n + (i & 3); }

struct Unit { int pm, pn; };
struct Gemm { const bf16_t* A; const bf16_t* Bt; int M, N, K; };

struct StaticOrder {
    int nM, nN, nwg, G, c;
    __host__ __device__ void init(int M, int N, int G_, int c_) { nM = M / BM; nN = N / BM; nwg = nM * nN; G = G_; c = c_; }
    __host__ __device__ bool next(int i, Unit& u) const {
        const long L = (long)i * G + c; if (L >= nwg) return false;
        int wgid = (int)L; { const int q = nwg / NXCD, r = nwg % NXCD, xcd = wgid % NXCD, off = wgid / NXCD; wgid = (xcd < r ? xcd * (q + 1) : r * (q + 1) + (xcd - r) * q) + off; }
        const int nig = WGM * nN, gid = wgid / nig, fm = gid * WGM, gsz = (nM - fm) < WGM ? (nM - fm) : WGM;
        u.pm = fm + ((wgid % nig) % gsz); u.pn = (wgid % nig) / gsz; return true;
    }
    __device__ __forceinline__ void a_ready(const Unit&) const {}
    __device__ __forceinline__ void done(const Unit&) const {}
};

template <class Epi, class Sched>
__device__ __forceinline__ void gemm_phase(PG8_LAS unsigned char* lds, const Gemm g, const Sched& S, const Epi& E) {
    const int tid = tid_now(), wid = __builtin_amdgcn_readfirstlane(tid >> 6), lane = tid & 63, wr = wid >> 2, wc = wid & 3, fr = lane & 15, fq = lane >> 4;
    const int K = g.K, nt = K / BK;
    unsigned voffA[2], voffB[2];
#pragma unroll
    for (int i = 0; i < 2; ++i) { int R, C; stage_rc(tid * 16 + i * 8192, R, C); const int Rb = Epi::PERM ? ((R & ~31) + perm32(R & 31)) : R;
        voffA[i] = (unsigned)(R * K + C) * 2u; voffB[i] = (unsigned)(Rb * K + C) * 2u; }
    const size_t kstep = (size_t)(BK * 2);
    const size_t hstep = (size_t)HALF * K * 2;
    const size_t tstep = 2 * hstep;
    const unsigned ldsw = (unsigned)wid * 1024u;
    const int aoff = lds_byte(wr * 64 + fr, fq * 8), boff = lds_byte(wc * 32 + fr, fq * 8);
#define PG8_SA(b, h) (((b) * 2 + (h)) * HTB)
#define PG8_SB(b, h) ((4 + (b) * 2 + (h)) * HTB)
#define PG8_STAGE(bufoff, gbase, voff) do { _Pragma("unroll") for (int _i = 0; _i < 2; ++_i) \
        __builtin_amdgcn_global_load_lds((const unsigned*)((const char*)(gbase) + (voff)[_i]), (PG8_LAS unsigned*)(lds + (bufoff) + ldsw + _i * 8192), 16, 0, 0); } while (0)
#define PG8_LDA(dst, b, h) do { _Pragma("unroll") for (int m = 0; m < 4; ++m) _Pragma("unroll") for (int k = 0; k < 2; ++k) dst[m][k] = *(const PG8_LAS bf16x8*)(lds + PG8_SA(b, h) + aoff + m * 2048 + k * 1024); } while (0)
#define PG8_LDB(dst, b, h) do { _Pragma("unroll") for (int n = 0; n < 2; ++n) _Pragma("unroll") for (int k = 0; k < 2; ++k) dst[n][k] = *(const PG8_LAS bf16x8*)(lds + PG8_SB(b, h) + boff + n * 2048 + k * 1024); } while (0)
#define PG8_MMA(ai, bj, At, Bt) do { __builtin_amdgcn_s_setprio(1); _Pragma("unroll") for (int m = 0; m < 4; ++m) _Pragma("unroll") for (int n = 0; n < 2; ++n) _Pragma("unroll") for (int k = 0; k < 2; ++k) \
        acc[ai][bj][m][n] = __builtin_amdgcn_mfma_f32_16x16x32_bf16(Bt[n][k], At[m][k], acc[ai][bj][m][n], 0, 0, 0); __builtin_amdgcn_s_setprio(0); } while (0)
#define PG8_WAIT_V(n) asm volatile("s_waitcnt vmcnt(" #n ")" ::: "memory")
#define PG8_WAIT_L(n) asm volatile("s_waitcnt lgkmcnt(" #n ")" ::: "memory")
#define PG8_BAR __builtin_amdgcn_s_barrier()
#define PG8_SCHED __builtin_amdgcn_sched_barrier(0)
    Unit cur, nxt; int ui = 0;
    if (!S.next(0, cur)) return;
    f32x4 acc[2][2][4][2];
#pragma unroll
    for (int a = 0; a < 2; ++a)
#pragma unroll
        for (int b = 0; b < 2; ++b)
#pragma unroll
            for (int m = 0; m < 4; ++m)
#pragma unroll
                for (int n = 0; n < 2; ++n) acc[a][b][m][n] = (f32x4){0.f, 0.f, 0.f, 0.f};
    bf16x8 At[4][2], B0[2][2], B1[2][2];
    const char* cA = (const char*)g.A + (size_t)cur.pm * tstep; const char* cB = (const char*)g.Bt + (size_t)cur.pn * tstep;
    S.a_ready(cur);
    PG8_STAGE(PG8_SB(0, 0), cB, voffB); PG8_STAGE(PG8_SA(0, 0), cA, voffA); PG8_STAGE(PG8_SB(0, 1), cB + hstep, voffB); PG8_STAGE(PG8_SA(0, 1), cA + hstep, voffA);
    if (wr == 1) PG8_BAR;
    PG8_WAIT_V(4); PG8_BAR;
    PG8_STAGE(PG8_SB(1, 0), cB + kstep, voffB); PG8_STAGE(PG8_SA(1, 0), cA + kstep, voffA); PG8_STAGE(PG8_SB(1, 1), cB + hstep + kstep, voffB);
    PG8_WAIT_V(6); PG8_BAR;
    for (;;) {
        const bool has_next = S.next(ui + 1, nxt);
        const char* nA = has_next ? (const char*)g.A + (size_t)nxt.pm * tstep : cA; const char* nB = has_next ? (const char*)g.Bt + (size_t)nxt.pn * tstep : cB;
        for (int t = 0; t < nt; t += 2) {
            const bool last = (t == nt - 2);
            const char* a1 = cA + (size_t)(t + 1) * kstep;
            const char* a2 = last ? nA : cA + (size_t)(t + 2) * kstep; const char* b2 = last ? nB : cB + (size_t)(t + 2) * kstep;
            const char* a3 = a2 + kstep; const char* b3 = b2 + kstep;
            if (last && has_next) S.a_ready(nxt);
            PG8_LDB(B0, 0, 0); PG8_SCHED; PG8_LDA(At, 0, 0); PG8_STAGE(PG8_SA(1, 1), a1 + hstep, voffA);
            PG8_WAIT_L(8); PG8_BAR; PG8_WAIT_L(0); PG8_MMA(0, 0, At, B0); PG8_BAR; PG8_SCHED;
            PG8_LDB(B1, 0, 1); PG8_STAGE(PG8_SB(0, 0), b2, voffB);
            PG8_BAR; PG8_WAIT_L(0); PG8_MMA(0, 1, At, B1); PG8_BAR;
            PG8_LDA(At, 0, 1); PG8_STAGE(PG8_SA(0, 0), a2, voffA);
            PG8_BAR; PG8_WAIT_L(0); PG8_MMA(1, 0, At, B0); PG8_BAR; PG8_SCHED;
            PG8_STAGE(PG8_SB(0, 1), b2 + hstep, voffB);
            PG8_WAIT_V(6); PG8_BAR; PG8_MMA(1, 1, At, B1); PG8_BAR;
            PG8_LDB(B0, 1, 0); PG8_SCHED; PG8_LDA(At, 1, 0); PG8_STAGE(PG8_SA(0, 1), a2 + hstep, voffA);
            PG8_WAIT_L(8); PG8_BAR; PG8_WAIT_L(0); PG8_MMA(0, 0, At, B0); PG8_BAR; PG8_SCHED;
            PG8_LDB(B1, 1, 1); PG8_STAGE(PG8_SB(1, 0), b3, voffB);
            PG8_BAR; PG8_WAIT_L(0); PG8_MMA(0, 1, At, B1); PG8_BAR;
            PG8_LDA(At, 1, 1); PG8_STAGE(PG8_SA(1, 0), a3, voffA);
            PG8_BAR; PG8_WAIT_L(0); PG8_MMA(1, 0, At, B0); PG8_BAR; PG8_SCHED;
            PG8_STAGE(PG8_SB(1, 1), b3 + hstep, voffB);
            PG8_WAIT_V(6); PG8_BAR; PG8_MMA(1, 1, At, B1); PG8_BAR;
        }
        if constexpr (!Epi::AFTER_DRAIN) { E(acc, cur, wr, wc, fr, fq); S.done(cur); }
        if (!has_next) break;
#pragma unroll
        for (int a = 0; a < 2; ++a)
#pragma unroll
            for (int b = 0; b < 2; ++b)
#pragma unroll
                for (int m = 0; m < 4; ++m)
#pragma unroll
                    for (int n = 0; n < 2; ++n) acc[a][b][m][n] = (f32x4){0.f, 0.f, 0.f, 0.f};
        cur = nxt; cA = nA; cB = nB; ++ui;
    }
    PG8_WAIT_V(0);
    if (wr == 0) PG8_BAR;
    PG8_BAR;
    if constexpr (Epi::AFTER_DRAIN) { E.fused(acc, cur, wr, wc, fr, fq, lds, wid, lane); S.done(cur); }
#undef PG8_SA
#undef PG8_SB
#undef PG8_STAGE
#undef PG8_LDA
#undef PG8_LDB
#undef PG8_MMA
#undef PG8_WAIT_V
#undef PG8_WAIT_L
#undef PG8_BAR
#undef PG8_SCHED
}
}


using pg8::bf16_t; using pg8::bf16x8; using pg8::f32x4; using pg8::u32x4;
typedef short s16x4 __attribute__((ext_vector_type(4)));
typedef float f32x2 __attribute__((ext_vector_type(2)));
typedef float f32x16 __attribute__((ext_vector_type(16)));
typedef unsigned u32x2 __attribute__((ext_vector_type(2)));
typedef __bf16 bf16v2 __attribute__((ext_vector_type(2)));
#define LAS __attribute__((address_space(3)))
#define DI __device__ __forceinline__
#define XB_TMO      128
#define XB_XCNT(j)  (256  + 64 * (j))
#define XB_XSUB(j)  (1280 + 64 * (j))
#define XB_XGEN(j)  (2304 + 64 * (j))
#define XB_TOP      3328
#define XB_TOPGEN   3392
#define XCD_BAR_WORDS 3456
#define XB_SPIN_CAP (1u << 18)

__device__ __forceinline__ unsigned xb_ld(unsigned* p)              { return __hip_atomic_load(p, __ATOMIC_RELAXED, __HIP_MEMORY_SCOPE_AGENT); }
__device__ __forceinline__ unsigned xb_add(unsigned* p, unsigned v) { return __hip_atomic_fetch_add(p, v, __ATOMIC_RELAXED, __HIP_MEMORY_SCOPE_AGENT); }
__device__ __forceinline__ unsigned xb_xcc_id() { return (unsigned)__builtin_amdgcn_s_getreg((3 << 11) | 20) & 0xFu; }
#define XB_SPIN(cond, bar) do { unsigned _sp = 0; while (cond) { __builtin_amdgcn_s_sleep(1); \
    if ((++_sp & 255u) == 0u) { if (xb_ld(&(bar)[XB_TMO])) break; if (_sp > XB_SPIN_CAP) { atomicAdd(&(bar)[XB_TMO], 1u); break; } } } } while (0)

struct XcdBarrier {
    unsigned* bar; unsigned x;
    volatile LAS unsigned* st;
};

__device__ __forceinline__ XcdBarrier xcd_barrier_post(unsigned* bar, volatile LAS unsigned* st) {
    XcdBarrier b; b.bar = bar; b.x = xb_xcc_id(); b.st = st;
    if (threadIdx.x == 0) (void)xb_add(&bar[XB_XCNT(b.x)], 1u);
    return b;
}
__device__ __forceinline__ void xcd_barrier_complete(unsigned* bar, unsigned x, unsigned& nloc, unsigned& nx) {
    const unsigned G = (unsigned)nwg_now();
    unsigned sum, cnt, mine, sp = 0u;
    for (;;) {
        sum = 0u; cnt = 0u; mine = 0u;
#pragma unroll
        for (unsigned j = 0; j < 16; ++j) { const unsigned c = xb_ld(&bar[XB_XCNT(j)]); sum += c; cnt += (c > 0u) ? 1u : 0u; mine = (j == x) ? c : mine; }
        if (sum == G) break;
        __builtin_amdgcn_s_sleep(1);
        if ((++sp & 255u) == 0u) { if (xb_ld(&bar[XB_TMO])) break; if (sp > XB_SPIN_CAP) { atomicAdd(&bar[XB_TMO], 1u); break; } }
    }
    nloc = mine > 0u ? mine : 1u; nx = cnt > 0u ? cnt : 1u;
}

__device__ __forceinline__ void xcd_barrier(const XcdBarrier& b) {
    asm volatile("s_waitcnt vmcnt(0)" ::: "memory");
    __syncthreads();
    if (tid_now() == 0) {
        unsigned* bar = b.bar; unsigned bx = b.x; asm volatile("" : "+s"(bar), "+s"(bx));
        __builtin_amdgcn_s_waitcnt(0);
        unsigned nloc = b.st[0], nx = b.st[1];
        if (nloc == 0u) { xcd_barrier_complete(bar, bx, nloc, nx); b.st[0] = nloc; b.st[1] = nx; }
        const unsigned old = xb_add(&bar[XB_XSUB(bx)], 1u);
        const unsigned gen = old / nloc;
        if (old + 1u == (gen + 1u) * nloc) {
            __builtin_amdgcn_fence(__ATOMIC_RELEASE, "agent");
            asm volatile("s_waitcnt vmcnt(0)" ::: "memory");
            const unsigned og = xb_add(&bar[XB_TOP], 1u);
            const unsigned tg = og / nx;
            if (og + 1u == (tg + 1u) * nx) xb_add(&bar[XB_TOPGEN], 1u);
            else XB_SPIN(xb_ld(&bar[XB_TOPGEN]) == tg, bar);
            __builtin_amdgcn_fence(__ATOMIC_ACQUIRE, "agent");
            xb_add(&bar[XB_XGEN(bx)], 1u);
            asm volatile("s_waitcnt vmcnt(0)" ::: "memory");
        } else {
            XB_SPIN(xb_ld(&bar[XB_XGEN(bx)]) == gen, bar);
            __builtin_amdgcn_fence(__ATOMIC_ACQUIRE, "agent");
            asm volatile("s_waitcnt vmcnt(0)" ::: "memory");
        }
    }
    __syncthreads();
}


#define MFMA32(a, b, c) __builtin_amdgcn_mfma_f32_32x32x16_bf16((a), (b), (c), 0, 0, 0)

constexpr int T_ALL = 65536, SEQ = 2048, NGRP = 4, TG = 16384, BPG = 8, PLD = 4864;
constexpr float EPS = 1e-6f;
constexpr size_t SZ_GU = (size_t)5632 * 1024 * 2, SZ_D = (size_t)1024 * 2816 * 2;
constexpr size_t O_WGU1 = 0, O_WD1 = O_WGU1 + SZ_GU, O_WGU2 = O_WD1 + SZ_D, O_WD2 = O_WGU2 + SZ_GU, O_WIN = O_WD2 + SZ_D;
constexpr size_t O_WGATE = O_WIN + (size_t)4864 * 1024 * 2, O_WBR = O_WGATE + (size_t)4096 * 1024 * 2, O_WOUT = O_WBR + (size_t)4 * 1024 * 512 * 2;
constexpr size_t O_WQB = O_WOUT + (size_t)1024 * 1024 * 2, O_WKVB = O_WQB + (size_t)768 * 384 * 2, O_XN = O_WKVB + (size_t)1024 * 256 * 2;
constexpr size_t O_R0 = O_XN + (size_t)T_ALL * 1024 * 2;
constexpr size_t O_H = O_R0;
constexpr size_t O_PROJ = O_R0, O_XBCC = O_PROJ + (size_t)TG * PLD * 2, O_DTB = O_XBCC + (size_t)TG * 1024 * 2, O_AQ = O_DTB + (size_t)TG * 16 * 4;
constexpr size_t O_AKV = O_AQ + (size_t)TG * 384 * 2, O_QRAW = O_AKV + (size_t)TG * 256 * 2, O_KVRAW = O_QRAW + (size_t)TG * 768 * 2;
constexpr size_t O_QF = O_KVRAW + (size_t)TG * 1024 * 2, O_KF = O_QF + (size_t)TG * 768 * 2, O_VT = O_KF + (size_t)TG * 768 * 2;
constexpr size_t O_YRAW = O_VT + (size_t)TG * 512 * 2, O_YA = O_YRAW + (size_t)TG * 512 * 4;
constexpr size_t O_PB = O_YA + (size_t)4 * TG * 512 * 2, O_MIXB = O_PB + (size_t)4 * TG * 1024 * 2;
constexpr size_t O_ST = O_MIXB + (size_t)TG * 1024 * 2, O_ATOT = O_ST + (size_t)BPG * 16 * 8 * 8192 * 4;
constexpr size_t O_STB = O_ATOT + 4096;
constexpr size_t O_BAR = O_STB + (size_t)BPG * 16 * 8 * 8192 * 2;
constexpr size_t O_WQ = O_BAR + (size_t)XCD_BAR_WORDS * 4;
constexpr size_t ZERO_BYTES = (size_t)XCD_BAR_WORDS * 4 + 256;
constexpr size_t O_CS = O_WQ + 256 + 256 - ((size_t)XCD_BAR_WORDS * 4) % 256;
constexpr size_t O_SSQ = O_CS + (size_t)T_ALL * 32 * 8;
constexpr size_t O_END = O_SSQ + (size_t)3 * T_ALL * 16 * 4;
constexpr size_t O_END_H = O_H + (size_t)T_ALL * 2816 * 2;
constexpr size_t WS_NEED = O_END > O_END_H ? O_END : O_END_H;
constexpr int LDS_BYTES = 147456;

struct Params { const float* in[28]; float* out; unsigned char* ws; int only_phase; int pad; };

DI unsigned pk2(float a, float b) { f32x2 v = {a, b}; return __builtin_bit_cast(unsigned, __builtin_convertvector(v, bf16v2)); }
DI bf16_t f2bf(float a) { return (bf16_t)(pk2(a, 0.f) & 0xffffu); }
DI float bf2f(bf16_t b) { return __uint_as_float(((unsigned)b) << 16); }
DI float bflo(unsigned u) { return __uint_as_float(u << 16); }
DI float bfhi(unsigned u) { return __uint_as_float(u & 0xffff0000u); }
#define UNPACK8(v, f) do { f[0] = bflo(v.x); f[1] = bfhi(v.x); f[2] = bflo(v.y); f[3] = bfhi(v.y); f[4] = bflo(v.z); f[5] = bfhi(v.z); f[6] = bflo(v.w); f[7] = bfhi(v.w); } while (0)
#define PACK8(f) ((u32x4){pk2(f[0], f[1]), pk2(f[2], f[3]), pk2(f[4], f[5]), pk2(f[6], f[7])})
DI float wave_sum(float v) {
#pragma unroll
    for (int o = 1; o < 64; o <<= 1) v += __shfl_xor(v, o);
    return v;
}
DI float silu_f(float x) { return x * __builtin_amdgcn_rcpf(1.f + __builtin_amdgcn_exp2f(-1.4426950408889634f * x)); }
DI float sigmoid_f(float x) { return __builtin_amdgcn_rcpf(1.f + __builtin_amdgcn_exp2f(-1.4426950408889634f * x)); }
DI float gelu_f(float v) {
    const float t = __builtin_amdgcn_rcpf(fabsf(v) * 0.2316418882f + 1.0f);
    float q = t * 0.5307027145f + (-0.7265760135f); q = q * t + 0.7107068705f; q = q * t + (-0.142248368f); q = q * t + 0.127414796f; q = q * t;
    const float m = v * (q * __builtin_amdgcn_exp2f(v * v * (-0.72134752044f)));
    return v < 0.f ? m : v - m;
}
DI int crow(int i, int h) { return (i & 3) + 8 * (i >> 2) + 4 * h; }
DI void rows_rstd(const float* ssq, int row0, int fq, float (&rs)[2][4]) {
    f32x4 q[2][4];
#pragma unroll
    for (int ai = 0; ai < 2; ++ai)
#pragma unroll
        for (int m = 0; m < 4; ++m) q[ai][m] = ((const f32x4*)(ssq + (size_t)(row0 + ai * 128 + m * 16) * 16))[fq];
#pragma unroll
    for (int ai = 0; ai < 2; ++ai)
#pragma unroll
        for (int m = 0; m < 4; ++m) { float t = (q[ai][m][0] + q[ai][m][1]) + (q[ai][m][2] + q[ai][m][3]); t += __shfl_xor(t, 16); t += __shfl_xor(t, 32);
            rs[ai][m] = rsqrtf(t * (1.f / 1024.f) + EPS); }
}
struct EpiStore {
    static constexpr bool PERM = true, AFTER_DRAIN = false;
    bf16_t* O; int ldc; int pnmask; const float* ssq;
    DI void operator()(const f32x4 (&acc)[2][2][4][2], const pg8::Unit& u, int wr, int wc, int fr, int fq) const {
        const int row0 = u.pm * 256 + wr * 64 + fr, col0 = (u.pn & pnmask) * 256 + wc * 32 + 8 * fq;
        float rsv[2][4];
        if (ssq) rows_rstd(ssq, row0, fq, rsv);
        else {
#pragma unroll
            for (int ai = 0; ai < 2; ++ai)
#pragma unroll
                for (int m = 0; m < 4; ++m) rsv[ai][m] = 1.f; }
#pragma unroll
        for (int ai = 0; ai < 2; ++ai)
#pragma unroll
            for (int m = 0; m < 4; ++m) { bf16_t* rowp = O + (size_t)(row0 + ai * 128 + m * 16) * ldc + col0;
                const float rs = rsv[ai][m];
#pragma unroll
                for (int bj = 0; bj < 2; ++bj) { const f32x4 v0 = acc[ai][bj][m][0] * rs, v1 = acc[ai][bj][m][1] * rs;
                    u32x4 w; w.x = pk2(v0[0], v0[1]); w.y = pk2(v0[2], v0[3]); w.z = pk2(v1[0], v1[1]); w.w = pk2(v1[2], v1[3]);
                    *(u32x4*)(rowp + bj * 128) = w; } }
    }
};
struct EpiGU {
    static constexpr bool PERM = true, AFTER_DRAIN = false;
    bf16_t* H; const float* ssq;
    DI void operator()(const f32x4 (&acc)[2][2][4][2], const pg8::Unit& u, int wr, int wc, int fr, int fq) const {
        const int row0 = u.pm * 256 + wr * 64 + fr, col0 = u.pn * 128 + wc * 32 + 8 * fq;
        float rsv[2][4]; rows_rstd(ssq, row0, fq, rsv);
#pragma unroll
        for (int ai = 0; ai < 2; ++ai)
#pragma unroll
            for (int m = 0; m < 4; ++m) { bf16_t* rowp = H + (size_t)(row0 + ai * 128 + m * 16) * 2816 + col0;
                const float rs = rsv[ai][m];
                float o[8];
#pragma unroll
                for (int n = 0; n < 2; ++n)
#pragma unroll
                    for (int j = 0; j < 4; ++j) o[4 * n + j] = silu_f(acc[ai][0][m][n][j] * rs) * (acc[ai][1][m][n][j] * rs);
                *(u32x4*)rowp = PACK8(o); }
    }
};
struct EpiRes {
    static constexpr bool PERM = false, AFTER_DRAIN = false;
    bf16_t* XB; float* SSQ; float* OUT; float sc;
    DI void operator()(const f32x4 (&acc)[2][2][4][2], const pg8::Unit& u, int wr, int wc, int fr, int fq) const {
        const int row0 = u.pm * 256 + wr * 64 + fr, col0 = u.pn * 256 + wc * 32 + 4 * fq;
#pragma unroll
        for (int ai = 0; ai < 2; ++ai) {
            u32x2 xv[4][2][2];
#pragma unroll
            for (int m = 0; m < 4; ++m)
#pragma unroll
                for (int bj = 0; bj < 2; ++bj)
#pragma unroll
                    for (int n = 0; n < 2; ++n) xv[m][bj][n] = *(const u32x2*)(XB + (size_t)(row0 + ai * 128 + m * 16) * 1024 + col0 + bj * 128 + n * 16);
#pragma unroll
            for (int m = 0; m < 4; ++m) { const int row = row0 + ai * 128 + m * 16; const size_t ro = (size_t)row * 1024 + col0;
                float ss = 0.f;
#pragma unroll
                for (int bj = 0; bj < 2; ++bj)
#pragma unroll
                    for (int n = 0; n < 2; ++n) { const u32x2 xo = xv[m][bj][n]; const f32x4 a = acc[ai][bj][m][n];
                        const f32x4 v = {bflo(xo.x) + a[0] * sc, bfhi(xo.x) + a[1] * sc, bflo(xo.y) + a[2] * sc, bfhi(xo.y) + a[3] * sc};
                        if (OUT) *(f32x4*)(OUT + ro + bj * 128 + n * 16) = v;
                        else *(u32x2*)(XB + ro + bj * 128 + n * 16) = (u32x2){pk2(v[0], v[1]), pk2(v[2], v[3])};
                        ss += v[0] * v[0] + v[1] * v[1] + v[2] * v[2] + v[3] * v[3]; }
                ss += __shfl_xor(ss, 16); ss += __shfl_xor(ss, 32);
                if (fq == 0) SSQ[(size_t)row * 16 + u.pn * 4 + wc] = ss; }
        }
    }
};
struct EpiMerge {
    static constexpr bool PERM = false, AFTER_DRAIN = false;
    const bf16_t* P; bf16_t* MIX; const float* ssq;
    DI void operator()(const f32x4 (&acc)[2][2][4][2], const pg8::Unit& u, int wr, int wc, int fr, int fq) const {
        const int row0 = u.pm * 256 + wr * 64 + fr, e0 = u.pn * 64 + wc * 16 + 4 * fq;
        float rsv[2][4]; rows_rstd(ssq, row0, fq, rsv);
#pragma unroll
        for (int ai = 0; ai < 2; ++ai) {
            u32x2 pv[4][4];
#pragma unroll
            for (int m = 0; m < 4; ++m)
#pragma unroll
                for (int b = 0; b < 4; ++b) pv[m][b] = *(const u32x2*)(P + (size_t)b * TG * 1024 + (size_t)(row0 + ai * 128 + m * 16) * 1024 + e0);
#pragma unroll
            for (int m = 0; m < 4; ++m) { const float rs = rsv[ai][m];
                float o[4] = {0.f, 0.f, 0.f, 0.f};
#pragma unroll
                for (int bj = 0; bj < 2; ++bj)
#pragma unroll
                    for (int n = 0; n < 2; ++n) { const u32x2 q = pv[m][2 * bj + n]; const f32x4 g = acc[ai][bj][m][n] * rs;
                        o[0] += sigmoid_f(g[0]) * bflo(q.x); o[1] += sigmoid_f(g[1]) * bfhi(q.x); o[2] += sigmoid_f(g[2]) * bflo(q.y); o[3] += sigmoid_f(g[3]) * bfhi(q.y); }
                *(u32x2*)(MIX + (size_t)(row0 + ai * 128 + m * 16) * 1024 + e0) = (u32x2){pk2(o[0], o[1]), pk2(o[2], o[3])}; }
        }
    }
};
struct BranchOrder {
    int G, c;
    DI bool next(int i, pg8::Unit& u) const { const int L = i * G + c; if (L >= 1024) return false; const int br = L >> 8, rem = L & 255; u.pm = br * 64 + (rem >> 2); u.pn = br * 4 + (rem & 3); return true; }
    DI void a_ready(const pg8::Unit&) const {}
    DI void done(const pg8::Unit&) const {}
};
template <class Epi> DI void run_gemm(LAS unsigned char* lds, const bf16_t* A, const bf16_t* Bt, int M, int N, int K, const Epi& E) {
    pg8::Gemm g{A, Bt, M, N, K}; pg8::StaticOrder S; S.init(M, N, nwg_now(), wg_now());
    pg8::gemm_phase<Epi, pg8::StaticOrder>(lds, g, S, E);
}

DI void conv_mat(const float* src, int ld, int c0, int nvalid, int kvalid, int mode, bf16_t* dst, int Nd, int Kd, LAS float* scr, int wg, int nwg, const float* ksc = nullptr) {
    const int tid = tid_now(); const int ntk = Kd >> 6, ntiles = (Nd >> 6) * ntk;
    for (int tile = wg; tile < ntiles; tile += nwg) {
        const int n0 = (tile / ntk) << 6, k0 = (tile % ntk) << 6;
        const int nn = tid & 63, kq = tid >> 6, n = n0 + nn;
        int col;
        if (mode == 1) { const int blk = n >> 7; col = ((blk & 1) ? 2816 : 0) + (blk >> 1) * 128 + (n & 127); }
        else if (mode == 2) { const int c = n & 255, br = 2 * (c >> 7) + ((c >> 4) & 1), e = 64 * (n >> 8) + 16 * ((c >> 5) & 3) + (c & 15); col = c0 + br * 1024 + e; }
        else col = c0 + n;
#pragma unroll
        for (int i = 0; i < 8; ++i) { const int kk = i * 8 + kq; float v = 0.f;
            if (k0 + kk < kvalid && n < nvalid) { v = src[(size_t)(k0 + kk) * ld + col]; if (ksc) v *= ksc[k0 + kk]; }
            scr[kk * 65 + nn] = v; }
        __syncthreads();
        { const int nr = tid >> 3, kc = tid & 7; const LAS float* sp = scr + (kc * 8) * 65 + nr;
          u32x4 o; o.x = pk2(sp[0], sp[65]); o.y = pk2(sp[130], sp[195]); o.z = pk2(sp[260], sp[325]); o.w = pk2(sp[390], sp[455]);
          *(u32x4*)(dst + (size_t)(n0 + nr) * Kd + k0 + kc * 8) = o; }
        __syncthreads();
    }
}
DI void convert_layer(const Params& p, int l, LAS float* scr, int wg, int nwg) {
    unsigned char* ws = p.ws;
    conv_mat(p.in[3] + (size_t)l * 1024 * 5632, 5632, 0, 5632, 1024, 1, (bf16_t*)(ws + O_WGU1), 5632, 1024, scr, wg, nwg, p.in[2] + l * 1024);
    conv_mat(p.in[26] + (size_t)l * 1024 * 5632, 5632, 0, 5632, 1024, 1, (bf16_t*)(ws + O_WGU2), 5632, 1024, scr, wg, nwg, p.in[25] + l * 1024);
    conv_mat(p.in[4] + (size_t)l * 2816 * 1024, 1024, 0, 1024, 2816, 0, (bf16_t*)(ws + O_WD1), 1024, 2816, scr, wg, nwg);
    conv_mat(p.in[27] + (size_t)l * 2816 * 1024, 1024, 0, 1024, 2816, 0, (bf16_t*)(ws + O_WD2), 1024, 2816, scr, wg, nwg);
    conv_mat(p.in[6] + (size_t)l * 1024 * 8776, 8776, 0, 4680, 1024, 0, (bf16_t*)(ws + O_WIN), 4864, 1024, scr, wg, nwg, p.in[5] + l * 1024);
    conv_mat(p.in[6] + (size_t)l * 1024 * 8776, 8776, 4680, 4096, 1024, 2, (bf16_t*)(ws + O_WGATE), 4096, 1024, scr, wg, nwg, p.in[5] + l * 1024);
#pragma unroll 1
    for (int i = 0; i < 4; ++i)
        conv_mat(p.in[23] + ((size_t)l * 4 + i) * 512 * 1024, 1024, 0, 1024, 512, 0, (bf16_t*)(ws + O_WBR) + (size_t)i * 1024 * 512, 1024, 512, scr, wg, nwg);
    conv_mat(p.in[24] + (size_t)l * 1024 * 1024, 1024, 0, 1024, 1024, 0, (bf16_t*)(ws + O_WOUT), 1024, 1024, scr, wg, nwg);
    conv_mat(p.in[17] + (size_t)l * 384 * 768, 768, 0, 768, 384, 0, (bf16_t*)(ws + O_WQB), 768, 384, scr, wg, nwg);
    conv_mat(p.in[19] + (size_t)l * 128 * 1024, 1024, 0, 1024, 128, 0, (bf16_t*)(ws + O_WKVB), 1024, 256, scr, wg, nwg);
}

DI void init_rows(const float* x, bf16_t* xb, float* ssq) {
    const int tidn = tid_now(); const int lane = tidn & 63, gwave = wg_now() * 8 + (tidn >> 6), ngw = nwg_now() * 8;
    for (int row = gwave; row < T_ALL; row += ngw) {
        const f32x4* xr = (const f32x4*)(x + (size_t)row * 1024);
        f32x4 v[4]; float ss = 0.f;
#pragma unroll
        for (int j = 0; j < 4; ++j) { v[j] = xr[lane + 64 * j]; ss += v[j][0] * v[j][0] + v[j][1] * v[j][1] + v[j][2] * v[j][2] + v[j][3] * v[j][3]; }
        ss = wave_sum(ss);
        u32x2* o = (u32x2*)(xb + (size_t)row * 1024);
#pragma unroll
        for (int j = 0; j < 4; ++j) o[lane + 64 * j] = (u32x2){pk2(v[j][0], v[j][1]), pk2(v[j][2], v[j][3])};
        if (lane < 16) ssq[(size_t)row * 16 + lane] = lane == 0 ? ss : 0.f;
    }
}
DI void zero_f32(float* q, int n) { const int tidn = tid_now(); for (int i = wg_now() * 512 + tidn; i < n; i += nwg_now() * 512) q[i] = 0.f; }

DI void prep1(const Params& p, int l, const bf16_t* __restrict__ proj, bf16_t* __restrict__ xbcc, float* __restrict__ dtb, bf16_t* __restrict__ aq, bf16_t* __restrict__ akv, bf16_t* __restrict__ yd) {
    const int tidn = tid_now(); const int gtid = wg_now() * 512 + tidn, gthreads = nwg_now() * 512;
    const float* cw = p.in[7] + l * 4096; const float* cb = p.in[8] + l * 1024;
    for (int idx = gtid; idx < (TG / 16) * 128; idx += gthreads) {
        const int c8 = (idx & 127) << 3, tl0 = (idx >> 7) << 4, s0 = tl0 & 2047;
        float w[4][8], bb[8], r0[8], r1[8], r2[8];
#pragma unroll
        for (int k = 0; k < 4; ++k) { const f32x4 a = *(const f32x4*)(cw + k * 1024 + c8), b = *(const f32x4*)(cw + k * 1024 + c8 + 4);
#pragma unroll
            for (int j = 0; j < 4; ++j) { w[k][j] = a[j]; w[k][4 + j] = b[j]; } }
        { const f32x4 a = *(const f32x4*)(cb + c8), b = *(const f32x4*)(cb + c8 + 4);
#pragma unroll
          for (int j = 0; j < 4; ++j) { bb[j] = a[j]; bb[4 + j] = b[j]; } }
        const bf16_t* src = proj + (size_t)tl0 * PLD + 512 + c8;
        if (s0 > 0) { const u32x4 v0 = *(const u32x4*)(src - 3 * PLD), v1 = *(const u32x4*)(src - 2 * PLD), v2 = *(const u32x4*)(src - PLD); UNPACK8(v0, r0); UNPACK8(v1, r1); UNPACK8(v2, r2); }
        else {
#pragma unroll
            for (int j = 0; j < 8; ++j) { r0[j] = 0.f; r1[j] = 0.f; r2[j] = 0.f; } }
#pragma unroll 8
        for (int tt = 0; tt < 16; ++tt) {
            const u32x4 v = *(const u32x4*)(src + (size_t)tt * PLD); float cur[8], o[8]; UNPACK8(v, cur);
#pragma unroll
            for (int j = 0; j < 8; ++j) { o[j] = silu_f(bb[j] + w[0][j] * r0[j] + w[1][j] * r1[j] + w[2][j] * r2[j] + w[3][j] * cur[j]); r0[j] = r1[j]; r1[j] = r2[j]; r2[j] = cur[j]; }
            *(u32x4*)(xbcc + (size_t)(tl0 + tt) * 1024 + c8) = PACK8(o);
        }
    }
    const float* sw = p.in[22] + l * 1536;
    for (int idx = gtid; idx < (TG / 16) * 64; idx += gthreads) {
        const int c8 = (idx & 63) << 3, tl0 = (idx >> 6) << 4, s0 = tl0 & 2047;
        float w[3][8], p1[8], p2[8];
#pragma unroll
        for (int k = 0; k < 3; ++k) { const f32x4 a = *(const f32x4*)(sw + k * 512 + c8), b = *(const f32x4*)(sw + k * 512 + c8 + 4);
#pragma unroll
            for (int j = 0; j < 4; ++j) { w[k][j] = a[j]; w[k][4 + j] = b[j]; } }
        const bf16_t* src = proj + (size_t)tl0 * PLD + c8;
        if (s0 > 0) { const u32x4 c1 = *(const u32x4*)(src - 2 * PLD + 3656), x1 = *(const u32x4*)(src - 2 * PLD + 4168), c2 = *(const u32x4*)(src - PLD + 3656), x2 = *(const u32x4*)(src - PLD + 4168);
            float a[8], b[8]; UNPACK8(c1, a); UNPACK8(x1, b);
#pragma unroll
            for (int j = 0; j < 8; ++j) p1[j] = a[j] * b[j];
            UNPACK8(c2, a); UNPACK8(x2, b);
#pragma unroll
            for (int j = 0; j < 8; ++j) p2[j] = a[j] * b[j]; }
        else {
#pragma unroll
            for (int j = 0; j < 8; ++j) { p1[j] = 0.f; p2[j] = 0.f; } }
#pragma unroll 8
        for (int tt = 0; tt < 16; ++tt) {
            const bf16_t* pr = src + (size_t)tt * PLD;
            const u32x4 vc = *(const u32x4*)(pr + 3656), vx = *(const u32x4*)(pr + 4168), vb = *(const u32x4*)(pr + 3144);
            float fc[8], fx[8], fb[8], o[8]; UNPACK8(vc, fc); UNPACK8(vx, fx); UNPACK8(vb, fb);
#pragma unroll
            for (int j = 0; j < 8; ++j) { const float cur = fc[j] * fx[j]; o[j] = fb[j] * (w[0][j] * p1[j] + w[1][j] * p2[j] + w[2][j] * cur); p1[j] = p2[j]; p2[j] = cur; }
            *(u32x4*)(yd + (size_t)(tl0 + tt) * 512 + c8) = PACK8(o);
        }
    }
    const int gwave = gtid >> 6, ngw = gthreads >> 6, lane = tidn & 63;
    const float* qn = p.in[16] + l * 384; const float* kn = p.in[18] + l * 128;
#pragma unroll 4
    for (int tl = gwave; tl < TG; tl += ngw) {
        const bf16_t* pr = proj + (size_t)tl * PLD;
        const u32x4 v = *(const u32x4*)(pr + 2568 + lane * 8); float f[8]; UNPACK8(v, f);
        float ss = 0.f;
#pragma unroll
        for (int j = 0; j < 8; ++j) ss += f[j] * f[j];
        const float ssq = wave_sum(lane < 48 ? ss : 0.f), ssk = wave_sum(lane >= 48 ? ss : 0.f);
        if (lane < 48) {
            const float rstd = rsqrtf(ssq * (1.f / 384.f) + EPS);
#pragma unroll
            for (int j = 0; j < 8; ++j) f[j] *= rstd * qn[lane * 8 + j];
            *(u32x4*)(aq + (size_t)tl * 384 + lane * 8) = PACK8(f);
        } else {
            const float rstd = rsqrtf(ssk * (1.f / 128.f) + EPS);
#pragma unroll
            for (int j = 0; j < 8; ++j) f[j] *= rstd * kn[(lane - 48) * 8 + j];
            *(u32x4*)(akv + (size_t)tl * 256 + (lane - 48) * 8) = PACK8(f);
            { unsigned z = 0u; asm volatile("" : "+v"(z)); *(u32x4*)(akv + (size_t)tl * 256 + 128 + (lane - 48) * 8) = (u32x4){z, z, z, z}; }
        }
        if (lane < 8) {
            const float xr = bf2f(pr[1536 + lane]) + p.in[9][l * 8 + lane];
            const float dt = xr > 20.f ? xr : log1pf(expf(xr));
            const float A = -expf(p.in[10][l * 8 + lane]);
            dtb[(size_t)tl * 16 + lane] = dt; dtb[(size_t)tl * 16 + 8 + lane] = dt * A;
        }
    }
}

DI void rope_table(const Params& p, f32x2* CS) {
    const int* pos = (const int*)p.in[1];
    const int tidn = tid_now();
    for (int idx = wg_now() * 512 + tidn; idx < T_ALL * 32; idx += nwg_now() * 512) {
        const float invf = exp2f(-(float)(idx & 31) * (13.287712379549449f / 32.f));
        const float ang = (float)pos[idx >> 5] * invf;
        CS[idx] = (f32x2){cosf(ang), sinf(ang)};
    }
}
DI void prep2_unit(const Params& p, int l, int g, const bf16_t* __restrict__ proj, const bf16_t* __restrict__ qraw, const bf16_t* __restrict__ kvraw, const f32x2* __restrict__ CSt, bf16_t* __restrict__ Qf, bf16_t* __restrict__ Kf, bf16_t* __restrict__ Vt, int bl, int tile, LAS unsigned char* lds) {
    const int tid = tid_now(), wave = tid >> 6, lane = tid & 63;
    const float* wq = p.in[20] + l * 192; const float* wk = p.in[21] + l * 192;
    const float qscale = 0.07216878364870322f * 1.4426950408889634f;
    const float wq0 = wq[lane], wq1 = wq[64 + lane], wq2 = wq[128 + lane], wk0 = wk[lane], wk1 = wk[64 + lane], wk2 = wk[128 + lane];
    LAS bf16_t* img = (LAS bf16_t*)lds;
    const int t0 = tile * 64;
#pragma unroll 2
    for (int tt = 0; tt < 8; ++tt) {
        const int tloc = wave * 8 + tt, s = t0 + tloc; const size_t tl = (size_t)bl * SEQ + s;
        const f32x2 cssn = CSt[((size_t)(g * BPG + bl) * SEQ + s) * 32 + (lane & 31)];
        const float cs = cssn[0], sn = cssn[1];
        const float kpe = bf2f(proj[tl * PLD + 3080 + lane]);
#pragma unroll
        for (int h = 0; h < 4; ++h) {
            const size_t ob = ((size_t)(bl * 4 + h) * SEQ + s) * 192;
            {
                const bf16_t* qr = qraw + tl * 768 + h * 192;
                float q0 = bf2f(qr[lane]), q1 = bf2f(qr[64 + lane]), q2 = bf2f(qr[128 + lane]);
                const float r = rsqrtf(wave_sum(q0 * q0 + q1 * q1 + q2 * q2) * (1.f / 192.f) + EPS);
                q0 *= r * wq0; q1 *= r * wq1; q2 *= r * wq2;
                const float qp = __shfl_xor(q2, 32);
                q2 = (lane < 32) ? q2 * cs - qp * sn : q2 * cs + qp * sn;
                bf16_t* qo = Qf + ob;
                qo[lane] = f2bf(q0 * qscale); qo[64 + lane] = f2bf(q1 * qscale); qo[128 + lane] = f2bf(q2 * qscale);
            }
            const bf16_t* kr = kvraw + tl * 1024 + h * 256;
            {
                float k0 = bf2f(kr[lane]), k1 = bf2f(kr[64 + lane]), k2 = kpe;
                const float r = rsqrtf(wave_sum(k0 * k0 + k1 * k1 + k2 * k2) * (1.f / 192.f) + EPS);
                k0 *= r * wk0; k1 *= r * wk1; k2 *= r * wk2;
                const float kp = __shfl_xor(k2, 32);
                k2 = (lane < 32) ? k2 * cs - kp * sn : k2 * cs + kp * sn;
                bf16_t* ko = Kf + ob;
                ko[lane] = f2bf(k0); ko[64 + lane] = f2bf(k1); ko[128 + lane] = f2bf(k2);
            }
            img[(h * 128 + lane) * 72 + tloc] = kr[128 + lane]; img[(h * 128 + 64 + lane) * 72 + tloc] = kr[192 + lane];
        }
    }
    __syncthreads();
#pragma unroll
    for (int i = 0; i < 8; ++i) {
        const int ch = tid + 512 * i, row = ch >> 3, cc = ch & 7;
        *(u32x4*)(Vt + ((size_t)(bl * 4 + (row >> 7)) * 128 + (row & 127)) * SEQ + t0 + cc * 8) = *(const LAS u32x4*)(lds + row * 144 + cc * 16);
    }
    __syncthreads();
}

constexpr int KP = 400, VP = 136, KBYTES = 64 * KP, VBYTES = 128 * VP, ASTAGE = KBYTES + VBYTES;
DI void attn_unit(const bf16_t* Qf, const bf16_t* Kf, const bf16_t* Vt, bf16_t* yc, int bh, int qb, LAS unsigned char* lds) {
    const int tid = tid_now(), wave = tid >> 6, lane = tid & 63, r31 = lane & 31, hh = lane >> 5;
    const int q0 = qb * 256, qrow = q0 + wave * 32 + r31;
    const bf16_t* Qp = Qf + ((size_t)bh * SEQ + qrow) * 192 + 8 * hh;
    bf16x8 qf[12];
#pragma unroll
    for (int kk = 0; kk < 12; ++kk) qf[kk] = *(const bf16x8*)(Qp + kk * 16);
    f32x16 o[4];
#pragma unroll
    for (int d = 0; d < 4; ++d)
#pragma unroll
        for (int i = 0; i < 16; ++i) o[d][i] = 0.f;
    float m = -1e30f, l = 0.f;
    const int ntiles = qb * 4 + 4;
    const bf16_t* Kb = Kf + (size_t)bh * SEQ * 192; const bf16_t* Vb = Vt + (size_t)bh * 128 * SEQ;
    int krow[3], kcc[3], vd[2], vcc[2];
#pragma unroll
    for (int i = 0; i < 3; ++i) { const int c = tid + 512 * i; krow[i] = c / 24; kcc[i] = c % 24; }
#pragma unroll
    for (int i = 0; i < 2; ++i) { const int c = tid + 512 * i; vd[i] = c >> 3; vcc[i] = c & 7; }
    u32x4 kreg[3], vreg[2];
#define ATT_GLOAD(j) do { _Pragma("unroll") for (int i = 0; i < 3; ++i) kreg[i] = *(const u32x4*)(Kb + (size_t)((j) * 64 + krow[i]) * 192 + kcc[i] * 8); \
        _Pragma("unroll") for (int i = 0; i < 2; ++i) vreg[i] = *(const u32x4*)(Vb + (size_t)vd[i] * SEQ + (j) * 64 + vcc[i] * 8); } while (0)
#define ATT_LSTORE(st) do { LAS unsigned char* b_ = lds + (st) * ASTAGE; \
        _Pragma("unroll") for (int i = 0; i < 3; ++i) *(LAS u32x4*)(b_ + krow[i] * KP + kcc[i] * 16) = kreg[i]; \
        _Pragma("unroll") for (int i = 0; i < 2; ++i) { LAS u32x2* d_ = (LAS u32x2*)(b_ + KBYTES + vd[i] * VP + vcc[i] * 16); d_[0] = (u32x2){vreg[i].x, vreg[i].y}; d_[1] = (u32x2){vreg[i].z, vreg[i].w}; } } while (0)
    ATT_GLOAD(0); ATT_LSTORE(0);
    __syncthreads();
    for (int j = 0; j < ntiles; ++j) {
        const int cur = j & 1;
        if (j + 1 < ntiles) ATT_GLOAD(j + 1);
        if (j * 64 <= q0 + wave * 32 + 31) {
            const LAS unsigned char* Kl = lds + cur * ASTAGE; const LAS unsigned char* Vl = Kl + KBYTES;
            f32x16 s0, s1;
#pragma unroll
            for (int i = 0; i < 16; ++i) { s0[i] = 0.f; s1[i] = 0.f; }
#pragma unroll
            for (int kk = 0; kk < 12; ++kk) {
                const bf16x8 a0 = *(const LAS bf16x8*)(Kl + r31 * KP + (kk * 16 + 8 * hh) * 2);
                const bf16x8 a1 = *(const LAS bf16x8*)(Kl + (32 + r31) * KP + (kk * 16 + 8 * hh) * 2);
                s0 = MFMA32(a0, qf[kk], s0); s1 = MFMA32(a1, qf[kk], s1);
            }
            if (j * 64 + 63 > q0 + wave * 32) {
#pragma unroll
                for (int i = 0; i < 16; ++i) { const int key = j * 64 + crow(i, hh); if (key > qrow) s0[i] = -1e30f; if (key + 32 > qrow) s1[i] = -1e30f; }
            }
            float mx = s0[0];
#pragma unroll
            for (int i = 1; i < 16; ++i) mx = fmaxf(mx, s0[i]);
#pragma unroll
            for (int i = 0; i < 16; ++i) mx = fmaxf(mx, s1[i]);
            mx = fmaxf(mx, __shfl_xor(mx, 32));
            const float mn = fmaxf(m, mx);
            if (__ballot(mx > m) != 0ull) {
                const float alpha = __builtin_amdgcn_exp2f(m - mn);
                l *= alpha;
#pragma unroll
                for (int d = 0; d < 4; ++d)
#pragma unroll
                    for (int i = 0; i < 16; ++i) o[d][i] *= alpha;
            }
            m = mn;
            float ls = 0.f;
#pragma unroll
            for (int i = 0; i < 16; ++i) { s0[i] = __builtin_amdgcn_exp2f(s0[i] - mn); s1[i] = __builtin_amdgcn_exp2f(s1[i] - mn); ls += s0[i] + s1[i]; }
            l += ls;
            bf16x8 pf[2][2];
#pragma unroll
            for (int s = 0; s < 2; ++s) {
                u32x4 w0, w1;
                w0.x = pk2(s0[8 * s], s0[8 * s + 1]); w0.y = pk2(s0[8 * s + 2], s0[8 * s + 3]); w0.z = pk2(s0[8 * s + 4], s0[8 * s + 5]); w0.w = pk2(s0[8 * s + 6], s0[8 * s + 7]);
                w1.x = pk2(s1[8 * s], s1[8 * s + 1]); w1.y = pk2(s1[8 * s + 2], s1[8 * s + 3]); w1.z = pk2(s1[8 * s + 4], s1[8 * s + 5]); w1.w = pk2(s1[8 * s + 6], s1[8 * s + 7]);
                pf[0][s] = __builtin_bit_cast(bf16x8, w0); pf[1][s] = __builtin_bit_cast(bf16x8, w1);
            }
#pragma unroll
            for (int d = 0; d < 4; ++d)
#pragma unroll
                for (int kb = 0; kb < 2; ++kb)
#pragma unroll
                    for (int s = 0; s < 2; ++s) {
                        const LAS unsigned char* vp = Vl + (d * 32 + r31) * VP + (kb * 32 + 16 * s + 4 * hh) * 2;
                        const s16x4 lo = *(const LAS s16x4*)vp, hi = *(const LAS s16x4*)(vp + 16);
                        const bf16x8 a = __builtin_shufflevector(lo, hi, 0, 1, 2, 3, 4, 5, 6, 7);
                        o[d] = MFMA32(a, pf[kb][s], o[d]);
                    }
        }
        if (j + 1 < ntiles) ATT_LSTORE(cur ^ 1);
        __syncthreads();
    }
#undef ATT_GLOAD
#undef ATT_LSTORE
    l += __shfl_xor(l, 32);
    const float inv = 1.f / l;
    const int bl = bh >> 2, h = bh & 3;
    bf16_t* op = yc + ((size_t)bl * SEQ + qrow) * 512 + h * 128 + 4 * hh;
#pragma unroll
    for (int d = 0; d < 4; ++d)
#pragma unroll
        for (int i4 = 0; i4 < 4; ++i4)
            *(u32x2*)(op + d * 32 + 8 * i4) = (u32x2){pk2(o[d][4 * i4] * inv, o[d][4 * i4 + 1] * inv), pk2(o[d][4 * i4 + 2] * inv, o[d][4 * i4 + 3] * inv)};
}

DI void gmlp_unit(const Params& p, int l, const bf16_t* proj, bf16_t* yb, int bl, int c, LAS unsigned char* lds) {
    const int tid = tid_now(), wave = tid >> 6, lane = tid & 63, r31 = lane & 31, hh = lane >> 5;
    const float* wsp = p.in[14] + (size_t)l * 4 * 128 * 128; const float* bs = p.in[15] + l * 512; const float* vn = p.in[13] + l * 512;
    const size_t tl0 = (size_t)bl * SEQ + c * 128;
    float w8[8];
#pragma unroll
    for (int j = 0; j < 8; ++j) w8[j] = vn[lane + 64 * j];
    LAS bf16_t* vt = (LAS bf16_t*)lds;
#pragma unroll 2
    for (int rr = 0; rr < 16; ++rr) {
        const int row = wave * 16 + rr;
        const bf16_t* vr = proj + (tl0 + row) * PLD + 2056 + lane;
        float f[8]; float ss = 0.f;
#pragma unroll
        for (int j = 0; j < 8; ++j) { f[j] = gelu_f(bf2f(vr[64 * j])); ss += f[j] * f[j]; }
        const float rstd = rsqrtf(wave_sum(ss) * (1.f / 512.f) + EPS);
#pragma unroll
        for (int j = 0; j < 8; ++j) vt[(lane + 64 * j) * 136 + row] = f2bf(f[j] * rstd * w8[j]);
    }
    __syncthreads();
    const int mb = wave & 3, nh = wave >> 2, trow = mb * 32 + r31;
#pragma unroll 1
    for (int g = 0; g < 4; ++g) {
        f32x16 a0, a1;
#pragma unroll
        for (int i = 0; i < 16; ++i) { a0[i] = 0.f; a1[i] = 0.f; }
        const float* wrow = wsp + ((size_t)g * 128 + trow) * 128 + 8 * hh;
#pragma unroll
        for (int kk = 0; kk < 8; ++kk) if (kk * 16 <= mb * 32 + 31) {
            const f32x4 x0 = *(const f32x4*)(wrow + kk * 16), x1 = *(const f32x4*)(wrow + kk * 16 + 4);
            const int sb = kk * 16 + 8 * hh;
            float f[8];
#pragma unroll
            for (int j = 0; j < 4; ++j) { f[j] = (sb + j <= trow) ? x0[j] : 0.f; f[4 + j] = (sb + 4 + j <= trow) ? x1[j] : 0.f; }
            const bf16x8 a = __builtin_bit_cast(bf16x8, PACK8(f));
            const bf16x8 b0 = *(const LAS bf16x8*)(vt + (g * 128 + nh * 64 + r31) * 136 + kk * 16 + 8 * hh);
            const bf16x8 b1 = *(const LAS bf16x8*)(vt + (g * 128 + nh * 64 + 32 + r31) * 136 + kk * 16 + 8 * hh);
            a0 = MFMA32(a, b0, a0); a1 = MFMA32(a, b1, a1);
        }
#pragma unroll
        for (int i = 0; i < 16; ++i) {
            const int t = mb * 32 + crow(i, hh); const float bias = bs[g * 128 + t];
            const bf16_t* ur = proj + (tl0 + t) * PLD + 1544 + g * 128 + nh * 64 + r31;
            bf16_t* orow = yb + (tl0 + t) * 512 + g * 128 + nh * 64 + r31;
            orow[0] = f2bf(gelu_f(bf2f(ur[0])) * (a0[i] + bias));
            orow[32] = f2bf(gelu_f(bf2f(ur[32])) * (a1[i] + bias));
        }
    }
    __syncthreads();
}

constexpr int SP = 136;
DI void scan128(float& v0, float& v1, int lane) {
#pragma unroll
    for (int o = 1; o < 64; o <<= 1) { const float n0 = __shfl_up(v0, o), n1 = __shfl_up(v1, o); if (lane >= o) { v0 += n0; v1 += n1; } }
    v1 += __shfl(v0, 63);
}
DI void ssd_states_unit(const bf16_t* xbcc, const float* dtb, float* ST, float* ATOT, int bl, int c, int grp, LAS unsigned char* lds) {
    const int tid = tid_now(), wave = tid >> 6, lane = tid & 63, r31 = lane & 31, hh = lane >> 5;
    LAS bf16_t* BT = (LAS bf16_t*)lds; LAS bf16_t* XT = (LAS bf16_t*)(lds + 34816); LAS float* WS = (LAS float*)(lds + 104448);
    const size_t row0 = (size_t)bl * SEQ + c * 128;
    if (wave < 4) {
        const int h = grp * 4 + wave;
        const float d0 = dtb[(row0 + lane) * 16 + h], d1 = dtb[(row0 + 64 + lane) * 16 + h];
        float v0 = dtb[(row0 + lane) * 16 + 8 + h], v1 = dtb[(row0 + 64 + lane) * 16 + 8 + h];
        scan128(v0, v1, lane);
        const float tot = __shfl(v1, 63);
        WS[wave * 128 + lane] = d0 * __expf(tot - v0); WS[wave * 128 + 64 + lane] = d1 * __expf(tot - v1);
        if (lane == 0) ATOT[(bl * 16 + c) * 8 + h] = tot;
    }
    __syncthreads();
#pragma unroll
    for (int i = 0; i < 4; ++i) {
        const int ch = tid + 512 * i, s = ch >> 4, n8 = (ch & 15) * 8;
        const u32x4 v = *(const u32x4*)(xbcc + (row0 + s) * 1024 + 512 + grp * 128 + n8);
        LAS bf16_t* d = BT + n8 * SP + s;
        d[0] = (bf16_t)(v.x & 0xffffu); d[SP] = (bf16_t)(v.x >> 16); d[2 * SP] = (bf16_t)(v.y & 0xffffu); d[3 * SP] = (bf16_t)(v.y >> 16);
        d[4 * SP] = (bf16_t)(v.z & 0xffffu); d[5 * SP] = (bf16_t)(v.z >> 16); d[6 * SP] = (bf16_t)(v.w & 0xffffu); d[7 * SP] = (bf16_t)(v.w >> 16);
    }
#pragma unroll
    for (int i = 0; i < 8; ++i) {
        const int ch = tid + 512 * i, s = ch >> 5, c8 = (ch & 31) * 8;
        const u32x4 v = *(const u32x4*)(xbcc + (row0 + s) * 1024 + grp * 256 + c8); float f[8]; UNPACK8(v, f);
        const float w = WS[(c8 >> 6) * 128 + s];
        LAS bf16_t* d = XT + c8 * SP + s;
#pragma unroll
        for (int j = 0; j < 8; ++j) d[j * SP] = f2bf(f[j] * w);
    }
    __syncthreads();
    const int hl = wave >> 1, pb = wave & 1;
    f32x16 acc[4];
#pragma unroll
    for (int nb = 0; nb < 4; ++nb)
#pragma unroll
        for (int i = 0; i < 16; ++i) acc[nb][i] = 0.f;
#pragma unroll
    for (int k = 0; k < 8; ++k) {
        const bf16x8 a = *(const LAS bf16x8*)(XT + (hl * 64 + pb * 32 + r31) * SP + k * 16 + 8 * hh);
#pragma unroll
        for (int nb = 0; nb < 4; ++nb) { const bf16x8 b = *(const LAS bf16x8*)(BT + (nb * 32 + r31) * SP + k * 16 + 8 * hh); acc[nb] = MFMA32(a, b, acc[nb]); }
    }
    float* so = ST + (((size_t)bl * 16 + c) * 8 + grp * 4 + hl) * 8192;
#pragma unroll
    for (int nb = 0; nb < 4; ++nb)
#pragma unroll
        for (int i = 0; i < 16; ++i) so[(pb * 32 + crow(i, hh)) * 128 + nb * 32 + r31] = acc[nb][i];
    __syncthreads();
}
DI void ssd_scan(const float* ST, bf16_t* STB, const float* ATOT) {
    const int tidn = tid_now();
    for (int idx = wg_now() * 512 + tidn; idx < 64 * 2048; idx += nwg_now() * 512) {
        const int bh = idx >> 11, e4 = idx & 2047, bl = bh >> 3, head = bh & 7;
        const size_t off = ((size_t)bl * 16 * 8 + head) * 8192 + e4 * 4;
        f32x4 sv[16];
#pragma unroll
        for (int c = 0; c < 16; ++c) sv[c] = *(const f32x4*)(ST + off + (size_t)c * 8 * 8192);
        f32x4 run = {0.f, 0.f, 0.f, 0.f};
#pragma unroll
        for (int c = 0; c < 16; ++c) { const float ea = __expf(ATOT[(bl * 16 + c) * 8 + head]);
            *(u32x2*)(STB + off + (size_t)c * 8 * 8192) = (u32x2){pk2(run[0], run[1]), pk2(run[2], run[3])}; run = run * ea + sv[c]; }
    }
}
DI void ssd_out_grp(const Params& p, int l, const bf16_t* proj, const bf16_t* xbcc, const float* dtb, const bf16_t* STB, float* yraw, bf16_t* ya, int bl, int c, int grp, LAS unsigned char* lds) {
    const int tid = tid_now(), wave = tid >> 6, lane = tid & 63, r31 = lane & 31, hh = lane >> 5;
    LAS bf16_t* CL = (LAS bf16_t*)lds; LAS bf16_t* BL = (LAS bf16_t*)(lds + 34816); LAS bf16_t* XT = (LAS bf16_t*)(lds + 69632); LAS bf16_t* PV = (LAS bf16_t*)(lds + 104448);
    LAS float* ACS = (LAS float*)(lds + 139264); LAS float* DTL = (LAS float*)(lds + 140288); LAS float* RS = (LAS float*)(lds + 141312); LAS float* OUT = (LAS float*)(lds + 69632);
    const size_t row0 = (size_t)bl * SEQ + c * 128;
#pragma unroll
    for (int i = 0; i < 4; ++i) {
        const int ch = tid + 512 * i, s = ch >> 4, n8 = (ch & 15) * 8;
        const bf16_t* xr = xbcc + (row0 + s) * 1024;
        *(LAS u32x4*)(CL + s * SP + n8) = *(const u32x4*)(xr + 768 + grp * 128 + n8);
        *(LAS u32x4*)(BL + s * SP + n8) = *(const u32x4*)(xr + 512 + grp * 128 + n8);
    }
#pragma unroll 1
    for (int pi = 0; pi < 2; ++pi) {
        const int pair = grp * 2 + pi;
        if (wave < 2) {
            const int h = pair * 2 + wave;
            const float d0 = dtb[(row0 + lane) * 16 + h], d1 = dtb[(row0 + 64 + lane) * 16 + h];
            float v0 = dtb[(row0 + lane) * 16 + 8 + h], v1 = dtb[(row0 + 64 + lane) * 16 + 8 + h];
            scan128(v0, v1, lane);
            ACS[wave * 128 + lane] = v0; ACS[wave * 128 + 64 + lane] = v1; DTL[wave * 128 + lane] = d0; DTL[wave * 128 + 64 + lane] = d1;
        }
        __syncthreads();
#pragma unroll
        for (int i = 0; i < 4; ++i) {
            const int ch = tid + 512 * i, s = ch >> 4, n8 = (ch & 15) * 8;
            const u32x4 v = *(const u32x4*)(xbcc + (row0 + s) * 1024 + pair * 128 + n8); float f[8]; UNPACK8(v, f);
            const float w = DTL[(n8 >> 6) * 128 + s];
            LAS bf16_t* d = XT + n8 * SP + s;
#pragma unroll
            for (int j = 0; j < 8; ++j) d[j * SP] = f2bf(f[j] * w);
            *(LAS u32x4*)(PV + s * SP + n8) = *(const u32x4*)(STB + (((size_t)bl * 16 + c) * 8 + pair * 2) * 8192 + (size_t)s * 128 + n8);
        }
        __syncthreads();
        const int tb = wave >> 1, hl = wave & 1;
        f32x16 acc[2];
#pragma unroll
        for (int pb = 0; pb < 2; ++pb)
#pragma unroll
            for (int i = 0; i < 16; ++i) acc[pb][i] = 0.f;
        const LAS bf16_t* crw = CL + (tb * 32 + r31) * SP + 8 * hh;
#pragma unroll
        for (int k = 0; k < 8; ++k) {
            const bf16x8 b = *(const LAS bf16x8*)(crw + k * 16);
#pragma unroll
            for (int pb = 0; pb < 2; ++pb) { const bf16x8 a = *(const LAS bf16x8*)(PV + (hl * 64 + pb * 32 + r31) * SP + k * 16 + 8 * hh); acc[pb] = MFMA32(a, b, acc[pb]); }
        }
        const float at = ACS[hl * 128 + tb * 32 + r31], eat = __expf(at);
#pragma unroll
        for (int pb = 0; pb < 2; ++pb)
#pragma unroll
            for (int i = 0; i < 16; ++i) acc[pb][i] *= eat;
#pragma unroll 1
        for (int sb = 0; sb <= tb; ++sb) {
            f32x16 cbt;
#pragma unroll
            for (int i = 0; i < 16; ++i) cbt[i] = 0.f;
#pragma unroll
            for (int k = 0; k < 8; ++k) {
                const bf16x8 a = *(const LAS bf16x8*)(BL + (sb * 32 + r31) * SP + k * 16 + 8 * hh);
                const bf16x8 b = *(const LAS bf16x8*)(crw + k * 16);
                cbt = MFMA32(a, b, cbt);
            }
#pragma unroll
            for (int i = 0; i < 16; ++i) {
                const int sl = crow(i, hh); const float as = ACS[hl * 128 + sb * 32 + sl];
                const float mv = cbt[i] * __expf(fminf(at - as, 0.f));
                cbt[i] = (sb == tb && sl > r31) ? 0.f : mv;
            }
#pragma unroll
            for (int ks = 0; ks < 2; ++ks) {
                u32x4 w; w.x = pk2(cbt[8 * ks], cbt[8 * ks + 1]); w.y = pk2(cbt[8 * ks + 2], cbt[8 * ks + 3]); w.z = pk2(cbt[8 * ks + 4], cbt[8 * ks + 5]); w.w = pk2(cbt[8 * ks + 6], cbt[8 * ks + 7]);
                const bf16x8 pfr = __builtin_bit_cast(bf16x8, w);
#pragma unroll
                for (int pb = 0; pb < 2; ++pb) {
                    const LAS bf16_t* vp = XT + (hl * 64 + pb * 32 + r31) * SP + sb * 32 + 16 * ks + 4 * hh;
                    const s16x4 lo = *(const LAS s16x4*)vp, hi = *(const LAS s16x4*)(vp + 8);
                    const bf16x8 a = __builtin_shufflevector(lo, hi, 0, 1, 2, 3, 4, 5, 6, 7);
                    acc[pb] = MFMA32(a, pfr, acc[pb]);
                }
            }
        }
        __syncthreads();
#pragma unroll
        for (int pb = 0; pb < 2; ++pb)
#pragma unroll
            for (int i = 0; i < 16; ++i) OUT[(tb * 32 + r31) * 132 + hl * 64 + pb * 32 + crow(i, hh)] = acc[pb][i];
        __syncthreads();
#pragma unroll
        for (int i = 0; i < 4; ++i) {
            const int it = tid + 512 * i, t = it >> 4, c8 = (it & 15) * 8;
            const f32x4 y0 = *(const LAS f32x4*)(OUT + t * 132 + c8), y1 = *(const LAS f32x4*)(OUT + t * 132 + c8 + 4);
            const u32x4 xv = *(const u32x4*)(xbcc + (row0 + t) * 1024 + pair * 128 + c8), zv = *(const u32x4*)(proj + (row0 + t) * PLD + pair * 128 + c8);
            float fx[8], fz[8]; UNPACK8(xv, fx); UNPACK8(zv, fz);
            const float Dh = p.in[11][l * 8 + pair * 2 + (c8 >> 6)];
            f32x4 o0, o1;
#pragma unroll
            for (int j = 0; j < 4; ++j) { o0[j] = (y0[j] + Dh * fx[j]) * silu_f(fz[j]); o1[j] = (y1[j] + Dh * fx[4 + j]) * silu_f(fz[4 + j]); }
            float* op = yraw + (row0 + t) * 512 + pair * 128 + c8; *(f32x4*)op = o0; *(f32x4*)(op + 4) = o1;
            float ss = 0.f;
#pragma unroll
            for (int j = 0; j < 4; ++j) ss += o0[j] * o0[j] + o1[j] * o1[j];
            ss += __shfl_xor(ss, 1); ss += __shfl_xor(ss, 2); ss += __shfl_xor(ss, 4); ss += __shfl_xor(ss, 8);
            if ((tid & 15) == 0) RS[t] = pi == 0 ? ss : RS[t] + ss;
        }
        __syncthreads();
    }
    const float* nw = p.in[12] + l * 512 + grp * 256;
#pragma unroll
    for (int i = 0; i < 8; ++i) {
        const int it = tid + 512 * i, t = it >> 5, c8 = (it & 31) * 8;
        const float* yr = yraw + (row0 + t) * 512 + grp * 256 + c8;
        const f32x4 a = *(const f32x4*)yr, b = *(const f32x4*)(yr + 4), w0 = *(const f32x4*)(nw + c8), w1 = *(const f32x4*)(nw + c8 + 4);
        const float rstd = rsqrtf(RS[t] * (1.f / 256.f) + EPS);
        *(u32x4*)(ya + (row0 + t) * 512 + grp * 256 + c8) = (u32x4){pk2(a[0] * rstd * w0[0], a[1] * rstd * w0[1]), pk2(a[2] * rstd * w0[2], a[3] * rstd * w0[3]),
                                                                      pk2(b[0] * rstd * w1[0], b[1] * rstd * w1[1]), pk2(b[2] * rstd * w1[2], b[3] * rstd * w1[3])};
    }
    __syncthreads();
}

#if MULTI_LAUNCH
#define RUNPH(x) ((x) == p.only_phase)
#define GSYNC() do {} while (0)
#else
#define RUNPH(x) true
#define GSYNC() do { XcdBarrier xb_; xb_.bar = (unsigned*)(p.ws + O_BAR); xb_.x = xb_xcc_id(); xb_.st = (volatile LAS unsigned*)(lds + LDS_BYTES - 16); xcd_barrier(xb_); if (PROBE & 1) xcd_barrier(xb_); } while (0)
#endif
#define PH_BEGIN if (RUNPH(ph)) { unsigned char* ws = p.ws; float* X = p.out; asm volatile("" : "+s"(ws), "+s"(X)); const int wg = wg_now(), nwg = nwg_now();
#define PH_END } ++ph; GSYNC();
__global__ void __launch_bounds__(512) mega(Params p) {
    extern __shared__ __attribute__((aligned(16))) unsigned char smem[];
    LAS unsigned char* lds = (LAS unsigned char*)smem;
#if !MULTI_LAUNCH
    cg::grid_group grid = cg::this_grid();
    volatile LAS unsigned* xst = (volatile LAS unsigned*)(lds + LDS_BYTES - 16);
    if (threadIdx.x == 0) { xst[0] = 0u; xst[1] = 0u; }
    __syncthreads();
    (void)xcd_barrier_post((unsigned*)(p.ws + O_BAR), xst);
    grid.sync();
#endif
#define XN ((bf16_t*)(ws + O_XN))
#define SSQ0 ((float*)(ws + O_SSQ))
#define SSQ1 (SSQ0 + (size_t)T_ALL * 16)
#define SSQ2 (SSQ0 + (size_t)2 * T_ALL * 16)
#define H ((bf16_t*)(ws + O_H))
#define PROJ ((bf16_t*)(ws + O_PROJ))
#define XBCC ((bf16_t*)(ws + O_XBCC))
#define ST ((float*)(ws + O_ST))
#define ATOT ((float*)(ws + O_ATOT))
#define STB ((bf16_t*)(ws + O_STB))
#define DTB ((float*)(ws + O_DTB))
#define AQ ((bf16_t*)(ws + O_AQ))
#define AKV ((bf16_t*)(ws + O_AKV))
#define QRAW ((bf16_t*)(ws + O_QRAW))
#define KVRAW ((bf16_t*)(ws + O_KVRAW))
#define QF ((bf16_t*)(ws + O_QF))
#define KF ((bf16_t*)(ws + O_KF))
#define VT ((bf16_t*)(ws + O_VT))
#define YRAW ((float*)(ws + O_YRAW))
#define YA ((bf16_t*)(ws + O_YA))
#define YB (YA + (size_t)TG * 512)
#define YC (YA + (size_t)2 * TG * 512)
#define YD (YA + (size_t)3 * TG * 512)
#define CS ((f32x2*)(ws + O_CS))
#define PB ((bf16_t*)(ws + O_PB))
#define MIXB ((bf16_t*)(ws + O_MIXB))
#define WIN ((const bf16_t*)(ws + O_WIN))
#define WGATE ((const bf16_t*)(ws + O_WGATE))
#define WBR ((const bf16_t*)(ws + O_WBR))
#define WOUT ((const bf16_t*)(ws + O_WOUT))
#define WQB ((const bf16_t*)(ws + O_WQB))
#define WKVB ((const bf16_t*)(ws + O_WKVB))
#define XNg (XN + (size_t)g * TG * 1024)
    int ph = 0;
#pragma unroll 1
    for (int l = 0; l < 4; ++l) {
#pragma unroll 1
        for (int f = 0; f < 2; ++f) {
            if (f == 0) {
                PH_BEGIN
                    REP(32) convert_layer(p, l, (LAS float*)lds, wg, nwg);
                    if (l == 0) { rope_table(p, CS); init_rows(p.in[0], XN, SSQ0); }
                PH_END
            }
            PH_BEGIN
                EpiGU e{H, f == 0 ? SSQ0 : SSQ2};
#pragma unroll 1
                for (int rep = 0; rep < ((PROBE & 16) ? 2 : 1); ++rep) run_gemm(lds, XN, (const bf16_t*)(ws + (f == 0 ? O_WGU1 : O_WGU2)), T_ALL, 5632, 1024, e);
            PH_END
            PH_BEGIN
                if (PROBE & 256) { EpiRes e0{XN, f == 0 ? SSQ1 : SSQ0, (l == 3 && f == 1) ? X : nullptr, 0.0f}; run_gemm(lds, H, (const bf16_t*)(ws + (f == 0 ? O_WD1 : O_WD2)), T_ALL, 1024, 2816, e0); }
                EpiRes e{XN, f == 0 ? SSQ1 : SSQ0, (l == 3 && f == 1) ? X : nullptr, 0.5f}; run_gemm(lds, H, (const bf16_t*)(ws + (f == 0 ? O_WD1 : O_WD2)), T_ALL, 1024, 2816, e);
            PH_END
            if (f == 0) {
#pragma unroll 1
                for (int g = 0; g < NGRP; ++g) {
                    if (g == 0) {
                        PH_BEGIN
                            EpiStore e{PROJ, PLD, 0x7fffffff, SSQ1}; run_gemm(lds, XN, WIN, TG, 4864, 1024, e);
                        PH_END
                    }
                    PH_BEGIN
                        REP(4) prep1(p, l, PROJ, XBCC, DTB, AQ, AKV, YD);
                    PH_END
                    PH_BEGIN
                        REP(64) {
                        { EpiStore e{QRAW, 768, 0x7fffffff, nullptr}; run_gemm(lds, AQ, WQB, TG, 768, 384, e); }
                        { EpiStore e{KVRAW, 1024, 0x7fffffff, nullptr}; run_gemm(lds, AKV, WKVB, TG, 1024, 256, e); }
#pragma unroll 1
                        for (int u = wg; u < 256; u += nwg) {
                            ssd_states_unit(XBCC, DTB, ST, ATOT, u >> 5, (u >> 1) & 15, u & 1, lds);
                        }
                        }
                    PH_END
                    PH_BEGIN
                        REP(4) for (int u = wg; u < 256; u += nwg) prep2_unit(p, l, g, PROJ, QRAW, KVRAW, CS, QF, KF, VT, u >> 5, u & 31, lds);
                        ssd_scan(ST, STB, ATOT);
                    PH_END
                    PH_BEGIN
                        {
                            unsigned* ctr = (unsigned*)(ws + O_WQ) + (l * 4 + g);
                            volatile LAS unsigned* wq = (volatile LAS unsigned*)(lds + LDS_BYTES - 32);
#pragma unroll 1
                            for (;;) {
                                __syncthreads();
                                if (tid_now() == 0) *wq = atomicAdd(ctr, 1u);
                                __syncthreads();
                                const int u = (int)*wq;
                                if (u >= 640) break;
                                if (u < 64) { REP(2048) attn_unit(QF, KF, VT, YC, u & 31, 7 - (u >> 5), lds); }
                                else if (u < 320) { const int k = u - 64; REP(1024) ssd_out_grp(p, l, PROJ, XBCC, DTB, STB, YRAW, YA, k >> 5, (k >> 1) & 15, k & 1, lds); }
                                else if (u < 512) { const int k = u - 320; REP(2048) attn_unit(QF, KF, VT, YC, k & 31, 5 - (k >> 5), lds); }
                                else { const int k = u - 512; gmlp_unit(p, l, PROJ, YB, k >> 4, k & 15, lds); }
                            }
                        }
                    PH_END
                    PH_BEGIN
                        EpiStore e{PB, 1024, 3, nullptr}; pg8::Gemm gm{YA, WBR, 4 * TG, 4096, 512}; BranchOrder S; S.G = nwg; S.c = wg;
                        REP(128) pg8::gemm_phase<EpiStore, BranchOrder>(lds, gm, S, e);
                    PH_END
                    PH_BEGIN
                        EpiMerge e{PB, MIXB, SSQ1 + (size_t)g * TG * 16}; REP(128) run_gemm(lds, XNg, WGATE, TG, 4096, 1024, e);
                    PH_END
                    PH_BEGIN
                        { EpiRes e{XNg, SSQ2 + (size_t)g * TG * 16, nullptr, 1.0f}; run_gemm(lds, MIXB, WOUT, TG, 1024, 1024, e); }
                        if (g < NGRP - 1) {
                            EpiStore e{PROJ, PLD, 0x7fffffff, SSQ1 + (size_t)(g + 1) * TG * 16}; run_gemm(lds, XN + (size_t)(g + 1) * TG * 1024, WIN, TG, 4864, 1024, e); }
                    PH_END
                }
            }
        }
    }
}

constexpr int N_PHASES = 4 * (1 + 2 + 1 + 4 * 7 + 2);

extern "C" void kernel_launch(void* const* d_in, const int* in_sizes, int n_in, void* d_out, int out_size, void* d_ws, size_t ws_size, hipStream_t stream) {
    static int grid_blocks = 0;
    if (!grid_blocks) {
        if (n_in != 28 || ws_size < WS_NEED) { fprintf(stderr, "kernel_launch: need 28 inputs and %zu bytes of workspace (got %d, %zu)\n", (size_t)WS_NEED, n_in, ws_size); grid_blocks = -1; return; }
        if (hipFuncSetAttribute((const void*)mega, hipFuncAttributeMaxDynamicSharedMemorySize, LDS_BYTES) != hipSuccess) { fprintf(stderr, "kernel_launch: hipFuncSetAttribute failed\n"); grid_blocks = -1; return; }
        int dev = 0, cus = 0, per_cu = 0;
        hipGetDevice(&dev); hipDeviceGetAttribute(&cus, hipDeviceAttributeMultiprocessorCount, dev);
        hipOccupancyMaxActiveBlocksPerMultiprocessor(&per_cu, mega, 512, LDS_BYTES);
        if (per_cu < 1) { fprintf(stderr, "kernel_launch: occupancy query returned %d\n", per_cu); per_cu = 1; }
        (void)hipGetLastError();
        grid_blocks = cus * per_cu;
    }
    if (grid_blocks < 0) return;
    Params p{};
    for (int i = 0; i < 28; ++i) p.in[i] = (const float*)d_in[i];
    p.out = (float*)d_out; p.ws = (unsigned char*)d_ws; p.only_phase = -1; p.pad = 0;
#if MULTI_LAUNCH
    for (int ph = 0; ph < N_PHASES; ++ph) { p.only_phase = ph; hipLaunchKernelGGL(mega, dim3(grid_blocks), dim3(512), LDS_BYTES, stream, p); }
#else
    if (hipMemsetAsync((unsigned char*)d_ws + O_BAR, 0, ZERO_BYTES, stream) != hipSuccess) { fprintf(stderr, "kernel_launch: memset of barrier words failed\n"); return; }
    void* args[] = {&p};
    hipError_t e = hipLaunchCooperativeKernel((void*)mega, dim3(grid_blocks), dim3(512), args, LDS_BYTES, stream);
    if (e != hipSuccess) fprintf(stderr, "cooperative launch failed: %s (grid %d)\n", hipGetErrorString(e), grid_blocks);
#endif
}
```

```cpp
#include <hip/hip_runtime.h>
#include <hip/hip_cooperative_groups.h>
#include <cstdio>
namespace cg = cooperative_groups;

#ifndef PROBE
#define PROBE 0
#endif
#define REP(bit) _Pragma("unroll 1") for (int rep_ = 0; rep_ < ((PROBE & (bit)) ? 2 : 1); ++rep_)
#ifndef MULTI_LAUNCH
#define MULTI_LAUNCH 0
#endif

__device__ __forceinline__ int tid_now() { int t = threadIdx.x; asm volatile("" : "+v"(t)); return t; }
__device__ __forceinline__ int wg_now() { int t = blockIdx.x; asm volatile("" : "+s"(t)); return t; }
__device__ __forceinline__ int nwg_now() { int t = gridDim.x; asm volatile("" : "+s"(t)); return t; }
namespace pg8 {
#define PG8_LAS __attribute__((address_space(3)))
typedef unsigned short bf16_t;
typedef short bf16x8 __attribute__((ext_vector_type(8)));
typedef float f32x4 __attribute__((ext_vector_type(4)));
typedef unsigned u32x4 __attribute__((ext_vector_type(4)));
constexpr int BM = 256, BK = 64, HALF = 128, HTB = HALF * BK * 2  , STAGE_BYTES = 8 * HTB, NXCD = 8, WGM = 8;

__host__ __device__ __forceinline__ int lds_byte(int r, int c) { const int st = (r >> 4) * 2 + (c >> 5), rr = r & 15, cc = c & 31, ob = rr * 64 + cc * 2; return st * 1024 + (ob ^ (((ob >> 9) & 1) << 5)); }
__host__ __device__ __forceinline__ void stage_rc(int b, int& R, int& C) { const int st = b / 1024, sb = b % 1024, swz = sb ^ (((sb >> 9) & 1) << 5); R = (st >> 1) * 16 + swz / 64; C = (st & 1) * 32 + (swz % 64) / 2; }
__host__ __device__ __forceinline__ int perm32(int rho) { const int n = rho >> 4, i = rho & 15; return 8 * (i >> 2) + 4 * n + (i & 3); }

struct Unit { int pm, pn; };
struct Gemm { const bf16_t* A; const bf16_t* Bt; int M, N, K; };

struct StaticOrder {
    int nM, nN, nwg, G, c;
    __host__ __device__ void init(int M, int N, int G_, int c_) { nM = M / BM; nN = N / BM; nwg = nM * nN; G = G_; c = c_; }
    __host__ __device__ bool next(int i, Unit& u) const {
        const long L = (long)i * G + c; if (L >= nwg) return false;
        int wgid = (int)L; { const int q = nwg / NXCD, r = nwg % NXCD, xcd = wgid % NXCD, off = wgid / NXCD; wgid = (xcd < r ? xcd * (q + 1) : r * (q + 1) + (xcd - r) * q) + off; }
        const int nig = WGM * nN, gid = wgid / nig, fm = gid * WGM, gsz = (nM - fm) < WGM ? (nM - fm) : WGM;
        u.pm = fm + ((wgid % nig) % gsz); u.pn = (wgid % nig) / gsz; return true;
    }
    __device__ __forceinline__ void a_ready(const Unit&) const {}
    __device__ __forceinline__ void done(const Unit&) const {}
};

template <class Epi, class Sched>
__device__ __forceinline__ void gemm_phase(PG8_LAS unsigned char* lds, const Gemm g, const Sched& S, const Epi& E) {
    const int tid = tid_now(), wid = __builtin_amdgcn_readfirstlane(tid >> 6), lane = tid & 63, wr = wid >> 2, wc = wid & 3, fr = lane & 15, fq = lane >> 4;
    const int K = g.K, nt = K / BK;
    unsigned voffA[2], voffB[2];
#pragma unroll
    for (int i = 0; i < 2; ++i) { int R, C; stage_rc(tid * 16 + i * 8192, R, C); const int Rb = Epi::PERM ? ((R & ~31) + perm32(R & 31)) : R;
        voffA[i] = (unsigned)(R * K + C) * 2u; voffB[i] = (unsigned)(Rb * K + C) * 2u; }
    const size_t kstep = (size_t)(BK * 2);
    const size_t hstep = (size_t)HALF * K * 2;
    const size_t tstep = 2 * hstep;
    const unsigned ldsw = (unsigned)wid * 1024u;
    const int aoff = lds_byte(wr * 64 + fr, fq * 8), boff = lds_byte(wc * 32 + fr, fq * 8);
#define PG8_SA(b, h) (((b) * 2 + (h)) * HTB)
#define PG8_SB(b, h) ((4 + (b) * 2 + (h)) * HTB)
#define PG8_STAGE(bufoff, gbase, voff) do { _Pragma("unroll") for (int _i = 0; _i < 2; ++_i) \
        __builtin_amdgcn_global_load_lds((const unsigned*)((const char*)(gbase) + (voff)[_i]), (PG8_LAS unsigned*)(lds + (bufoff) + ldsw + _i * 8192), 16, 0, 0); } while (0)
#define PG8_LDA(dst, b, h) do { _Pragma("unroll") for (int m = 0; m < 4; ++m) _Pragma("unroll") for (int k = 0; k < 2; ++k) dst[m][k] = *(const PG8_LAS bf16x8*)(lds + PG8_SA(b, h) + aoff + m * 2048 + k * 1024); } while (0)
#define PG8_LDB(dst, b, h) do { _Pragma("unroll") for (int n = 0; n < 2; ++n) _Pragma("unroll") for (int k = 0; k < 2; ++k) dst[n][k] = *(const PG8_LAS bf16x8*)(lds + PG8_SB(b, h) + boff + n * 2048 + k * 1024); } while (0)
#define PG8_MMA(ai, bj, At, Bt) do { __builtin_amdgcn_s_setprio(1); _Pragma("unroll") for (int m = 0; m < 4; ++m) _Pragma("unroll") for (int n = 0; n < 2; ++n) _Pragma("unroll") for (int k = 0; k < 2; ++k) \
        acc[ai][bj][m][n] = __builtin_amdgcn_mfma_f32_16x16x32_bf16(Bt[n][k], At[m][k], acc[ai][bj][m][n], 0, 0, 0); __builtin_amdgcn_s_setprio(0); } while (0)
#define PG8_WAIT_V(n) asm volatile("s_waitcnt vmcnt(" #n ")" ::: "memory")
#define PG8_WAIT_L(n) asm volatile("s_waitcnt lgkmcnt(" #n ")" ::: "memory")
#define PG8_BAR __builtin_amdgcn_s_barrier()
#define PG8_SCHED __builtin_amdgcn_sched_barrier(0)
    Unit cur, nxt; int ui = 0;
    if (!S.next(0, cur)) return;
    f32x4 acc[2][2][4][2];
#pragma unroll
    for (int a = 0; a < 2; ++a)
#pragma unroll
        for (int b = 0; b < 2; ++b)
#pragma unroll
            for (int m = 0; m < 4; ++m)
#pragma unroll
                for (int n = 0; n < 2; ++n) acc[a][b][m][n] = (f32x4){0.f, 0.f, 0.f, 0.f};
    bf16x8 At[4][2], B0[2][2], B1[2][2];
    const char* cA = (const char*)g.A + (size_t)cur.pm * tstep; const char* cB = (const char*)g.Bt + (size_t)cur.pn * tstep;
    S.a_ready(cur);
    PG8_STAGE(PG8_SB(0, 0), cB, voffB); PG8_STAGE(PG8_SA(0, 0), cA, voffA); PG8_STAGE(PG8_SB(0, 1), cB + hstep, voffB); PG8_STAGE(PG8_SA(0, 1), cA + hstep, voffA);
    if (wr == 1) PG8_BAR;
    PG8_WAIT_V(4); PG8_BAR;
    PG8_STAGE(PG8_SB(1, 0), cB + kstep, voffB); PG8_STAGE(PG8_SA(1, 0), cA + kstep, voffA); PG8_STAGE(PG8_SB(1, 1), cB + hstep + kstep, voffB);
    PG8_WAIT_V(6); PG8_BAR;
    for (;;) {
        const bool has_next = S.next(ui + 1, nxt);
        const char* nA = has_next ? (const char*)g.A + (size_t)nxt.pm * tstep : cA; const char* nB = has_next ? (const char*)g.Bt + (size_t)nxt.pn * tstep : cB;
        for (int t = 0; t < nt; t += 2) {
            const bool last = (t == nt - 2);
            const char* a1 = cA + (size_t)(t + 1) * kstep;
            const char* a2 = last ? nA : cA + (size_t)(t + 2) * kstep; const char* b2 = last ? nB : cB + (size_t)(t + 2) * kstep;
            const char* a3 = a2 + kstep; const char* b3 = b2 + kstep;
            if (last && has_next) S.a_ready(nxt);
            PG8_LDB(B0, 0, 0); PG8_SCHED; PG8_LDA(At, 0, 0); PG8_STAGE(PG8_SA(1, 1), a1 + hstep, voffA);
            PG8_WAIT_L(8); PG8_BAR; PG8_WAIT_L(0); PG8_MMA(0, 0, At, B0); PG8_BAR; PG8_SCHED;
            PG8_LDB(B1, 0, 1); PG8_STAGE(PG8_SB(0, 0), b2, voffB);
            PG8_BAR; PG8_WAIT_L(0); PG8_MMA(0, 1, At, B1); PG8_BAR;
            PG8_LDA(At, 0, 1); PG8_STAGE(PG8_SA(0, 0), a2, voffA);
            PG8_BAR; PG8_WAIT_L(0); PG8_MMA(1, 0, At, B0); PG8_BAR; PG8_SCHED;
            PG8_STAGE(PG8_SB(0, 1), b2 + hstep, voffB);
            PG8_WAIT_V(6); PG8_BAR; PG8_MMA(1, 1, At, B1); PG8_BAR;
            PG8_LDB(B0, 1, 0); PG8_SCHED; PG8_LDA(At, 1, 0); PG8_STAGE(PG8_SA(0, 1), a2 + hstep, voffA);
            PG8_WAIT_L(8); PG8_BAR; PG8_WAIT_L(0); PG8_MMA(0, 0, At, B0); PG8_BAR; PG8_SCHED;
            PG8_LDB(B1, 1, 1); PG8_STAGE(PG8_SB(1, 0), b3, voffB);
            PG8_BAR; PG8_WAIT_L(0); PG8_MMA(0, 1, At, B1); PG8_BAR;
            PG8_LDA(At, 1, 1); PG8_STAGE(PG8_SA(1, 0), a3, voffA);
            PG8_BAR; PG8_WAIT_L(0); PG8_MMA(1, 0, At, B0); PG8_BAR; PG8_SCHED;
            PG8_STAGE(PG8_SB(1, 1), b3 + hstep, voffB);
            PG8_WAIT_V(6); PG8_BAR; PG8_MMA(1, 1, At, B1); PG8_BAR;
        }
        if constexpr (!Epi::AFTER_DRAIN) { E(acc, cur, wr, wc, fr, fq); S.done(cur); }
        if (!has_next) break;
#pragma unroll
        for (int a = 0; a < 2; ++a)
#pragma unroll
            for (int b = 0; b < 2; ++b)
#pragma unroll
                for (int m = 0; m < 4; ++m)
#pragma unroll
                    for (int n = 0; n < 2; ++n) acc[a][b][m][n] = (f32x4){0.f, 0.f, 0.f, 0.f};
        cur = nxt; cA = nA; cB = nB; ++ui;
    }
    PG8_WAIT_V(0);
    if (wr == 0) PG8_BAR;
    PG8_BAR;
    if constexpr (Epi::AFTER_DRAIN) { E.fused(acc, cur, wr, wc, fr, fq, lds, wid, lane); S.done(cur); }
#undef PG8_SA
#undef PG8_SB
#undef PG8_STAGE
#undef PG8_LDA
#undef PG8_LDB
#undef PG8_MMA
#undef PG8_WAIT_V
#undef PG8_WAIT_L
#undef PG8_BAR
#undef PG8_SCHED
}
}


using pg8::bf16_t; using pg8::bf16x8; using pg8::f32x4; using pg8::u32x4;
typedef short s16x4 __attribute__((ext_vector_type(4)));
typedef float f32x2 __attribute__((ext_vector_type(2)));
typedef float f32x16 __attribute__((ext_vector_type(16)));
typedef unsigned u32x2 __attribute__((ext_vector_type(2)));
typedef __bf16 bf16v2 __attribute__((ext_vector_type(2)));
#define LAS __attribute__((address_space(3)))
#define DI __device__ __forceinline__
#define XB_TMO      128
#define XB_XCNT(j)  (256  + 64 * (j))
#define XB_XSUB(j)  (1280 + 64 * (j))
#define XB_XGEN(j)  (2304 + 64 * (j))
#define XB_TOP      3328
#define XB_TOPGEN   3392
#define XCD_BAR_WORDS 3456
#define XB_SPIN_CAP (1u << 18)

__device__ __forceinline__ unsigned xb_ld(unsigned* p)              { return __hip_atomic_load(p, __ATOMIC_RELAXED, __HIP_MEMORY_SCOPE_AGENT); }
__device__ __forceinline__ unsigned xb_add(unsigned* p, unsigned v) { return __hip_atomic_fetch_add(p, v, __ATOMIC_RELAXED, __HIP_MEMORY_SCOPE_AGENT); }
__device__ __forceinline__ unsigned xb_xcc_id() { return (unsigned)__builtin_amdgcn_s_getreg((3 << 11) | 20) & 0xFu; }
#define XB_SPIN(cond, bar) do { unsigned _sp = 0; while (cond) { __builtin_amdgcn_s_sleep(1); \
    if ((++_sp & 255u) == 0u) { if (xb_ld(&(bar)[XB_TMO])) break; if (_sp > XB_SPIN_CAP) { atomicAdd(&(bar)[XB_TMO], 1u); break; } } } } while (0)

struct XcdBarrier {
    unsigned* bar; unsigned x;
    volatile LAS unsigned* st;
};

__device__ __forceinline__ XcdBarrier xcd_barrier_post(unsigned* bar, volatile LAS unsigned* st) {
    XcdBarrier b; b.bar = bar; b.x = xb_xcc_id(); b.st = st;
    if (threadIdx.x == 0) (void)xb_add(&bar[XB_XCNT(b.x)], 1u);
    return b;
}
__device__ __forceinline__ void xcd_barrier_complete(unsigned* bar, unsigned x, unsigned& nloc, unsigned& nx) {
    const unsigned G = (unsigned)nwg_now();
    unsigned sum, cnt, mine, sp = 0u;
    for (;;) {
        sum = 0u; cnt = 0u; mine = 0u;
#pragma unroll
        for (unsigned j = 0; j < 16; ++j) { const unsigned c = xb_ld(&bar[XB_XCNT(j)]); sum += c; cnt += (c > 0u) ? 1u : 0u; mine = (j == x) ? c : mine; }
        if (sum == G) break;
        __builtin_amdgcn_s_sleep(1);
        if ((++sp & 255u) == 0u) { if (xb_ld(&bar[XB_TMO])) break; if (sp > XB_SPIN_CAP) { atomicAdd(&bar[XB_TMO], 1u); break; } }
    }
    nloc = mine > 0u ? mine : 1u; nx = cnt > 0u ? cnt : 1u;
}

__device__ __forceinline__ void xcd_barrier(const XcdBarrier& b) {
    asm volatile("s_waitcnt vmcnt(0)" ::: "memory");
    __syncthreads();
    if (tid_now() == 0) {
        unsigned* bar = b.bar; unsigned bx = b.x; asm volatile("" : "+s"(bar), "+s"(bx));
        __builtin_amdgcn_s_waitcnt(0);
        unsigned nloc = b.st[0], nx = b.st[1];
        if (nloc == 0u) { xcd_barrier_complete(bar, bx, nloc, nx); b.st[0] = nloc; b.st[1] = nx; }
        const unsigned old = xb_add(&bar[XB_XSUB(bx)], 1u);
        const unsigned gen = old / nloc;
        if (old + 1u == (gen + 1u) * nloc) {
            __builtin_amdgcn_fence(__ATOMIC_RELEASE, "agent");
            asm volatile("s_waitcnt vmcnt(0)" ::: "memory");
            const unsigned og = xb_add(&bar[XB_TOP], 1u);
            const unsigned tg = og / nx;
            if (og + 1u == (tg + 1u) * nx) xb_add(&bar[XB_TOPGEN], 1u);
            else XB_SPIN(xb_ld(&bar[XB_TOPGEN]) == tg, bar);
            __builtin_amdgcn_fence(__ATOMIC_ACQUIRE, "agent");
            xb_add(&bar[XB_XGEN(bx)], 1u);
            asm volatile("s_waitcnt vmcnt(0)" ::: "memory");
        } else {
            XB_SPIN(xb_ld(&bar[XB_XGEN(bx)]) == gen, bar);
            __builtin_amdgcn_fence(__ATOMIC_ACQUIRE, "agent");
            asm volatile("s_waitcnt vmcnt(0)" ::: "memory");
        }
    }
    __syncthreads();
}


#define MFMA32(a, b, c) __builtin_amdgcn_mfma_f32_32x32x16_bf16((a), (b), (c), 0, 0, 0)

constexpr int T_ALL = 65536, SEQ = 2048, NGRP = 4, TG = 16384, BPG = 8, PLD = 4864;
constexpr float EPS = 1e-6f;
constexpr size_t SZ_GU = (size_t)5632 * 1024 * 2, SZ_D = (size_t)1024 * 2816 * 2;
constexpr size_t O_WGU1 = 0, O_WD1 = O_WGU1 + SZ_GU, O_WGU2 = O_WD1 + SZ_D, O_WD2 = O_WGU2 + SZ_GU, O_WIN = O_WD2 + SZ_D;
constexpr size_t O_WGATE = O_WIN + (size_t)4864 * 1024 * 2, O_WBR = O_WGATE + (size_t)4096 * 1024 * 2, O_WOUT = O_WBR + (size_t)4 * 1024 * 512 * 2;
constexpr size_t O_WQB = O_WOUT + (size_t)1024 * 1024 * 2, O_WKVB = O_WQB + (size_t)768 * 384 * 2, O_XN = O_WKVB + (size_t)1024 * 256 * 2;
constexpr size_t O_R0 = O_XN + (size_t)T_ALL * 1024 * 2;
constexpr size_t O_H = O_R0;
constexpr size_t O_PROJ = O_R0, O_XBCC = O_PROJ + (size_t)TG * PLD * 2, O_DTB = O_XBCC + (size_t)TG * 1024 * 2, O_AQ = O_DTB + (size_t)TG * 16 * 4;
constexpr size_t O_AKV = O_AQ + (size_t)TG * 384 * 2, O_QRAW = O_AKV + (size_t)TG * 256 * 2, O_KVRAW = O_QRAW + (size_t)TG * 768 * 2;
constexpr size_t O_QF = O_KVRAW + (size_t)TG * 1024 * 2, O_KF = O_QF + (size_t)TG * 768 * 2, O_VT = O_KF + (size_t)TG * 768 * 2;
constexpr size_t O_YRAW = O_VT + (size_t)TG * 512 * 2, O_YA = O_YRAW + (size_t)TG * 512 * 4;
constexpr size_t O_PB = O_YA + (size_t)4 * TG * 512 * 2, O_MIXB = O_PB + (size_t)4 * TG * 1024 * 2;
constexpr size_t O_ST = O_MIXB + (size_t)TG * 1024 * 2, O_ATOT = O_ST + (size_t)BPG * 16 * 8 * 8192 * 4;
constexpr size_t O_STB = O_ATOT + 4096;
constexpr size_t O_BAR = O_STB + (size_t)BPG * 16 * 8 * 8192 * 2;
constexpr size_t O_WQ = O_BAR + (size_t)XCD_BAR_WORDS * 4;
constexpr size_t ZERO_BYTES = (size_t)XCD_BAR_WORDS * 4 + 256;
constexpr size_t O_CS = O_WQ + 256 + 256 - ((size_t)XCD_BAR_WORDS * 4) % 256;
constexpr size_t O_SSQ = O_CS + (size_t)T_ALL * 32 * 8;
constexpr size_t O_END = O_SSQ + (size_t)3 * T_ALL * 16 * 4;
constexpr size_t O_END_H = O_H + (size_t)T_ALL * 2816 * 2;
constexpr size_t WS_NEED = O_END > O_END_H ? O_END : O_END_H;
constexpr int LDS_BYTES = 147456;

struct Params { const float* in[28]; float* out; unsigned char* ws; int only_phase; int pad; };

DI unsigned pk2(float a, float b) { f32x2 v = {a, b}; return __builtin_bit_cast(unsigned, __builtin_convertvector(v, bf16v2)); }
DI bf16_t f2bf(float a) { return (bf16_t)(pk2(a, 0.f) & 0xffffu); }
DI float bf2f(bf16_t b) { return __uint_as_float(((unsigned)b) << 16); }
DI float bflo(unsigned u) { return __uint_as_float(u << 16); }
DI float bfhi(unsigned u) { return __uint_as_float(u & 0xffff0000u); }
#define UNPACK8(v, f) do { f[0] = bflo(v.x); f[1] = bfhi(v.x); f[2] = bflo(v.y); f[3] = bfhi(v.y); f[4] = bflo(v.z); f[5] = bfhi(v.z); f[6] = bflo(v.w); f[7] = bfhi(v.w); } while (0)
#define PACK8(f) ((u32x4){pk2(f[0], f[1]), pk2(f[2], f[3]), pk2(f[4], f[5]), pk2(f[6], f[7])})
DI float wave_sum(float v) {
#pragma unroll
    for (int o = 1; o < 64; o <<= 1) v += __shfl_xor(v, o);
    return v;
}
DI float silu_f(float x) { return x * __builtin_amdgcn_rcpf(1.f + __builtin_amdgcn_exp2f(-1.4426950408889634f * x)); }
DI float sigmoid_f(float x) { return __builtin_amdgcn_rcpf(1.f + __builtin_amdgcn_exp2f(-1.4426950408889634f * x)); }
DI float gelu_f(float v) {
    const float t = __builtin_amdgcn_rcpf(fabsf(v) * 0.2316418882f + 1.0f);
    float q = t * 0.5307027145f + (-0.7265760135f); q = q * t + 0.7107068705f; q = q * t + (-0.142248368f); q = q * t + 0.127414796f; q = q * t;
    const float m = v * (q * __builtin_amdgcn_exp2f(v * v * (-0.72134752044f)));
    return v < 0.f ? m : v - m;
}
DI int crow(int i, int h) { return (i & 3) + 8 * (i >> 2) + 4 * h; }
DI void rows_rstd(const float* ssq, int row0, int fq, float (&rs)[2][4]) {
    f32x4 q[2][4];
#pragma unroll
    for (int ai = 0; ai < 2; ++ai)
#pragma unroll
        for (int m = 0; m < 4; ++m) q[ai][m] = ((const f32x4*)(ssq + (size_t)(row0 + ai * 128 + m * 16) * 16))[fq];
#pragma unroll
    for (int ai = 0; ai < 2; ++ai)
#pragma unroll
        for (int m = 0; m < 4; ++m) { float t = (q[ai][m][0] + q[ai][m][1]) + (q[ai][m][2] + q[ai][m][3]); t += __shfl_xor(t, 16); t += __shfl_xor(t, 32);
            rs[ai][m] = rsqrtf(t * (1.f / 1024.f) + EPS); }
}
struct EpiStore {
    static constexpr bool PERM = true, AFTER_DRAIN = false;
    bf16_t* O; int ldc; int pnmask; const float* ssq;
    DI void operator()(const f32x4 (&acc)[2][2][4][2], const pg8::Unit& u, int wr, int wc, int fr, int fq) const {
        const int row0 = u.pm * 256 + wr * 64 + fr, col0 = (u.pn & pnmask) * 256 + wc * 32 + 8 * fq;
        float rsv[2][4];
        if (ssq) rows_rstd(ssq, row0, fq, rsv);
        else {
#pragma unroll
            for (int ai = 0; ai < 2; ++ai)
#pragma unroll
                for (int m = 0; m < 4; ++m) rsv[ai][m] = 1.f; }
#pragma unroll
        for (int ai = 0; ai < 2; ++ai)
#pragma unroll
            for (int m = 0; m < 4; ++m) { bf16_t* rowp = O + (size_t)(row0 + ai * 128 + m * 16) * ldc + col0;
                const float rs = rsv[ai][m];
#pragma unroll
                for (int bj = 0; bj < 2; ++bj) { const f32x4 v0 = acc[ai][bj][m][0] * rs, v1 = acc[ai][bj][m][1] * rs;
                    u32x4 w; w.x = pk2(v0[0], v0[1]); w.y = pk2(v0[2], v0[3]); w.z = pk2(v1[0], v1[1]); w.w = pk2(v1[2], v1[3]);
                    *(u32x4*)(rowp + bj * 128) = w; } }
    }
};
struct EpiGU {
    static constexpr bool PERM = true, AFTER_DRAIN = false;
    bf16_t* H; const float* ssq;
    DI void operator()(const f32x4 (&acc)[2][2][4][2], const pg8::Unit& u, int wr, int wc, int fr, int fq) const {
        const int row0 = u.pm * 256 + wr * 64 + fr, col0 = u.pn * 128 + wc * 32 + 8 * fq;
        float rsv[2][4]; rows_rstd(ssq, row0, fq, rsv);
#pragma unroll
        for (int ai = 0; ai < 2; ++ai)
#pragma unroll
            for (int m = 0; m < 4; ++m) { bf16_t* rowp = H + (size_t)(row0 + ai * 128 + m * 16) * 2816 + col0;
                const float rs = rsv[ai][m];
                float o[8];
#pragma unroll
                for (int n = 0; n < 2; ++n)
#pragma unroll
                    for (int j = 0; j < 4; ++j) o[4 * n + j] = silu_f(acc[ai][0][m][n][j] * rs) * (acc[ai][1][m][n][j] * rs);
                *(u32x4*)rowp = PACK8(o); }
    }
};
struct EpiRes {
    static constexpr bool PERM = false, AFTER_DRAIN = false;
    bf16_t* XB; float* SSQ; float* OUT; float sc;
    DI void operator()(const f32x4 (&acc)[2][2][4][2], const pg8::Unit& u, int wr, int wc, int fr, int fq) const {
        const int row0 = u.pm * 256 + wr * 64 + fr, col0 = u.pn * 256 + wc * 32 + 4 * fq;
#pragma unroll
        for (int ai = 0; ai < 2; ++ai) {
            u32x2 xv[4][2][2];
#pragma unroll
            for (int m = 0; m < 4; ++m)
#pragma unroll
                for (int bj = 0; bj < 2; ++bj)
#pragma unroll
                    for (int n = 0; n < 2; ++n) xv[m][bj][n] = *(const u32x2*)(XB + (size_t)(row0 + ai * 128 + m * 16) * 1024 + col0 + bj * 128 + n * 16);
#pragma unroll
            for (int m = 0; m < 4; ++m) { const int row = row0 + ai * 128 + m * 16; const size_t ro = (size_t)row * 1024 + col0;
                float ss = 0.f;
#pragma unroll
                for (int bj = 0; bj < 2; ++bj)
#pragma unroll
                    for (int n = 0; n < 2; ++n) { const u32x2 xo = xv[m][bj][n]; const f32x4 a = acc[ai][bj][m][n];
                        const f32x4 v = {bflo(xo.x) + a[0] * sc, bfhi(xo.x) + a[1] * sc, bflo(xo.y) + a[2] * sc, bfhi(xo.y) + a[3] * sc};
                        if (OUT) *(f32x4*)(OUT + ro + bj * 128 + n * 16) = v;
                        else *(u32x2*)(XB + ro + bj * 128 + n * 16) = (u32x2){pk2(v[0], v[1]), pk2(v[2], v[3])};
                        ss += v[0] * v[0] + v[1] * v[1] + v[2] * v[2] + v[3] * v[3]; }
                ss += __shfl_xor(ss, 16); ss += __shfl_xor(ss, 32);
                if (fq == 0) SSQ[(size_t)row * 16 + u.pn * 4 + wc] = ss; }
        }
    }
};
struct EpiMerge {
    static constexpr bool PERM = false, AFTER_DRAIN = false;
    const bf16_t* P; bf16_t* MIX; const float* ssq;
    DI void operator()(const f32x4 (&acc)[2][2][4][2], const pg8::Unit& u, int wr, int wc, int fr, int fq) const {
        const int row0 = u.pm * 256 + wr * 64 + fr, e0 = u.pn * 64 + wc * 16 + 4 * fq;
        float rsv[2][4]; rows_rstd(ssq, row0, fq, rsv);
#pragma unroll
        for (int ai = 0; ai < 2; ++ai) {
            u32x2 pv[4][4];
#pragma unroll
            for (int m = 0; m < 4; ++m)
#pragma unroll
                for (int b = 0; b < 4; ++b) pv[m][b] = *(const u32x2*)(P + (size_t)b * TG * 1024 + (size_t)(row0 + ai * 128 + m * 16) * 1024 + e0);
#pragma unroll
            for (int m = 0; m < 4; ++m) { const float rs = rsv[ai][m];
                float o[4] = {0.f, 0.f, 0.f, 0.f};
#pragma unroll
                for (int bj = 0; bj < 2; ++bj)
#pragma unroll
                    for (int n = 0; n < 2; ++n) { const u32x2 q = pv[m][2 * bj + n]; const f32x4 g = acc[ai][bj][m][n] * rs;
                        o[0] += sigmoid_f(g[0]) * bflo(q.x); o[1] += sigmoid_f(g[1]) * bfhi(q.x); o[2] += sigmoid_f(g[2]) * bflo(q.y); o[3] += sigmoid_f(g[3]) * bfhi(q.y); }
                *(u32x2*)(MIX + (size_t)(row0 + ai * 128 + m * 16) * 1024 + e0) = (u32x2){pk2(o[0], o[1]), pk2(o[2], o[3])}; }
        }
    }
};
struct BranchOrder {
    int G, c;
    DI bool next(int i, pg8::Unit& u) const { const int L = i * G + c; if (L >= 1024) return false; const int br = L >> 8, rem = L & 255; u.pm = br * 64 + (rem >> 2); u.pn = br * 4 + (rem & 3); return true; }
    DI void a_ready(const pg8::Unit&) const {}
    DI void done(const pg8::Unit&) const {}
};
template <class Epi> DI void run_gemm(LAS unsigned char* lds, const bf16_t* A, const bf16_t* Bt, int M, int N, int K, const Epi& E) {
    pg8::Gemm g{A, Bt, M, N, K}; pg8::StaticOrder S; S.init(M, N, nwg_now(), wg_now());
    pg8::gemm_phase<Epi, pg8::StaticOrder>(lds, g, S, E);
}

DI void conv_mat(const float* src, int ld, int c0, int nvalid, int kvalid, int mode, bf16_t* dst, int Nd, int Kd, LAS float* scr, int wg, int nwg, const float* ksc = nullptr) {
    const int tid = tid_now(); const int ntk = Kd >> 6, ntiles = (Nd >> 6) * ntk;
    for (int tile = wg; tile < ntiles; tile += nwg) {
        const int n0 = (tile / ntk) << 6, k0 = (tile % ntk) << 6;
        const int nn = tid & 63, kq = tid >> 6, n = n0 + nn;
        int col;
        if (mode == 1) { const int blk = n >> 7; col = ((blk & 1) ? 2816 : 0) + (blk >> 1) * 128 + (n & 127); }
        else if (mode == 2) { const int c = n & 255, br = 2 * (c >> 7) + ((c >> 4) & 1), e = 64 * (n >> 8) + 16 * ((c >> 5) & 3) + (c & 15); col = c0 + br * 1024 + e; }
        else col = c0 + n;
#pragma unroll
        for (int i = 0; i < 8; ++i) { const int kk = i * 8 + kq; float v = 0.f;
            if (k0 + kk < kvalid && n < nvalid) { v = src[(size_t)(k0 + kk) * ld + col]; if (ksc) v *= ksc[k0 + kk]; }
            scr[kk * 65 + nn] = v; }
        __syncthreads();
        { const int nr = tid >> 3, kc = tid & 7; const LAS float* sp = scr + (kc * 8) * 65 + nr;
          u32x4 o; o.x = pk2(sp[0], sp[65]); o.y = pk2(sp[130], sp[195]); o.z = pk2(sp[260], sp[325]); o.w = pk2(sp[390], sp[455]);
          *(u32x4*)(dst + (size_t)(n0 + nr) * Kd + k0 + kc * 8) = o; }
        __syncthreads();
    }
}
DI void convert_layer(const Params& p, int l, LAS float* scr, int wg, int nwg) {
    unsigned char* ws = p.ws;
    conv_mat(p.in[3] + (size_t)l * 1024 * 5632, 5632, 0, 5632, 1024, 1, (bf16_t*)(ws + O_WGU1), 5632, 1024, scr, wg, nwg, p.in[2] + l * 1024);
    conv_mat(p.in[26] + (size_t)l * 1024 * 5632, 5632, 0, 5632, 1024, 1, (bf16_t*)(ws + O_WGU2), 5632, 1024, scr, wg, nwg, p.in[25] + l * 1024);
    conv_mat(p.in[4] + (size_t)l * 2816 * 1024, 1024, 0, 1024, 2816, 0, (bf16_t*)(ws + O_WD1), 1024, 2816, scr, wg, nwg);
    conv_mat(p.in[27] + (size_t)l * 2816 * 1024, 1024, 0, 1024, 2816, 0, (bf16_t*)(ws + O_WD2), 1024, 2816, scr, wg, nwg);
    conv_mat(p.in[6] + (size_t)l * 1024 * 8776, 8776, 0, 4680, 1024, 0, (bf16_t*)(ws + O_WIN), 4864, 1024, scr, wg, nwg, p.in[5] + l * 1024);
    conv_mat(p.in[6] + (size_t)l * 1024 * 8776, 8776, 4680, 4096, 1024, 2, (bf16_t*)(ws + O_WGATE), 4096, 1024, scr, wg, nwg, p.in[5] + l * 1024);
#pragma unroll 1
    for (int i = 0; i < 4; ++i)
        conv_mat(p.in[23] + ((size_t)l * 4 + i) * 512 * 1024, 1024, 0, 1024, 512, 0, (bf16_t*)(ws + O_WBR) + (size_t)i * 1024 * 512, 1024, 512, scr, wg, nwg);
    conv_mat(p.in[24] + (size_t)l * 1024 * 1024, 1024, 0, 1024, 1024, 0, (bf16_t*)(ws + O_WOUT), 1024, 1024, scr, wg, nwg);
    conv_mat(p.in[17] + (size_t)l * 384 * 768, 768, 0, 768, 384, 0, (bf16_t*)(ws + O_WQB), 768, 384, scr, wg, nwg);
    conv_mat(p.in[19] + (size_t)l * 128 * 1024, 1024, 0, 1024, 128, 0, (bf16_t*)(ws + O_WKVB), 1024, 256, scr, wg, nwg);
}

DI void init_rows(const float* x, bf16_t* xb, float* ssq) {
    const int tidn = tid_now(); const int lane = tidn & 63, gwave = wg_now() * 8 + (tidn >> 6), ngw = nwg_now() * 8;
    for (int row = gwave; row < T_ALL; row += ngw) {
        const f32x4* xr = (const f32x4*)(x + (size_t)row * 1024);
        f32x4 v[4]; float ss = 0.f;
#pragma unroll
        for (int j = 0; j < 4; ++j) { v[j] = xr[lane + 64 * j]; ss += v[j][0] * v[j][0] + v[j][1] * v[j][1] + v[j][2] * v[j][2] + v[j][3] * v[j][3]; }
        ss = wave_sum(ss);
        u32x2* o = (u32x2*)(xb + (size_t)row * 1024);
#pragma unroll
        for (int j = 0; j < 4; ++j) o[lane + 64 * j] = (u32x2){pk2(v[j][0], v[j][1]), pk2(v[j][2], v[j][3])};
        if (lane < 16) ssq[(size_t)row * 16 + lane] = lane == 0 ? ss : 0.f;
    }
}
DI void zero_f32(float* q, int n) { const int tidn = tid_now(); for (int i = wg_now() * 512 + tidn; i < n; i += nwg_now() * 512) q[i] = 0.f; }

DI void prep1(const Params& p, int l, const bf16_t* __restrict__ proj, bf16_t* __restrict__ xbcc, float* __restrict__ dtb, bf16_t* __restrict__ aq, bf16_t* __restrict__ akv, bf16_t* __restrict__ yd) {
    const int tidn = tid_now(); const int gtid = wg_now() * 512 + tidn, gthreads = nwg_now() * 512;
    const float* cw = p.in[7] + l * 4096; const float* cb = p.in[8] + l * 1024;
    for (int idx = gtid; idx < (TG / 16) * 128; idx += gthreads) {
        const int c8 = (idx & 127) << 3, tl0 = (idx >> 7) << 4, s0 = tl0 & 2047;
        float w[4][8], bb[8], r0[8], r1[8], r2[8];
#pragma unroll
        for (int k = 0; k < 4; ++k) { const f32x4 a = *(const f32x4*)(cw + k * 1024 + c8), b = *(const f32x4*)(cw + k * 1024 + c8 + 4);
#pragma unroll
            for (int j = 0; j < 4; ++j) { w[k][j] = a[j]; w[k][4 + j] = b[j]; } }
        { const f32x4 a = *(const f32x4*)(cb + c8), b = *(const f32x4*)(cb + c8 + 4);
#pragma unroll
          for (int j = 0; j < 4; ++j) { bb[j] = a[j]; bb[4 + j] = b[j]; } }
        const bf16_t* src = proj + (size_t)tl0 * PLD + 512 + c8;
        if (s0 > 0) { const u32x4 v0 = *(const u32x4*)(src - 3 * PLD), v1 = *(const u32x4*)(src - 2 * PLD), v2 = *(const u32x4*)(src - PLD); UNPACK8(v0, r0); UNPACK8(v1, r1); UNPACK8(v2, r2); }
        else {
#pragma unroll
            for (int j = 0; j < 8; ++j) { r0[j] = 0.f; r1[j] = 0.f; r2[j] = 0.f; } }
#pragma unroll 8
        for (int tt = 0; tt < 16; ++tt) {
            const u32x4 v = *(const u32x4*)(src + (size_t)tt * PLD); float cur[8], o[8]; UNPACK8(v, cur);
#pragma unroll
            for (int j = 0; j < 8; ++j) { o[j] = silu_f(bb[j] + w[0][j] * r0[j] + w[1][j] * r1[j] + w[2][j] * r2[j] + w[3][j] * cur[j]); r0[j] = r1[j]; r1[j] = r2[j]; r2[j] = cur[j]; }
            *(u32x4*)(xbcc + (size_t)(tl0 + tt) * 1024 + c8) = PACK8(o);
        }
    }
    const float* sw = p.in[22] + l * 1536;
    for (int idx = gtid; idx < (TG / 16) * 64; idx += gthreads) {
        const int c8 = (idx & 63) << 3, tl0 = (idx >> 6) << 4, s0 = tl0 & 2047;
        float w[3][8], p1[8], p2[8];
#pragma unroll
        for (int k = 0; k < 3; ++k) { const f32x4 a = *(const f32x4*)(sw + k * 512 + c8), b = *(const f32x4*)(sw + k * 512 + c8 + 4);
#pragma unroll
            for (int j = 0; j < 4; ++j) { w[k][j] = a[j]; w[k][4 + j] = b[j]; } }
        const bf16_t* src = proj + (size_t)tl0 * PLD + c8;
        if (s0 > 0) { const u32x4 c1 = *(const u32x4*)(src - 2 * PLD + 3656), x1 = *(const u32x4*)(src - 2 * PLD + 4168), c2 = *(const u32x4*)(src - PLD + 3656), x2 = *(const u32x4*)(src - PLD + 4168);
            float a[8], b[8]; UNPACK8(c1, a); UNPACK8(x1, b);
#pragma unroll
            for (int j = 0; j < 8; ++j) p1[j] = a[j] * b[j];
            UNPACK8(c2, a); UNPACK8(x2, b);
#pragma unroll
            for (int j = 0; j < 8; ++j) p2[j] = a[j] * b[j]; }
        else {
#pragma unroll
            for (int j = 0; j < 8; ++j) { p1[j] = 0.f; p2[j] = 0.f; } }
#pragma unroll 8
        for (int tt = 0; tt < 16; ++tt) {
            const bf16_t* pr = src + (size_t)tt * PLD;
            const u32x4 vc = *(const u32x4*)(pr + 3656), vx = *(const u32x4*)(pr + 4168), vb = *(const u32x4*)(pr + 3144);
            float fc[8], fx[8], fb[8], o[8]; UNPACK8(vc, fc); UNPACK8(vx, fx); UNPACK8(vb, fb);
#pragma unroll
            for (int j = 0; j < 8; ++j) { const float cur = fc[j] * fx[j]; o[j] = fb[j] * (w[0][j] * p1[j] + w[1][j] * p2[j] + w[2][j] * cur); p1[j] = p2[j]; p2[j] = cur; }
            *(u32x4*)(yd + (size_t)(tl0 + tt) * 512 + c8) = PACK8(o);
        }
    }
    const int gwave = gtid >> 6, ngw = gthreads >> 6, lane = tidn & 63;
    const float* qn = p.in[16] + l * 384; const float* kn = p.in[18] + l * 128;
#pragma unroll 4
    for (int tl = gwave; tl < TG; tl += ngw) {
        const bf16_t* pr = proj + (size_t)tl * PLD;
        const u32x4 v = *(const u32x4*)(pr + 2568 + lane * 8); float f[8]; UNPACK8(v, f);
        float ss = 0.f;
#pragma unroll
        for (int j = 0; j < 8; ++j) ss += f[j] * f[j];
        const float ssq = wave_sum(lane < 48 ? ss : 0.f), ssk = wave_sum(lane >= 48 ? ss : 0.f);
        if (lane < 48) {
            const float rstd = rsqrtf(ssq * (1.f / 384.f) + EPS);
#pragma unroll
            for (int j = 0; j < 8; ++j) f[j] *= rstd * qn[lane * 8 + j];
            *(u32x4*)(aq + (size_t)tl * 384 + lane * 8) = PACK8(f);
        } else {
            const float rstd = rsqrtf(ssk * (1.f / 128.f) + EPS);
#pragma unroll
            for (int j = 0; j < 8; ++j) f[j] *= rstd * kn[(lane - 48) * 8 + j];
            *(u32x4*)(akv + (size_t)tl * 256 + (lane - 48) * 8) = PACK8(f);
            { unsigned z = 0u; asm volatile("" : "+v"(z)); *(u32x4*)(akv + (size_t)tl * 256 + 128 + (lane - 48) * 8) = (u32x4){z, z, z, z}; }
        }
        if (lane < 8) {
            const float xr = bf2f(pr[1536 + lane]) + p.in[9][l * 8 + lane];
            const float dt = xr > 20.f ? xr : log1pf(expf(xr));
            const float A = -expf(p.in[10][l * 8 + lane]);
            dtb[(size_t)tl * 16 + lane] = dt; dtb[(size_t)tl * 16 + 8 + lane] = dt * A;
        }
    }
}

DI void rope_table(const Params& p, f32x2* CS) {
    const int* pos = (const int*)p.in[1];
    const int tidn = tid_now();
    for (int idx = wg_now() * 512 + tidn; idx < T_ALL * 32; idx += nwg_now() * 512) {
        const float invf = exp2f(-(float)(idx & 31) * (13.287712379549449f / 32.f));
        const float ang = (float)pos[idx >> 5] * invf;
        CS[idx] = (f32x2){cosf(ang), sinf(ang)};
    }
}
DI void prep2_unit(const Params& p, int l, int g, const bf16_t* __restrict__ proj, const bf16_t* __restrict__ qraw, const bf16_t* __restrict__ kvraw, const f32x2* __restrict__ CSt, bf16_t* __restrict__ Qf, bf16_t* __restrict__ Kf, bf16_t* __restrict__ Vt, int bl, int tile, LAS unsigned char* lds) {
    const int tid = tid_now(), wave = tid >> 6, lane = tid & 63;
    const float* wq = p.in[20] + l * 192; const float* wk = p.in[21] + l * 192;
    const float qscale = 0.07216878364870322f * 1.4426950408889634f;
    const float wq0 = wq[lane], wq1 = wq[64 + lane], wq2 = wq[128 + lane], wk0 = wk[lane], wk1 = wk[64 + lane], wk2 = wk[128 + lane];
    LAS bf16_t* img = (LAS bf16_t*)lds;
    const int t0 = tile * 64;
#pragma unroll 2
    for (int tt = 0; tt < 8; ++tt) {
        const int tloc = wave * 8 + tt, s = t0 + tloc; const size_t tl = (size_t)bl * SEQ + s;
        const f32x2 cssn = CSt[((size_t)(g * BPG + bl) * SEQ + s) * 32 + (lane & 31)];
        const float cs = cssn[0], sn = cssn[1];
        const float kpe = bf2f(proj[tl * PLD + 3080 + lane]);
#pragma unroll
        for (int h = 0; h < 4; ++h) {
            const size_t ob = ((size_t)(bl * 4 + h) * SEQ + s) * 192;
            {
                const bf16_t* qr = qraw + tl * 768 + h * 192;
                float q0 = bf2f(qr[lane]), q1 = bf2f(qr[64 + lane]), q2 = bf2f(qr[128 + lane]);
                const float r = rsqrtf(wave_sum(q0 * q0 + q1 * q1 + q2 * q2) * (1.f / 192.f) + EPS);
                q0 *= r * wq0; q1 *= r * wq1; q2 *= r * wq2;
                const float qp = __shfl_xor(q2, 32);
                q2 = (lane < 32) ? q2 * cs - qp * sn : q2 * cs + qp * sn;
                bf16_t* qo = Qf + ob;
                qo[lane] = f2bf(q0 * qscale); qo[64 + lane] = f2bf(q1 * qscale); qo[128 + lane] = f2bf(q2 * qscale);
            }
            const bf16_t* kr = kvraw + tl * 1024 + h * 256;
            {
                float k0 = bf2f(kr[lane]), k1 = bf2f(kr[64 + lane]), k2 = kpe;
                const float r = rsqrtf(wave_sum(k0 * k0 + k1 * k1 + k2 * k2) * (1.f / 192.f) + EPS);
                k0 *= r * wk0; k1 *= r * wk1; k2 *= r * wk2;
                const float kp = __shfl_xor(k2, 32);
                k2 = (lane < 32) ? k2 * cs - kp * sn : k2 * cs + kp * sn;
                bf16_t* ko = Kf + ob;
                ko[lane] = f2bf(k0); ko[64 + lane] = f2bf(k1); ko[128 + lane] = f2bf(k2);
            }
            img[(h * 128 + lane) * 72 + tloc] = kr[128 + lane]; img[(h * 128 + 64 + lane) * 72 + tloc] = kr[192 + lane];
        }
    }
    __syncthreads();
#pragma unroll
    for (int i = 0; i < 8; ++i) {
        const int ch = tid + 512 * i, row = ch >> 3, cc = ch & 7;
        *(u32x4*)(Vt + ((size_t)(bl * 4 + (row >> 7)) * 128 + (row & 127)) * SEQ + t0 + cc * 8) = *(const LAS u32x4*)(lds + row * 144 + cc * 16);
    }
    __syncthreads();
}

constexpr int KP = 400, VP = 136, KBYTES = 64 * KP, VBYTES = 128 * VP, ASTAGE = KBYTES + VBYTES;
DI void attn_unit(const bf16_t* Qf, const bf16_t* Kf, const bf16_t* Vt, bf16_t* yc, int bh, int qb, LAS unsigned char* lds) {
    const int tid = tid_now(), wave = tid >> 6, lane = tid & 63, r31 = lane & 31, hh = lane >> 5;
    const int q0 = qb * 256, qrow = q0 + wave * 32 + r31;
    const bf16_t* Qp = Qf + ((size_t)bh * SEQ + qrow) * 192 + 8 * hh;
    bf16x8 qf[12];
#pragma unroll
    for (int kk = 0; kk < 12; ++kk) qf[kk] = *(const bf16x8*)(Qp + kk * 16);
    f32x16 o[4];
#pragma unroll
    for (int d = 0; d < 4; ++d)
#pragma unroll
        for (int i = 0; i < 16; ++i) o[d][i] = 0.f;
    float m = -1e30f, l = 0.f;
    const int ntiles = qb * 4 + 4;
    const bf16_t* Kb = Kf + (size_t)bh * SEQ * 192; const bf16_t* Vb = Vt + (size_t)bh * 128 * SEQ;
    int krow[3], kcc[3], vd[2], vcc[2];
#pragma unroll
    for (int i = 0; i < 3; ++i) { const int c = tid + 512 * i; krow[i] = c / 24; kcc[i] = c % 24; }
#pragma unroll
    for (int i = 0; i < 2; ++i) { const int c = tid + 512 * i; vd[i] = c >> 3; vcc[i] = c & 7; }
    u32x4 kreg[3], vreg[2];
#define ATT_GLOAD(j) do { _Pragma("unroll") for (int i = 0; i < 3; ++i) kreg[i] = *(const u32x4*)(Kb + (size_t)((j) * 64 + krow[i]) * 192 + kcc[i] * 8); \
        _Pragma("unroll") for (int i = 0; i < 2; ++i) vreg[i] = *(const u32x4*)(Vb + (size_t)vd[i] * SEQ + (j) * 64 + vcc[i] * 8); } while (0)
#define ATT_LSTORE(st) do { LAS unsigned char* b_ = lds + (st) * ASTAGE; \
        _Pragma("unroll") for (int i = 0; i < 3; ++i) *(LAS u32x4*)(b_ + krow[i] * KP + kcc[i] * 16) = kreg[i]; \
        _Pragma("unroll") for (int i = 0; i < 2; ++i) { LAS u32x2* d_ = (LAS u32x2*)(b_ + KBYTES + vd[i] * VP + vcc[i] * 16); d_[0] = (u32x2){vreg[i].x, vreg[i].y}; d_[1] = (u32x2){vreg[i].z, vreg[i].w}; } } while (0)
    ATT_GLOAD(0); ATT_LSTORE(0);
    __syncthreads();
    for (int j = 0; j < ntiles; ++j) {
        const int cur = j & 1;
        if (j + 1 < ntiles) ATT_GLOAD(j + 1);
        if (j * 64 <= q0 + wave * 32 + 31) {
            const LAS unsigned char* Kl = lds + cur * ASTAGE; const LAS unsigned char* Vl = Kl + KBYTES;
            f32x16 s0, s1;
#pragma unroll
            for (int i = 0; i < 16; ++i) { s0[i] = 0.f; s1[i] = 0.f; }
#pragma unroll
            for (int kk = 0; kk < 12; ++kk) {
                const bf16x8 a0 = *(const LAS bf16x8*)(Kl + r31 * KP + (kk * 16 + 8 * hh) * 2);
                const bf16x8 a1 = *(const LAS bf16x8*)(Kl + (32 + r31) * KP + (kk * 16 + 8 * hh) * 2);
                s0 = MFMA32(a0, qf[kk], s0); s1 = MFMA32(a1, qf[kk], s1);
            }
            if (j * 64 + 63 > q0 + wave * 32) {
#pragma unroll
                for (int i = 0; i < 16; ++i) { const int key = j * 64 + crow(i, hh); if (key > qrow) s0[i] = -1e30f; if (key + 32 > qrow) s1[i] = -1e30f; }
            }
            float mx = s0[0];
#pragma unroll
            for (int i = 1; i < 16; ++i) mx = fmaxf(mx, s0[i]);
#pragma unroll
            for (int i = 0; i < 16; ++i) mx = fmaxf(mx, s1[i]);
            mx = fmaxf(mx, __shfl_xor(mx, 32));
            const float mn = fmaxf(m, mx);
            if (__ballot(mx > m) != 0ull) {
                const float alpha = __builtin_amdgcn_exp2f(m - mn);
                l *= alpha;
#pragma unroll
                for (int d = 0; d < 4; ++d)
#pragma unroll
                    for (int i = 0; i < 16; ++i) o[d][i] *= alpha;
            }
            m = mn;
            float ls = 0.f;
#pragma unroll
            for (int i = 0; i < 16; ++i) { s0[i] = __builtin_amdgcn_exp2f(s0[i] - mn); s1[i] = __builtin_amdgcn_exp2f(s1[i] - mn); ls += s0[i] + s1[i]; }
            l += ls;
            bf16x8 pf[2][2];
#pragma unroll
            for (int s = 0; s < 2; ++s) {
                u32x4 w0, w1;
                w0.x = pk2(s0[8 * s], s0[8 * s + 1]); w0.y = pk2(s0[8 * s + 2], s0[8 * s + 3]); w0.z = pk2(s0[8 * s + 4], s0[8 * s + 5]); w0.w = pk2(s0[8 * s + 6], s0[8 * s + 7]);
                w1.x = pk2(s1[8 * s], s1[8 * s + 1]); w1.y = pk2(s1[8 * s + 2], s1[8 * s + 3]); w1.z = pk2(s1[8 * s + 4], s1[8 * s + 5]); w1.w = pk2(s1[8 * s + 6], s1[8 * s + 7]);
                pf[0][s] = __builtin_bit_cast(bf16x8, w0); pf[1][s] = __builtin_bit_cast(bf16x8, w1);
            }
#pragma unroll
            for (int d = 0; d < 4; ++d)
#pragma unroll
                for (int kb = 0; kb < 2; ++kb)
#pragma unroll
                    for (int s = 0; s < 2; ++s) {
                        const LAS unsigned char* vp = Vl + (d * 32 + r31) * VP + (kb * 32 + 16 * s + 4 * hh) * 2;
                        const s16x4 lo = *(const LAS s16x4*)vp, hi = *(const LAS s16x4*)(vp + 16);
                        const bf16x8 a = __builtin_shufflevector(lo, hi, 0, 1, 2, 3, 4, 5, 6, 7);
                        o[d] = MFMA32(a, pf[kb][s], o[d]);
                    }
        }
        if (j + 1 < ntiles) ATT_LSTORE(cur ^ 1);
        __syncthreads();
    }
#undef ATT_GLOAD
#undef ATT_LSTORE
    l += __shfl_xor(l, 32);
    const float inv = 1.f / l;
    const int bl = bh >> 2, h = bh & 3;
    bf16_t* op = yc + ((size_t)bl * SEQ + qrow) * 512 + h * 128 + 4 * hh;
#pragma unroll
    for (int d = 0; d < 4; ++d)
#pragma unroll
        for (int i4 = 0; i4 < 4; ++i4)
            *(u32x2*)(op + d * 32 + 8 * i4) = (u32x2){pk2(o[d][4 * i4] * inv, o[d][4 * i4 + 1] * inv), pk2(o[d][4 * i4 + 2] * inv, o[d][4 * i4 + 3] * inv)};
}

DI void gmlp_unit(const Params& p, int l, const bf16_t* proj, bf16_t* yb, int bl, int c, LAS unsigned char* lds) {
    const int tid = tid_now(), wave = tid >> 6, lane = tid & 63, r31 = lane & 31, hh = lane >> 5;
    const float* wsp = p.in[14] + (size_t)l * 4 * 128 * 128; const float* bs = p.in[15] + l * 512; const float* vn = p.in[13] + l * 512;
    const size_t tl0 = (size_t)bl * SEQ + c * 128;
    float w8[8];
#pragma unroll
    for (int j = 0; j < 8; ++j) w8[j] = vn[lane + 64 * j];
    LAS bf16_t* vt = (LAS bf16_t*)lds;
#pragma unroll 2
    for (int rr = 0; rr < 16; ++rr) {
        const int row = wave * 16 + rr;
        const bf16_t* vr = proj + (tl0 + row) * PLD + 2056 + lane;
        float f[8]; float ss = 0.f;
#pragma unroll
        for (int j = 0; j < 8; ++j) { f[j] = gelu_f(bf2f(vr[64 * j])); ss += f[j] * f[j]; }
        const float rstd = rsqrtf(wave_sum(ss) * (1.f / 512.f) + EPS);
#pragma unroll
        for (int j = 0; j < 8; ++j) vt[(lane + 64 * j) * 136 + row] = f2bf(f[j] * rstd * w8[j]);
    }
    __syncthreads();
    const int mb = wave & 3, nh = wave >> 2, trow = mb * 32 + r31;
#pragma unroll 1
    for (int g = 0; g < 4; ++g) {
        f32x16 a0, a1;
#pragma unroll
        for (int i = 0; i < 16; ++i) { a0[i] = 0.f; a1[i] = 0.f; }
        const float* wrow = wsp + ((size_t)g * 128 + trow) * 128 + 8 * hh;
#pragma unroll
        for (int kk = 0; kk < 8; ++kk) if (kk * 16 <= mb * 32 + 31) {
            const f32x4 x0 = *(const f32x4*)(wrow + kk * 16), x1 = *(const f32x4*)(wrow + kk * 16 + 4);
            const int sb = kk * 16 + 8 * hh;
            float f[8];
#pragma unroll
            for (int j = 0; j < 4; ++j) { f[j] = (sb + j <= trow) ? x0[j] : 0.f; f[4 + j] = (sb + 4 + j <= trow) ? x1[j] : 0.f; }
            const bf16x8 a = __builtin_bit_cast(bf16x8, PACK8(f));
            const bf16x8 b0 = *(const LAS bf16x8*)(vt + (g * 128 + nh * 64 + r31) * 136 + kk * 16 + 8 * hh);
            const bf16x8 b1 = *(const LAS bf16x8*)(vt + (g * 128 + nh * 64 + 32 + r31) * 136 + kk * 16 + 8 * hh);
            a0 = MFMA32(a, b0, a0); a1 = MFMA32(a, b1, a1);
        }
#pragma unroll
        for (int i = 0; i < 16; ++i) {
            const int t = mb * 32 + crow(i, hh); const float bias = bs[g * 128 + t];
            const bf16_t* ur = proj + (tl0 + t) * PLD + 1544 + g * 128 + nh * 64 + r31;
            bf16_t* orow = yb + (tl0 + t) * 512 + g * 128 + nh * 64 + r31;
            orow[0] = f2bf(gelu_f(bf2f(ur[0])) * (a0[i] + bias));
            orow[32] = f2bf(gelu_f(bf2f(ur[32])) * (a1[i] + bias));
        }
    }
    __syncthreads();
}

constexpr int SP = 136;
DI void scan128(float& v0, float& v1, int lane) {
#pragma unroll
    for (int o = 1; o < 64; o <<= 1) { const float n0 = __shfl_up(v0, o), n1 = __shfl_up(v1, o); if (lane >= o) { v0 += n0; v1 += n1; } }
    v1 += __shfl(v0, 63);
}
DI void ssd_states_unit(const bf16_t* xbcc, const float* dtb, float* ST, float* ATOT, int bl, int c, int grp, LAS unsigned char* lds) {
    const int tid = tid_now(), wave = tid >> 6, lane = tid & 63, r31 = lane & 31, hh = lane >> 5;
    LAS bf16_t* BT = (LAS bf16_t*)lds; LAS bf16_t* XT = (LAS bf16_t*)(lds + 34816); LAS float* WS = (LAS float*)(lds + 104448);
    const size_t row0 = (size_t)bl * SEQ + c * 128;
    if (wave < 4) {
        const int h = grp * 4 + wave;
        const float d0 = dtb[(row0 + lane) * 16 + h], d1 = dtb[(row0 + 64 + lane) * 16 + h];
        float v0 = dtb[(row0 + lane) * 16 + 8 + h], v1 = dtb[(row0 + 64 + lane) * 16 + 8 + h];
        scan128(v0, v1, lane);
        const float tot = __shfl(v1, 63);
        WS[wave * 128 + lane] = d0 * __expf(tot - v0); WS[wave * 128 + 64 + lane] = d1 * __expf(tot - v1);
        if (lane == 0) ATOT[(bl * 16 + c) * 8 + h] = tot;
    }
    __syncthreads();
#pragma unroll
    for (int i = 0; i < 4; ++i) {
        const int ch = tid + 512 * i, s = ch >> 4, n8 = (ch & 15) * 8;
        const u32x4 v = *(const u32x4*)(xbcc + (row0 + s) * 1024 + 512 + grp * 128 + n8);
        LAS bf16_t* d = BT + n8 * SP + s;
        d[0] = (bf16_t)(v.x & 0xffffu); d[SP] = (bf16_t)(v.x >> 16); d[2 * SP] = (bf16_t)(v.y & 0xffffu); d[3 * SP] = (bf16_t)(v.y >> 16);
        d[4 * SP] = (bf16_t)(v.z & 0xffffu); d[5 * SP] = (bf16_t)(v.z >> 16); d[6 * SP] = (bf16_t)(v.w & 0xffffu); d[7 * SP] = (bf16_t)(v.w >> 16);
    }
#pragma unroll
    for (int i = 0; i < 8; ++i) {
        const int ch = tid + 512 * i, s = ch >> 5, c8 = (ch & 31) * 8;
        const u32x4 v = *(const u32x4*)(xbcc + (row0 + s) * 1024 + grp * 256 + c8); float f[8]; UNPACK8(v, f);
        const float w = WS[(c8 >> 6) * 128 + s];
        LAS bf16_t* d = XT + c8 * SP + s;
#pragma unroll
        for (int j = 0; j < 8; ++j) d[j * SP] = f2bf(f[j] * w);
    }
    __syncthreads();
    const int hl = wave >> 1, pb = wave & 1;
    f32x16 acc[4];
#pragma unroll
    for (int nb = 0; nb < 4; ++nb)
#pragma unroll
        for (int i = 0; i < 16; ++i) acc[nb][i] = 0.f;
#pragma unroll
    for (int k = 0; k < 8; ++k) {
        const bf16x8 a = *(const LAS bf16x8*)(XT + (hl * 64 + pb * 32 + r31) * SP + k * 16 + 8 * hh);
#pragma unroll
        for (int nb = 0; nb < 4; ++nb) { const bf16x8 b = *(const LAS bf16x8*)(BT + (nb * 32 + r31) * SP + k * 16 + 8 * hh); acc[nb] = MFMA32(a, b, acc[nb]); }
    }
    float* so = ST + (((size_t)bl * 16 + c) * 8 + grp * 4 + hl) * 8192;
#pragma unroll
    for (int nb = 0; nb < 4; ++nb)
#pragma unroll
        for (int i = 0; i < 16; ++i) so[(pb * 32 + crow(i, hh)) * 128 + nb * 32 + r31] = acc[nb][i];
    __syncthreads();
}
DI void ssd_scan(const float* ST, bf16_t* STB, const float* ATOT) {
    const int tidn = tid_now();
    for (int idx = wg_now() * 512 + tidn; idx < 64 * 2048; idx += nwg_now() * 512) {
        const int bh = idx >> 11, e4 = idx & 2047, bl = bh >> 3, head = bh & 7;
        const size_t off = ((size_t)bl * 16 * 8 + head) * 8192 + e4 * 4;
        f32x4 sv[16];
#pragma unroll
        for (int c = 0; c < 16; ++c) sv[c] = *(const f32x4*)(ST + off + (size_t)c * 8 * 8192);
        f32x4 run = {0.f, 0.f, 0.f, 0.f};
#pragma unroll
        for (int c = 0; c < 16; ++c) { const float ea = __expf(ATOT[(bl * 16 + c) * 8 + head]);
            *(u32x2*)(STB + off + (size_t)c * 8 * 8192) = (u32x2){pk2(run[0], run[1]), pk2(run[2], run[3])}; run = run * ea + sv[c]; }
    }
}
DI void ssd_out_grp(const Params& p, int l, const bf16_t* proj, const bf16_t* xbcc, const float* dtb, const bf16_t* STB, float* yraw, bf16_t* ya, int bl, int c, int grp, LAS unsigned char* lds) {
    const int tid = tid_now(), wave = tid >> 6, lane = tid & 63, r31 = lane & 31, hh = lane >> 5;
    LAS bf16_t* CL = (LAS bf16_t*)lds; LAS bf16_t* BL = (LAS bf16_t*)(lds + 34816); LAS bf16_t* XT = (LAS bf16_t*)(lds + 69632); LAS bf16_t* PV = (LAS bf16_t*)(lds + 104448);
    LAS float* ACS = (LAS float*)(lds + 139264); LAS float* DTL = (LAS float*)(lds + 140288); LAS float* RS = (LAS float*)(lds + 141312); LAS float* OUT = (LAS float*)(lds + 69632);
    const size_t row0 = (size_t)bl * SEQ + c * 128;
#pragma unroll
    for (int i = 0; i < 4; ++i) {
        const int ch = tid + 512 * i, s = ch >> 4, n8 = (ch & 15) * 8;
        const bf16_t* xr = xbcc + (row0 + s) * 1024;
        *(LAS u32x4*)(CL + s * SP + n8) = *(const u32x4*)(xr + 768 + grp * 128 + n8);
        *(LAS u32x4*)(BL + s * SP + n8) = *(const u32x4*)(xr + 512 + grp * 128 + n8);
    }
#pragma unroll 1
    for (int pi = 0; pi < 2; ++pi) {
        const int pair = grp * 2 + pi;
        if (wave < 2) {
            const int h = pair * 2 + wave;
            const float d0 = dtb[(row0 + lane) * 16 + h], d1 = dtb[(row0 + 64 + lane) * 16 + h];
            float v0 = dtb[(row0 + lane) * 16 + 8 + h], v1 = dtb[(row0 + 64 + lane) * 16 + 8 + h];
            scan128(v0, v1, lane);
            ACS[wave * 128 + lane] = v0; ACS[wave * 128 + 64 + lane] = v1; DTL[wave * 128 + lane] = d0; DTL[wave * 128 + 64 + lane] = d1;
        }
        __syncthreads();
#pragma unroll
        for (int i = 0; i < 4; ++i) {
            const int ch = tid + 512 * i, s = ch >> 4, n8 = (ch & 15) * 8;
            const u32x4 v = *(const u32x4*)(xbcc + (row0 + s) * 1024 + pair * 128 + n8); float f[8]; UNPACK8(v, f);
            const float w = DTL[(n8 >> 6) * 128 + s];
            LAS bf16_t* d = XT + n8 * SP + s;
#pragma unroll
            for (int j = 0; j < 8; ++j) d[j * SP] = f2bf(f[j] * w);
            *(LAS u32x4*)(PV + s * SP + n8) = *(const u32x4*)(STB + (((size_t)bl * 16 + c) * 8 + pair * 2) * 8192 + (size_t)s * 128 + n8);
        }
        __syncthreads();
        const int tb = wave >> 1, hl = wave & 1;
        f32x16 acc[2];
#pragma unroll
        for (int pb = 0; pb < 2; ++pb)
#pragma unroll
            for (int i = 0; i < 16; ++i) acc[pb][i] = 0.f;
        const LAS bf16_t* crw = CL + (tb * 32 + r31) * SP + 8 * hh;
#pragma unroll
        for (int k = 0; k < 8; ++k) {
            const bf16x8 b = *(const LAS bf16x8*)(crw + k * 16);
#pragma unroll
            for (int pb = 0; pb < 2; ++pb) { const bf16x8 a = *(const LAS bf16x8*)(PV + (hl * 64 + pb * 32 + r31) * SP + k * 16 + 8 * hh); acc[pb] = MFMA32(a, b, acc[pb]); }
        }
        const float at = ACS[hl * 128 + tb * 32 + r31], eat = __expf(at);
#pragma unroll
        for (int pb = 0; pb < 2; ++pb)
#pragma unroll
            for (int i = 0; i < 16; ++i) acc[pb][i] *= eat;
#pragma unroll 1
        for (int sb = 0; sb <= tb; ++sb) {
            f32x16 cbt;
#pragma unroll
            for (int i = 0; i < 16; ++i) cbt[i] = 0.f;
#pragma unroll
            for (int k = 0; k < 8; ++k) {
                const bf16x8 a = *(const LAS bf16x8*)(BL + (sb * 32 + r31) * SP + k * 16 + 8 * hh);
                const bf16x8 b = *(const LAS bf16x8*)(crw + k * 16);
                cbt = MFMA32(a, b, cbt);
            }
#pragma unroll
            for (int i = 0; i < 16; ++i) {
                const int sl = crow(i, hh); const float as = ACS[hl * 128 + sb * 32 + sl];
                const float mv = cbt[i] * __expf(fminf(at - as, 0.f));
                cbt[i] = (sb == tb && sl > r31) ? 0.f : mv;
            }
#pragma unroll
            for (int ks = 0; ks < 2; ++ks) {
                u32x4 w; w.x = pk2(cbt[8 * ks], cbt[8 * ks + 1]); w.y = pk2(cbt[8 * ks + 2], cbt[8 * ks + 3]); w.z = pk2(cbt[8 * ks + 4], cbt[8 * ks + 5]); w.w = pk2(cbt[8 * ks + 6], cbt[8 * ks + 7]);
                const bf16x8 pfr = __builtin_bit_cast(bf16x8, w);
#pragma unroll
                for (int pb = 0; pb < 2; ++pb) {
                    const LAS bf16_t* vp = XT + (hl * 64 + pb * 32 + r31) * SP + sb * 32 + 16 * ks + 4 * hh;
                    const s16x4 lo = *(const LAS s16x4*)vp, hi = *(const LAS s16x4*)(vp + 8);
                    const bf16x8 a = __builtin_shufflevector(lo, hi, 0, 1, 2, 3, 4, 5, 6, 7);
                    acc[pb] = MFMA32(a, pfr, acc[pb]);
                }
            }
        }
        __syncthreads();
#pragma unroll
        for (int pb = 0; pb < 2; ++pb)
#pragma unroll
            for (int i = 0; i < 16; ++i) OUT[(tb * 32 + r31) * 132 + hl * 64 + pb * 32 + crow(i, hh)] = acc[pb][i];
        __syncthreads();
#pragma unroll
        for (int i = 0; i < 4; ++i) {
            const int it = tid + 512 * i, t = it >> 4, c8 = (it & 15) * 8;
            const f32x4 y0 = *(const LAS f32x4*)(OUT + t * 132 + c8), y1 = *(const LAS f32x4*)(OUT + t * 132 + c8 + 4);
            const u32x4 xv = *(const u32x4*)(xbcc + (row0 + t) * 1024 + pair * 128 + c8), zv = *(const u32x4*)(proj + (row0 + t) * PLD + pair * 128 + c8);
            float fx[8], fz[8]; UNPACK8(xv, fx); UNPACK8(zv, fz);
            const float Dh = p.in[11][l * 8 + pair * 2 + (c8 >> 6)];
            f32x4 o0, o1;
#pragma unroll
            for (int j = 0; j < 4; ++j) { o0[j] = (y0[j] + Dh * fx[j]) * silu_f(fz[j]); o1[j] = (y1[j] + Dh * fx[4 + j]) * silu_f(fz[4 + j]); }
            float* op = yraw + (row0 + t) * 512 + pair * 128 + c8; *(f32x4*)op = o0; *(f32x4*)(op + 4) = o1;
            float ss = 0.f;
#pragma unroll
            for (int j = 0; j < 4; ++j) ss += o0[j] * o0[j] + o1[j] * o1[j];
            ss += __shfl_xor(ss, 1); ss += __shfl_xor(ss, 2); ss += __shfl_xor(ss, 4); ss += __shfl_xor(ss, 8);
            if ((tid & 15) == 0) RS[t] = pi == 0 ? ss : RS[t] + ss;
        }
        __syncthreads();
    }
    const float* nw = p.in[12] + l * 512 + grp * 256;
#pragma unroll
    for (int i = 0; i < 8; ++i) {
        const int it = tid + 512 * i, t = it >> 5, c8 = (it & 31) * 8;
        const float* yr = yraw + (row0 + t) * 512 + grp * 256 + c8;
        const f32x4 a = *(const f32x4*)yr, b = *(const f32x4*)(yr + 4), w0 = *(const f32x4*)(nw + c8), w1 = *(const f32x4*)(nw + c8 + 4);
        const float rstd = rsqrtf(RS[t] * (1.f / 256.f) + EPS);
        *(u32x4*)(ya + (row0 + t) * 512 + grp * 256 + c8) = (u32x4){pk2(a[0] * rstd * w0[0], a[1] * rstd * w0[1]), pk2(a[2] * rstd * w0[2], a[3] * rstd * w0[3]),
                                                                      pk2(b[0] * rstd * w1[0], b[1] * rstd * w1[1]), pk2(b[2] * rstd * w1[2], b[3] * rstd * w1[3])};
    }
    __syncthreads();
}

#if MULTI_LAUNCH
#define RUNPH(x) ((x) == p.only_phase)
#define GSYNC() do {} while (0)
#else
#define RUNPH(x) true
#define GSYNC() do { XcdBarrier xb_; xb_.bar = (unsigned*)(p.ws + O_BAR); xb_.x = xb_xcc_id(); xb_.st = (volatile LAS unsigned*)(lds + LDS_BYTES - 16); xcd_barrier(xb_); if (PROBE & 1) xcd_barrier(xb_); } while (0)
#endif
#define PH_BEGIN if (RUNPH(ph)) { size_t z_ = 0; asm volatile("" : "+s"(z_)); unsigned char* ws = p.ws + z_; float* X = p.out + z_; const int wg = wg_now(), nwg = nwg_now();
#define PH_END } ++ph; GSYNC();
__global__ void __launch_bounds__(512) mega(Params p) {
    extern __shared__ __attribute__((aligned(16))) unsigned char smem[];
    LAS unsigned char* lds = (LAS unsigned char*)smem;
#if !MULTI_LAUNCH
    cg::grid_group grid = cg::this_grid();
    volatile LAS unsigned* xst = (volatile LAS unsigned*)(lds + LDS_BYTES - 16);
    if (threadIdx.x == 0) { xst[0] = 0u; xst[1] = 0u; }
    __syncthreads();
    (void)xcd_barrier_post((unsigned*)(p.ws + O_BAR), xst);
    grid.sync();
#endif
#define XN ((bf16_t*)(ws + O_XN))
#define SSQ0 ((float*)(ws + O_SSQ))
#define SSQ1 (SSQ0 + (size_t)T_ALL * 16)
#define SSQ2 (SSQ0 + (size_t)2 * T_ALL * 16)
#define H ((bf16_t*)(ws + O_H))
#define PROJ ((bf16_t*)(ws + O_PROJ))
#define XBCC ((bf16_t*)(ws + O_XBCC))
#define ST ((float*)(ws + O_ST))
#define ATOT ((float*)(ws + O_ATOT))
#define STB ((bf16_t*)(ws + O_STB))
#define DTB ((float*)(ws + O_DTB))
#define AQ ((bf16_t*)(ws + O_AQ))
#define AKV ((bf16_t*)(ws + O_AKV))
#define QRAW ((bf16_t*)(ws + O_QRAW))
#define KVRAW ((bf16_t*)(ws + O_KVRAW))
#define QF ((bf16_t*)(ws + O_QF))
#define KF ((bf16_t*)(ws + O_KF))
#define VT ((bf16_t*)(ws + O_VT))
#define YRAW ((float*)(ws + O_YRAW))
#define YA ((bf16_t*)(ws + O_YA))
#define YB (YA + (size_t)TG * 512)
#define YC (YA + (size_t)2 * TG * 512)
#define YD (YA + (size_t)3 * TG * 512)
#define CS ((f32x2*)(ws + O_CS))
#define PB ((bf16_t*)(ws + O_PB))
#define MIXB ((bf16_t*)(ws + O_MIXB))
#define WIN ((const bf16_t*)(ws + O_WIN))
#define WGATE ((const bf16_t*)(ws + O_WGATE))
#define WBR ((const bf16_t*)(ws + O_WBR))
#define WOUT ((const bf16_t*)(ws + O_WOUT))
#define WQB ((const bf16_t*)(ws + O_WQB))
#define WKVB ((const bf16_t*)(ws + O_WKVB))
#define XNg (XN + (size_t)g * TG * 1024)
    int ph = 0;
#pragma unroll 1
    for (int l = 0; l < 4; ++l) {
#pragma unroll 1
        for (int f = 0; f < 2; ++f) {
            if (f == 0) {
                PH_BEGIN
                    REP(32) convert_layer(p, l, (LAS float*)lds, wg, nwg);
                    if (l == 0) { rope_table(p, CS); init_rows(p.in[0], XN, SSQ0); }
                PH_END
            }
            PH_BEGIN
                EpiGU e{H, f == 0 ? SSQ0 : SSQ2};
#pragma unroll 1
                for (int rep = 0; rep < ((PROBE & 16) ? 2 : 1); ++rep) run_gemm(lds, XN, (const bf16_t*)(ws + (f == 0 ? O_WGU1 : O_WGU2)), T_ALL, 5632, 1024, e);
            PH_END
            PH_BEGIN
                if (PROBE & 256) { EpiRes e0{XN, f == 0 ? SSQ1 : SSQ0, (l == 3 && f == 1) ? X : nullptr, 0.0f}; run_gemm(lds, H, (const bf16_t*)(ws + (f == 0 ? O_WD1 : O_WD2)), T_ALL, 1024, 2816, e0); }
                EpiRes e{XN, f == 0 ? SSQ1 : SSQ0, (l == 3 && f == 1) ? X : nullptr, 0.5f}; run_gemm(lds, H, (const bf16_t*)(ws + (f == 0 ? O_WD1 : O_WD2)), T_ALL, 1024, 2816, e);
            PH_END
            if (f == 0) {
#pragma unroll 1
                for (int g = 0; g < NGRP; ++g) {
                    if (g == 0) {
                        PH_BEGIN
                            EpiStore e{PROJ, PLD, 0x7fffffff, SSQ1}; run_gemm(lds, XN, WIN, TG, 4864, 1024, e);
                        PH_END
                    }
                    PH_BEGIN
                        REP(4) prep1(p, l, PROJ, XBCC, DTB, AQ, AKV, YD);
                    PH_END
                    PH_BEGIN
                        REP(64) {
                        { EpiStore e{QRAW, 768, 0x7fffffff, nullptr}; run_gemm(lds, AQ, WQB, TG, 768, 384, e); }
                        { EpiStore e{KVRAW, 1024, 0x7fffffff, nullptr}; run_gemm(lds, AKV, WKVB, TG, 1024, 256, e); }
#pragma unroll 1
                        for (int u = wg; u < 256; u += nwg) {
                            ssd_states_unit(XBCC, DTB, ST, ATOT, u >> 5, (u >> 1) & 15, u & 1, lds);
                        }
                        }
                    PH_END
                    PH_BEGIN
                        REP(4) for (int u = wg; u < 256; u += nwg) prep2_unit(p, l, g, PROJ, QRAW, KVRAW, CS, QF, KF, VT, u >> 5, u & 31, lds);
                        ssd_scan(ST, STB, ATOT);
                    PH_END
                    PH_BEGIN
                        {
                            unsigned* ctr = (unsigned*)(ws + O_WQ) + (l * 4 + g);
                            volatile LAS unsigned* wq = (volatile LAS unsigned*)(lds + LDS_BYTES - 32);
#pragma unroll 1
                            for (;;) {
                                __syncthreads();
                                if (tid_now() == 0) *wq = atomicAdd(ctr, 1u);
                                __syncthreads();
                                const int u = (int)*wq;
                                if (u >= 640) break;
                                if (u < 64) { REP(2048) attn_unit(QF, KF, VT, YC, u & 31, 7 - (u >> 5), lds); }
                                else if (u < 320) { const int k = u - 64; REP(1024) ssd_out_grp(p, l, PROJ, XBCC, DTB, STB, YRAW, YA, k >> 5, (k >> 1) & 15, k & 1, lds); }
                                else if (u < 512) { const int k = u - 320; REP(2048) attn_unit(QF, KF, VT, YC, k & 31, 5 - (k >> 5), lds); }
                                else { const int k = u - 512; gmlp_unit(p, l, PROJ, YB, k >> 4, k & 15, lds); }
                            }
                        }
                    PH_END
                    PH_BEGIN
                        EpiStore e{PB, 1024, 3, nullptr}; pg8::Gemm gm{YA, WBR, 4 * TG, 4096, 512}; BranchOrder S; S.G = nwg; S.c = wg;
                        REP(128) pg8::gemm_phase<EpiStore, BranchOrder>(lds, gm, S, e);
                    PH_END
                    PH_BEGIN
                        EpiMerge e{PB, MIXB, SSQ1 + (size_t)g * TG * 16}; REP(128) run_gemm(lds, XNg, WGATE, TG, 4096, 1024, e);
                    PH_END
                    PH_BEGIN
                        { EpiRes e{XNg, SSQ2 + (size_t)g * TG * 16, nullptr, 1.0f}; run_gemm(lds, MIXB, WOUT, TG, 1024, 1024, e); }
                        if (g < NGRP - 1) {
                            EpiStore e{PROJ, PLD, 0x7fffffff, SSQ1 + (size_t)(g + 1) * TG * 16}; run_gemm(lds, XN + (size_t)(g + 1) * TG * 1024, WIN, TG, 4864, 1024, e); }
                    PH_END
                }
            }
        }
    }
}

constexpr int N_PHASES = 4 * (1 + 2 + 1 + 4 * 7 + 2);

extern "C" void kernel_launch(void* const* d_in, const int* in_sizes, int n_in, void* d_out, int out_size, void* d_ws, size_t ws_size, hipStream_t stream) {
    static int grid_blocks = 0;
    if (!grid_blocks) {
        if (n_in != 28 || ws_size < WS_NEED) { fprintf(stderr, "kernel_launch: need 28 inputs and %zu bytes of workspace (got %d, %zu)\n", (size_t)WS_NEED, n_in, ws_size); grid_blocks = -1; return; }
        if (hipFuncSetAttribute((const void*)mega, hipFuncAttributeMaxDynamicSharedMemorySize, LDS_BYTES) != hipSuccess) { fprintf(stderr, "kernel_launch: hipFuncSetAttribute failed\n"); grid_blocks = -1; return; }
        int dev = 0, cus = 0, per_cu = 0;
        hipGetDevice(&dev); hipDeviceGetAttribute(&cus, hipDeviceAttributeMultiprocessorCount, dev);
        hipOccupancyMaxActiveBlocksPerMultiprocessor(&per_cu, mega, 512, LDS_BYTES);
        if (per_cu < 1) { fprintf(stderr, "kernel_launch: occupancy query returned %d\n", per_cu); per_cu = 1; }
        (void)hipGetLastError();
        grid_blocks = cus * per_cu;
    }
    if (grid_blocks < 0) return;
    Params p{};
    for (int i = 0; i < 28; ++i) p.in[i] = (const float*)d_in[i];
    p.out = (float*)d_out; p.ws = (unsigned char*)d_ws; p.only_phase = -1; p.pad = 0;
#if MULTI_LAUNCH
    for (int ph = 0; ph < N_PHASES; ++ph) { p.only_phase = ph; hipLaunchKernelGGL(mega, dim3(grid_blocks), dim3(512), LDS_BYTES, stream, p); }
#else
    if (hipMemsetAsync((unsigned char*)d_ws + O_BAR, 0, ZERO_BYTES, stream) != hipSuccess) { fprintf(stderr, "kernel_launch: memset of barrier words failed\n"); return; }
    void* args[] = {&p};
    hipError_t e = hipLaunchCooperativeKernel((void*)mega, dim3(grid_blocks), dim3(512), args, LDS_BYTES, stream);
    if (e != hipSuccess) fprintf(stderr, "cooperative launch failed: %s (grid %d)\n", hipGetErrorString(e), grid_blocks);
#endif
}
```

```cpp
#include <hip/hip_runtime.h>
#include <hip/hip_cooperative_groups.h>
#include <cstdio>
namespace cg = cooperative_groups;

#ifndef PROBE
#define PROBE 0
#endif
#define REP(bit) _Pragma("unroll 1") for (int rep_ = 0; rep_ < ((PROBE & (bit)) ? 2 : 1); ++rep_)
#ifndef PROBE_T
#define PROBE_T 0
#endif
#ifndef MULTI_LAUNCH
#define MULTI_LAUNCH 0
#endif

__device__ __forceinline__ int tid_now() { int t = threadIdx.x; asm volatile("" : "+v"(t)); return t; }
__device__ __forceinline__ int wg_now() { int t = blockIdx.x; asm volatile("" : "+s"(t)); return t; }
__device__ __forceinline__ int nwg_now() { int t = gridDim.x; asm volatile("" : "+s"(t)); return t; }
namespace pg8 {
#define PG8_LAS __attribute__((address_space(3)))
typedef unsigned short bf16_t;
typedef short bf16x8 __attribute__((ext_vector_type(8)));
typedef float f32x4 __attribute__((ext_vector_type(4)));
typedef unsigned u32x4 __attribute__((ext_vector_type(4)));
constexpr int BM = 256, BK = 64, HALF = 128, HTB = HALF * BK * 2  , STAGE_BYTES = 8 * HTB, NXCD = 8, WGM = 8;

__host__ __device__ __forceinline__ int lds_byte(int r, int c) { const int st = (r >> 4) * 2 + (c >> 5), rr = r & 15, cc = c & 31, ob = rr * 64 + cc * 2; return st * 1024 + (ob ^ (((ob >> 9) & 1) << 5)); }
__host__ __device__ __forceinline__ void stage_rc(int b, int& R, int& C) { const int st = b / 1024, sb = b % 1024, swz = sb ^ (((sb >> 9) & 1) << 5); R = (st >> 1) * 16 + swz / 64; C = (st & 1) * 32 + (swz % 64) / 2; }
__host__ __device__ __forceinline__ int perm32(int rho) { const int n = rho >> 4, i = rho & 15; return 8 * (i >> 2) + 4 * n + (i & 3); }

struct Unit { int pm, pn; };
struct Gemm { const bf16_t* A; const bf16_t* Bt; int M, N, K; };

struct StaticOrder {
    int nM, nN, nwg, G, c;
    __host__ __device__ void init(int M, int N, int G_, int c_) { nM = M / BM; nN = N / BM; nwg = nM * nN; G = G_; c = c_; }
    __host__ __device__ bool next(int i, Unit& u) const {
        const long L = (long)i * G + c; if (L >= nwg) return false;
        int wgid = (int)L; { const int q = nwg / NXCD, r = nwg % NXCD, xcd = wgid % NXCD, off = wgid / NXCD; wgid = (xcd < r ? xcd * (q + 1) : r * (q + 1) + (xcd - r) * q) + off; }
        const int nig = WGM * nN, gid = wgid / nig, fm = gid * WGM, gsz = (nM - fm) < WGM ? (nM - fm) : WGM;
        u.pm = fm + ((wgid % nig) % gsz); u.pn = (wgid % nig) / gsz; return true;
    }
    __device__ __forceinline__ void a_ready(const Unit&) const {}
    __device__ __forceinline__ void done(const Unit&) const {}
};

template <class Epi, class Sched>
__device__ __forceinline__ void gemm_phase(PG8_LAS unsigned char* lds, const Gemm g, const Sched& S, const Epi& E) {
    const int tid = tid_now(), wid = __builtin_amdgcn_readfirstlane(tid >> 6), lane = tid & 63, wr = wid >> 2, wc = wid & 3, fr = lane & 15, fq = lane >> 4;
    const int K = g.K, nt = K / BK;
    unsigned voffA[2], voffB[2];
#pragma unroll
    for (int i = 0; i < 2; ++i) { int R, C; stage_rc(tid * 16 + i * 8192, R, C); const int Rb = Epi::PERM ? ((R & ~31) + perm32(R & 31)) : R;
        voffA[i] = (unsigned)(R * K + C) * 2u; voffB[i] = (unsigned)(Rb * K + C) * 2u; }
    const size_t kstep = (size_t)(BK * 2);
    const size_t hstep = (size_t)HALF * K * 2;
    const size_t tstep = 2 * hstep;
    const unsigned ldsw = (unsigned)wid * 1024u;
    const int aoff = lds_byte(wr * 64 + fr, fq * 8), boff = lds_byte(wc * 32 + fr, fq * 8);
#define PG8_SA(b, h) (((b) * 2 + (h)) * HTB)
#define PG8_SB(b, h) ((4 + (b) * 2 + (h)) * HTB)
#define PG8_STAGE(bufoff, gbase, voff) do { _Pragma("unroll") for (int _i = 0; _i < 2; ++_i) \
        __builtin_amdgcn_global_load_lds((const unsigned*)((const char*)(gbase) + (voff)[_i]), (PG8_LAS unsigned*)(lds + (bufoff) + ldsw + _i * 8192), 16, 0, 0); } while (0)
#define PG8_LDA(dst, b, h) do { _Pragma("unroll") for (int m = 0; m < 4; ++m) _Pragma("unroll") for (int k = 0; k < 2; ++k) dst[m][k] = *(const PG8_LAS bf16x8*)(lds + PG8_SA(b, h) + aoff + m * 2048 + k * 1024); } while (0)
#define PG8_LDB(dst, b, h) do { _Pragma("unroll") for (int n = 0; n < 2; ++n) _Pragma("unroll") for (int k = 0; k < 2; ++k) dst[n][k] = *(const PG8_LAS bf16x8*)(lds + PG8_SB(b, h) + boff + n * 2048 + k * 1024); } while (0)
#define PG8_MMA(ai, bj, At, Bt) do { __builtin_amdgcn_s_setprio(1); _Pragma("unroll") for (int m = 0; m < 4; ++m) _Pragma("unroll") for (int n = 0; n < 2; ++n) _Pragma("unroll") for (int k = 0; k < 2; ++k) \
        acc[ai][bj][m][n] = __builtin_amdgcn_mfma_f32_16x16x32_bf16(Bt[n][k], At[m][k], acc[ai][bj][m][n], 0, 0, 0); __builtin_amdgcn_s_setprio(0); } while (0)
#define PG8_WAIT_V(n) asm volatile("s_waitcnt vmcnt(" #n ")" ::: "memory")
#define PG8_WAIT_L(n) asm volatile("s_waitcnt lgkmcnt(" #n ")" ::: "memory")
#define PG8_BAR __builtin_amdgcn_s_barrier()
#define PG8_SCHED __builtin_amdgcn_sched_barrier(0)
    Unit cur, nxt; int ui = 0;
    if (!S.next(0, cur)) return;
    f32x4 acc[2][2][4][2];
#pragma unroll
    for (int a = 0; a < 2; ++a)
#pragma unroll
        for (int b = 0; b < 2; ++b)
#pragma unroll
            for (int m = 0; m < 4; ++m)
#pragma unroll
                for (int n = 0; n < 2; ++n) acc[a][b][m][n] = (f32x4){0.f, 0.f, 0.f, 0.f};
    bf16x8 At[4][2], B0[2][2], B1[2][2];
    const char* cA = (const char*)g.A + (size_t)cur.pm * tstep; const char* cB = (const char*)g.Bt + (size_t)cur.pn * tstep;
    S.a_ready(cur);
    PG8_STAGE(PG8_SB(0, 0), cB, voffB); PG8_STAGE(PG8_SA(0, 0), cA, voffA); PG8_STAGE(PG8_SB(0, 1), cB + hstep, voffB); PG8_STAGE(PG8_SA(0, 1), cA + hstep, voffA);
    if (wr == 1) PG8_BAR;
    PG8_WAIT_V(4); PG8_BAR;
    PG8_STAGE(PG8_SB(1, 0), cB + kstep, voffB); PG8_STAGE(PG8_SA(1, 0), cA + kstep, voffA); PG8_STAGE(PG8_SB(1, 1), cB + hstep + kstep, voffB);
    PG8_WAIT_V(6); PG8_BAR;
    for (;;) {
        const bool has_next = S.next(ui + 1, nxt);
        const char* nA = has_next ? (const char*)g.A + (size_t)nxt.pm * tstep : cA; const char* nB = has_next ? (const char*)g.Bt + (size_t)nxt.pn * tstep : cB;
        for (int t = 0; t < nt; t += 2) {
            const bool last = (t == nt - 2);
            const char* a1 = cA + (size_t)(t + 1) * kstep;
            const char* a2 = last ? nA : cA + (size_t)(t + 2) * kstep; const char* b2 = last ? nB : cB + (size_t)(t + 2) * kstep;
            const char* a3 = a2 + kstep; const char* b3 = b2 + kstep;
            if (last && has_next) S.a_ready(nxt);
            PG8_LDB(B0, 0, 0); PG8_SCHED; PG8_LDA(At, 0, 0); PG8_STAGE(PG8_SA(1, 1), a1 + hstep, voffA);
            PG8_WAIT_L(8); PG8_BAR; PG8_WAIT_L(0); PG8_MMA(0, 0, At, B0); PG8_BAR; PG8_SCHED;
            PG8_LDB(B1, 0, 1); PG8_STAGE(PG8_SB(0, 0), b2, voffB);
            PG8_BAR; PG8_WAIT_L(0); PG8_MMA(0, 1, At, B1); PG8_BAR;
            PG8_LDA(At, 0, 1); PG8_STAGE(PG8_SA(0, 0), a2, voffA);
            PG8_BAR; PG8_WAIT_L(0); PG8_MMA(1, 0, At, B0); PG8_BAR; PG8_SCHED;
            PG8_STAGE(PG8_SB(0, 1), b2 + hstep, voffB);
            PG8_WAIT_V(6); PG8_BAR; PG8_MMA(1, 1, At, B1); PG8_BAR;
            PG8_LDB(B0, 1, 0); PG8_SCHED; PG8_LDA(At, 1, 0); PG8_STAGE(PG8_SA(0, 1), a2 + hstep, voffA);
            PG8_WAIT_L(8); PG8_BAR; PG8_WAIT_L(0); PG8_MMA(0, 0, At, B0); PG8_BAR; PG8_SCHED;
            PG8_LDB(B1, 1, 1); PG8_STAGE(PG8_SB(1, 0), b3, voffB);
            PG8_BAR; PG8_WAIT_L(0); PG8_MMA(0, 1, At, B1); PG8_BAR;
            PG8_LDA(At, 1, 1); PG8_STAGE(PG8_SA(1, 0), a3, voffA);
            PG8_BAR; PG8_WAIT_L(0); PG8_MMA(1, 0, At, B0); PG8_BAR; PG8_SCHED;
            PG8_STAGE(PG8_SB(1, 1), b3 + hstep, voffB);
            PG8_WAIT_V(6); PG8_BAR; PG8_MMA(1, 1, At, B1); PG8_BAR;
        }
        if constexpr (!Epi::AFTER_DRAIN) { E(acc, cur, wr, wc, fr, fq); S.done(cur); }
        if (!has_next) break;
#pragma unroll
        for (int a = 0; a < 2; ++a)
#pragma unroll
            for (int b = 0; b < 2; ++b)
#pragma unroll
                for (int m = 0; m < 4; ++m)
#pragma unroll
                    for (int n = 0; n < 2; ++n) acc[a][b][m][n] = (f32x4){0.f, 0.f, 0.f, 0.f};
        cur = nxt; cA = nA; cB = nB; ++ui;
    }
    PG8_WAIT_V(0);
    if (wr == 0) PG8_BAR;
    PG8_BAR;
    if constexpr (Epi::AFTER_DRAIN) { E.fused(acc, cur, wr, wc, fr, fq, lds, wid, lane); S.done(cur); }
#undef PG8_SA
#undef PG8_SB
#undef PG8_STAGE
#undef PG8_LDA
#undef PG8_LDB
#undef PG8_MMA
#undef PG8_WAIT_V
#undef PG8_WAIT_L
#undef PG8_BAR
#undef PG8_SCHED
}
}


using pg8::bf16_t; using pg8::bf16x8; using pg8::f32x4; using pg8::u32x4;
typedef short s16x4 __attribute__((ext_vector_type(4)));
typedef float f32x2 __attribute__((ext_vector_type(2)));
typedef float f32x16 __attribute__((ext_vector_type(16)));
typedef unsigned u32x2 __attribute__((ext_vector_type(2)));
typedef __bf16 bf16v2 __attribute__((ext_vector_type(2)));
#define LAS __attribute__((address_space(3)))
#define DI __device__ __forceinline__
#define XB_TMO      128
#define XB_XCNT(j)  (256  + 64 * (j))
#define XB_XSUB(j)  (1280 + 64 * (j))
#define XB_XGEN(j)  (2304 + 64 * (j))
#define XB_TOP      3328
#define XB_TOPGEN   3392
#define XCD_BAR_WORDS 3456
#define XB_SPIN_CAP (1u << 18)

__device__ __forceinline__ unsigned xb_ld(unsigned* p)              { return __hip_atomic_load(p, __ATOMIC_RELAXED, __HIP_MEMORY_SCOPE_AGENT); }
__device__ __forceinline__ unsigned xb_add(unsigned* p, unsigned v) { return __hip_atomic_fetch_add(p, v, __ATOMIC_RELAXED, __HIP_MEMORY_SCOPE_AGENT); }
__device__ __forceinline__ unsigned xb_xcc_id() { return (unsigned)__builtin_amdgcn_s_getreg((3 << 11) | 20) & 0xFu; }
#define XB_SPIN(cond, bar) do { unsigned _sp = 0; while (cond) { __builtin_amdgcn_s_sleep(1); \
    if ((++_sp & 255u) == 0u) { if (xb_ld(&(bar)[XB_TMO])) break; if (_sp > XB_SPIN_CAP) { atomicAdd(&(bar)[XB_TMO], 1u); break; } } } } while (0)

struct XcdBarrier {
    unsigned* bar; unsigned x;
    volatile LAS unsigned* st;
};

__device__ __forceinline__ XcdBarrier xcd_barrier_post(unsigned* bar, volatile LAS unsigned* st) {
    XcdBarrier b; b.bar = bar; b.x = xb_xcc_id(); b.st = st;
    if (threadIdx.x == 0) (void)xb_add(&bar[XB_XCNT(b.x)], 1u);
    return b;
}
__device__ __forceinline__ void xcd_barrier_complete(unsigned* bar, unsigned x, unsigned& nloc, unsigned& nx) {
    const unsigned G = (unsigned)nwg_now();
    unsigned sum, cnt, mine, sp = 0u;
    for (;;) {
        sum = 0u; cnt = 0u; mine = 0u;
#pragma unroll
        for (unsigned j = 0; j < 16; ++j) { const unsigned c = xb_ld(&bar[XB_XCNT(j)]); sum += c; cnt += (c > 0u) ? 1u : 0u; mine = (j == x) ? c : mine; }
        if (sum == G) break;
        __builtin_amdgcn_s_sleep(1);
        if ((++sp & 255u) == 0u) { if (xb_ld(&bar[XB_TMO])) break; if (sp > XB_SPIN_CAP) { atomicAdd(&bar[XB_TMO], 1u); break; } }
    }
    nloc = mine > 0u ? mine : 1u; nx = cnt > 0u ? cnt : 1u;
}

__device__ __forceinline__ void xcd_barrier(const XcdBarrier& b) {
    asm volatile("s_waitcnt vmcnt(0)" ::: "memory");
    __syncthreads();
    if (tid_now() == 0) {
        unsigned* bar = b.bar; unsigned bx = b.x; asm volatile("" : "+s"(bar), "+s"(bx));
        __builtin_amdgcn_s_waitcnt(0);
        unsigned nloc = b.st[0], nx = b.st[1];
        if (nloc == 0u) { xcd_barrier_complete(bar, bx, nloc, nx); b.st[0] = nloc; b.st[1] = nx; }
        const unsigned old = xb_add(&bar[XB_XSUB(bx)], 1u);
        const unsigned gen = old / nloc;
        if (old + 1u == (gen + 1u) * nloc) {
            __builtin_amdgcn_fence(__ATOMIC_RELEASE, "agent");
            asm volatile("s_waitcnt vmcnt(0)" ::: "memory");
            const unsigned og = xb_add(&bar[XB_TOP], 1u);
            const unsigned tg = og / nx;
            if (og + 1u == (tg + 1u) * nx) xb_add(&bar[XB_TOPGEN], 1u);
            else XB_SPIN(xb_ld(&bar[XB_TOPGEN]) == tg, bar);
            __builtin_amdgcn_fence(__ATOMIC_ACQUIRE, "agent");
            xb_add(&bar[XB_XGEN(bx)], 1u);
            asm volatile("s_waitcnt vmcnt(0)" ::: "memory");
        } else {
            XB_SPIN(xb_ld(&bar[XB_XGEN(bx)]) == gen, bar);
            __builtin_amdgcn_fence(__ATOMIC_ACQUIRE, "agent");
            asm volatile("s_waitcnt vmcnt(0)" ::: "memory");
        }
    }
    __syncthreads();
}


#define MFMA32(a, b, c) __builtin_amdgcn_mfma_f32_32x32x16_bf16((a), (b), (c), 0, 0, 0)

constexpr int T_ALL = 65536, SEQ = 2048, NGRP = 4, TG = 16384, BPG = 8, PLD = 4864;
constexpr float EPS = 1e-6f;
constexpr size_t SZ_GU = (size_t)5632 * 1024 * 2, SZ_D = (size_t)1024 * 2816 * 2;
constexpr size_t O_WGU1 = 0, O_WD1 = O_WGU1 + SZ_GU, O_WGU2 = O_WD1 + SZ_D, O_WD2 = O_WGU2 + SZ_GU, O_WIN = O_WD2 + SZ_D;
constexpr size_t O_WGATE = O_WIN + (size_t)4864 * 1024 * 2, O_WBR = O_WGATE + (size_t)4096 * 1024 * 2, O_WOUT = O_WBR + (size_t)4 * 1024 * 512 * 2;
constexpr size_t O_WQB = O_WOUT + (size_t)1024 * 1024 * 2, O_WKVB = O_WQB + (size_t)768 * 384 * 2, O_XN = O_WKVB + (size_t)1024 * 256 * 2;
constexpr size_t O_R0 = O_XN + (size_t)T_ALL * 1024 * 2;
constexpr size_t O_H = O_R0;
constexpr size_t O_PROJ = O_R0, O_XBCC = O_PROJ + (size_t)TG * PLD * 2, O_DTB = O_XBCC + (size_t)TG * 1024 * 2, O_AQ = O_DTB + (size_t)TG * 16 * 4;
constexpr size_t O_AKV = O_AQ + (size_t)TG * 384 * 2, O_QRAW = O_AKV + (size_t)TG * 256 * 2, O_KVRAW = O_QRAW + (size_t)TG * 768 * 2;
constexpr size_t O_QF = O_KVRAW + (size_t)TG * 1024 * 2, O_KF = O_QF + (size_t)TG * 768 * 2, O_VT = O_KF + (size_t)TG * 768 * 2;
constexpr size_t O_YRAW = O_VT + (size_t)TG * 512 * 2, O_YA = O_YRAW + (size_t)TG * 512 * 4;
constexpr size_t O_PB = O_YA + (size_t)4 * TG * 512 * 2, O_MIXB = O_PB + (size_t)4 * TG * 1024 * 2;
constexpr size_t O_ST = O_MIXB + (size_t)TG * 1024 * 2, O_ATOT = O_ST + (size_t)BPG * 16 * 8 * 8192 * 4;
constexpr size_t O_STB = O_ATOT + 4096;
constexpr size_t O_BAR = O_STB + (size_t)BPG * 16 * 8 * 8192 * 2;
constexpr size_t O_WQ = O_BAR + (size_t)XCD_BAR_WORDS * 4;
constexpr size_t ZERO_BYTES = (size_t)XCD_BAR_WORDS * 4 + 256;
constexpr size_t O_CS = O_WQ + 256 + 256 - ((size_t)XCD_BAR_WORDS * 4) % 256;
constexpr size_t O_SSQ = O_CS + (size_t)T_ALL * 32 * 8;
constexpr size_t O_END = O_SSQ + (size_t)3 * T_ALL * 16 * 4;
constexpr size_t O_END_H = O_H + (size_t)T_ALL * 2816 * 2;
constexpr size_t WS_NEED = O_END > O_END_H ? O_END : O_END_H;
constexpr int LDS_BYTES = 147456;

struct Params { const float* in[28]; float* out; unsigned char* ws; int only_phase; int pad; };

DI unsigned pk2(float a, float b) { f32x2 v = {a, b}; return __builtin_bit_cast(unsigned, __builtin_convertvector(v, bf16v2)); }
DI bf16_t f2bf(float a) { return (bf16_t)(pk2(a, 0.f) & 0xffffu); }
DI float bf2f(bf16_t b) { return __uint_as_float(((unsigned)b) << 16); }
DI float bflo(unsigned u) { return __uint_as_float(u << 16); }
DI float bfhi(unsigned u) { return __uint_as_float(u & 0xffff0000u); }
#define UNPACK8(v, f) do { f[0] = bflo(v.x); f[1] = bfhi(v.x); f[2] = bflo(v.y); f[3] = bfhi(v.y); f[4] = bflo(v.z); f[5] = bfhi(v.z); f[6] = bflo(v.w); f[7] = bfhi(v.w); } while (0)
#define PACK8(f) ((u32x4){pk2(f[0], f[1]), pk2(f[2], f[3]), pk2(f[4], f[5]), pk2(f[6], f[7])})
DI float wave_sum(float v) {
#pragma unroll
    for (int o = 1; o < 64; o <<= 1) v += __shfl_xor(v, o);
    return v;
}
DI float silu_f(float x) { return x * __builtin_amdgcn_rcpf(1.f + __builtin_amdgcn_exp2f(-1.4426950408889634f * x)); }
DI float sigmoid_f(float x) { return __builtin_amdgcn_rcpf(1.f + __builtin_amdgcn_exp2f(-1.4426950408889634f * x)); }
DI float gelu_f(float v) {
    const float t = __builtin_amdgcn_rcpf(fabsf(v) * 0.2316418882f + 1.0f);
    float q = t * 0.5307027145f + (-0.7265760135f); q = q * t + 0.7107068705f; q = q * t + (-0.142248368f); q = q * t + 0.127414796f; q = q * t;
    const float m = v * (q * __builtin_amdgcn_exp2f(v * v * (-0.72134752044f)));
    return v < 0.f ? m : v - m;
}
DI int crow(int i, int h) { return (i & 3) + 8 * (i >> 2) + 4 * h; }
DI void rows_rstd(const float* ssq, int row0, int fq, float (&rs)[2][4]) {
    f32x4 q[2][4];
#pragma unroll
    for (int ai = 0; ai < 2; ++ai)
#pragma unroll
        for (int m = 0; m < 4; ++m) q[ai][m] = ((const f32x4*)(ssq + (size_t)(row0 + ai * 128 + m * 16) * 16))[fq];
#pragma unroll
    for (int ai = 0; ai < 2; ++ai)
#pragma unroll
        for (int m = 0; m < 4; ++m) { float t = (q[ai][m][0] + q[ai][m][1]) + (q[ai][m][2] + q[ai][m][3]); t += __shfl_xor(t, 16); t += __shfl_xor(t, 32);
            rs[ai][m] = rsqrtf(t * (1.f / 1024.f) + EPS); }
}
struct EpiStore {
    static constexpr bool PERM = true, AFTER_DRAIN = false;
    bf16_t* O; int ldc; int pnmask; const float* ssq;
    DI void operator()(const f32x4 (&acc)[2][2][4][2], const pg8::Unit& u, int wr, int wc, int fr, int fq) const {
        const int row0 = u.pm * 256 + wr * 64 + fr, col0 = (u.pn & pnmask) * 256 + wc * 32 + 8 * fq;
        float rsv[2][4];
        if (ssq) rows_rstd(ssq, row0, fq, rsv);
        else {
#pragma unroll
            for (int ai = 0; ai < 2; ++ai)
#pragma unroll
                for (int m = 0; m < 4; ++m) rsv[ai][m] = 1.f; }
#pragma unroll
        for (int ai = 0; ai < 2; ++ai)
#pragma unroll
            for (int m = 0; m < 4; ++m) { bf16_t* rowp = O + (size_t)(row0 + ai * 128 + m * 16) * ldc + col0;
                const float rs = rsv[ai][m];
#pragma unroll
                for (int bj = 0; bj < 2; ++bj) { const f32x4 v0 = acc[ai][bj][m][0] * rs, v1 = acc[ai][bj][m][1] * rs;
                    u32x4 w; w.x = pk2(v0[0], v0[1]); w.y = pk2(v0[2], v0[3]); w.z = pk2(v1[0], v1[1]); w.w = pk2(v1[2], v1[3]);
                    *(u32x4*)(rowp + bj * 128) = w; } }
    }
};
struct EpiGU {
    static constexpr bool PERM = true, AFTER_DRAIN = false;
    bf16_t* H; const float* ssq;
    DI void operator()(const f32x4 (&acc)[2][2][4][2], const pg8::Unit& u, int wr, int wc, int fr, int fq) const {
        const int row0 = u.pm * 256 + wr * 64 + fr, col0 = u.pn * 128 + wc * 32 + 8 * fq;
        float rsv[2][4]; rows_rstd(ssq, row0, fq, rsv);
#pragma unroll
        for (int ai = 0; ai < 2; ++ai)
#pragma unroll
            for (int m = 0; m < 4; ++m) { bf16_t* rowp = H + (size_t)(row0 + ai * 128 + m * 16) * 2816 + col0;
                const float rs = rsv[ai][m];
                float o[8];
#pragma unroll
                for (int n = 0; n < 2; ++n)
#pragma unroll
                    for (int j = 0; j < 4; ++j) o[4 * n + j] = silu_f(acc[ai][0][m][n][j] * rs) * (acc[ai][1][m][n][j] * rs);
                *(u32x4*)rowp = PACK8(o); }
    }
};
struct EpiRes {
    static constexpr bool PERM = false, AFTER_DRAIN = false;
    bf16_t* XB; float* SSQ; float* OUT; float sc;
    DI void operator()(const f32x4 (&acc)[2][2][4][2], const pg8::Unit& u, int wr, int wc, int fr, int fq) const {
        const int row0 = u.pm * 256 + wr * 64 + fr, col0 = u.pn * 256 + wc * 32 + 4 * fq;
#pragma unroll
        for (int ai = 0; ai < 2; ++ai) {
            u32x2 xv[4][2][2];
#pragma unroll
            for (int m = 0; m < 4; ++m)
#pragma unroll
                for (int bj = 0; bj < 2; ++bj)
#pragma unroll
                    for (int n = 0; n < 2; ++n) xv[m][bj][n] = *(const u32x2*)(XB + (size_t)(row0 + ai * 128 + m * 16) * 1024 + col0 + bj * 128 + n * 16);
#pragma unroll
            for (int m = 0; m < 4; ++m) { const int row = row0 + ai * 128 + m * 16; const size_t ro = (size_t)row * 1024 + col0;
                float ss = 0.f;
#pragma unroll
                for (int bj = 0; bj < 2; ++bj)
#pragma unroll
                    for (int n = 0; n < 2; ++n) { const u32x2 xo = xv[m][bj][n]; const f32x4 a = acc[ai][bj][m][n];
                        const f32x4 v = {bflo(xo.x) + a[0] * sc, bfhi(xo.x) + a[1] * sc, bflo(xo.y) + a[2] * sc, bfhi(xo.y) + a[3] * sc};
                        if (OUT) *(f32x4*)(OUT + ro + bj * 128 + n * 16) = v;
                        else *(u32x2*)(XB + ro + bj * 128 + n * 16) = (u32x2){pk2(v[0], v[1]), pk2(v[2], v[3])};
                        ss += v[0] * v[0] + v[1] * v[1] + v[2] * v[2] + v[3] * v[3]; }
                ss += __shfl_xor(ss, 16); ss += __shfl_xor(ss, 32);
                if (fq == 0) SSQ[(size_t)row * 16 + u.pn * 4 + wc] = ss; }
        }
    }
};
struct EpiMerge {
    static constexpr bool PERM = false, AFTER_DRAIN = false;
    const bf16_t* P; bf16_t* MIX; const float* ssq;
    DI void operator()(const f32x4 (&acc)[2][2][4][2], const pg8::Unit& u, int wr, int wc, int fr, int fq) const {
        const int row0 = u.pm * 256 + wr * 64 + fr, e0 = u.pn * 64 + wc * 16 + 4 * fq;
        float rsv[2][4]; rows_rstd(ssq, row0, fq, rsv);
#pragma unroll
        for (int ai = 0; ai < 2; ++ai) {
            u32x2 pv[4][4];
#pragma unroll
            for (int m = 0; m < 4; ++m)
#pragma unroll
                for (int b = 0; b < 4; ++b) pv[m][b] = *(const u32x2*)(P + (size_t)b * TG * 1024 + (size_t)(row0 + ai * 128 + m * 16) * 1024 + e0);
#pragma unroll
            for (int m = 0; m < 4; ++m) { const float rs = rsv[ai][m];
                float o[4] = {0.f, 0.f, 0.f, 0.f};
#pragma unroll
                for (int bj = 0; bj < 2; ++bj)
#pragma unroll
                    for (int n = 0; n < 2; ++n) { const u32x2 q = pv[m][2 * bj + n]; const f32x4 g = acc[ai][bj][m][n] * rs;
                        o[0] += sigmoid_f(g[0]) * bflo(q.x); o[1] += sigmoid_f(g[1]) * bfhi(q.x); o[2] += sigmoid_f(g[2]) * bflo(q.y); o[3] += sigmoid_f(g[3]) * bfhi(q.y); }
                *(u32x2*)(MIX + (size_t)(row0 + ai * 128 + m * 16) * 1024 + e0) = (u32x2){pk2(o[0], o[1]), pk2(o[2], o[3])}; }
        }
    }
};
struct BranchOrder {
    int G, c;
    DI bool next(int i, pg8::Unit& u) const { const int L = i * G + c; if (L >= 1024) return false; const int br = L >> 8, rem = L & 255; u.pm = br * 64 + (rem >> 2); u.pn = br * 4 + (rem & 3); return true; }
    DI void a_ready(const pg8::Unit&) const {}
    DI void done(const pg8::Unit&) const {}
};
template <class Epi> DI void run_gemm(LAS unsigned char* lds, const bf16_t* A, const bf16_t* Bt, int M, int N, int K, const Epi& E) {
    pg8::Gemm g{A, Bt, M, N, K}; pg8::StaticOrder S; S.init(M, N, nwg_now(), wg_now());
    pg8::gemm_phase<Epi, pg8::StaticOrder>(lds, g, S, E);
}

DI void conv_mat(const float* src, int ld, int c0, int nvalid, int kvalid, int mode, bf16_t* dst, int Nd, int Kd, LAS float* scr, int wg, int nwg, const float* ksc = nullptr, const int use_ksc = 0) {
    const int tid = tid_now(); const int ntk = Kd >> 6, ntiles = (Nd >> 6) * ntk;
    for (int tile = wg; tile < ntiles; tile += nwg) {
        const int n0 = (tile / ntk) << 6, k0 = (tile % ntk) << 6;
        const int nn = tid & 63, kq = tid >> 6, n = n0 + nn;
        int col;
        if (mode == 1) { const int blk = n >> 7; col = ((blk & 1) ? 2816 : 0) + (blk >> 1) * 128 + (n & 127); }
        else if (mode == 2) { const int c = n & 255, br = 2 * (c >> 7) + ((c >> 4) & 1), e = 64 * (n >> 8) + 16 * ((c >> 5) & 3) + (c & 15); col = c0 + br * 1024 + e; }
        else col = c0 + n;
#pragma unroll
        for (int i = 0; i < 8; ++i) { const int kk = i * 8 + kq; float v = 0.f;
            if (k0 + kk < kvalid && n < nvalid) { v = src[(size_t)(k0 + kk) * ld + col]; if (use_ksc) v *= ksc[k0 + kk]; }
            scr[kk * 65 + nn] = v; }
        __syncthreads();
        { const int nr = tid >> 3, kc = tid & 7; const LAS float* sp = scr + (kc * 8) * 65 + nr;
          u32x4 o; o.x = pk2(sp[0], sp[65]); o.y = pk2(sp[130], sp[195]); o.z = pk2(sp[260], sp[325]); o.w = pk2(sp[390], sp[455]);
          *(u32x4*)(dst + (size_t)(n0 + nr) * Kd + k0 + kc * 8) = o; }
        __syncthreads();
    }
}
DI void convert_layer(const Params& p, int l, LAS float* scr, int wg, int nwg) {
    unsigned char* ws = p.ws;
    conv_mat(p.in[3] + (size_t)l * 1024 * 5632, 5632, 0, 5632, 1024, 1, (bf16_t*)(ws + O_WGU1), 5632, 1024, scr, wg, nwg, p.in[2] + l * 1024, 1);
    conv_mat(p.in[26] + (size_t)l * 1024 * 5632, 5632, 0, 5632, 1024, 1, (bf16_t*)(ws + O_WGU2), 5632, 1024, scr, wg, nwg, p.in[25] + l * 1024, 1);
    conv_mat(p.in[4] + (size_t)l * 2816 * 1024, 1024, 0, 1024, 2816, 0, (bf16_t*)(ws + O_WD1), 1024, 2816, scr, wg, nwg);
    conv_mat(p.in[27] + (size_t)l * 2816 * 1024, 1024, 0, 1024, 2816, 0, (bf16_t*)(ws + O_WD2), 1024, 2816, scr, wg, nwg);
    conv_mat(p.in[6] + (size_t)l * 1024 * 8776, 8776, 0, 4680, 1024, 0, (bf16_t*)(ws + O_WIN), 4864, 1024, scr, wg, nwg, p.in[5] + l * 1024, 1);
    conv_mat(p.in[6] + (size_t)l * 1024 * 8776, 8776, 4680, 4096, 1024, 2, (bf16_t*)(ws + O_WGATE), 4096, 1024, scr, wg, nwg, p.in[5] + l * 1024, 1);
#pragma unroll 1
    for (int i = 0; i < 4; ++i)
        conv_mat(p.in[23] + ((size_t)l * 4 + i) * 512 * 1024, 1024, 0, 1024, 512, 0, (bf16_t*)(ws + O_WBR) + (size_t)i * 1024 * 512, 1024, 512, scr, wg, nwg);
    conv_mat(p.in[24] + (size_t)l * 1024 * 1024, 1024, 0, 1024, 1024, 0, (bf16_t*)(ws + O_WOUT), 1024, 1024, scr, wg, nwg);
    conv_mat(p.in[17] + (size_t)l * 384 * 768, 768, 0, 768, 384, 0, (bf16_t*)(ws + O_WQB), 768, 384, scr, wg, nwg);
    conv_mat(p.in[19] + (size_t)l * 128 * 1024, 1024, 0, 1024, 128, 0, (bf16_t*)(ws + O_WKVB), 1024, 256, scr, wg, nwg);
}

DI void init_rows(const float* x, bf16_t* xb, float* ssq) {
    const int tidn = tid_now(); const int lane = tidn & 63, gwave = wg_now() * 8 + (tidn >> 6), ngw = nwg_now() * 8;
    for (int row = gwave; row < T_ALL; row += ngw) {
        const f32x4* xr = (const f32x4*)(x + (size_t)row * 1024);
        f32x4 v[4]; float ss = 0.f;
#pragma unroll
        for (int j = 0; j < 4; ++j) { v[j] = xr[lane + 64 * j]; ss += v[j][0] * v[j][0] + v[j][1] * v[j][1] + v[j][2] * v[j][2] + v[j][3] * v[j][3]; }
        ss = wave_sum(ss);
        u32x2* o = (u32x2*)(xb + (size_t)row * 1024);
#pragma unroll
        for (int j = 0; j < 4; ++j) o[lane + 64 * j] = (u32x2){pk2(v[j][0], v[j][1]), pk2(v[j][2], v[j][3])};
        if (lane < 16) ssq[(size_t)row * 16 + lane] = lane == 0 ? ss : 0.f;
    }
}
DI void zero_f32(float* q, int n) { const int tidn = tid_now(); for (int i = wg_now() * 512 + tidn; i < n; i += nwg_now() * 512) q[i] = 0.f; }

DI void prep1(const Params& p, int l, const bf16_t* __restrict__ proj, bf16_t* __restrict__ xbcc, float* __restrict__ dtb, bf16_t* __restrict__ aq, bf16_t* __restrict__ akv, bf16_t* __restrict__ yd) {
    const int tidn = tid_now(); const int gtid = wg_now() * 512 + tidn, gthreads = nwg_now() * 512;
    const float* cw = p.in[7] + l * 4096; const float* cb = p.in[8] + l * 1024;
    for (int idx = gtid; idx < (TG / 16) * 128; idx += gthreads) {
        const int c8 = (idx & 127) << 3, tl0 = (idx >> 7) << 4, s0 = tl0 & 2047;
        float w[4][8], bb[8], r0[8], r1[8], r2[8];
#pragma unroll
        for (int k = 0; k < 4; ++k) { const f32x4 a = *(const f32x4*)(cw + k * 1024 + c8), b = *(const f32x4*)(cw + k * 1024 + c8 + 4);
#pragma unroll
            for (int j = 0; j < 4; ++j) { w[k][j] = a[j]; w[k][4 + j] = b[j]; } }
        { const f32x4 a = *(const f32x4*)(cb + c8), b = *(const f32x4*)(cb + c8 + 4);
#pragma unroll
          for (int j = 0; j < 4; ++j) { bb[j] = a[j]; bb[4 + j] = b[j]; } }
        const bf16_t* src = proj + (size_t)tl0 * PLD + 512 + c8;
        if (s0 > 0) { const u32x4 v0 = *(const u32x4*)(src - 3 * PLD), v1 = *(const u32x4*)(src - 2 * PLD), v2 = *(const u32x4*)(src - PLD); UNPACK8(v0, r0); UNPACK8(v1, r1); UNPACK8(v2, r2); }
        else {
#pragma unroll
            for (int j = 0; j < 8; ++j) { r0[j] = 0.f; r1[j] = 0.f; r2[j] = 0.f; } }
#pragma unroll 8
        for (int tt = 0; tt < 16; ++tt) {
            const u32x4 v = *(const u32x4*)(src + (size_t)tt * PLD); float cur[8], o[8]; UNPACK8(v, cur);
#pragma unroll
            for (int j = 0; j < 8; ++j) { o[j] = silu_f(bb[j] + w[0][j] * r0[j] + w[1][j] * r1[j] + w[2][j] * r2[j] + w[3][j] * cur[j]); r0[j] = r1[j]; r1[j] = r2[j]; r2[j] = cur[j]; }
            *(u32x4*)(xbcc + (size_t)(tl0 + tt) * 1024 + c8) = PACK8(o);
        }
    }
    const float* sw = p.in[22] + l * 1536;
    for (int idx = gtid; idx < (TG / 16) * 64; idx += gthreads) {
        const int c8 = (idx & 63) << 3, tl0 = (idx >> 6) << 4, s0 = tl0 & 2047;
        float w[3][8], p1[8], p2[8];
#pragma unroll
        for (int k = 0; k < 3; ++k) { const f32x4 a = *(const f32x4*)(sw + k * 512 + c8), b = *(const f32x4*)(sw + k * 512 + c8 + 4);
#pragma unroll
            for (int j = 0; j < 4; ++j) { w[k][j] = a[j]; w[k][4 + j] = b[j]; } }
        const bf16_t* src = proj + (size_t)tl0 * PLD + c8;
        if (s0 > 0) { const u32x4 c1 = *(const u32x4*)(src - 2 * PLD + 3656), x1 = *(const u32x4*)(src - 2 * PLD + 4168), c2 = *(const u32x4*)(src - PLD + 3656), x2 = *(const u32x4*)(src - PLD + 4168);
            float a[8], b[8]; UNPACK8(c1, a); UNPACK8(x1, b);
#pragma unroll
            for (int j = 0; j < 8; ++j) p1[j] = a[j] * b[j];
            UNPACK8(c2, a); UNPACK8(x2, b);
#pragma unroll
            for (int j = 0; j < 8; ++j) p2[j] = a[j] * b[j]; }
        else {
#pragma unroll
            for (int j = 0; j < 8; ++j) { p1[j] = 0.f; p2[j] = 0.f; } }
#pragma unroll 8
        for (int tt = 0; tt < 16; ++tt) {
            const bf16_t* pr = src + (size_t)tt * PLD;
            const u32x4 vc = *(const u32x4*)(pr + 3656), vx = *(const u32x4*)(pr + 4168), vb = *(const u32x4*)(pr + 3144);
            float fc[8], fx[8], fb[8], o[8]; UNPACK8(vc, fc); UNPACK8(vx, fx); UNPACK8(vb, fb);
#pragma unroll
            for (int j = 0; j < 8; ++j) { const float cur = fc[j] * fx[j]; o[j] = fb[j] * (w[0][j] * p1[j] + w[1][j] * p2[j] + w[2][j] * cur); p1[j] = p2[j]; p2[j] = cur; }
            *(u32x4*)(yd + (size_t)(tl0 + tt) * 512 + c8) = PACK8(o);
        }
    }
    const int gwave = gtid >> 6, ngw = gthreads >> 6, lane = tidn & 63;
    const float* qn = p.in[16] + l * 384; const float* kn = p.in[18] + l * 128;
#pragma unroll 4
    for (int tl = gwave; tl < TG; tl += ngw) {
        const bf16_t* pr = proj + (size_t)tl * PLD;
        const u32x4 v = *(const u32x4*)(pr + 2568 + lane * 8); float f[8]; UNPACK8(v, f);
        float ss = 0.f;
#pragma unroll
        for (int j = 0; j < 8; ++j) ss += f[j] * f[j];
        const float ssq = wave_sum(lane < 48 ? ss : 0.f), ssk = wave_sum(lane >= 48 ? ss : 0.f);
        if (lane < 48) {
            const float rstd = rsqrtf(ssq * (1.f / 384.f) + EPS);
#pragma unroll
            for (int j = 0; j < 8; ++j) f[j] *= rstd * qn[lane * 8 + j];
            *(u32x4*)(aq + (size_t)tl * 384 + lane * 8) = PACK8(f);
        } else {
            const float rstd = rsqrtf(ssk * (1.f / 128.f) + EPS);
#pragma unroll
            for (int j = 0; j < 8; ++j) f[j] *= rstd * kn[(lane - 48) * 8 + j];
            *(u32x4*)(akv + (size_t)tl * 256 + (lane - 48) * 8) = PACK8(f);
            { unsigned z = 0u; asm volatile("" : "+v"(z)); *(u32x4*)(akv + (size_t)tl * 256 + 128 + (lane - 48) * 8) = (u32x4){z, z, z, z}; }
        }
        if (lane < 8) {
            const float xr = bf2f(pr[1536 + lane]) + p.in[9][l * 8 + lane];
            const float dt = xr > 20.f ? xr : log1pf(expf(xr));
            const float A = -expf(p.in[10][l * 8 + lane]);
            dtb[(size_t)tl * 16 + lane] = dt; dtb[(size_t)tl * 16 + 8 + lane] = dt * A;
        }
    }
}

DI void rope_table(const Params& p, f32x2* CS) {
    const int* pos = (const int*)p.in[1];
    const int tidn = tid_now();
    for (int idx = wg_now() * 512 + tidn; idx < T_ALL * 32; idx += nwg_now() * 512) {
        const float invf = exp2f(-(float)(idx & 31) * (13.287712379549449f / 32.f));
        const float ang = (float)pos[idx >> 5] * invf;
        CS[idx] = (f32x2){cosf(ang), sinf(ang)};
    }
}
DI void prep2_unit(const Params& p, int l, int g, const bf16_t* __restrict__ proj, const bf16_t* __restrict__ qraw, const bf16_t* __restrict__ kvraw, const f32x2* __restrict__ CSt, bf16_t* __restrict__ Qf, bf16_t* __restrict__ Kf, bf16_t* __restrict__ Vt, int bl, int tile, LAS unsigned char* lds) {
    const int tid = tid_now(), wave = tid >> 6, lane = tid & 63;
    const float* wq = p.in[20] + l * 192; const float* wk = p.in[21] + l * 192;
    const float qscale = 0.07216878364870322f * 1.4426950408889634f;
    const float wq0 = wq[lane], wq1 = wq[64 + lane], wq2 = wq[128 + lane], wk0 = wk[lane], wk1 = wk[64 + lane], wk2 = wk[128 + lane];
    LAS bf16_t* img = (LAS bf16_t*)lds;
    const int t0 = tile * 64;
#pragma unroll 4
    for (int tt = 0; tt < 8; ++tt) {
        const int tloc = wave * 8 + tt, s = t0 + tloc; const size_t tl = (size_t)bl * SEQ + s;
        const f32x2 cssn = CSt[((size_t)(g * BPG + bl) * SEQ + s) * 32 + (lane & 31)];
        const float cs = cssn[0], sn = cssn[1];
        const float kpe = bf2f(proj[tl * PLD + 3080 + lane]);
#pragma unroll
        for (int h = 0; h < 4; ++h) {
            const size_t ob = ((size_t)(bl * 4 + h) * SEQ + s) * 192;
            {
                const bf16_t* qr = qraw + tl * 768 + h * 192;
                float q0 = bf2f(qr[lane]), q1 = bf2f(qr[64 + lane]), q2 = bf2f(qr[128 + lane]);
                const float r = rsqrtf(wave_sum(q0 * q0 + q1 * q1 + q2 * q2) * (1.f / 192.f) + EPS);
                q0 *= r * wq0; q1 *= r * wq1; q2 *= r * wq2;
                const float qp = __shfl_xor(q2, 32);
                q2 = (lane < 32) ? q2 * cs - qp * sn : q2 * cs + qp * sn;
                bf16_t* qo = Qf + ob;
                qo[lane] = f2bf(q0 * qscale); qo[64 + lane] = f2bf(q1 * qscale); qo[128 + lane] = f2bf(q2 * qscale);
            }
            const bf16_t* kr = kvraw + tl * 1024 + h * 256;
            {
                float k0 = bf2f(kr[lane]), k1 = bf2f(kr[64 + lane]), k2 = kpe;
                const float r = rsqrtf(wave_sum(k0 * k0 + k1 * k1 + k2 * k2) * (1.f / 192.f) + EPS);
                k0 *= r * wk0; k1 *= r * wk1; k2 *= r * wk2;
                const float kp = __shfl_xor(k2, 32);
                k2 = (lane < 32) ? k2 * cs - kp * sn : k2 * cs + kp * sn;
                bf16_t* ko = Kf + ob;
                ko[lane] = f2bf(k0); ko[64 + lane] = f2bf(k1); ko[128 + lane] = f2bf(k2);
            }
            img[(h * 128 + lane) * 72 + tloc] = kr[128 + lane]; img[(h * 128 + 64 + lane) * 72 + tloc] = kr[192 + lane];
        }
    }
    __syncthreads();
#pragma unroll
    for (int i = 0; i < 8; ++i) {
        const int ch = tid + 512 * i, row = ch >> 3, cc = ch & 7;
        *(u32x4*)(Vt + ((size_t)(bl * 4 + (row >> 7)) * 128 + (row & 127)) * SEQ + t0 + cc * 8) = *(const LAS u32x4*)(lds + row * 144 + cc * 16);
    }
    __syncthreads();
}

constexpr int KP = 400, VP = 136, KBYTES = 64 * KP, VBYTES = 128 * VP, ASTAGE = KBYTES + VBYTES;
DI void attn_unit(const bf16_t* Qf, const bf16_t* Kf, const bf16_t* Vt, bf16_t* yc, int bh, int qb, LAS unsigned char* lds) {
    const int tid = tid_now(), wave = tid >> 6, lane = tid & 63, r31 = lane & 31, hh = lane >> 5;
    const int q0 = qb * 256, qrow = q0 + wave * 32 + r31;
    const bf16_t* Qp = Qf + ((size_t)bh * SEQ + qrow) * 192 + 8 * hh;
    bf16x8 qf[12];
#pragma unroll
    for (int kk = 0; kk < 12; ++kk) qf[kk] = *(const bf16x8*)(Qp + kk * 16);
    f32x16 o[4];
#pragma unroll
    for (int d = 0; d < 4; ++d)
#pragma unroll
        for (int i = 0; i < 16; ++i) o[d][i] = 0.f;
    float m = -1e30f, l = 0.f;
    const int ntiles = qb * 4 + 4;
    const bf16_t* Kb = Kf + (size_t)bh * SEQ * 192; const bf16_t* Vb = Vt + (size_t)bh * 128 * SEQ;
    int krow[3], kcc[3], vd[2], vcc[2];
#pragma unroll
    for (int i = 0; i < 3; ++i) { const int c = tid + 512 * i; krow[i] = c / 24; kcc[i] = c % 24; }
#pragma unroll
    for (int i = 0; i < 2; ++i) { const int c = tid + 512 * i; vd[i] = c >> 3; vcc[i] = c & 7; }
    u32x4 kA[3], vA[2], kB[3], vB[2];
#define ATT_GLOAD(j, kreg, vreg) do { _Pragma("unroll") for (int i = 0; i < 3; ++i) kreg[i] = *(const u32x4*)(Kb + (size_t)((j) * 64 + krow[i]) * 192 + kcc[i] * 8); \
        _Pragma("unroll") for (int i = 0; i < 2; ++i) vreg[i] = *(const u32x4*)(Vb + (size_t)vd[i] * SEQ + (j) * 64 + vcc[i] * 8); } while (0)
#define ATT_LSTORE(st, kreg, vreg) do { LAS unsigned char* b_ = lds + (st) * ASTAGE; \
        _Pragma("unroll") for (int i = 0; i < 3; ++i) *(LAS u32x4*)(b_ + krow[i] * KP + kcc[i] * 16) = kreg[i]; \
        _Pragma("unroll") for (int i = 0; i < 2; ++i) { LAS u32x2* d_ = (LAS u32x2*)(b_ + KBYTES + vd[i] * VP + vcc[i] * 16); d_[0] = (u32x2){vreg[i].x, vreg[i].y}; d_[1] = (u32x2){vreg[i].z, vreg[i].w}; } } while (0)
    auto compute = [&](const int j, const int cur) __attribute__((always_inline)) {
        if (j * 64 <= q0 + wave * 32 + 31) {
            const LAS unsigned char* Kl = lds + cur * ASTAGE; const LAS unsigned char* Vl = Kl + KBYTES;
            f32x16 s0, s1;
#pragma unroll
            for (int i = 0; i < 16; ++i) { s0[i] = 0.f; s1[i] = 0.f; }
#pragma unroll
            for (int kk = 0; kk < 12; ++kk) {
                const bf16x8 a0 = *(const LAS bf16x8*)(Kl + r31 * KP + (kk * 16 + 8 * hh) * 2);
                const bf16x8 a1 = *(const LAS bf16x8*)(Kl + (32 + r31) * KP + (kk * 16 + 8 * hh) * 2);
                s0 = MFMA32(a0, qf[kk], s0); s1 = MFMA32(a1, qf[kk], s1);
            }
            if (j * 64 + 63 > q0 + wave * 32) {
#pragma unroll
                for (int i = 0; i < 16; ++i) { const int key = j * 64 + crow(i, hh); if (key > qrow) s0[i] = -1e30f; if (key + 32 > qrow) s1[i] = -1e30f; }
            }
            float mx = s0[0];
#pragma unroll
            for (int i = 1; i < 16; ++i) mx = fmaxf(mx, s0[i]);
#pragma unroll
            for (int i = 0; i < 16; ++i) mx = fmaxf(mx, s1[i]);
            mx = fmaxf(mx, __shfl_xor(mx, 32));
            const float mn = fmaxf(m, mx);
            if (__ballot(mx > m) != 0ull) {
                const float alpha = __builtin_amdgcn_exp2f(m - mn);
                l *= alpha;
#pragma unroll
                for (int d = 0; d < 4; ++d)
#pragma unroll
                    for (int i = 0; i < 16; ++i) o[d][i] *= alpha;
            }
            m = mn;
            float ls = 0.f;
#pragma unroll
            for (int i = 0; i < 16; ++i) { s0[i] = __builtin_amdgcn_exp2f(s0[i] - mn); s1[i] = __builtin_amdgcn_exp2f(s1[i] - mn); ls += s0[i] + s1[i]; }
            l += ls;
            bf16x8 pf[2][2];
#pragma unroll
            for (int s = 0; s < 2; ++s) {
                u32x4 w0, w1;
                w0.x = pk2(s0[8 * s], s0[8 * s + 1]); w0.y = pk2(s0[8 * s + 2], s0[8 * s + 3]); w0.z = pk2(s0[8 * s + 4], s0[8 * s + 5]); w0.w = pk2(s0[8 * s + 6], s0[8 * s + 7]);
                w1.x = pk2(s1[8 * s], s1[8 * s + 1]); w1.y = pk2(s1[8 * s + 2], s1[8 * s + 3]); w1.z = pk2(s1[8 * s + 4], s1[8 * s + 5]); w1.w = pk2(s1[8 * s + 6], s1[8 * s + 7]);
                pf[0][s] = __builtin_bit_cast(bf16x8, w0); pf[1][s] = __builtin_bit_cast(bf16x8, w1);
            }
#pragma unroll
            for (int d = 0; d < 4; ++d)
#pragma unroll
                for (int kb = 0; kb < 2; ++kb)
#pragma unroll
                    for (int s = 0; s < 2; ++s) {
                        const LAS unsigned char* vp = Vl + (d * 32 + r31) * VP + (kb * 32 + 16 * s + 4 * hh) * 2;
                        const s16x4 lo = *(const LAS s16x4*)vp, hi = *(const LAS s16x4*)(vp + 16);
                        const bf16x8 a = __builtin_shufflevector(lo, hi, 0, 1, 2, 3, 4, 5, 6, 7);
                        o[d] = MFMA32(a, pf[kb][s], o[d]);
                    }
        }
    };
    ATT_GLOAD(0, kA, vA); ATT_LSTORE(0, kA, vA); ATT_GLOAD(1, kB, vB);
    __syncthreads();
#pragma unroll 1
    for (int j = 0; j < ntiles; j += 2) {
        if (j + 2 < ntiles) ATT_GLOAD(j + 2, kA, vA);
        compute(j, 0);
        ATT_LSTORE(1, kB, vB);
        __syncthreads();
        if (j + 3 < ntiles) ATT_GLOAD(j + 3, kB, vB);
        compute(j + 1, 1);
        if (j + 2 < ntiles) ATT_LSTORE(0, kA, vA);
        __syncthreads();
    }
#undef ATT_GLOAD
#undef ATT_LSTORE
    l += __shfl_xor(l, 32);
    const float inv = 1.f / l;
    const int bl = bh >> 2, h = bh & 3;
    bf16_t* op = yc + ((size_t)bl * SEQ + qrow) * 512 + h * 128 + 4 * hh;
#pragma unroll
    for (int d = 0; d < 4; ++d)
#pragma unroll
        for (int i4 = 0; i4 < 4; ++i4)
            *(u32x2*)(op + d * 32 + 8 * i4) = (u32x2){pk2(o[d][4 * i4] * inv, o[d][4 * i4 + 1] * inv), pk2(o[d][4 * i4 + 2] * inv, o[d][4 * i4 + 3] * inv)};
}

DI void gmlp_unit(const Params& p, int l, const bf16_t* __restrict__ proj, bf16_t* __restrict__ yb, int bl, int c, LAS unsigned char* lds) {
    const int tid = tid_now(), wave = tid >> 6, lane = tid & 63, r31 = lane & 31, hh = lane >> 5;
    const float* wsp = p.in[14] + (size_t)l * 4 * 128 * 128; const float* bs = p.in[15] + l * 512; const float* vn = p.in[13] + l * 512;
    const size_t tl0 = (size_t)bl * SEQ + c * 128;
    float w8[8];
#pragma unroll
    for (int j = 0; j < 8; ++j) w8[j] = vn[lane + 64 * j];
    LAS bf16_t* vt = (LAS bf16_t*)lds;
#pragma unroll 8
    for (int rr = 0; rr < 16; ++rr) {
        const int row = wave * 16 + rr;
        const bf16_t* vr = proj + (tl0 + row) * PLD + 2056 + lane;
        float f[8]; float ss = 0.f;
#pragma unroll
        for (int j = 0; j < 8; ++j) { f[j] = gelu_f(bf2f(vr[64 * j])); ss += f[j] * f[j]; }
        const float rstd = rsqrtf(wave_sum(ss) * (1.f / 512.f) + EPS);
#pragma unroll
        for (int j = 0; j < 8; ++j) vt[(lane + 64 * j) * 136 + row] = f2bf(f[j] * rstd * w8[j]);
    }
    __syncthreads();
    const int mb = wave & 3, nh = wave >> 2, trow = mb * 32 + r31;
#pragma unroll 1
    for (int g = 0; g < 4; ++g) {
        f32x16 a0, a1;
#pragma unroll
        for (int i = 0; i < 16; ++i) { a0[i] = 0.f; a1[i] = 0.f; }
        const float* wrow = wsp + ((size_t)g * 128 + trow) * 128 + 8 * hh;
#pragma unroll
        for (int kk = 0; kk < 8; ++kk) if (kk * 16 <= mb * 32 + 31) {
            const f32x4 x0 = *(const f32x4*)(wrow + kk * 16), x1 = *(const f32x4*)(wrow + kk * 16 + 4);
            const int sb = kk * 16 + 8 * hh;
            float f[8];
#pragma unroll
            for (int j = 0; j < 4; ++j) { f[j] = (sb + j <= trow) ? x0[j] : 0.f; f[4 + j] = (sb + 4 + j <= trow) ? x1[j] : 0.f; }
            const bf16x8 a = __builtin_bit_cast(bf16x8, PACK8(f));
            const bf16x8 b0 = *(const LAS bf16x8*)(vt + (g * 128 + nh * 64 + r31) * 136 + kk * 16 + 8 * hh);
            const bf16x8 b1 = *(const LAS bf16x8*)(vt + (g * 128 + nh * 64 + 32 + r31) * 136 + kk * 16 + 8 * hh);
            a0 = MFMA32(a, b0, a0); a1 = MFMA32(a, b1, a1);
        }
        __syncthreads();
        LAS bf16_t* og = vt + (g * 128) * 136;
#pragma unroll
        for (int i = 0; i < 16; ++i) {
            const int t = mb * 32 + crow(i, hh); const float bias = bs[g * 128 + t];
            og[t * 136 + nh * 64 + r31] = f2bf(a0[i] + bias); og[t * 136 + nh * 64 + 32 + r31] = f2bf(a1[i] + bias);
        }
        __syncthreads();
#pragma unroll
        for (int k = 0; k < 4; ++k) {
            const int ch = tid + 512 * k, t = ch >> 4, d8 = (ch & 15) * 8;
            const u32x4 sv = *(const LAS u32x4*)(og + t * 136 + d8);
            const u32x4 uv = *(const u32x4*)(proj + (tl0 + t) * PLD + 1544 + g * 128 + d8);
            float fs[8], fu[8]; UNPACK8(sv, fs); UNPACK8(uv, fu);
#pragma unroll
            for (int j = 0; j < 8; ++j) fu[j] = gelu_f(fu[j]) * fs[j];
            *(u32x4*)(yb + (tl0 + t) * 512 + g * 128 + d8) = PACK8(fu);
        }
    }
    __syncthreads();
}

constexpr int SP = 136;
DI void scan128(float& v0, float& v1, int lane) {
#pragma unroll
    for (int o = 1; o < 64; o <<= 1) { const float n0 = __shfl_up(v0, o), n1 = __shfl_up(v1, o); if (lane >= o) { v0 += n0; v1 += n1; } }
    v1 += __shfl(v0, 63);
}
DI void ssd_states_unit(const bf16_t* xbcc, const float* dtb, float* ST, float* ATOT, int bl, int c, int grp, LAS unsigned char* lds) {
    const int tid = tid_now(), wave = tid >> 6, lane = tid & 63, r31 = lane & 31, hh = lane >> 5;
    LAS bf16_t* BT = (LAS bf16_t*)lds; LAS bf16_t* XT = (LAS bf16_t*)(lds + 34816); LAS float* WS = (LAS float*)(lds + 104448);
    const size_t row0 = (size_t)bl * SEQ + c * 128;
    if (wave < 4) {
        const int h = grp * 4 + wave;
        const float d0 = dtb[(row0 + lane) * 16 + h], d1 = dtb[(row0 + 64 + lane) * 16 + h];
        float v0 = dtb[(row0 + lane) * 16 + 8 + h], v1 = dtb[(row0 + 64 + lane) * 16 + 8 + h];
        scan128(v0, v1, lane);
        const float tot = __shfl(v1, 63);
        WS[wave * 128 + lane] = d0 * __expf(tot - v0); WS[wave * 128 + 64 + lane] = d1 * __expf(tot - v1);
        if (lane == 0) ATOT[(bl * 16 + c) * 8 + h] = tot;
    }
    __syncthreads();
#pragma unroll
    for (int i = 0; i < 4; ++i) {
        const int ch = tid + 512 * i, s = ch >> 4, n8 = (ch & 15) * 8;
        const u32x4 v = *(const u32x4*)(xbcc + (row0 + s) * 1024 + 512 + grp * 128 + n8);
        LAS bf16_t* d = BT + n8 * SP + s;
        d[0] = (bf16_t)(v.x & 0xffffu); d[SP] = (bf16_t)(v.x >> 16); d[2 * SP] = (bf16_t)(v.y & 0xffffu); d[3 * SP] = (bf16_t)(v.y >> 16);
        d[4 * SP] = (bf16_t)(v.z & 0xffffu); d[5 * SP] = (bf16_t)(v.z >> 16); d[6 * SP] = (bf16_t)(v.w & 0xffffu); d[7 * SP] = (bf16_t)(v.w >> 16);
    }
#pragma unroll
    for (int i = 0; i < 8; ++i) {
        const int ch = tid + 512 * i, s = ch >> 5, c8 = (ch & 31) * 8;
        const u32x4 v = *(const u32x4*)(xbcc + (row0 + s) * 1024 + grp * 256 + c8); float f[8]; UNPACK8(v, f);
        const float w = WS[(c8 >> 6) * 128 + s];
        LAS bf16_t* d = XT + c8 * SP + s;
#pragma unroll
        for (int j = 0; j < 8; ++j) d[j * SP] = f2bf(f[j] * w);
    }
    __syncthreads();
    const int hl = wave >> 1, pb = wave & 1;
    f32x16 acc[4];
#pragma unroll
    for (int nb = 0; nb < 4; ++nb)
#pragma unroll
        for (int i = 0; i < 16; ++i) acc[nb][i] = 0.f;
#pragma unroll
    for (int k = 0; k < 8; ++k) {
        const bf16x8 a = *(const LAS bf16x8*)(XT + (hl * 64 + pb * 32 + r31) * SP + k * 16 + 8 * hh);
#pragma unroll
        for (int nb = 0; nb < 4; ++nb) { const bf16x8 b = *(const LAS bf16x8*)(BT + (nb * 32 + r31) * SP + k * 16 + 8 * hh); acc[nb] = MFMA32(a, b, acc[nb]); }
    }
    float* so = ST + (((size_t)bl * 16 + c) * 8 + grp * 4 + hl) * 8192;
#pragma unroll
    for (int nb = 0; nb < 4; ++nb)
#pragma unroll
        for (int i = 0; i < 16; ++i) so[(pb * 32 + crow(i, hh)) * 128 + nb * 32 + r31] = acc[nb][i];
    __syncthreads();
}
DI void ssd_scan(const float* ST, bf16_t* STB, const float* ATOT) {
    const int tidn = tid_now();
    for (int idx = wg_now() * 512 + tidn; idx < 64 * 2048; idx += nwg_now() * 512) {
        const int bh = idx >> 11, e4 = idx & 2047, bl = bh >> 3, head = bh & 7;
        const size_t off = ((size_t)bl * 16 * 8 + head) * 8192 + e4 * 4;
        f32x4 sv[16];
#pragma unroll
        for (int c = 0; c < 16; ++c) sv[c] = *(const f32x4*)(ST + off + (size_t)c * 8 * 8192);
        f32x4 run = {0.f, 0.f, 0.f, 0.f};
#pragma unroll
        for (int c = 0; c < 16; ++c) { const float ea = __expf(ATOT[(bl * 16 + c) * 8 + head]);
            *(u32x2*)(STB + off + (size_t)c * 8 * 8192) = (u32x2){pk2(run[0], run[1]), pk2(run[2], run[3])}; run = run * ea + sv[c]; }
    }
}
DI void ssd_out_grp(const Params& p, int l, const bf16_t* proj, const bf16_t* xbcc, const float* dtb, const bf16_t* STB, float* yraw, bf16_t* ya, int bl, int c, int grp, LAS unsigned char* lds) {
    const int tid = tid_now(), wave = tid >> 6, lane = tid & 63, r31 = lane & 31, hh = lane >> 5;
    LAS bf16_t* CL = (LAS bf16_t*)lds; LAS bf16_t* BL = (LAS bf16_t*)(lds + 34816); LAS bf16_t* XT = (LAS bf16_t*)(lds + 69632); LAS bf16_t* PV = (LAS bf16_t*)(lds + 104448);
    LAS float* ACS = (LAS float*)(lds + 139264); LAS float* DTL = (LAS float*)(lds + 140288); LAS float* RS = (LAS float*)(lds + 141312); LAS float* OUT = (LAS float*)(lds + 69632);
    const size_t row0 = (size_t)bl * SEQ + c * 128;
#pragma unroll
    for (int i = 0; i < 4; ++i) {
        const int ch = tid + 512 * i, s = ch >> 4, n8 = (ch & 15) * 8;
        const bf16_t* xr = xbcc + (row0 + s) * 1024;
        *(LAS u32x4*)(CL + s * SP + n8) = *(const u32x4*)(xr + 768 + grp * 128 + n8);
        *(LAS u32x4*)(BL + s * SP + n8) = *(const u32x4*)(xr + 512 + grp * 128 + n8);
    }
#pragma unroll 1
    for (int pi = 0; pi < 2; ++pi) {
        const int pair = grp * 2 + pi;
        if (wave < 2) {
            const int h = pair * 2 + wave;
            const float d0 = dtb[(row0 + lane) * 16 + h], d1 = dtb[(row0 + 64 + lane) * 16 + h];
            float v0 = dtb[(row0 + lane) * 16 + 8 + h], v1 = dtb[(row0 + 64 + lane) * 16 + 8 + h];
            scan128(v0, v1, lane);
            ACS[wave * 128 + lane] = v0; ACS[wave * 128 + 64 + lane] = v1; DTL[wave * 128 + lane] = d0; DTL[wave * 128 + 64 + lane] = d1;
        }
        __syncthreads();
#pragma unroll
        for (int i = 0; i < 4; ++i) {
            const int ch = tid + 512 * i, s = ch >> 4, n8 = (ch & 15) * 8;
            const u32x4 v = *(const u32x4*)(xbcc + (row0 + s) * 1024 + pair * 128 + n8); float f[8]; UNPACK8(v, f);
            const float w = DTL[(n8 >> 6) * 128 + s];
            LAS bf16_t* d = XT + n8 * SP + s;
#pragma unroll
            for (int j = 0; j < 8; ++j) d[j * SP] = f2bf(f[j] * w);
            *(LAS u32x4*)(PV + s * SP + n8) = *(const u32x4*)(STB + (((size_t)bl * 16 + c) * 8 + pair * 2) * 8192 + (size_t)s * 128 + n8);
        }
        __syncthreads();
        const int tb = wave >> 1, hl = wave & 1;
        f32x16 acc[2];
#pragma unroll
        for (int pb = 0; pb < 2; ++pb)
#pragma unroll
            for (int i = 0; i < 16; ++i) acc[pb][i] = 0.f;
        const LAS bf16_t* crw = CL + (tb * 32 + r31) * SP + 8 * hh;
#pragma unroll
        for (int k = 0; k < 8; ++k) {
            const bf16x8 b = *(const LAS bf16x8*)(crw + k * 16);
#pragma unroll
            for (int pb = 0; pb < 2; ++pb) { const bf16x8 a = *(const LAS bf16x8*)(PV + (hl * 64 + pb * 32 + r31) * SP + k * 16 + 8 * hh); acc[pb] = MFMA32(a, b, acc[pb]); }
        }
        const float at = ACS[hl * 128 + tb * 32 + r31], eat = __expf(at);
#pragma unroll
        for (int pb = 0; pb < 2; ++pb)
#pragma unroll
            for (int i = 0; i < 16; ++i) acc[pb][i] *= eat;
#pragma unroll 1
        for (int sb = 0; sb <= tb; ++sb) {
            f32x16 cbt;
#pragma unroll
            for (int i = 0; i < 16; ++i) cbt[i] = 0.f;
#pragma unroll
            for (int k = 0; k < 8; ++k) {
                const bf16x8 a = *(const LAS bf16x8*)(BL + (sb * 32 + r31) * SP + k * 16 + 8 * hh);
                const bf16x8 b = *(const LAS bf16x8*)(crw + k * 16);
                cbt = MFMA32(a, b, cbt);
            }
#pragma unroll
            for (int i = 0; i < 16; ++i) {
                const int sl = crow(i, hh); const float as = ACS[hl * 128 + sb * 32 + sl];
                const float mv = cbt[i] * __expf(fminf(at - as, 0.f));
                cbt[i] = (sb == tb && sl > r31) ? 0.f : mv;
            }
#pragma unroll
            for (int ks = 0; ks < 2; ++ks) {
                u32x4 w; w.x = pk2(cbt[8 * ks], cbt[8 * ks + 1]); w.y = pk2(cbt[8 * ks + 2], cbt[8 * ks + 3]); w.z = pk2(cbt[8 * ks + 4], cbt[8 * ks + 5]); w.w = pk2(cbt[8 * ks + 6], cbt[8 * ks + 7]);
                const bf16x8 pfr = __builtin_bit_cast(bf16x8, w);
#pragma unroll
                for (int pb = 0; pb < 2; ++pb) {
                    const LAS bf16_t* vp = XT + (hl * 64 + pb * 32 + r31) * SP + sb * 32 + 16 * ks + 4 * hh;
                    const s16x4 lo = *(const LAS s16x4*)vp, hi = *(const LAS s16x4*)(vp + 8);
                    const bf16x8 a = __builtin_shufflevector(lo, hi, 0, 1, 2, 3, 4, 5, 6, 7);
                    acc[pb] = MFMA32(a, pfr, acc[pb]);
                }
            }
        }
        __syncthreads();
#pragma unroll
        for (int pb = 0; pb < 2; ++pb)
#pragma unroll
            for (int i = 0; i < 16; ++i) OUT[(tb * 32 + r31) * 132 + hl * 64 + pb * 32 + crow(i, hh)] = acc[pb][i];
        __syncthreads();
#pragma unroll
        for (int i = 0; i < 4; ++i) {
            const int it = tid + 512 * i, t = it >> 4, c8 = (it & 15) * 8;
            const f32x4 y0 = *(const LAS f32x4*)(OUT + t * 132 + c8), y1 = *(const LAS f32x4*)(OUT + t * 132 + c8 + 4);
            const u32x4 xv = *(const u32x4*)(xbcc + (row0 + t) * 1024 + pair * 128 + c8), zv = *(const u32x4*)(proj + (row0 + t) * PLD + pair * 128 + c8);
            float fx[8], fz[8]; UNPACK8(xv, fx); UNPACK8(zv, fz);
            const float Dh = p.in[11][l * 8 + pair * 2 + (c8 >> 6)];
            f32x4 o0, o1;
#pragma unroll
            for (int j = 0; j < 4; ++j) { o0[j] = (y0[j] + Dh * fx[j]) * silu_f(fz[j]); o1[j] = (y1[j] + Dh * fx[4 + j]) * silu_f(fz[4 + j]); }
            float* op = yraw + (row0 + t) * 512 + pair * 128 + c8; *(f32x4*)op = o0; *(f32x4*)(op + 4) = o1;
            float ss = 0.f;
#pragma unroll
            for (int j = 0; j < 4; ++j) ss += o0[j] * o0[j] + o1[j] * o1[j];
            ss += __shfl_xor(ss, 1); ss += __shfl_xor(ss, 2); ss += __shfl_xor(ss, 4); ss += __shfl_xor(ss, 8);
            if ((tid & 15) == 0) RS[t] = pi == 0 ? ss : RS[t] + ss;
        }
        __syncthreads();
    }
    const float* nw = p.in[12] + l * 512 + grp * 256;
#pragma unroll
    for (int i = 0; i < 8; ++i) {
        const int it = tid + 512 * i, t = it >> 5, c8 = (it & 31) * 8;
        const float* yr = yraw + (row0 + t) * 512 + grp * 256 + c8;
        const f32x4 a = *(const f32x4*)yr, b = *(const f32x4*)(yr + 4), w0 = *(const f32x4*)(nw + c8), w1 = *(const f32x4*)(nw + c8 + 4);
        const float rstd = rsqrtf(RS[t] * (1.f / 256.f) + EPS);
        *(u32x4*)(ya + (row0 + t) * 512 + grp * 256 + c8) = (u32x4){pk2(a[0] * rstd * w0[0], a[1] * rstd * w0[1]), pk2(a[2] * rstd * w0[2], a[3] * rstd * w0[3]),
                                                                      pk2(b[0] * rstd * w1[0], b[1] * rstd * w1[1]), pk2(b[2] * rstd * w1[2], b[3] * rstd * w1[3])};
    }
    __syncthreads();
}

#if MULTI_LAUNCH
#define RUNPH(x) ((x) == p.only_phase)
#define GSYNC() do {} while (0)
#else
#define RUNPH(x) true
#define GSYNC() do { XcdBarrier xb_; xb_.bar = (unsigned*)(p.ws + O_BAR); xb_.x = xb_xcc_id(); xb_.st = (volatile LAS unsigned*)(lds + LDS_BYTES - 16); xcd_barrier(xb_); if (PROBE & 1) xcd_barrier(xb_); } while (0)
#endif
#define PH_BEGIN if (RUNPH(ph)) { size_t z_ = 0; asm volatile("" : "+s"(z_)); unsigned char* ws = p.ws + z_; float* X = p.out + z_; const int wg = wg_now(), nwg = nwg_now();
#define PH_END_C(cls) } ++ph; GSYNC(); if (PROBE_T) { const unsigned long long t1_ = __builtin_amdgcn_s_memrealtime(); if ((PROBE_T >> (cls)) & 1) tacc_ += t1_ - t0_; if ((cls) == 7 && ((PROBE_T >> 14) & 1)) tacc_ += t1_; t0_ = t1_; }
__global__ void __launch_bounds__(512) mega(Params p) {
    extern __shared__ __attribute__((aligned(16))) unsigned char smem[];
    LAS unsigned char* lds = (LAS unsigned char*)smem;
#if !MULTI_LAUNCH
    cg::grid_group grid = cg::this_grid();
    volatile LAS unsigned* xst = (volatile LAS unsigned*)(lds + LDS_BYTES - 16);
    if (threadIdx.x == 0) { xst[0] = 0u; xst[1] = 0u; }
    __syncthreads();
    (void)xcd_barrier_post((unsigned*)(p.ws + O_BAR), xst);
    grid.sync();
#endif
#define XN ((bf16_t*)(ws + O_XN))
#define SSQ0 ((float*)(ws + O_SSQ))
#define SSQ1 (SSQ0 + (size_t)T_ALL * 16)
#define SSQ2 (SSQ0 + (size_t)2 * T_ALL * 16)
#define H ((bf16_t*)(ws + O_H))
#define PROJ ((bf16_t*)(ws + O_PROJ))
#define XBCC ((bf16_t*)(ws + O_XBCC))
#define ST ((float*)(ws + O_ST))
#define ATOT ((float*)(ws + O_ATOT))
#define STB ((bf16_t*)(ws + O_STB))
#define DTB ((float*)(ws + O_DTB))
#define AQ ((bf16_t*)(ws + O_AQ))
#define AKV ((bf16_t*)(ws + O_AKV))
#define QRAW ((bf16_t*)(ws + O_QRAW))
#define KVRAW ((bf16_t*)(ws + O_KVRAW))
#define QF ((bf16_t*)(ws + O_QF))
#define KF ((bf16_t*)(ws + O_KF))
#define VT ((bf16_t*)(ws + O_VT))
#define YRAW ((float*)(ws + O_YRAW))
#define YA ((bf16_t*)(ws + O_YA))
#define YB (YA + (size_t)TG * 512)
#define YC (YA + (size_t)2 * TG * 512)
#define YD (YA + (size_t)3 * TG * 512)
#define CS ((f32x2*)(ws + O_CS))
#define PB ((bf16_t*)(ws + O_PB))
#define MIXB ((bf16_t*)(ws + O_MIXB))
#define WIN ((const bf16_t*)(ws + O_WIN))
#define WGATE ((const bf16_t*)(ws + O_WGATE))
#define WBR ((const bf16_t*)(ws + O_WBR))
#define WOUT ((const bf16_t*)(ws + O_WOUT))
#define WQB ((const bf16_t*)(ws + O_WQB))
#define WKVB ((const bf16_t*)(ws + O_WKVB))
#define XNg (XN + (size_t)g * TG * 1024)
    int ph = 0;
    unsigned long long t0_ = PROBE_T ? __builtin_amdgcn_s_memrealtime() : 0ull, tacc_ = 0ull;
#pragma unroll 1
    for (int l = 0; l < 4; ++l) {
#pragma unroll 1
        for (int f = 0; f < 2; ++f) {
            if (f == 0) {
                PH_BEGIN
                    REP(32) convert_layer(p, l, (LAS float*)lds, wg, nwg);
                    if (l == 0) { rope_table(p, CS); init_rows(p.in[0], XN, SSQ0); }
                PH_END_C(0)
            }
            PH_BEGIN
                EpiGU e{H, f == 0 ? SSQ0 : SSQ2};
#pragma unroll 1
                for (int rep = 0; rep < ((PROBE & 16) ? 2 : 1); ++rep) run_gemm(lds, XN, (const bf16_t*)(ws + (f == 0 ? O_WGU1 : O_WGU2)), T_ALL, 5632, 1024, e);
            PH_END_C(1)
            PH_BEGIN
                if (PROBE & 256) { EpiRes e0{XN, f == 0 ? SSQ1 : SSQ0, (l == 3 && f == 1) ? X : nullptr, 0.0f}; run_gemm(lds, H, (const bf16_t*)(ws + (f == 0 ? O_WD1 : O_WD2)), T_ALL, 1024, 2816, e0); }
                EpiRes e{XN, f == 0 ? SSQ1 : SSQ0, (l == 3 && f == 1) ? X : nullptr, 0.5f}; run_gemm(lds, H, (const bf16_t*)(ws + (f == 0 ? O_WD1 : O_WD2)), T_ALL, 1024, 2816, e);
            PH_END_C(2)
            if (f == 0) {
#pragma unroll 1
                for (int g = 0; g < NGRP; ++g) {
                    if (g == 0) {
                        PH_BEGIN
                            EpiStore e{PROJ, PLD, 0x7fffffff, SSQ1}; run_gemm(lds, XN, WIN, TG, 4864, 1024, e);
                        PH_END_C(3)
                    }
                    PH_BEGIN
                        REP(4) prep1(p, l, PROJ, XBCC, DTB, AQ, AKV, YD);
                    PH_END_C(4)
                    PH_BEGIN
                        REP(64) {
                        { EpiStore e{QRAW, 768, 0x7fffffff, nullptr}; run_gemm(lds, AQ, WQB, TG, 768, 384, e); }
                        { EpiStore e{KVRAW, 1024, 0x7fffffff, nullptr}; run_gemm(lds, AKV, WKVB, TG, 1024, 256, e); }
#pragma unroll 1
                        for (int u = wg; u < 256; u += nwg) {
                            ssd_states_unit(XBCC, DTB, ST, ATOT, u >> 5, (u >> 1) & 15, u & 1, lds);
                        }
                        }
                    PH_END_C(5)
                    PH_BEGIN
                        REP(4) for (int u = wg; u < 256; u += nwg) prep2_unit(p, l, g, PROJ, QRAW, KVRAW, CS, QF, KF, VT, u >> 5, u & 31, lds);
                        ssd_scan(ST, STB, ATOT);
                    PH_END_C(6)
                    PH_BEGIN
                        {
                            unsigned* ctr = (unsigned*)(ws + O_WQ) + (l * 4 + g);
                            volatile LAS unsigned* wq = (volatile LAS unsigned*)(lds + LDS_BYTES - 32);
#pragma unroll 1
                            for (;;) {
                                __syncthreads();
                                if (tid_now() == 0) *wq = atomicAdd(ctr, 1u);
                                __syncthreads();
                                const int u = (int)*wq;
                                unsigned long long tu0_ = PROBE_T ? __builtin_amdgcn_s_memrealtime() : 0ull;
                                if (u >= 640) { if ((PROBE_T >> 14) & 1) { tacc_ -= tu0_; } break; }
                                int cls_;
                                if (u < 64) { attn_unit(QF, KF, VT, YC, u & 31, 7 - (u >> 5), lds); cls_ = 11; }
                                else if (u < 192) { const int k = u - 64; gmlp_unit(p, l, PROJ, YB, k >> 4, k & 15, lds); cls_ = 13; }
                                else if (u < 256) { const int k = u - 192; attn_unit(QF, KF, VT, YC, k & 31, 5 - (k >> 5), lds); cls_ = 11; }
                                else if (u < 512) { const int k = u - 256; ssd_out_grp(p, l, PROJ, XBCC, DTB, STB, YRAW, YA, k >> 5, (k >> 1) & 15, k & 1, lds); cls_ = 12; }
                                else { const int k = u - 512; attn_unit(QF, KF, VT, YC, k & 31, 3 - (k >> 5), lds); cls_ = 11; }
                                if (PROBE_T) { const unsigned long long tu1_ = __builtin_amdgcn_s_memrealtime(); if ((PROBE_T >> cls_) & 1) tacc_ += tu1_ - tu0_; }
                            }
                        }
                    PH_END_C(7)
                    PH_BEGIN
                        EpiStore e{PB, 1024, 3, nullptr}; pg8::Gemm gm{YA, WBR, 4 * TG, 4096, 512}; BranchOrder S; S.G = nwg; S.c = wg;
                        REP(128) pg8::gemm_phase<EpiStore, BranchOrder>(lds, gm, S, e);
                    PH_END_C(8)
                    PH_BEGIN
                        EpiMerge e{PB, MIXB, SSQ1 + (size_t)g * TG * 16}; REP(128) run_gemm(lds, XNg, WGATE, TG, 4096, 1024, e);
                    PH_END_C(9)
                    PH_BEGIN
                        { EpiRes e{XNg, SSQ2 + (size_t)g * TG * 16, nullptr, 1.0f}; run_gemm(lds, MIXB, WOUT, TG, 1024, 1024, e); }
                        if (g < NGRP - 1) {
                            EpiStore e{PROJ, PLD, 0x7fffffff, SSQ1 + (size_t)(g + 1) * TG * 16}; run_gemm(lds, XN + (size_t)(g + 1) * TG * 1024, WIN, TG, 4864, 1024, e); }
                    PH_END_C(10)
                }
            }
        }
    }
    if (PROBE_T) { const unsigned long long te_ = __builtin_amdgcn_s_memrealtime(); while (__builtin_amdgcn_s_memrealtime() - te_ < tacc_) __builtin_amdgcn_s_sleep(8); }
}

constexpr int N_PHASES = 4 * (1 + 2 + 1 + 4 * 7 + 2);

extern "C" void kernel_launch(void* const* d_in, const int* in_sizes, int n_in, void* d_out, int out_size, void* d_ws, size_t ws_size, hipStream_t stream) {
    static int grid_blocks = 0;
    if (!grid_blocks) {
        if (n_in != 28 || ws_size < WS_NEED) { fprintf(stderr, "kernel_launch: need 28 inputs and %zu bytes of workspace (got %d, %zu)\n", (size_t)WS_NEED, n_in, ws_size); grid_blocks = -1; return; }
        if (hipFuncSetAttribute((const void*)mega, hipFuncAttributeMaxDynamicSharedMemorySize, LDS_BYTES) != hipSuccess) { fprintf(stderr, "kernel_launch: hipFuncSetAttribute failed\n"); grid_blocks = -1; return; }
        int dev = 0, cus = 0, per_cu = 0;
        hipGetDevice(&dev); hipDeviceGetAttribute(&cus, hipDeviceAttributeMultiprocessorCount, dev);
        hipOccupancyMaxActiveBlocksPerMultiprocessor(&per_cu, mega, 512, LDS_BYTES);
        if (per_cu < 1) { fprintf(stderr, "kernel_launch: occupancy query returned %d\n", per_cu); per_cu = 1; }
        (void)hipGetLastError();
        grid_blocks = cus * per_cu;
    }
    if (grid_blocks < 0) return;
    Params p{};
    for (int i = 0; i < 28; ++i) p.in[i] = (const float*)d_in[i];
    p.out = (float*)d_out; p.ws = (unsigned char*)d_ws; p.only_phase = -1; p.pad = 0;
#if MULTI_LAUNCH
    for (int ph = 0; ph < N_PHASES; ++ph) { p.only_phase = ph; hipLaunchKernelGGL(mega, dim3(grid_blocks), dim3(512), LDS_BYTES, stream, p); }
#else
    if (hipMemsetAsync((unsigned char*)d_ws + O_BAR, 0, ZERO_BYTES, stream) != hipSuccess) { fprintf(stderr, "kernel_launch: memset of barrier words failed\n"); return; }
    void* args[] = {&p};
    hipError_t e = hipLaunchCooperativeKernel((void*)mega, dim3(grid_blocks), dim3(512), args, LDS_BYTES, stream);
    if (e != hipSuccess) fprintf(stderr, "cooperative launch failed: %s (grid %d)\n", hipGetErrorString(e), grid_blocks);
#endif
}
```

```cpp
#include <hip/hip_runtime.h>
#include <hip/hip_cooperative_groups.h>
#include <cstdio>
namespace cg = cooperative_groups;

#ifndef PROBE
#define PROBE 0
#endif
#define REP(bit) _Pragma("unroll 1") for (int rep_ = 0; rep_ < ((PROBE & (bit)) ? 2 : 1); ++rep_)
#ifndef PROBE_T
#define PROBE_T 0
#endif
#ifndef MULTI_LAUNCH
#define MULTI_LAUNCH 0
#endif

__device__ __forceinline__ int tid_now() { int t = threadIdx.x; asm volatile("" : "+v"(t)); return t; }
__device__ __forceinline__ int wg_now() { int t = blockIdx.x; asm volatile("" : "+s"(t)); return t; }
__device__ __forceinline__ int nwg_now() { int t = gridDim.x; asm volatile("" : "+s"(t)); return t; }
namespace pg8 {
#define PG8_LAS __attribute__((address_space(3)))
typedef unsigned short bf16_t;
typedef short bf16x8 __attribute__((ext_vector_type(8)));
typedef float f32x4 __attribute__((ext_vector_type(4)));
typedef unsigned u32x4 __attribute__((ext_vector_type(4)));
constexpr int BM = 256, BK = 64, HALF = 128, HTB = HALF * BK * 2  , STAGE_BYTES = 8 * HTB, NXCD = 8, WGM = 8;

__host__ __device__ __forceinline__ int lds_byte(int r, int c) { const int st = (r >> 4) * 2 + (c >> 5), rr = r & 15, cc = c & 31, ob = rr * 64 + cc * 2; return st * 1024 + (ob ^ (((ob >> 9) & 1) << 5)); }
__host__ __device__ __forceinline__ void stage_rc(int b, int& R, int& C) { const int st = b / 1024, sb = b % 1024, swz = sb ^ (((sb >> 9) & 1) << 5); R = (st >> 1) * 16 + swz / 64; C = (st & 1) * 32 + (swz % 64) / 2; }
__host__ __device__ __forceinline__ int perm32(int rho) { const int n = rho >> 4, i = rho & 15; return 8 * (i >> 2) + 4 * n + (i & 3); }

struct Unit { int pm, pn; };
struct Gemm { const bf16_t* A; const bf16_t* Bt; int M, N, K; };

struct StaticOrder {
    int nM, nN, nwg, G, c;
    __host__ __device__ void init(int M, int N, int G_, int c_) { nM = M / BM; nN = N / BM; nwg = nM * nN; G = G_; c = c_; }
    __host__ __device__ bool next(int i, Unit& u) const {
        const long L = (long)i * G + c; if (L >= nwg) return false;
        int wgid = (int)L; { const int q = nwg / NXCD, r = nwg % NXCD, xcd = wgid % NXCD, off = wgid / NXCD; wgid = (xcd < r ? xcd * (q + 1) : r * (q + 1) + (xcd - r) * q) + off; }
        const int nig = WGM * nN, gid = wgid / nig, fm = gid * WGM, gsz = (nM - fm) < WGM ? (nM - fm) : WGM;
        u.pm = fm + ((wgid % nig) % gsz); u.pn = (wgid % nig) / gsz; return true;
    }
    __device__ __forceinline__ void a_ready(const Unit&) const {}
    __device__ __forceinline__ void done(const Unit&) const {}
};

template <class Epi, class Sched>
__device__ __forceinline__ void gemm_phase(PG8_LAS unsigned char* lds, const Gemm g, const Sched& S, const Epi& E) {
    const int tid = tid_now(), wid = __builtin_amdgcn_readfirstlane(tid >> 6), lane = tid & 63, wr = wid >> 2, wc = wid & 3, fr = lane & 15, fq = lane >> 4;
    const int K = g.K, nt = K / BK;
    unsigned voffA[2], voffB[2];
#pragma unroll
    for (int i = 0; i < 2; ++i) { int R, C; stage_rc(tid * 16 + i * 8192, R, C); const int Rb = Epi::PERM ? ((R & ~31) + perm32(R & 31)) : R;
        voffA[i] = (unsigned)(R * K + C) * 2u; voffB[i] = (unsigned)(Rb * K + C) * 2u; }
    const size_t kstep = (size_t)(BK * 2);
    const size_t hstep = (size_t)HALF * K * 2;
    const size_t tstep = 2 * hstep;
    const unsigned ldsw = (unsigned)wid * 1024u;
    const int aoff = lds_byte(wr * 64 + fr, fq * 8), boff = lds_byte(wc * 32 + fr, fq * 8);
#define PG8_SA(b, h) (((b) * 2 + (h)) * HTB)
#define PG8_SB(b, h) ((4 + (b) * 2 + (h)) * HTB)
#define PG8_STAGE(bufoff, gbase, voff) do { _Pragma("unroll") for (int _i = 0; _i < 2; ++_i) \
        __builtin_amdgcn_global_load_lds((const unsigned*)((const char*)(gbase) + (voff)[_i]), (PG8_LAS unsigned*)(lds + (bufoff) + ldsw + _i * 8192), 16, 0, 0); } while (0)
#define PG8_LDA(dst, b, h) do { _Pragma("unroll") for (int m = 0; m < 4; ++m) _Pragma("unroll") for (int k = 0; k < 2; ++k) dst[m][k] = *(const PG8_LAS bf16x8*)(lds + PG8_SA(b, h) + aoff + m * 2048 + k * 1024); } while (0)
#define PG8_LDB(dst, b, h) do { _Pragma("unroll") for (int n = 0; n < 2; ++n) _Pragma("unroll") for (int k = 0; k < 2; ++k) dst[n][k] = *(const PG8_LAS bf16x8*)(lds + PG8_SB(b, h) + boff + n * 2048 + k * 1024); } while (0)
#define PG8_MMA(ai, bj, At, Bt) do { __builtin_amdgcn_s_setprio(1); _Pragma("unroll") for (int m = 0; m < 4; ++m) _Pragma("unroll") for (int n = 0; n < 2; ++n) _Pragma("unroll") for (int k = 0; k < 2; ++k) \
        acc[ai][bj][m][n] = __builtin_amdgcn_mfma_f32_16x16x32_bf16(Bt[n][k], At[m][k], acc[ai][bj][m][n], 0, 0, 0); __builtin_amdgcn_s_setprio(0); } while (0)
#define PG8_WAIT_V(n) asm volatile("s_waitcnt vmcnt(" #n ")" ::: "memory")
#define PG8_WAIT_L(n) asm volatile("s_waitcnt lgkmcnt(" #n ")" ::: "memory")
#define PG8_BAR __builtin_amdgcn_s_barrier()
#define PG8_SCHED __builtin_amdgcn_sched_barrier(0)
    Unit cur, nxt; int ui = 0;
    if (!S.next(0, cur)) return;
    f32x4 acc[2][2][4][2];
#pragma unroll
    for (int a = 0; a < 2; ++a)
#pragma unroll
        for (int b = 0; b < 2; ++b)
#pragma unroll
            for (int m = 0; m < 4; ++m)
#pragma unroll
                for (int n = 0; n < 2; ++n) acc[a][b][m][n] = (f32x4){0.f, 0.f, 0.f, 0.f};
    bf16x8 At[4][2], B0[2][2], B1[2][2];
    const char* cA = (const char*)g.A + (size_t)cur.pm * tstep; const char* cB = (const char*)g.Bt + (size_t)cur.pn * tstep;
    S.a_ready(cur);
    PG8_STAGE(PG8_SB(0, 0), cB, voffB); PG8_STAGE(PG8_SA(0, 0), cA, voffA); PG8_STAGE(PG8_SB(0, 1), cB + hstep, voffB); PG8_STAGE(PG8_SA(0, 1), cA + hstep, voffA);
    if (wr == 1) PG8_BAR;
    PG8_WAIT_V(4); PG8_BAR;
    PG8_STAGE(PG8_SB(1, 0), cB + kstep, voffB); PG8_STAGE(PG8_SA(1, 0), cA + kstep, voffA); PG8_STAGE(PG8_SB(1, 1), cB + hstep + kstep, voffB);
    PG8_WAIT_V(6); PG8_BAR;
    for (;;) {
        const bool has_next = S.next(ui + 1, nxt);
        const char* nA = has_next ? (const char*)g.A + (size_t)nxt.pm * tstep : cA; const char* nB = has_next ? (const char*)g.Bt + (size_t)nxt.pn * tstep : cB;
        for (int t = 0; t < nt; t += 2) {
            const bool last = (t == nt - 2);
            const char* a1 = cA + (size_t)(t + 1) * kstep;
            const char* a2 = last ? nA : cA + (size_t)(t + 2) * kstep; const char* b2 = last ? nB : cB + (size_t)(t + 2) * kstep;
            const char* a3 = a2 + kstep; const char* b3 = b2 + kstep;
            if (last && has_next) S.a_ready(nxt);
            PG8_LDB(B0, 0, 0); PG8_SCHED; PG8_LDA(At, 0, 0); PG8_STAGE(PG8_SA(1, 1), a1 + hstep, voffA);
            PG8_WAIT_L(8); PG8_BAR; PG8_WAIT_L(0); PG8_MMA(0, 0, At, B0); PG8_BAR; PG8_SCHED;
            PG8_LDB(B1, 0, 1); PG8_STAGE(PG8_SB(0, 0), b2, voffB);
            PG8_BAR; PG8_WAIT_L(0); PG8_MMA(0, 1, At, B1); PG8_BAR;
            PG8_LDA(At, 0, 1); PG8_STAGE(PG8_SA(0, 0), a2, voffA);
            PG8_BAR; PG8_WAIT_L(0); PG8_MMA(1, 0, At, B0); PG8_BAR; PG8_SCHED;
            PG8_STAGE(PG8_SB(0, 1), b2 + hstep, voffB);
            PG8_WAIT_V(6); PG8_BAR; PG8_MMA(1, 1, At, B1); PG8_BAR;
            PG8_LDB(B0, 1, 0); PG8_SCHED; PG8_LDA(At, 1, 0); PG8_STAGE(PG8_SA(0, 1), a2 + hstep, voffA);
            PG8_WAIT_L(8); PG8_BAR; PG8_WAIT_L(0); PG8_MMA(0, 0, At, B0); PG8_BAR; PG8_SCHED;
            PG8_LDB(B1, 1, 1); PG8_STAGE(PG8_SB(1, 0), b3, voffB);
            PG8_BAR; PG8_WAIT_L(0); PG8_MMA(0, 1, At, B1); PG8_BAR;
            PG8_LDA(At, 1, 1); PG8_STAGE(PG8_SA(1, 0), a3, voffA);
            PG8_BAR; PG8_WAIT_L(0); PG8_MMA(1, 0, At, B0); PG8_BAR; PG8_SCHED;
            PG8_STAGE(PG8_SB(1, 1), b3 + hstep, voffB);
            PG8_WAIT_V(6); PG8_BAR; PG8_MMA(1, 1, At, B1); PG8_BAR;
        }
        if constexpr (!Epi::AFTER_DRAIN) { E(acc, cur, wr, wc, fr, fq); S.done(cur); }
        if (!has_next) break;
#pragma unroll
        for (int a = 0; a < 2; ++a)
#pragma unroll
            for (int b = 0; b < 2; ++b)
#pragma unroll
                for (int m = 0; m < 4; ++m)
#pragma unroll
                    for (int n = 0; n < 2; ++n) acc[a][b][m][n] = (f32x4){0.f, 0.f, 0.f, 0.f};
        cur = nxt; cA = nA; cB = nB; ++ui;
    }
    PG8_WAIT_V(0);
    if (wr == 0) PG8_BAR;
    PG8_BAR;
    if constexpr (Epi::AFTER_DRAIN) { E.fused(acc, cur, wr, wc, fr, fq, lds, wid, lane); S.done(cur); }
#undef PG8_SA
#undef PG8_SB
#undef PG8_STAGE
#undef PG8_LDA
#undef PG8_LDB
#undef PG8_MMA
#undef PG8_WAIT_V
#undef PG8_WAIT_L
#undef PG8_BAR
#undef PG8_SCHED
}
}


using pg8::bf16_t; using pg8::bf16x8; using pg8::f32x4; using pg8::u32x4;
typedef short s16x4 __attribute__((ext_vector_type(4)));
typedef float f32x2 __attribute__((ext_vector_type(2)));
typedef float f32x16 __attribute__((ext_vector_type(16)));
typedef unsigned u32x2 __attribute__((ext_vector_type(2)));
typedef __bf16 bf16v2 __attribute__((ext_vector_type(2)));
#define LAS __attribute__((address_space(3)))
#define DI __device__ __forceinline__
#define XB_TMO      128
#define XB_XCNT(j)  (256  + 64 * (j))
#define XB_XSUB(j)  (1280 + 64 * (j))
#define XB_XGEN(j)  (2304 + 64 * (j))
#define XB_TOP      3328
#define XB_TOPGEN   3392
#define XCD_BAR_WORDS 3456
#define XB_SPIN_CAP (1u << 18)

__device__ __forceinline__ unsigned xb_ld(unsigned* p)              { return __hip_atomic_load(p, __ATOMIC_RELAXED, __HIP_MEMORY_SCOPE_AGENT); }
__device__ __forceinline__ unsigned xb_add(unsigned* p, unsigned v) { return __hip_atomic_fetch_add(p, v, __ATOMIC_RELAXED, __HIP_MEMORY_SCOPE_AGENT); }
__device__ __forceinline__ unsigned xb_xcc_id() { return (unsigned)__builtin_amdgcn_s_getreg((3 << 11) | 20) & 0xFu; }
#define XB_SPIN(cond, bar) do { unsigned _sp = 0; while (cond) { __builtin_amdgcn_s_sleep(1); \
    if ((++_sp & 255u) == 0u) { if (xb_ld(&(bar)[XB_TMO])) break; if (_sp > XB_SPIN_CAP) { atomicAdd(&(bar)[XB_TMO], 1u); break; } } } } while (0)

struct XcdBarrier {
    unsigned* bar; unsigned x;
    volatile LAS unsigned* st;
};

__device__ __forceinline__ XcdBarrier xcd_barrier_post(unsigned* bar, volatile LAS unsigned* st) {
    XcdBarrier b; b.bar = bar; b.x = xb_xcc_id(); b.st = st;
    if (threadIdx.x == 0) (void)xb_add(&bar[XB_XCNT(b.x)], 1u);
    return b;
}
__device__ __forceinline__ void xcd_barrier_complete(unsigned* bar, unsigned x, unsigned& nloc, unsigned& nx) {
    const unsigned G = (unsigned)nwg_now();
    unsigned sum, cnt, mine, sp = 0u;
    for (;;) {
        sum = 0u; cnt = 0u; mine = 0u;
#pragma unroll
        for (unsigned j = 0; j < 16; ++j) { const unsigned c = xb_ld(&bar[XB_XCNT(j)]); sum += c; cnt += (c > 0u) ? 1u : 0u; mine = (j == x) ? c : mine; }
        if (sum == G) break;
        __builtin_amdgcn_s_sleep(1);
        if ((++sp & 255u) == 0u) { if (xb_ld(&bar[XB_TMO])) break; if (sp > XB_SPIN_CAP) { atomicAdd(&bar[XB_TMO], 1u); break; } }
    }
    nloc = mine > 0u ? mine : 1u; nx = cnt > 0u ? cnt : 1u;
}

__device__ __forceinline__ void xcd_barrier(const XcdBarrier& b) {
    asm volatile("s_waitcnt vmcnt(0)" ::: "memory");
    __syncthreads();
    if (tid_now() == 0) {
        unsigned* bar = b.bar; unsigned bx = b.x; asm volatile("" : "+s"(bar), "+s"(bx));
        __builtin_amdgcn_s_waitcnt(0);
        unsigned nloc = b.st[0], nx = b.st[1];
        if (nloc == 0u) { xcd_barrier_complete(bar, bx, nloc, nx); b.st[0] = nloc; b.st[1] = nx; }
        const unsigned old = xb_add(&bar[XB_XSUB(bx)], 1u);
        const unsigned gen = old / nloc;
        if (old + 1u == (gen + 1u) * nloc) {
            __builtin_amdgcn_fence(__ATOMIC_RELEASE, "agent");
            asm volatile("s_waitcnt vmcnt(0)" ::: "memory");
            const unsigned og = xb_add(&bar[XB_TOP], 1u);
            const unsigned tg = og / nx;
            if (og + 1u == (tg + 1u) * nx) xb_add(&bar[XB_TOPGEN], 1u);
            else XB_SPIN(xb_ld(&bar[XB_TOPGEN]) == tg, bar);
            __builtin_amdgcn_fence(__ATOMIC_ACQUIRE, "agent");
            xb_add(&bar[XB_XGEN(bx)], 1u);
            asm volatile("s_waitcnt vmcnt(0)" ::: "memory");
        } else {
            XB_SPIN(xb_ld(&bar[XB_XGEN(bx)]) == gen, bar);
            __builtin_amdgcn_fence(__ATOMIC_ACQUIRE, "agent");
            asm volatile("s_waitcnt vmcnt(0)" ::: "memory");
        }
    }
    __syncthreads();
}


#define MFMA32(a, b, c) __builtin_amdgcn_mfma_f32_32x32x16_bf16((a), (b), (c), 0, 0, 0)

constexpr int T_ALL = 65536, SEQ = 2048, NGRP = 4, TG = 16384, BPG = 8, PLD = 4864;
constexpr float EPS = 1e-6f;
constexpr size_t SZ_GU = (size_t)5632 * 1024 * 2, SZ_D = (size_t)1024 * 2816 * 2;
constexpr size_t O_WGU1 = 0, O_WD1 = O_WGU1 + SZ_GU, O_WGU2 = O_WD1 + SZ_D, O_WD2 = O_WGU2 + SZ_GU, O_WIN = O_WD2 + SZ_D;
constexpr size_t O_WGATE = O_WIN + (size_t)4864 * 1024 * 2, O_WBR = O_WGATE + (size_t)4096 * 1024 * 2, O_WOUT = O_WBR + (size_t)4 * 1024 * 512 * 2;
constexpr size_t O_WQB = O_WOUT + (size_t)1024 * 1024 * 2, O_WKVB = O_WQB + (size_t)768 * 384 * 2, O_XN = O_WKVB + (size_t)1024 * 256 * 2;
constexpr size_t O_R0 = O_XN + (size_t)T_ALL * 1024 * 2;
constexpr size_t O_H = O_R0;
constexpr size_t O_PROJ = O_R0, O_XBCC = O_PROJ + (size_t)TG * PLD * 2, O_DTB = O_XBCC + (size_t)TG * 1024 * 2, O_AQ = O_DTB + (size_t)TG * 16 * 4;
constexpr size_t O_AKV = O_AQ + (size_t)TG * 384 * 2, O_QRAW = O_AKV + (size_t)TG * 256 * 2, O_KVRAW = O_QRAW + (size_t)TG * 768 * 2;
constexpr size_t O_QF = O_KVRAW + (size_t)TG * 1024 * 2, O_KF = O_QF + (size_t)TG * 768 * 2, O_VT = O_KF + (size_t)TG * 768 * 2;
constexpr size_t O_YRAW = O_VT + (size_t)TG * 512 * 2, O_YA = O_YRAW + (size_t)TG * 512 * 4;
constexpr size_t O_PB = O_YA + (size_t)4 * TG * 512 * 2, O_MIXB = O_PB + (size_t)4 * TG * 1024 * 2;
constexpr size_t O_ST = O_MIXB + (size_t)TG * 1024 * 2, O_ATOT = O_ST + (size_t)BPG * 16 * 8 * 8192 * 4;
constexpr size_t O_STB = O_ATOT + 4096;
constexpr size_t O_BAR = O_STB + (size_t)BPG * 16 * 8 * 8192 * 2;
constexpr size_t O_WQ = O_BAR + (size_t)XCD_BAR_WORDS * 4;
constexpr size_t ZERO_BYTES = (size_t)XCD_BAR_WORDS * 4 + 256;
constexpr size_t O_CS = O_WQ + 256 + 256 - ((size_t)XCD_BAR_WORDS * 4) % 256;
constexpr size_t O_SSQ = O_CS + (size_t)T_ALL * 32 * 8;
constexpr size_t O_END = O_SSQ + (size_t)3 * T_ALL * 16 * 4;
constexpr size_t O_END_H = O_H + (size_t)T_ALL * 2816 * 2;
constexpr size_t WS_NEED = O_END > O_END_H ? O_END : O_END_H;
constexpr int LDS_BYTES = 147456;

struct Params { const float* in[28]; float* out; unsigned char* ws; int only_phase; int pad; };

DI unsigned pk2(float a, float b) { f32x2 v = {a, b}; return __builtin_bit_cast(unsigned, __builtin_convertvector(v, bf16v2)); }
DI bf16_t f2bf(float a) { return (bf16_t)(pk2(a, 0.f) & 0xffffu); }
DI float bf2f(bf16_t b) { return __uint_as_float(((unsigned)b) << 16); }
DI float bflo(unsigned u) { return __uint_as_float(u << 16); }
DI float bfhi(unsigned u) { return __uint_as_float(u & 0xffff0000u); }
#define UNPACK8(v, f) do { f[0] = bflo(v.x); f[1] = bfhi(v.x); f[2] = bflo(v.y); f[3] = bfhi(v.y); f[4] = bflo(v.z); f[5] = bfhi(v.z); f[6] = bflo(v.w); f[7] = bfhi(v.w); } while (0)
#define PACK8(f) ((u32x4){pk2(f[0], f[1]), pk2(f[2], f[3]), pk2(f[4], f[5]), pk2(f[6], f[7])})
DI float wave_sum(float v) {
#pragma unroll
    for (int o = 1; o < 64; o <<= 1) v += __shfl_xor(v, o);
    return v;
}
DI float silu_f(float x) { return x * __builtin_amdgcn_rcpf(1.f + __builtin_amdgcn_exp2f(-1.4426950408889634f * x)); }
DI float sigmoid_f(float x) { return __builtin_amdgcn_rcpf(1.f + __builtin_amdgcn_exp2f(-1.4426950408889634f * x)); }
DI float gelu_f(float v) {
    const float t = __builtin_amdgcn_rcpf(fabsf(v) * 0.2316418882f + 1.0f);
    float q = t * 0.5307027145f + (-0.7265760135f); q = q * t + 0.7107068705f; q = q * t + (-0.142248368f); q = q * t + 0.127414796f; q = q * t;
    const float m = v * (q * __builtin_amdgcn_exp2f(v * v * (-0.72134752044f)));
    return v < 0.f ? m : v - m;
}
DI int crow(int i, int h) { return (i & 3) + 8 * (i >> 2) + 4 * h; }
DI void rows_rstd(const float* ssq, int row0, int fq, float (&rs)[2][4]) {
    f32x4 q[2][4];
#pragma unroll
    for (int ai = 0; ai < 2; ++ai)
#pragma unroll
        for (int m = 0; m < 4; ++m) q[ai][m] = ((const f32x4*)(ssq + (size_t)(row0 + ai * 128 + m * 16) * 16))[fq];
#pragma unroll
    for (int ai = 0; ai < 2; ++ai)
#pragma unroll
        for (int m = 0; m < 4; ++m) { float t = (q[ai][m][0] + q[ai][m][1]) + (q[ai][m][2] + q[ai][m][3]); t += __shfl_xor(t, 16); t += __shfl_xor(t, 32);
            rs[ai][m] = rsqrtf(t * (1.f / 1024.f) + EPS); }
}
struct EpiStore {
    static constexpr bool PERM = true, AFTER_DRAIN = false;
    bf16_t* O; int ldc; int pnmask; const float* ssq;
    DI void operator()(const f32x4 (&acc)[2][2][4][2], const pg8::Unit& u, int wr, int wc, int fr, int fq) const {
        const int row0 = u.pm * 256 + wr * 64 + fr, col0 = (u.pn & pnmask) * 256 + wc * 32 + 8 * fq;
        float rsv[2][4];
        if (ssq) rows_rstd(ssq, row0, fq, rsv);
        else {
#pragma unroll
            for (int ai = 0; ai < 2; ++ai)
#pragma unroll
                for (int m = 0; m < 4; ++m) rsv[ai][m] = 1.f; }
#pragma unroll
        for (int ai = 0; ai < 2; ++ai)
#pragma unroll
            for (int m = 0; m < 4; ++m) { bf16_t* rowp = O + (size_t)(row0 + ai * 128 + m * 16) * ldc + col0;
                const float rs = rsv[ai][m];
#pragma unroll
                for (int bj = 0; bj < 2; ++bj) { const f32x4 v0 = acc[ai][bj][m][0] * rs, v1 = acc[ai][bj][m][1] * rs;
                    u32x4 w; w.x = pk2(v0[0], v0[1]); w.y = pk2(v0[2], v0[3]); w.z = pk2(v1[0], v1[1]); w.w = pk2(v1[2], v1[3]);
                    *(u32x4*)(rowp + bj * 128) = w; } }
    }
};
struct EpiGU {
    static constexpr bool PERM = true, AFTER_DRAIN = false;
    bf16_t* H; const float* ssq;
    DI void operator()(const f32x4 (&acc)[2][2][4][2], const pg8::Unit& u, int wr, int wc, int fr, int fq) const {
        const int row0 = u.pm * 256 + wr * 64 + fr, col0 = u.pn * 128 + wc * 32 + 8 * fq;
        float rsv[2][4]; rows_rstd(ssq, row0, fq, rsv);
#pragma unroll
        for (int ai = 0; ai < 2; ++ai)
#pragma unroll
            for (int m = 0; m < 4; ++m) { bf16_t* rowp = H + (size_t)(row0 + ai * 128 + m * 16) * 2816 + col0;
                const float rs = rsv[ai][m];
                float o[8];
#pragma unroll
                for (int n = 0; n < 2; ++n)
#pragma unroll
                    for (int j = 0; j < 4; ++j) o[4 * n + j] = silu_f(acc[ai][0][m][n][j] * rs) * (acc[ai][1][m][n][j] * rs);
                *(u32x4*)rowp = PACK8(o); }
    }
};
struct EpiRes {
    static constexpr bool PERM = false, AFTER_DRAIN = false;
    bf16_t* XB; float* SSQ; float* OUT; float sc;
    DI void operator()(const f32x4 (&acc)[2][2][4][2], const pg8::Unit& u, int wr, int wc, int fr, int fq) const {
        const int row0 = u.pm * 256 + wr * 64 + fr, col0 = u.pn * 256 + wc * 32 + 4 * fq;
#pragma unroll
        for (int ai = 0; ai < 2; ++ai) {
            u32x2 xv[4][2][2];
#pragma unroll
            for (int m = 0; m < 4; ++m)
#pragma unroll
                for (int bj = 0; bj < 2; ++bj)
#pragma unroll
                    for (int n = 0; n < 2; ++n) xv[m][bj][n] = *(const u32x2*)(XB + (size_t)(row0 + ai * 128 + m * 16) * 1024 + col0 + bj * 128 + n * 16);
#pragma unroll
            for (int m = 0; m < 4; ++m) { const int row = row0 + ai * 128 + m * 16; const size_t ro = (size_t)row * 1024 + col0;
                float ss = 0.f;
#pragma unroll
                for (int bj = 0; bj < 2; ++bj)
#pragma unroll
                    for (int n = 0; n < 2; ++n) { const u32x2 xo = xv[m][bj][n]; const f32x4 a = acc[ai][bj][m][n];
                        const f32x4 v = {bflo(xo.x) + a[0] * sc, bfhi(xo.x) + a[1] * sc, bflo(xo.y) + a[2] * sc, bfhi(xo.y) + a[3] * sc};
                        if (OUT) *(f32x4*)(OUT + ro + bj * 128 + n * 16) = v;
                        else *(u32x2*)(XB + ro + bj * 128 + n * 16) = (u32x2){pk2(v[0], v[1]), pk2(v[2], v[3])};
                        ss += v[0] * v[0] + v[1] * v[1] + v[2] * v[2] + v[3] * v[3]; }
                ss += __shfl_xor(ss, 16); ss += __shfl_xor(ss, 32);
                if (fq == 0) SSQ[(size_t)row * 16 + u.pn * 4 + wc] = ss; }
        }
    }
};
struct EpiMerge {
    static constexpr bool PERM = false, AFTER_DRAIN = false;
    const bf16_t* P; bf16_t* MIX; const float* ssq;
    DI void operator()(const f32x4 (&acc)[2][2][4][2], const pg8::Unit& u, int wr, int wc, int fr, int fq) const {
        const int row0 = u.pm * 256 + wr * 64 + fr, e0 = u.pn * 64 + wc * 16 + 4 * fq;
        float rsv[2][4]; rows_rstd(ssq, row0, fq, rsv);
#pragma unroll
        for (int ai = 0; ai < 2; ++ai) {
            u32x2 pv[4][4];
#pragma unroll
            for (int m = 0; m < 4; ++m)
#pragma unroll
                for (int b = 0; b < 4; ++b) pv[m][b] = *(const u32x2*)(P + (size_t)b * TG * 1024 + (size_t)(row0 + ai * 128 + m * 16) * 1024 + e0);
#pragma unroll
            for (int m = 0; m < 4; ++m) { const float rs = rsv[ai][m];
                float o[4] = {0.f, 0.f, 0.f, 0.f};
#pragma unroll
                for (int bj = 0; bj < 2; ++bj)
#pragma unroll
                    for (int n = 0; n < 2; ++n) { const u32x2 q = pv[m][2 * bj + n]; const f32x4 g = acc[ai][bj][m][n] * rs;
                        o[0] += sigmoid_f(g[0]) * bflo(q.x); o[1] += sigmoid_f(g[1]) * bfhi(q.x); o[2] += sigmoid_f(g[2]) * bflo(q.y); o[3] += sigmoid_f(g[3]) * bfhi(q.y); }
                *(u32x2*)(MIX + (size_t)(row0 + ai * 128 + m * 16) * 1024 + e0) = (u32x2){pk2(o[0], o[1]), pk2(o[2], o[3])}; }
        }
    }
};
struct BranchOrder {
    int G, c;
    DI bool next(int i, pg8::Unit& u) const { const int L = i * G + c; if (L >= 1024) return false; const int br = L >> 8, rem = L & 255; u.pm = br * 64 + (rem >> 2); u.pn = br * 4 + (rem & 3); return true; }
    DI void a_ready(const pg8::Unit&) const {}
    DI void done(const pg8::Unit&) const {}
};
template <class Epi> DI void run_gemm(LAS unsigned char* lds, const bf16_t* A, const bf16_t* Bt, int M, int N, int K, const Epi& E) {
    pg8::Gemm g{A, Bt, M, N, K}; pg8::StaticOrder S; S.init(M, N, nwg_now(), wg_now());
    pg8::gemm_phase<Epi, pg8::StaticOrder>(lds, g, S, E);
}

DI void conv_mat(const float* src, int ld, int c0, int nvalid, int kvalid, int mode, bf16_t* dst, int Nd, int Kd, LAS float* scr, int wg, int nwg, const float* ksc = nullptr, const int use_ksc = 0) {
    const int tid = tid_now(); const int ntk = Kd >> 6, ntiles = (Nd >> 6) * ntk;
    for (int tile = wg; tile < ntiles; tile += nwg) {
        const int n0 = (tile / ntk) << 6, k0 = (tile % ntk) << 6;
        const int nn = tid & 63, kq = tid >> 6, n = n0 + nn;
        int col;
        if (mode == 1) { const int blk = n >> 7; col = ((blk & 1) ? 2816 : 0) + (blk >> 1) * 128 + (n & 127); }
        else if (mode == 2) { const int c = n & 255, br = 2 * (c >> 7) + ((c >> 4) & 1), e = 64 * (n >> 8) + 16 * ((c >> 5) & 3) + (c & 15); col = c0 + br * 1024 + e; }
        else col = c0 + n;
#pragma unroll
        for (int i = 0; i < 8; ++i) { const int kk = i * 8 + kq; float v = 0.f;
            if (k0 + kk < kvalid && n < nvalid) { v = src[(size_t)(k0 + kk) * ld + col]; if (use_ksc) v *= ksc[k0 + kk]; }
            scr[kk * 65 + nn] = v; }
        __syncthreads();
        { const int nr = tid >> 3, kc = tid & 7; const LAS float* sp = scr + (kc * 8) * 65 + nr;
          u32x4 o; o.x = pk2(sp[0], sp[65]); o.y = pk2(sp[130], sp[195]); o.z = pk2(sp[260], sp[325]); o.w = pk2(sp[390], sp[455]);
          *(u32x4*)(dst + (size_t)(n0 + nr) * Kd + k0 + kc * 8) = o; }
        __syncthreads();
    }
}
DI void convert_layer(const Params& p, int l, LAS float* scr, int wg, int nwg) {
    unsigned char* ws = p.ws;
    conv_mat(p.in[3] + (size_t)l * 1024 * 5632, 5632, 0, 5632, 1024, 1, (bf16_t*)(ws + O_WGU1), 5632, 1024, scr, wg, nwg, p.in[2] + l * 1024, 1);
    conv_mat(p.in[26] + (size_t)l * 1024 * 5632, 5632, 0, 5632, 1024, 1, (bf16_t*)(ws + O_WGU2), 5632, 1024, scr, wg, nwg, p.in[25] + l * 1024, 1);
    conv_mat(p.in[4] + (size_t)l * 2816 * 1024, 1024, 0, 1024, 2816, 0, (bf16_t*)(ws + O_WD1), 1024, 2816, scr, wg, nwg);
    conv_mat(p.in[27] + (size_t)l * 2816 * 1024, 1024, 0, 1024, 2816, 0, (bf16_t*)(ws + O_WD2), 1024, 2816, scr, wg, nwg);
    conv_mat(p.in[6] + (size_t)l * 1024 * 8776, 8776, 0, 4680, 1024, 0, (bf16_t*)(ws + O_WIN), 4864, 1024, scr, wg, nwg, p.in[5] + l * 1024, 1);
    conv_mat(p.in[6] + (size_t)l * 1024 * 8776, 8776, 4680, 4096, 1024, 2, (bf16_t*)(ws + O_WGATE), 4096, 1024, scr, wg, nwg, p.in[5] + l * 1024, 1);
#pragma unroll 1
    for (int i = 0; i < 4; ++i)
        conv_mat(p.in[23] + ((size_t)l * 4 + i) * 512 * 1024, 1024, 0, 1024, 512, 0, (bf16_t*)(ws + O_WBR) + (size_t)i * 1024 * 512, 1024, 512, scr, wg, nwg);
    conv_mat(p.in[24] + (size_t)l * 1024 * 1024, 1024, 0, 1024, 1024, 0, (bf16_t*)(ws + O_WOUT), 1024, 1024, scr, wg, nwg);
    conv_mat(p.in[17] + (size_t)l * 384 * 768, 768, 0, 768, 384, 0, (bf16_t*)(ws + O_WQB), 768, 384, scr, wg, nwg);
    conv_mat(p.in[19] + (size_t)l * 128 * 1024, 1024, 0, 1024, 128, 0, (bf16_t*)(ws + O_WKVB), 1024, 256, scr, wg, nwg);
}

DI void init_rows(const float* x, bf16_t* xb, float* ssq) {
    const int tidn = tid_now(); const int lane = tidn & 63, gwave = wg_now() * 8 + (tidn >> 6), ngw = nwg_now() * 8;
    for (int row = gwave; row < T_ALL; row += ngw) {
        const f32x4* xr = (const f32x4*)(x + (size_t)row * 1024);
        f32x4 v[4]; float ss = 0.f;
#pragma unroll
        for (int j = 0; j < 4; ++j) { v[j] = xr[lane + 64 * j]; ss += v[j][0] * v[j][0] + v[j][1] * v[j][1] + v[j][2] * v[j][2] + v[j][3] * v[j][3]; }
        ss = wave_sum(ss);
        u32x2* o = (u32x2*)(xb + (size_t)row * 1024);
#pragma unroll
        for (int j = 0; j < 4; ++j) o[lane + 64 * j] = (u32x2){pk2(v[j][0], v[j][1]), pk2(v[j][2], v[j][3])};
        if (lane < 16) ssq[(size_t)row * 16 + lane] = lane == 0 ? ss : 0.f;
    }
}
DI void zero_f32(float* q, int n) { const int tidn = tid_now(); for (int i = wg_now() * 512 + tidn; i < n; i += nwg_now() * 512) q[i] = 0.f; }

DI void prep1(const Params& p, int l, const bf16_t* __restrict__ proj, bf16_t* __restrict__ xbcc, float* __restrict__ dtb, bf16_t* __restrict__ aq, bf16_t* __restrict__ akv, bf16_t* __restrict__ yd) {
    const int tidn = tid_now(); const int gtid = wg_now() * 512 + tidn, gthreads = nwg_now() * 512;
    const float* cw = p.in[7] + l * 4096; const float* cb = p.in[8] + l * 1024;
    for (int idx = gtid; idx < (TG / 16) * 128; idx += gthreads) {
        const int c8 = (idx & 127) << 3, tl0 = (idx >> 7) << 4, s0 = tl0 & 2047;
        float w[4][8], bb[8], r0[8], r1[8], r2[8];
#pragma unroll
        for (int k = 0; k < 4; ++k) { const f32x4 a = *(const f32x4*)(cw + k * 1024 + c8), b = *(const f32x4*)(cw + k * 1024 + c8 + 4);
#pragma unroll
            for (int j = 0; j < 4; ++j) { w[k][j] = a[j]; w[k][4 + j] = b[j]; } }
        { const f32x4 a = *(const f32x4*)(cb + c8), b = *(const f32x4*)(cb + c8 + 4);
#pragma unroll
          for (int j = 0; j < 4; ++j) { bb[j] = a[j]; bb[4 + j] = b[j]; } }
        const bf16_t* src = proj + (size_t)tl0 * PLD + 512 + c8;
        if (s0 > 0) { const u32x4 v0 = *(const u32x4*)(src - 3 * PLD), v1 = *(const u32x4*)(src - 2 * PLD), v2 = *(const u32x4*)(src - PLD); UNPACK8(v0, r0); UNPACK8(v1, r1); UNPACK8(v2, r2); }
        else {
#pragma unroll
            for (int j = 0; j < 8; ++j) { r0[j] = 0.f; r1[j] = 0.f; r2[j] = 0.f; } }
#pragma unroll 8
        for (int tt = 0; tt < 16; ++tt) {
            const u32x4 v = *(const u32x4*)(src + (size_t)tt * PLD); float cur[8], o[8]; UNPACK8(v, cur);
#pragma unroll
            for (int j = 0; j < 8; ++j) { o[j] = silu_f(bb[j] + w[0][j] * r0[j] + w[1][j] * r1[j] + w[2][j] * r2[j] + w[3][j] * cur[j]); r0[j] = r1[j]; r1[j] = r2[j]; r2[j] = cur[j]; }
            *(u32x4*)(xbcc + (size_t)(tl0 + tt) * 1024 + c8) = PACK8(o);
        }
    }
    const float* sw = p.in[22] + l * 1536;
    for (int idx = gtid; idx < (TG / 16) * 64; idx += gthreads) {
        const int c8 = (idx & 63) << 3, tl0 = (idx >> 6) << 4, s0 = tl0 & 2047;
        float w[3][8], p1[8], p2[8];
#pragma unroll
        for (int k = 0; k < 3; ++k) { const f32x4 a = *(const f32x4*)(sw + k * 512 + c8), b = *(const f32x4*)(sw + k * 512 + c8 + 4);
#pragma unroll
            for (int j = 0; j < 4; ++j) { w[k][j] = a[j]; w[k][4 + j] = b[j]; } }
        const bf16_t* src = proj + (size_t)tl0 * PLD + c8;
        if (s0 > 0) { const u32x4 c1 = *(const u32x4*)(src - 2 * PLD + 3656), x1 = *(const u32x4*)(src - 2 * PLD + 4168), c2 = *(const u32x4*)(src - PLD + 3656), x2 = *(const u32x4*)(src - PLD + 4168);
            float a[8], b[8]; UNPACK8(c1, a); UNPACK8(x1, b);
#pragma unroll
            for (int j = 0; j < 8; ++j) p1[j] = a[j] * b[j];
            UNPACK8(c2, a); UNPACK8(x2, b);
#pragma unroll
            for (int j = 0; j < 8; ++j) p2[j] = a[j] * b[j]; }
        else {
#pragma unroll
            for (int j = 0; j < 8; ++j) { p1[j] = 0.f; p2[j] = 0.f; } }
#pragma unroll 8
        for (int tt = 0; tt < 16; ++tt) {
            const bf16_t* pr = src + (size_t)tt * PLD;
            const u32x4 vc = *(const u32x4*)(pr + 3656), vx = *(const u32x4*)(pr + 4168), vb = *(const u32x4*)(pr + 3144);
            float fc[8], fx[8], fb[8], o[8]; UNPACK8(vc, fc); UNPACK8(vx, fx); UNPACK8(vb, fb);
#pragma unroll
            for (int j = 0; j < 8; ++j) { const float cur = fc[j] * fx[j]; o[j] = fb[j] * (w[0][j] * p1[j] + w[1][j] * p2[j] + w[2][j] * cur); p1[j] = p2[j]; p2[j] = cur; }
            *(u32x4*)(yd + (size_t)(tl0 + tt) * 512 + c8) = PACK8(o);
        }
    }
    const int gwave = gtid >> 6, ngw = gthreads >> 6, lane = tidn & 63;
    const float* qn = p.in[16] + l * 384; const float* kn = p.in[18] + l * 128;
#pragma unroll 4
    for (int tl = gwave; tl < TG; tl += ngw) {
        const bf16_t* pr = proj + (size_t)tl * PLD;
        const u32x4 v = *(const u32x4*)(pr + 2568 + lane * 8); float f[8]; UNPACK8(v, f);
        float ss = 0.f;
#pragma unroll
        for (int j = 0; j < 8; ++j) ss += f[j] * f[j];
        const float ssq = wave_sum(lane < 48 ? ss : 0.f), ssk = wave_sum(lane >= 48 ? ss : 0.f);
        if (lane < 48) {
            const float rstd = rsqrtf(ssq * (1.f / 384.f) + EPS);
#pragma unroll
            for (int j = 0; j < 8; ++j) f[j] *= rstd * qn[lane * 8 + j];
            *(u32x4*)(aq + (size_t)tl * 384 + lane * 8) = PACK8(f);
        } else {
            const float rstd = rsqrtf(ssk * (1.f / 128.f) + EPS);
#pragma unroll
            for (int j = 0; j < 8; ++j) f[j] *= rstd * kn[(lane - 48) * 8 + j];
            *(u32x4*)(akv + (size_t)tl * 256 + (lane - 48) * 8) = PACK8(f);
            { unsigned z = 0u; asm volatile("" : "+v"(z)); *(u32x4*)(akv + (size_t)tl * 256 + 128 + (lane - 48) * 8) = (u32x4){z, z, z, z}; }
        }
        if (lane < 8) {
            const float xr = bf2f(pr[1536 + lane]) + p.in[9][l * 8 + lane];
            const float dt = xr > 20.f ? xr : log1pf(expf(xr));
            const float A = -expf(p.in[10][l * 8 + lane]);
            dtb[(size_t)tl * 16 + lane] = dt; dtb[(size_t)tl * 16 + 8 + lane] = dt * A;
        }
    }
}

DI void rope_table(const Params& p, f32x2* CS) {
    const int* pos = (const int*)p.in[1];
    const int tidn = tid_now();
    for (int idx = wg_now() * 512 + tidn; idx < T_ALL * 32; idx += nwg_now() * 512) {
        const float invf = exp2f(-(float)(idx & 31) * (13.287712379549449f / 32.f));
        const float ang = (float)pos[idx >> 5] * invf;
        CS[idx] = (f32x2){cosf(ang), sinf(ang)};
    }
}
DI void prep2_unit(const Params& p, int l, int g, const bf16_t* __restrict__ proj, const bf16_t* __restrict__ qraw, const bf16_t* __restrict__ kvraw, const f32x2* __restrict__ CSt, bf16_t* __restrict__ Qf, bf16_t* __restrict__ Kf, bf16_t* __restrict__ Vt, int bl, int tile, LAS unsigned char* lds) {
    const int tid = tid_now(), wave = tid >> 6, lane = tid & 63;
    const float* wq = p.in[20] + l * 192; const float* wk = p.in[21] + l * 192;
    const float qscale = 0.07216878364870322f * 1.4426950408889634f;
    const float wq0 = wq[lane], wq1 = wq[64 + lane], wq2 = wq[128 + lane], wk0 = wk[lane], wk1 = wk[64 + lane], wk2 = wk[128 + lane];
    LAS bf16_t* img = (LAS bf16_t*)lds;
    const int t0 = tile * 64;
#pragma unroll 4
    for (int tt = 0; tt < 8; ++tt) {
        const int tloc = wave * 8 + tt, s = t0 + tloc; const size_t tl = (size_t)bl * SEQ + s;
        const f32x2 cssn = CSt[((size_t)(g * BPG + bl) * SEQ + s) * 32 + (lane & 31)];
        const float cs = cssn[0], sn = cssn[1];
        const float kpe = bf2f(proj[tl * PLD + 3080 + lane]);
#pragma unroll
        for (int h = 0; h < 4; ++h) {
            const size_t ob = ((size_t)(bl * 4 + h) * SEQ + s) * 192;
            {
                const bf16_t* qr = qraw + tl * 768 + h * 192;
                float q0 = bf2f(qr[lane]), q1 = bf2f(qr[64 + lane]), q2 = bf2f(qr[128 + lane]);
                const float r = rsqrtf(wave_sum(q0 * q0 + q1 * q1 + q2 * q2) * (1.f / 192.f) + EPS);
                q0 *= r * wq0; q1 *= r * wq1; q2 *= r * wq2;
                const float qp = __shfl_xor(q2, 32);
                q2 = (lane < 32) ? q2 * cs - qp * sn : q2 * cs + qp * sn;
                bf16_t* qo = Qf + ob;
                qo[lane] = f2bf(q0 * qscale); qo[64 + lane] = f2bf(q1 * qscale); qo[128 + lane] = f2bf(q2 * qscale);
            }
            const bf16_t* kr = kvraw + tl * 1024 + h * 256;
            {
                float k0 = bf2f(kr[lane]), k1 = bf2f(kr[64 + lane]), k2 = kpe;
                const float r = rsqrtf(wave_sum(k0 * k0 + k1 * k1 + k2 * k2) * (1.f / 192.f) + EPS);
                k0 *= r * wk0; k1 *= r * wk1; k2 *= r * wk2;
                const float kp = __shfl_xor(k2, 32);
                k2 = (lane < 32) ? k2 * cs - kp * sn : k2 * cs + kp * sn;
                bf16_t* ko = Kf + ob;
                ko[lane] = f2bf(k0); ko[64 + lane] = f2bf(k1); ko[128 + lane] = f2bf(k2);
            }
            img[(h * 128 + lane) * 72 + tloc] = kr[128 + lane]; img[(h * 128 + 64 + lane) * 72 + tloc] = kr[192 + lane];
        }
    }
    __syncthreads();
#pragma unroll
    for (int i = 0; i < 8; ++i) {
        const int ch = tid + 512 * i, row = ch >> 3, cc = ch & 7;
        *(u32x4*)(Vt + ((size_t)(bl * 4 + (row >> 7)) * 128 + (row & 127)) * SEQ + t0 + cc * 8) = *(const LAS u32x4*)(lds + row * 144 + cc * 16);
    }
    __syncthreads();
}

constexpr int KP = 400, VP = 136, KBYTES = 64 * KP, VBYTES = 128 * VP, ASTAGE = KBYTES + VBYTES;
DI void attn_unit(const bf16_t* Qf, const bf16_t* Kf, const bf16_t* Vt, bf16_t* yc, int bh, int qb, LAS unsigned char* lds) {
    const int tid = tid_now(), wave = tid >> 6, lane = tid & 63, r31 = lane & 31, hh = lane >> 5;
    const int q0 = qb * 256, qrow = q0 + wave * 32 + r31;
    const bf16_t* Qp = Qf + ((size_t)bh * SEQ + qrow) * 192 + 8 * hh;
    bf16x8 qf[12];
#pragma unroll
    for (int kk = 0; kk < 12; ++kk) qf[kk] = *(const bf16x8*)(Qp + kk * 16);
    f32x16 o[4];
#pragma unroll
    for (int d = 0; d < 4; ++d)
#pragma unroll
        for (int i = 0; i < 16; ++i) o[d][i] = 0.f;
    float m = -1e30f, l = 0.f;
    const int ntiles = qb * 4 + 4;
    const bf16_t* Kb = Kf + (size_t)bh * SEQ * 192; const bf16_t* Vb = Vt + (size_t)bh * 128 * SEQ;
    int krow[3], kcc[3], vd[2], vcc[2];
#pragma unroll
    for (int i = 0; i < 3; ++i) { const int c = tid + 512 * i; krow[i] = c / 24; kcc[i] = c % 24; }
#pragma unroll
    for (int i = 0; i < 2; ++i) { const int c = tid + 512 * i; vd[i] = c >> 3; vcc[i] = c & 7; }
    u32x4 kA[3], vA[2], kB[3], vB[2];
#define ATT_GLOAD(j, kreg, vreg) do { _Pragma("unroll") for (int i = 0; i < 3; ++i) kreg[i] = *(const u32x4*)(Kb + (size_t)((j) * 64 + krow[i]) * 192 + kcc[i] * 8); \
        _Pragma("unroll") for (int i = 0; i < 2; ++i) vreg[i] = *(const u32x4*)(Vb + (size_t)vd[i] * SEQ + (j) * 64 + vcc[i] * 8); } while (0)
#define ATT_LSTORE(st, kreg, vreg) do { LAS unsigned char* b_ = lds + (st) * ASTAGE; \
        _Pragma("unroll") for (int i = 0; i < 3; ++i) *(LAS u32x4*)(b_ + krow[i] * KP + kcc[i] * 16) = kreg[i]; \
        _Pragma("unroll") for (int i = 0; i < 2; ++i) { LAS u32x2* d_ = (LAS u32x2*)(b_ + KBYTES + vd[i] * VP + vcc[i] * 16); d_[0] = (u32x2){vreg[i].x, vreg[i].y}; d_[1] = (u32x2){vreg[i].z, vreg[i].w}; } } while (0)
    auto compute = [&](const int j, const int cur) __attribute__((always_inline)) {
        if (j * 64 <= q0 + wave * 32 + 31) {
            const LAS unsigned char* Kl = lds + cur * ASTAGE; const LAS unsigned char* Vl = Kl + KBYTES;
            f32x16 s0, s1;
#pragma unroll
            for (int i = 0; i < 16; ++i) { s0[i] = 0.f; s1[i] = 0.f; }
#pragma unroll
            for (int kk = 0; kk < 12; ++kk) {
                const bf16x8 a0 = *(const LAS bf16x8*)(Kl + r31 * KP + (kk * 16 + 8 * hh) * 2);
                const bf16x8 a1 = *(const LAS bf16x8*)(Kl + (32 + r31) * KP + (kk * 16 + 8 * hh) * 2);
                s0 = MFMA32(a0, qf[kk], s0); s1 = MFMA32(a1, qf[kk], s1);
            }
            if (j * 64 + 63 > q0 + wave * 32) {
#pragma unroll
                for (int i = 0; i < 16; ++i) { const int key = j * 64 + crow(i, hh); if (key > qrow) s0[i] = -1e30f; if (key + 32 > qrow) s1[i] = -1e30f; }
            }
            float mx = s0[0];
#pragma unroll
            for (int i = 1; i < 16; ++i) mx = fmaxf(mx, s0[i]);
#pragma unroll
            for (int i = 0; i < 16; ++i) mx = fmaxf(mx, s1[i]);
            mx = fmaxf(mx, __shfl_xor(mx, 32));
            const float mn = fmaxf(m, mx);
            if (__ballot(mx > m) != 0ull) {
                const float alpha = __builtin_amdgcn_exp2f(m - mn);
                l *= alpha;
#pragma unroll
                for (int d = 0; d < 4; ++d)
#pragma unroll
                    for (int i = 0; i < 16; ++i) o[d][i] *= alpha;
            }
            m = mn;
            float ls = 0.f;
#pragma unroll
            for (int i = 0; i < 16; ++i) { s0[i] = __builtin_amdgcn_exp2f(s0[i] - mn); s1[i] = __builtin_amdgcn_exp2f(s1[i] - mn); ls += s0[i] + s1[i]; }
            l += ls;
            bf16x8 pf[2][2];
#pragma unroll
            for (int s = 0; s < 2; ++s) {
                u32x4 w0, w1;
                w0.x = pk2(s0[8 * s], s0[8 * s + 1]); w0.y = pk2(s0[8 * s + 2], s0[8 * s + 3]); w0.z = pk2(s0[8 * s + 4], s0[8 * s + 5]); w0.w = pk2(s0[8 * s + 6], s0[8 * s + 7]);
                w1.x = pk2(s1[8 * s], s1[8 * s + 1]); w1.y = pk2(s1[8 * s + 2], s1[8 * s + 3]); w1.z = pk2(s1[8 * s + 4], s1[8 * s + 5]); w1.w = pk2(s1[8 * s + 6], s1[8 * s + 7]);
                pf[0][s] = __builtin_bit_cast(bf16x8, w0); pf[1][s] = __builtin_bit_cast(bf16x8, w1);
            }
#pragma unroll
            for (int d = 0; d < 4; ++d)
#pragma unroll
                for (int kb = 0; kb < 2; ++kb)
#pragma unroll
                    for (int s = 0; s < 2; ++s) {
                        const LAS unsigned char* vp = Vl + (d * 32 + r31) * VP + (kb * 32 + 16 * s + 4 * hh) * 2;
                        const s16x4 lo = *(const LAS s16x4*)vp, hi = *(const LAS s16x4*)(vp + 16);
                        const bf16x8 a = __builtin_shufflevector(lo, hi, 0, 1, 2, 3, 4, 5, 6, 7);
                        o[d] = MFMA32(a, pf[kb][s], o[d]);
                    }
        }
    };
    ATT_GLOAD(0, kA, vA); ATT_LSTORE(0, kA, vA); ATT_GLOAD(1, kB, vB);
    __syncthreads();
#pragma unroll 1
    for (int j = 0; j < ntiles; j += 2) {
        if (j + 2 < ntiles) ATT_GLOAD(j + 2, kA, vA);
        compute(j, 0);
        ATT_LSTORE(1, kB, vB);
        __syncthreads();
        if (j + 3 < ntiles) ATT_GLOAD(j + 3, kB, vB);
        compute(j + 1, 1);
        if (j + 2 < ntiles) ATT_LSTORE(0, kA, vA);
        __syncthreads();
    }
#undef ATT_GLOAD
#undef ATT_LSTORE
    l += __shfl_xor(l, 32);
    const float inv = 1.f / l;
    const int bl = bh >> 2, h = bh & 3;
    bf16_t* op = yc + ((size_t)bl * SEQ + qrow) * 512 + h * 128 + 4 * hh;
#pragma unroll
    for (int d = 0; d < 4; ++d)
#pragma unroll
        for (int i4 = 0; i4 < 4; ++i4)
            *(u32x2*)(op + d * 32 + 8 * i4) = (u32x2){pk2(o[d][4 * i4] * inv, o[d][4 * i4 + 1] * inv), pk2(o[d][4 * i4 + 2] * inv, o[d][4 * i4 + 3] * inv)};
}

DI void gmlp_unit(const Params& p, int l, const bf16_t* __restrict__ proj, bf16_t* __restrict__ yb, int bl, int c, LAS unsigned char* lds) {
    const int tid = tid_now(), wave = tid >> 6, lane = tid & 63, r31 = lane & 31, hh = lane >> 5;
    const float* wsp = p.in[14] + (size_t)l * 4 * 128 * 128; const float* bs = p.in[15] + l * 512; const float* vn = p.in[13] + l * 512;
    const size_t tl0 = (size_t)bl * SEQ + c * 128;
    float w8[8];
#pragma unroll
    for (int j = 0; j < 8; ++j) w8[j] = vn[lane + 64 * j];
    LAS bf16_t* vt = (LAS bf16_t*)lds;
#pragma unroll 8
    for (int rr = 0; rr < 16; ++rr) {
        const int row = wave * 16 + rr;
        const bf16_t* vr = proj + (tl0 + row) * PLD + 2056 + lane;
        float f[8]; float ss = 0.f;
#pragma unroll
        for (int j = 0; j < 8; ++j) { f[j] = gelu_f(bf2f(vr[64 * j])); ss += f[j] * f[j]; }
        const float rstd = rsqrtf(wave_sum(ss) * (1.f / 512.f) + EPS);
#pragma unroll
        for (int j = 0; j < 8; ++j) vt[(lane + 64 * j) * 136 + row] = f2bf(f[j] * rstd * w8[j]);
    }
    __syncthreads();
    const int mb = wave & 3, nh = wave >> 2, trow = mb * 32 + r31;
#pragma unroll 1
    for (int g = 0; g < 4; ++g) {
        f32x16 a0, a1;
#pragma unroll
        for (int i = 0; i < 16; ++i) { a0[i] = 0.f; a1[i] = 0.f; }
        const float* wrow = wsp + ((size_t)g * 128 + trow) * 128 + 8 * hh;
#pragma unroll
        for (int kk = 0; kk < 8; ++kk) if (kk * 16 <= mb * 32 + 31) {
            const f32x4 x0 = *(const f32x4*)(wrow + kk * 16), x1 = *(const f32x4*)(wrow + kk * 16 + 4);
            const int sb = kk * 16 + 8 * hh;
            float f[8];
#pragma unroll
            for (int j = 0; j < 4; ++j) { f[j] = (sb + j <= trow) ? x0[j] : 0.f; f[4 + j] = (sb + 4 + j <= trow) ? x1[j] : 0.f; }
            const bf16x8 a = __builtin_bit_cast(bf16x8, PACK8(f));
            const bf16x8 b0 = *(const LAS bf16x8*)(vt + (g * 128 + nh * 64 + r31) * 136 + kk * 16 + 8 * hh);
            const bf16x8 b1 = *(const LAS bf16x8*)(vt + (g * 128 + nh * 64 + 32 + r31) * 136 + kk * 16 + 8 * hh);
            a0 = MFMA32(a, b0, a0); a1 = MFMA32(a, b1, a1);
        }
        __syncthreads();
        LAS bf16_t* og = vt + (g * 128) * 136;
#pragma unroll
        for (int i = 0; i < 16; ++i) {
            const int t = mb * 32 + crow(i, hh); const float bias = bs[g * 128 + t];
            og[t * 136 + nh * 64 + r31] = f2bf(a0[i] + bias); og[t * 136 + nh * 64 + 32 + r31] = f2bf(a1[i] + bias);
        }
        __syncthreads();
#pragma unroll
        for (int k = 0; k < 4; ++k) {
            const int ch = tid + 512 * k, t = ch >> 4, d8 = (ch & 15) * 8;
            const u32x4 sv = *(const LAS u32x4*)(og + t * 136 + d8);
            const u32x4 uv = *(const u32x4*)(proj + (tl0 + t) * PLD + 1544 + g * 128 + d8);
            float fs[8], fu[8]; UNPACK8(sv, fs); UNPACK8(uv, fu);
#pragma unroll
            for (int j = 0; j < 8; ++j) fu[j] = gelu_f(fu[j]) * fs[j];
            *(u32x4*)(yb + (tl0 + t) * 512 + g * 128 + d8) = PACK8(fu);
        }
    }
    __syncthreads();
}

constexpr int SP = 136;
DI void scan128(float& v0, float& v1, int lane) {
#pragma unroll
    for (int o = 1; o < 64; o <<= 1) { const float n0 = __shfl_up(v0, o), n1 = __shfl_up(v1, o); if (lane >= o) { v0 += n0; v1 += n1; } }
    v1 += __shfl(v0, 63);
}
DI void ssd_states_unit(const bf16_t* xbcc, const float* dtb, float* ST, float* ATOT, int bl, int c, int grp, LAS unsigned char* lds) {
    const int tid = tid_now(), wave = tid >> 6, lane = tid & 63, r31 = lane & 31, hh = lane >> 5;
    LAS bf16_t* BT = (LAS bf16_t*)lds; LAS bf16_t* XT = (LAS bf16_t*)(lds + 34816); LAS float* WS = (LAS float*)(lds + 104448);
    const size_t row0 = (size_t)bl * SEQ + c * 128;
    if (wave < 4) {
        const int h = grp * 4 + wave;
        const float d0 = dtb[(row0 + lane) * 16 + h], d1 = dtb[(row0 + 64 + lane) * 16 + h];
        float v0 = dtb[(row0 + lane) * 16 + 8 + h], v1 = dtb[(row0 + 64 + lane) * 16 + 8 + h];
        scan128(v0, v1, lane);
        const float tot = __shfl(v1, 63);
        WS[wave * 128 + lane] = d0 * __expf(tot - v0); WS[wave * 128 + 64 + lane] = d1 * __expf(tot - v1);
        if (lane == 0) ATOT[(bl * 16 + c) * 8 + h] = tot;
    }
    __syncthreads();
#pragma unroll
    for (int i = 0; i < 4; ++i) {
        const int ch = tid + 512 * i, s = ch >> 4, n8 = (ch & 15) * 8;
        const u32x4 v = *(const u32x4*)(xbcc + (row0 + s) * 1024 + 512 + grp * 128 + n8);
        LAS bf16_t* d = BT + n8 * SP + s;
        d[0] = (bf16_t)(v.x & 0xffffu); d[SP] = (bf16_t)(v.x >> 16); d[2 * SP] = (bf16_t)(v.y & 0xffffu); d[3 * SP] = (bf16_t)(v.y >> 16);
        d[4 * SP] = (bf16_t)(v.z & 0xffffu); d[5 * SP] = (bf16_t)(v.z >> 16); d[6 * SP] = (bf16_t)(v.w & 0xffffu); d[7 * SP] = (bf16_t)(v.w >> 16);
    }
#pragma unroll
    for (int i = 0; i < 8; ++i) {
        const int ch = tid + 512 * i, s = ch >> 5, c8 = (ch & 31) * 8;
        const u32x4 v = *(const u32x4*)(xbcc + (row0 + s) * 1024 + grp * 256 + c8); float f[8]; UNPACK8(v, f);
        const float w = WS[(c8 >> 6) * 128 + s];
        LAS bf16_t* d = XT + c8 * SP + s;
#pragma unroll
        for (int j = 0; j < 8; ++j) d[j * SP] = f2bf(f[j] * w);
    }
    __syncthreads();
    const int hl = wave >> 1, pb = wave & 1;
    f32x16 acc[4];
#pragma unroll
    for (int nb = 0; nb < 4; ++nb)
#pragma unroll
        for (int i = 0; i < 16; ++i) acc[nb][i] = 0.f;
#pragma unroll
    for (int k = 0; k < 8; ++k) {
        const bf16x8 a = *(const LAS bf16x8*)(XT + (hl * 64 + pb * 32 + r31) * SP + k * 16 + 8 * hh);
#pragma unroll
        for (int nb = 0; nb < 4; ++nb) { const bf16x8 b = *(const LAS bf16x8*)(BT + (nb * 32 + r31) * SP + k * 16 + 8 * hh); acc[nb] = MFMA32(a, b, acc[nb]); }
    }
    float* so = ST + (((size_t)bl * 16 + c) * 8 + grp * 4 + hl) * 8192;
#pragma unroll
    for (int nb = 0; nb < 4; ++nb)
#pragma unroll
        for (int i = 0; i < 16; ++i) so[(pb * 32 + crow(i, hh)) * 128 + nb * 32 + r31] = acc[nb][i];
    __syncthreads();
}
DI void ssd_scan(const float* ST, bf16_t* STB, const float* ATOT) {
    const int tidn = tid_now();
    for (int idx = wg_now() * 512 + tidn; idx < 64 * 2048; idx += nwg_now() * 512) {
        const int bh = idx >> 11, e4 = idx & 2047, bl = bh >> 3, head = bh & 7;
        const size_t off = ((size_t)bl * 16 * 8 + head) * 8192 + e4 * 4;
        f32x4 sv[16];
#pragma unroll
        for (int c = 0; c < 16; ++c) sv[c] = *(const f32x4*)(ST + off + (size_t)c * 8 * 8192);
        f32x4 run = {0.f, 0.f, 0.f, 0.f};
#pragma unroll
        for (int c = 0; c < 16; ++c) { const float ea = __expf(ATOT[(bl * 16 + c) * 8 + head]);
            *(u32x2*)(STB + off + (size_t)c * 8 * 8192) = (u32x2){pk2(run[0], run[1]), pk2(run[2], run[3])}; run = run * ea + sv[c]; }
    }
}
DI void ssd_out_grp(const Params& p, int l, const bf16_t* proj, const bf16_t* xbcc, const float* dtb, const bf16_t* STB, bf16_t* ya, int bl, int c, int grp, LAS unsigned char* lds) {
    const int tid = tid_now(), wave = tid >> 6, lane = tid & 63, r31 = lane & 31, hh = lane >> 5;
    LAS bf16_t* CL = (LAS bf16_t*)lds; LAS bf16_t* BL = (LAS bf16_t*)(lds + 34816); LAS bf16_t* XT = (LAS bf16_t*)(lds + 69632); LAS bf16_t* PV = (LAS bf16_t*)(lds + 104448);
    LAS float* ACS = (LAS float*)(lds + 139264); LAS float* DTL = (LAS float*)(lds + 141312); LAS float* RS = (LAS float*)(lds + 143360); LAS float* OUT = (LAS float*)lds;
    const size_t row0 = (size_t)bl * SEQ + c * 128;
#pragma unroll
    for (int i = 0; i < 4; ++i) {
        const int ch = tid + 512 * i, s = ch >> 4, n8 = (ch & 15) * 8;
        const bf16_t* xr = xbcc + (row0 + s) * 1024;
        *(LAS u32x4*)(CL + s * SP + n8) = *(const u32x4*)(xr + 768 + grp * 128 + n8);
        *(LAS u32x4*)(BL + s * SP + n8) = *(const u32x4*)(xr + 512 + grp * 128 + n8);
    }
    if (wave < 4) {
        const int h = grp * 4 + wave;
        const float d0 = dtb[(row0 + lane) * 16 + h], d1 = dtb[(row0 + 64 + lane) * 16 + h];
        float v0 = dtb[(row0 + lane) * 16 + 8 + h], v1 = dtb[(row0 + 64 + lane) * 16 + 8 + h];
        scan128(v0, v1, lane);
        ACS[wave * 128 + lane] = v0; ACS[wave * 128 + 64 + lane] = v1; DTL[wave * 128 + lane] = d0; DTL[wave * 128 + 64 + lane] = d1;
    }
    const int tb = wave >> 1, hl = wave & 1;
    f32x16 acc[2][2];
#pragma unroll
    for (int pi = 0; pi < 2; ++pi) {
        const int pair = grp * 2 + pi;
        __syncthreads();
#pragma unroll
        for (int i = 0; i < 4; ++i) {
            const int ch = tid + 512 * i, s = ch >> 4, n8 = (ch & 15) * 8;
            const u32x4 v = *(const u32x4*)(xbcc + (row0 + s) * 1024 + pair * 128 + n8); float f[8]; UNPACK8(v, f);
            const float w = DTL[(pi * 2 + (n8 >> 6)) * 128 + s];
            LAS bf16_t* d = XT + n8 * SP + s;
#pragma unroll
            for (int j = 0; j < 8; ++j) d[j * SP] = f2bf(f[j] * w);
            *(LAS u32x4*)(PV + s * SP + n8) = *(const u32x4*)(STB + (((size_t)bl * 16 + c) * 8 + pair * 2) * 8192 + (size_t)s * 128 + n8);
        }
        __syncthreads();
#pragma unroll
        for (int pb = 0; pb < 2; ++pb)
#pragma unroll
            for (int i = 0; i < 16; ++i) acc[pi][pb][i] = 0.f;
        const LAS bf16_t* crw = CL + (tb * 32 + r31) * SP + 8 * hh;
#pragma unroll
        for (int k = 0; k < 8; ++k) {
            const bf16x8 b = *(const LAS bf16x8*)(crw + k * 16);
#pragma unroll
            for (int pb = 0; pb < 2; ++pb) { const bf16x8 a = *(const LAS bf16x8*)(PV + (hl * 64 + pb * 32 + r31) * SP + k * 16 + 8 * hh); acc[pi][pb] = MFMA32(a, b, acc[pi][pb]); }
        }
        const LAS float* acs = ACS + (pi * 2 + hl) * 128;
        const float at = acs[tb * 32 + r31], eat = __expf(at);
#pragma unroll
        for (int pb = 0; pb < 2; ++pb)
#pragma unroll
            for (int i = 0; i < 16; ++i) acc[pi][pb][i] *= eat;
#pragma unroll 1
        for (int sb = 0; sb <= tb; ++sb) {
            f32x16 cbt;
#pragma unroll
            for (int i = 0; i < 16; ++i) cbt[i] = 0.f;
#pragma unroll
            for (int k = 0; k < 8; ++k) {
                const bf16x8 a = *(const LAS bf16x8*)(BL + (sb * 32 + r31) * SP + k * 16 + 8 * hh);
                const bf16x8 b = *(const LAS bf16x8*)(crw + k * 16);
                cbt = MFMA32(a, b, cbt);
            }
#pragma unroll
            for (int i = 0; i < 16; ++i) {
                const int sl = crow(i, hh); const float as = acs[sb * 32 + sl];
                const float mv = cbt[i] * __expf(fminf(at - as, 0.f));
                cbt[i] = (sb == tb && sl > r31) ? 0.f : mv;
            }
#pragma unroll
            for (int ks = 0; ks < 2; ++ks) {
                u32x4 w; w.x = pk2(cbt[8 * ks], cbt[8 * ks + 1]); w.y = pk2(cbt[8 * ks + 2], cbt[8 * ks + 3]); w.z = pk2(cbt[8 * ks + 4], cbt[8 * ks + 5]); w.w = pk2(cbt[8 * ks + 6], cbt[8 * ks + 7]);
                const bf16x8 pfr = __builtin_bit_cast(bf16x8, w);
#pragma unroll
                for (int pb = 0; pb < 2; ++pb) {
                    const LAS bf16_t* vp = XT + (hl * 64 + pb * 32 + r31) * SP + sb * 32 + 16 * ks + 4 * hh;
                    const s16x4 lo = *(const LAS s16x4*)vp, hi = *(const LAS s16x4*)(vp + 8);
                    const bf16x8 a = __builtin_shufflevector(lo, hi, 0, 1, 2, 3, 4, 5, 6, 7);
                    acc[pi][pb] = MFMA32(a, pfr, acc[pi][pb]);
                }
            }
        }
    }
    __syncthreads();
#pragma unroll
    for (int pi = 0; pi < 2; ++pi)
#pragma unroll
        for (int pb = 0; pb < 2; ++pb)
#pragma unroll
            for (int i = 0; i < 16; ++i) OUT[(tb * 32 + r31) * 260 + pi * 128 + hl * 64 + pb * 32 + crow(i, hh)] = acc[pi][pb][i];
    __syncthreads();
#pragma unroll 2
    for (int i = 0; i < 8; ++i) {
        const int it = tid + 512 * i, t = it >> 5, c8 = (it & 31) * 8;
        LAS f32x4* op = (LAS f32x4*)(OUT + t * 260 + c8);
        const f32x4 y0 = op[0], y1 = op[1];
        const u32x4 xv = *(const u32x4*)(xbcc + (row0 + t) * 1024 + grp * 256 + c8), zv = *(const u32x4*)(proj + (row0 + t) * PLD + grp * 256 + c8);
        float fx[8], fz[8]; UNPACK8(xv, fx); UNPACK8(zv, fz);
        const float Dh = p.in[11][l * 8 + grp * 4 + (c8 >> 6)];
        f32x4 o0, o1;
#pragma unroll
        for (int j = 0; j < 4; ++j) { o0[j] = (y0[j] + Dh * fx[j]) * silu_f(fz[j]); o1[j] = (y1[j] + Dh * fx[4 + j]) * silu_f(fz[4 + j]); }
        op[0] = o0; op[1] = o1;
        float ss = 0.f;
#pragma unroll
        for (int j = 0; j < 4; ++j) ss += o0[j] * o0[j] + o1[j] * o1[j];
        ss += __shfl_xor(ss, 1); ss += __shfl_xor(ss, 2); ss += __shfl_xor(ss, 4); ss += __shfl_xor(ss, 8); ss += __shfl_xor(ss, 16);
        if ((tid & 31) == 0) RS[t] = ss;
    }
    __syncthreads();
    const float* nw = p.in[12] + l * 512 + grp * 256;
#pragma unroll 2
    for (int i = 0; i < 8; ++i) {
        const int it = tid + 512 * i, t = it >> 5, c8 = (it & 31) * 8;
        const LAS f32x4* op = (const LAS f32x4*)(OUT + t * 260 + c8);
        const f32x4 a = op[0], b = op[1], w0 = *(const f32x4*)(nw + c8), w1 = *(const f32x4*)(nw + c8 + 4);
        const float rstd = rsqrtf(RS[t] * (1.f / 256.f) + EPS);
        *(u32x4*)(ya + (row0 + t) * 512 + grp * 256 + c8) = (u32x4){pk2(a[0] * rstd * w0[0], a[1] * rstd * w0[1]), pk2(a[2] * rstd * w0[2], a[3] * rstd * w0[3]),
                                                                      pk2(b[0] * rstd * w1[0], b[1] * rstd * w1[1]), pk2(b[2] * rstd * w1[2], b[3] * rstd * w1[3])};
    }
    __syncthreads();
}

#if MULTI_LAUNCH
#define RUNPH(x) ((x) == p.only_phase)
#define GSYNC() do {} while (0)
#else
#define RUNPH(x) true
#define GSYNC() do { XcdBarrier xb_; xb_.bar = (unsigned*)(p.ws + O_BAR); xb_.x = xb_xcc_id(); xb_.st = (volatile LAS unsigned*)(lds + LDS_BYTES - 16); xcd_barrier(xb_); if (PROBE & 1) xcd_barrier(xb_); } while (0)
#endif
#define PH_BEGIN if (RUNPH(ph)) { size_t z_ = 0; asm volatile("" : "+s"(z_)); unsigned char* ws = p.ws + z_; float* X = p.out + z_; const int wg = wg_now(), nwg = nwg_now();
#define PH_END_C(cls) } ++ph; GSYNC(); if (PROBE_T) { const unsigned long long t1_ = __builtin_amdgcn_s_memrealtime(); if ((PROBE_T >> (cls)) & 1) tacc_ += t1_ - t0_; if ((cls) == 7 && ((PROBE_T >> 14) & 1)) tacc_ += t1_; t0_ = t1_; }
__global__ void __launch_bounds__(512) mega(Params p) {
    extern __shared__ __attribute__((aligned(16))) unsigned char smem[];
    LAS unsigned char* lds = (LAS unsigned char*)smem;
#if !MULTI_LAUNCH
    cg::grid_group grid = cg::this_grid();
    volatile LAS unsigned* xst = (volatile LAS unsigned*)(lds + LDS_BYTES - 16);
    if (threadIdx.x == 0) { xst[0] = 0u; xst[1] = 0u; }
    __syncthreads();
    (void)xcd_barrier_post((unsigned*)(p.ws + O_BAR), xst);
    grid.sync();
#endif
#define XN ((bf16_t*)(ws + O_XN))
#define SSQ0 ((float*)(ws + O_SSQ))
#define SSQ1 (SSQ0 + (size_t)T_ALL * 16)
#define SSQ2 (SSQ0 + (size_t)2 * T_ALL * 16)
#define H ((bf16_t*)(ws + O_H))
#define PROJ ((bf16_t*)(ws + O_PROJ))
#define XBCC ((bf16_t*)(ws + O_XBCC))
#define ST ((float*)(ws + O_ST))
#define ATOT ((float*)(ws + O_ATOT))
#define STB ((bf16_t*)(ws + O_STB))
#define DTB ((float*)(ws + O_DTB))
#define AQ ((bf16_t*)(ws + O_AQ))
#define AKV ((bf16_t*)(ws + O_AKV))
#define QRAW ((bf16_t*)(ws + O_QRAW))
#define KVRAW ((bf16_t*)(ws + O_KVRAW))
#define QF ((bf16_t*)(ws + O_QF))
#define KF ((bf16_t*)(ws + O_KF))
#define VT ((bf16_t*)(ws + O_VT))
#define YRAW ((float*)(ws + O_YRAW))
#define YA ((bf16_t*)(ws + O_YA))
#define YB (YA + (size_t)TG * 512)
#define YC (YA + (size_t)2 * TG * 512)
#define YD (YA + (size_t)3 * TG * 512)
#define CS ((f32x2*)(ws + O_CS))
#define PB ((bf16_t*)(ws + O_PB))
#define MIXB ((bf16_t*)(ws + O_MIXB))
#define WIN ((const bf16_t*)(ws + O_WIN))
#define WGATE ((const bf16_t*)(ws + O_WGATE))
#define WBR ((const bf16_t*)(ws + O_WBR))
#define WOUT ((const bf16_t*)(ws + O_WOUT))
#define WQB ((const bf16_t*)(ws + O_WQB))
#define WKVB ((const bf16_t*)(ws + O_WKVB))
#define XNg (XN + (size_t)g * TG * 1024)
    int ph = 0;
    unsigned long long t0_ = PROBE_T ? __builtin_amdgcn_s_memrealtime() : 0ull, tacc_ = 0ull;
#pragma unroll 1
    for (int l = 0; l < 4; ++l) {
#pragma unroll 1
        for (int f = 0; f < 2; ++f) {
            if (f == 0) {
                PH_BEGIN
                    REP(32) convert_layer(p, l, (LAS float*)lds, wg, nwg);
                    if (l == 0) { rope_table(p, CS); init_rows(p.in[0], XN, SSQ0); }
                PH_END_C(0)
            }
            PH_BEGIN
                EpiGU e{H, f == 0 ? SSQ0 : SSQ2};
#pragma unroll 1
                for (int rep = 0; rep < ((PROBE & 16) ? 2 : 1); ++rep) run_gemm(lds, XN, (const bf16_t*)(ws + (f == 0 ? O_WGU1 : O_WGU2)), T_ALL, 5632, 1024, e);
            PH_END_C(1)
            PH_BEGIN
                if (PROBE & 256) { EpiRes e0{XN, f == 0 ? SSQ1 : SSQ0, (l == 3 && f == 1) ? X : nullptr, 0.0f}; run_gemm(lds, H, (const bf16_t*)(ws + (f == 0 ? O_WD1 : O_WD2)), T_ALL, 1024, 2816, e0); }
                EpiRes e{XN, f == 0 ? SSQ1 : SSQ0, (l == 3 && f == 1) ? X : nullptr, 0.5f}; run_gemm(lds, H, (const bf16_t*)(ws + (f == 0 ? O_WD1 : O_WD2)), T_ALL, 1024, 2816, e);
            PH_END_C(2)
            if (f == 0) {
#pragma unroll 1
                for (int g = 0; g < NGRP; ++g) {
                    if (g == 0) {
                        PH_BEGIN
                            EpiStore e{PROJ, PLD, 0x7fffffff, SSQ1}; run_gemm(lds, XN, WIN, TG, 4864, 1024, e);
                        PH_END_C(3)
                    }
                    PH_BEGIN
                        REP(4) prep1(p, l, PROJ, XBCC, DTB, AQ, AKV, YD);
                    PH_END_C(4)
                    PH_BEGIN
                        REP(64) {
                        { EpiStore e{QRAW, 768, 0x7fffffff, nullptr}; run_gemm(lds, AQ, WQB, TG, 768, 384, e); }
                        { EpiStore e{KVRAW, 1024, 0x7fffffff, nullptr}; run_gemm(lds, AKV, WKVB, TG, 1024, 256, e); }
#pragma unroll 1
                        for (int u = wg; u < 256; u += nwg) {
                            ssd_states_unit(XBCC, DTB, ST, ATOT, u >> 5, (u >> 1) & 15, u & 1, lds);
                        }
                        }
                    PH_END_C(5)
                    PH_BEGIN
                        REP(4) for (int u = wg; u < 256; u += nwg) prep2_unit(p, l, g, PROJ, QRAW, KVRAW, CS, QF, KF, VT, u >> 5, u & 31, lds);
                        ssd_scan(ST, STB, ATOT);
                    PH_END_C(6)
                    PH_BEGIN
                        {
                            unsigned* ctr = (unsigned*)(ws + O_WQ) + (l * 4 + g);
                            volatile LAS unsigned* wq = (volatile LAS unsigned*)(lds + LDS_BYTES - 32);
#pragma unroll 1
                            for (;;) {
                                __syncthreads();
                                if (tid_now() == 0) *wq = atomicAdd(ctr, 1u);
                                __syncthreads();
                                const int u = (int)*wq;
                                unsigned long long tu0_ = PROBE_T ? __builtin_amdgcn_s_memrealtime() : 0ull;
                                if (u >= 640) { if ((PROBE_T >> 14) & 1) { tacc_ -= tu0_; } break; }
                                int cls_;
                                if (u < 64) { attn_unit(QF, KF, VT, YC, u & 31, 7 - (u >> 5), lds); cls_ = 11; }
                                else if (u < 192) { const int k = u - 64; gmlp_unit(p, l, PROJ, YB, k >> 4, k & 15, lds); cls_ = 13; }
                                else if (u < 256) { const int k = u - 192; attn_unit(QF, KF, VT, YC, k & 31, 5 - (k >> 5), lds); cls_ = 11; }
                                else if (u < 512) { const int k = u - 256; ssd_out_grp(p, l, PROJ, XBCC, DTB, STB, YA, k >> 5, (k >> 1) & 15, k & 1, lds); cls_ = 12; }
                                else { const int k = u - 512; attn_unit(QF, KF, VT, YC, k & 31, 3 - (k >> 5), lds); cls_ = 11; }
                                if (PROBE_T) { const unsigned long long tu1_ = __builtin_amdgcn_s_memrealtime(); if ((PROBE_T >> cls_) & 1) tacc_ += tu1_ - tu0_; }
                            }
                        }
                    PH_END_C(7)
                    PH_BEGIN
                        EpiStore e{PB, 1024, 3, nullptr}; pg8::Gemm gm{YA, WBR, 4 * TG, 4096, 512}; BranchOrder S; S.G = nwg; S.c = wg;
                        REP(128) pg8::gemm_phase<EpiStore, BranchOrder>(lds, gm, S, e);
                    PH_END_C(8)
                    PH_BEGIN
                        EpiMerge e{PB, MIXB, SSQ1 + (size_t)g * TG * 16}; REP(128) run_gemm(lds, XNg, WGATE, TG, 4096, 1024, e);
                    PH_END_C(9)
                    PH_BEGIN
                        { EpiRes e{XNg, SSQ2 + (size_t)g * TG * 16, nullptr, 1.0f}; run_gemm(lds, MIXB, WOUT, TG, 1024, 1024, e); }
                        if (g < NGRP - 1) {
                            EpiStore e{PROJ, PLD, 0x7fffffff, SSQ1 + (size_t)(g + 1) * TG * 16}; run_gemm(lds, XN + (size_t)(g + 1) * TG * 1024, WIN, TG, 4864, 1024, e); }
                    PH_END_C(10)
                }
            }
        }
    }
    if (PROBE_T) { const unsigned long long te_ = __builtin_amdgcn_s_memrealtime(); while (__builtin_amdgcn_s_memrealtime() - te_ < tacc_) __builtin_amdgcn_s_sleep(8); }
}

constexpr int N_PHASES = 4 * (1 + 2 + 1 + 4 * 7 + 2);

extern "C" void kernel_launch(void* const* d_in, const int* in_sizes, int n_in, void* d_out, int out_size, void* d_ws, size_t ws_size, hipStream_t stream) {
    static int grid_blocks = 0;
    if (!grid_blocks) {
        if (n_in != 28 || ws_size < WS_NEED) { fprintf(stderr, "kernel_launch: need 28 inputs and %zu bytes of workspace (got %d, %zu)\n", (size_t)WS_NEED, n_in, ws_size); grid_blocks = -1; return; }
        if (hipFuncSetAttribute((const void*)mega, hipFuncAttributeMaxDynamicSharedMemorySize, LDS_BYTES) != hipSuccess) { fprintf(stderr, "kernel_launch: hipFuncSetAttribute failed\n"); grid_blocks = -1; return; }
        int dev = 0, cus = 0, per_cu = 0;
        hipGetDevice(&dev); hipDeviceGetAttribute(&cus, hipDeviceAttributeMultiprocessorCount, dev);
        hipOccupancyMaxActiveBlocksPerMultiprocessor(&per_cu, mega, 512, LDS_BYTES);
        if (per_cu < 1) { fprintf(stderr, "kernel_launch: occupancy query returned %d\n", per_cu); per_cu = 1; }
        (void)hipGetLastError();
        grid_blocks = cus * per_cu;
    }
    if (grid_blocks < 0) return;
    Params p{};
    for (int i = 0; i < 28; ++i) p.in[i] = (const float*)d_in[i];
    p.out = (float*)d_out; p.ws = (unsigned char*)d_ws; p.only_phase = -1; p.pad = 0;
#if MULTI_LAUNCH
    for (int ph = 0; ph < N_PHASES; ++ph) { p.only_phase = ph; hipLaunchKernelGGL(mega, dim3(grid_blocks), dim3(512), LDS_BYTES, stream, p); }
#else
    if (hipMemsetAsync((unsigned char*)d_ws + O_BAR, 0, ZERO_BYTES, stream) != hipSuccess) { fprintf(stderr, "kernel_launch: memset of barrier words failed\n"); return; }
    void* args[] = {&p};
    hipError_t e = hipLaunchCooperativeKernel((void*)mega, dim3(grid_blocks), dim3(512), args, LDS_BYTES, stream);
    if (e != hipSuccess) fprintf(stderr, "cooperative launch failed: %s (grid %d)\n", hipGetErrorString(e), grid_blocks);
#endif
}
```

```cpp
#include <hip/hip_runtime.h>
#include <hip/hip_cooperative_groups.h>
#include <cstdio>
namespace cg = cooperative_groups;

#ifndef PROBE
#define PROBE 0
#endif
#define REP(bit) _Pragma("unroll 1") for (int rep_ = 0; rep_ < ((PROBE & (bit)) ? 2 : 1); ++rep_)
#ifndef PROBE_T
#define PROBE_T 0
#endif
#ifndef MULTI_LAUNCH
#define MULTI_LAUNCH 0
#endif

__device__ __forceinline__ int tid_now() { int t = threadIdx.x; asm volatile("" : "+v"(t)); return t; }
__device__ __forceinline__ int wg_now() { int t = blockIdx.x; asm volatile("" : "+s"(t)); return t; }
__device__ __forceinline__ int nwg_now() { int t = gridDim.x; asm volatile("" : "+s"(t)); return t; }
namespace pg8 {
#define PG8_LAS __attribute__((address_space(3)))
typedef unsigned short bf16_t;
typedef short bf16x8 __attribute__((ext_vector_type(8)));
typedef float f32x4 __attribute__((ext_vector_type(4)));
typedef unsigned u32x4 __attribute__((ext_vector_type(4)));
constexpr int BM = 256, BK = 64, HALF = 128, HTB = HALF * BK * 2  , STAGE_BYTES = 8 * HTB, NXCD = 8, WGM = 8;

__host__ __device__ __forceinline__ int lds_byte(int r, int c) { const int st = (r >> 4) * 2 + (c >> 5), rr = r & 15, cc = c & 31, ob = rr * 64 + cc * 2; return st * 1024 + (ob ^ (((ob >> 9) & 1) << 5)); }
__host__ __device__ __forceinline__ void stage_rc(int b, int& R, int& C) { const int st = b / 1024, sb = b % 1024, swz = sb ^ (((sb >> 9) & 1) << 5); R = (st >> 1) * 16 + swz / 64; C = (st & 1) * 32 + (swz % 64) / 2; }
__host__ __device__ __forceinline__ int perm32(int rho) { const int n = rho >> 4, i = rho & 15; return 8 * (i >> 2) + 4 * n + (i & 3); }

struct Unit { int pm, pn; };
struct Gemm { const bf16_t* A; const bf16_t* Bt; int M, N, K; };

struct StaticOrder {
    int nM, nN, nwg, G, c;
    __host__ __device__ void init(int M, int N, int G_, int c_) { nM = M / BM; nN = N / BM; nwg = nM * nN; G = G_; c = c_; }
    __host__ __device__ bool next(int i, Unit& u) const {
        const long L = (long)i * G + c; if (L >= nwg) return false;
        int wgid = (int)L; { const int q = nwg / NXCD, r = nwg % NXCD, xcd = wgid % NXCD, off = wgid / NXCD; wgid = (xcd < r ? xcd * (q + 1) : r * (q + 1) + (xcd - r) * q) + off; }
        const int nig = WGM * nN, gid = wgid / nig, fm = gid * WGM, gsz = (nM - fm) < WGM ? (nM - fm) : WGM;
        u.pm = fm + ((wgid % nig) % gsz); u.pn = (wgid % nig) / gsz; return true;
    }
    __device__ __forceinline__ void a_ready(const Unit&) const {}
    __device__ __forceinline__ void done(const Unit&) const {}
};

template <class Epi, class Sched>
__device__ __forceinline__ void gemm_phase(PG8_LAS unsigned char* lds, const Gemm g, const Sched& S, const Epi& E) {
    const int tid = tid_now(), wid = __builtin_amdgcn_readfirstlane(tid >> 6), lane = tid & 63, wr = wid >> 2, wc = wid & 3, fr = lane & 15, fq = lane >> 4;
    const int K = g.K, nt = K / BK;
    unsigned voffA[2], voffB[2];
#pragma unroll
    for (int i = 0; i < 2; ++i) { int R, C; stage_rc(tid * 16 + i * 8192, R, C); const int Rb = Epi::PERM ? ((R & ~31) + perm32(R & 31)) : R;
        voffA[i] = (unsigned)(R * K + C) * 2u; voffB[i] = (unsigned)(Rb * K + C) * 2u; }
    const size_t kstep = (size_t)(BK * 2);
    const size_t hstep = (size_t)HALF * K * 2;
    const size_t tstep = 2 * hstep;
    const unsigned ldsw = (unsigned)wid * 1024u;
    const int aoff = lds_byte(wr * 64 + fr, fq * 8), boff = lds_byte(wc * 32 + fr, fq * 8);
#define PG8_SA(b, h) (((b) * 2 + (h)) * HTB)
#define PG8_SB(b, h) ((4 + (b) * 2 + (h)) * HTB)
#define PG8_STAGE(bufoff, gbase, voff) do { _Pragma("unroll") for (int _i = 0; _i < 2; ++_i) \
        __builtin_amdgcn_global_load_lds((const unsigned*)((const char*)(gbase) + (voff)[_i]), (PG8_LAS unsigned*)(lds + (bufoff) + ldsw + _i * 8192), 16, 0, 0); } while (0)
#define PG8_LDA(dst, b, h) do { _Pragma("unroll") for (int m = 0; m < 4; ++m) _Pragma("unroll") for (int k = 0; k < 2; ++k) dst[m][k] = *(const PG8_LAS bf16x8*)(lds + PG8_SA(b, h) + aoff + m * 2048 + k * 1024); } while (0)
#define PG8_LDB(dst, b, h) do { _Pragma("unroll") for (int n = 0; n < 2; ++n) _Pragma("unroll") for (int k = 0; k < 2; ++k) dst[n][k] = *(const PG8_LAS bf16x8*)(lds + PG8_SB(b, h) + boff + n * 2048 + k * 1024); } while (0)
#define PG8_MMA(ai, bj, At, Bt) do { __builtin_amdgcn_s_setprio(1); _Pragma("unroll") for (int m = 0; m < 4; ++m) _Pragma("unroll") for (int n = 0; n < 2; ++n) _Pragma("unroll") for (int k = 0; k < 2; ++k) \
        acc[ai][bj][m][n] = __builtin_amdgcn_mfma_f32_16x16x32_bf16(Bt[n][k], At[m][k], acc[ai][bj][m][n], 0, 0, 0); __builtin_amdgcn_s_setprio(0); } while (0)
#define PG8_WAIT_V(n) asm volatile("s_waitcnt vmcnt(" #n ")" ::: "memory")
#define PG8_WAIT_L(n) asm volatile("s_waitcnt lgkmcnt(" #n ")" ::: "memory")
#define PG8_BAR __builtin_amdgcn_s_barrier()
#define PG8_SCHED __builtin_amdgcn_sched_barrier(0)
    Unit cur, nxt; int ui = 0;
    if (!S.next(0, cur)) return;
    f32x4 acc[2][2][4][2];
#pragma unroll
    for (int a = 0; a < 2; ++a)
#pragma unroll
        for (int b = 0; b < 2; ++b)
#pragma unroll
            for (int m = 0; m < 4; ++m)
#pragma unroll
                for (int n = 0; n < 2; ++n) acc[a][b][m][n] = (f32x4){0.f, 0.f, 0.f, 0.f};
    bf16x8 At[4][2], B0[2][2], B1[2][2];
    const char* cA = (const char*)g.A + (size_t)cur.pm * tstep; const char* cB = (const char*)g.Bt + (size_t)cur.pn * tstep;
    S.a_ready(cur);
    PG8_STAGE(PG8_SB(0, 0), cB, voffB); PG8_STAGE(PG8_SA(0, 0), cA, voffA); PG8_STAGE(PG8_SB(0, 1), cB + hstep, voffB); PG8_STAGE(PG8_SA(0, 1), cA + hstep, voffA);
    if (wr == 1) PG8_BAR;
    PG8_WAIT_V(4); PG8_BAR;
    PG8_STAGE(PG8_SB(1, 0), cB + kstep, voffB); PG8_STAGE(PG8_SA(1, 0), cA + kstep, voffA); PG8_STAGE(PG8_SB(1, 1), cB + hstep + kstep, voffB);
    PG8_WAIT_V(6); PG8_BAR;
    for (;;) {
        const bool has_next = S.next(ui + 1, nxt);
        const char* nA = has_next ? (const char*)g.A + (size_t)nxt.pm * tstep : cA; const char* nB = has_next ? (const char*)g.Bt + (size_t)nxt.pn * tstep : cB;
        for (int t = 0; t < nt; t += 2) {
            const bool last = (t == nt - 2);
            const char* a1 = cA + (size_t)(t + 1) * kstep;
            const char* a2 = last ? nA : cA + (size_t)(t + 2) * kstep; const char* b2 = last ? nB : cB + (size_t)(t + 2) * kstep;
            const char* a3 = a2 + kstep; const char* b3 = b2 + kstep;
            if (last && has_next) S.a_ready(nxt);
            PG8_LDB(B0, 0, 0); PG8_SCHED; PG8_LDA(At, 0, 0); PG8_STAGE(PG8_SA(1, 1), a1 + hstep, voffA);
            PG8_WAIT_L(8); PG8_BAR; PG8_WAIT_L(0); PG8_MMA(0, 0, At, B0); PG8_BAR; PG8_SCHED;
            PG8_LDB(B1, 0, 1); PG8_STAGE(PG8_SB(0, 0), b2, voffB);
            PG8_BAR; PG8_WAIT_L(0); PG8_MMA(0, 1, At, B1); PG8_BAR;
            PG8_LDA(At, 0, 1); PG8_STAGE(PG8_SA(0, 0), a2, voffA);
            PG8_BAR; PG8_WAIT_L(0); PG8_MMA(1, 0, At, B0); PG8_BAR; PG8_SCHED;
            PG8_STAGE(PG8_SB(0, 1), b2 + hstep, voffB);
            PG8_WAIT_V(6); PG8_BAR; PG8_MMA(1, 1, At, B1); PG8_BAR;
            PG8_LDB(B0, 1, 0); PG8_SCHED; PG8_LDA(At, 1, 0); PG8_STAGE(PG8_SA(0, 1), a2 + hstep, voffA);
            PG8_WAIT_L(8); PG8_BAR; PG8_WAIT_L(0); PG8_MMA(0, 0, At, B0); PG8_BAR; PG8_SCHED;
            PG8_LDB(B1, 1, 1); PG8_STAGE(PG8_SB(1, 0), b3, voffB);
            PG8_BAR; PG8_WAIT_L(0); PG8_MMA(0, 1, At, B1); PG8_BAR;
            PG8_LDA(At, 1, 1); PG8_STAGE(PG8_SA(1, 0), a3, voffA);
            PG8_BAR; PG8_WAIT_L(0); PG8_MMA(1, 0, At, B0); PG8_BAR; PG8_SCHED;
            PG8_STAGE(PG8_SB(1, 1), b3 + hstep, voffB);
            PG8_WAIT_V(6); PG8_BAR; PG8_MMA(1, 1, At, B1); PG8_BAR;
        }
        if constexpr (!Epi::AFTER_DRAIN) { E(acc, cur, wr, wc, fr, fq); S.done(cur); }
        if (!has_next) break;
#pragma unroll
        for (int a = 0; a < 2; ++a)
#pragma unroll
            for (int b = 0; b < 2; ++b)
#pragma unroll
                for (int m = 0; m < 4; ++m)
#pragma unroll
                    for (int n = 0; n < 2; ++n) acc[a][b][m][n] = (f32x4){0.f, 0.f, 0.f, 0.f};
        cur = nxt; cA = nA; cB = nB; ++ui;
    }
    PG8_WAIT_V(0);
    if (wr == 0) PG8_BAR;
    PG8_BAR;
    if constexpr (Epi::AFTER_DRAIN) { E.fused(acc, cur, wr, wc, fr, fq, lds, wid, lane); S.done(cur); }
#undef PG8_SA
#undef PG8_SB
#undef PG8_STAGE
#undef PG8_LDA
#undef PG8_LDB
#undef PG8_MMA
#undef PG8_WAIT_V
#undef PG8_WAIT_L
#undef PG8_BAR
#undef PG8_SCHED
}
}


using pg8::bf16_t; using pg8::bf16x8; using pg8::f32x4; using pg8::u32x4;
typedef short s16x4 __attribute__((ext_vector_type(4)));
typedef float f32x2 __attribute__((ext_vector_type(2)));
typedef float f32x16 __attribute__((ext_vector_type(16)));
typedef unsigned u32x2 __attribute__((ext_vector_type(2)));
typedef __bf16 bf16v2 __attribute__((ext_vector_type(2)));
#define LAS __attribute__((address_space(3)))
#define DI __device__ __forceinline__
#define XB_TMO      128
#define XB_XCNT(j)  (256  + 64 * (j))
#define XB_XSUB(j)  (1280 + 64 * (j))
#define XB_XGEN(j)  (2304 + 64 * (j))
#define XB_TOP      3328
#define XB_TOPGEN   3392
#define XCD_BAR_WORDS 3456
#define XB_SPIN_CAP (1u << 18)

__device__ __forceinline__ unsigned xb_ld(unsigned* p)              { return __hip_atomic_load(p, __ATOMIC_RELAXED, __HIP_MEMORY_SCOPE_AGENT); }
__device__ __forceinline__ unsigned xb_add(unsigned* p, unsigned v) { return __hip_atomic_fetch_add(p, v, __ATOMIC_RELAXED, __HIP_MEMORY_SCOPE_AGENT); }
__device__ __forceinline__ unsigned xb_xcc_id() { return (unsigned)__builtin_amdgcn_s_getreg((3 << 11) | 20) & 0xFu; }
#define XB_SPIN(cond, bar) do { unsigned _sp = 0; while (cond) { __builtin_amdgcn_s_sleep(1); \
    if ((++_sp & 255u) == 0u) { if (xb_ld(&(bar)[XB_TMO])) break; if (_sp > XB_SPIN_CAP) { atomicAdd(&(bar)[XB_TMO], 1u); break; } } } } while (0)

struct XcdBarrier {
    unsigned* bar; unsigned x;
    volatile LAS unsigned* st;
};

__device__ __forceinline__ XcdBarrier xcd_barrier_post(unsigned* bar, volatile LAS unsigned* st) {
    XcdBarrier b; b.bar = bar; b.x = xb_xcc_id(); b.st = st;
    if (threadIdx.x == 0) (void)xb_add(&bar[XB_XCNT(b.x)], 1u);
    return b;
}
__device__ __forceinline__ void xcd_barrier_complete(unsigned* bar, unsigned x, unsigned& nloc, unsigned& nx) {
    const unsigned G = (unsigned)nwg_now();
    unsigned sum, cnt, mine, sp = 0u;
    for (;;) {
        sum = 0u; cnt = 0u; mine = 0u;
#pragma unroll
        for (unsigned j = 0; j < 16; ++j) { const unsigned c = xb_ld(&bar[XB_XCNT(j)]); sum += c; cnt += (c > 0u) ? 1u : 0u; mine = (j == x) ? c : mine; }
        if (sum == G) break;
        __builtin_amdgcn_s_sleep(1);
        if ((++sp & 255u) == 0u) { if (xb_ld(&bar[XB_TMO])) break; if (sp > XB_SPIN_CAP) { atomicAdd(&bar[XB_TMO], 1u); break; } }
    }
    nloc = mine > 0u ? mine : 1u; nx = cnt > 0u ? cnt : 1u;
}

__device__ __forceinline__ void xcd_barrier(const XcdBarrier& b) {
    asm volatile("s_waitcnt vmcnt(0)" ::: "memory");
    __syncthreads();
    if (tid_now() == 0) {
        unsigned* bar = b.bar; unsigned bx = b.x; asm volatile("" : "+s"(bar), "+s"(bx));
        __builtin_amdgcn_s_waitcnt(0);
        unsigned nloc = b.st[0], nx = b.st[1];
        if (nloc == 0u) { xcd_barrier_complete(bar, bx, nloc, nx); b.st[0] = nloc; b.st[1] = nx; }
        const unsigned old = xb_add(&bar[XB_XSUB(bx)], 1u);
        const unsigned gen = old / nloc;
        if (old + 1u == (gen + 1u) * nloc) {
            __builtin_amdgcn_fence(__ATOMIC_RELEASE, "agent");
            asm volatile("s_waitcnt vmcnt(0)" ::: "memory");
            const unsigned og = xb_add(&bar[XB_TOP], 1u);
            const unsigned tg = og / nx;
            if (og + 1u == (tg + 1u) * nx) xb_add(&bar[XB_TOPGEN], 1u);
            else XB_SPIN(xb_ld(&bar[XB_TOPGEN]) == tg, bar);
            __builtin_amdgcn_fence(__ATOMIC_ACQUIRE, "agent");
            xb_add(&bar[XB_XGEN(bx)], 1u);
            asm volatile("s_waitcnt vmcnt(0)" ::: "memory");
        } else {
            XB_SPIN(xb_ld(&bar[XB_XGEN(bx)]) == gen, bar);
            __builtin_amdgcn_fence(__ATOMIC_ACQUIRE, "agent");
            asm volatile("s_waitcnt vmcnt(0)" ::: "memory");
        }
    }
    __syncthreads();
}


#define MFMA32(a, b, c) __builtin_amdgcn_mfma_f32_32x32x16_bf16((a), (b), (c), 0, 0, 0)

constexpr int T_ALL = 65536, SEQ = 2048, NGRP = 4, TG = 16384, BPG = 8, PLD = 4864;
constexpr float EPS = 1e-6f;
constexpr size_t SZ_GU = (size_t)5632 * 1024 * 2, SZ_D = (size_t)1024 * 2816 * 2;
constexpr size_t O_WGU1 = 0, O_WD1 = O_WGU1 + SZ_GU, O_WGU2 = O_WD1 + SZ_D, O_WD2 = O_WGU2 + SZ_GU, O_WIN = O_WD2 + SZ_D;
constexpr size_t O_WGATE = O_WIN + (size_t)4864 * 1024 * 2, O_WBR = O_WGATE + (size_t)4096 * 1024 * 2, O_WOUT = O_WBR + (size_t)4 * 1024 * 512 * 2;
constexpr size_t O_WQB = O_WOUT + (size_t)1024 * 1024 * 2, O_WKVB = O_WQB + (size_t)768 * 384 * 2, O_XN = O_WKVB + (size_t)1024 * 256 * 2;
constexpr size_t O_R0 = O_XN + (size_t)T_ALL * 1024 * 2;
constexpr size_t O_H = O_R0;
constexpr size_t O_PROJ = O_R0, O_XBCC = O_PROJ + (size_t)TG * PLD * 2, O_DTB = O_XBCC + (size_t)TG * 1024 * 2, O_AQ = O_DTB + (size_t)TG * 16 * 4;
constexpr size_t O_AKV = O_AQ + (size_t)TG * 384 * 2, O_QRAW = O_AKV + (size_t)TG * 256 * 2, O_KVRAW = O_QRAW + (size_t)TG * 768 * 2;
constexpr size_t O_QF = O_KVRAW + (size_t)TG * 1024 * 2, O_KF = O_QF + (size_t)TG * 768 * 2, O_VT = O_KF + (size_t)TG * 768 * 2;
constexpr size_t O_YRAW = O_VT + (size_t)TG * 512 * 2, O_YA = O_YRAW + (size_t)TG * 512 * 4;
constexpr size_t O_PB = O_YA + (size_t)4 * TG * 512 * 2, O_MIXB = O_PB + (size_t)4 * TG * 1024 * 2;
constexpr size_t O_ST = O_MIXB + (size_t)TG * 1024 * 2, O_ATOT = O_ST + (size_t)BPG * 16 * 8 * 8192 * 4;
constexpr size_t O_STB = O_ATOT + 4096;
constexpr size_t O_BAR = O_STB + (size_t)BPG * 16 * 8 * 8192 * 2;
constexpr size_t O_WQ = O_BAR + (size_t)XCD_BAR_WORDS * 4;
constexpr size_t ZERO_BYTES = (size_t)XCD_BAR_WORDS * 4 + 256;
constexpr size_t O_CS = O_WQ + 256 + 256 - ((size_t)XCD_BAR_WORDS * 4) % 256;
constexpr size_t O_SSQ = O_CS + (size_t)T_ALL * 32 * 8;
constexpr size_t O_END = O_SSQ + (size_t)3 * T_ALL * 16 * 4;
constexpr size_t O_END_H = O_H + (size_t)T_ALL * 2816 * 2;
constexpr size_t WS_NEED = O_END > O_END_H ? O_END : O_END_H;
constexpr int LDS_BYTES = 147456;

struct Params { const float* in[28]; float* out; unsigned char* ws; int only_phase; int pad; };

DI unsigned pk2(float a, float b) { f32x2 v = {a, b}; return __builtin_bit_cast(unsigned, __builtin_convertvector(v, bf16v2)); }
DI bf16_t f2bf(float a) { return (bf16_t)(pk2(a, 0.f) & 0xffffu); }
DI float bf2f(bf16_t b) { return __uint_as_float(((unsigned)b) << 16); }
DI float bflo(unsigned u) { return __uint_as_float(u << 16); }
DI float bfhi(unsigned u) { return __uint_as_float(u & 0xffff0000u); }
#define UNPACK8(v, f) do { f[0] = bflo(v.x); f[1] = bfhi(v.x); f[2] = bflo(v.y); f[3] = bfhi(v.y); f[4] = bflo(v.z); f[5] = bfhi(v.z); f[6] = bflo(v.w); f[7] = bfhi(v.w); } while (0)
#define PACK8(f) ((u32x4){pk2(f[0], f[1]), pk2(f[2], f[3]), pk2(f[4], f[5]), pk2(f[6], f[7])})
DI float wave_sum(float v) {
#pragma unroll
    for (int o = 1; o < 64; o <<= 1) v += __shfl_xor(v, o);
    return v;
}
DI float silu_f(float x) { return x * __builtin_amdgcn_rcpf(1.f + __builtin_amdgcn_exp2f(-1.4426950408889634f * x)); }
DI float sigmoid_f(float x) { return __builtin_amdgcn_rcpf(1.f + __builtin_amdgcn_exp2f(-1.4426950408889634f * x)); }
DI float gelu_f(float v) {
    const float t = __builtin_amdgcn_rcpf(fabsf(v) * 0.2316418882f + 1.0f);
    float q = t * 0.5307027145f + (-0.7265760135f); q = q * t + 0.7107068705f; q = q * t + (-0.142248368f); q = q * t + 0.127414796f; q = q * t;
    const float m = v * (q * __builtin_amdgcn_exp2f(v * v * (-0.72134752044f)));
    return v < 0.f ? m : v - m;
}
DI int crow(int i, int h) { return (i & 3) + 8 * (i >> 2) + 4 * h; }
DI void rows_rstd(const float* ssq, int row0, int fq, float (&rs)[2][4]) {
    f32x4 q[2][4];
#pragma unroll
    for (int ai = 0; ai < 2; ++ai)
#pragma unroll
        for (int m = 0; m < 4; ++m) q[ai][m] = ((const f32x4*)(ssq + (size_t)(row0 + ai * 128 + m * 16) * 16))[fq];
#pragma unroll
    for (int ai = 0; ai < 2; ++ai)
#pragma unroll
        for (int m = 0; m < 4; ++m) { float t = (q[ai][m][0] + q[ai][m][1]) + (q[ai][m][2] + q[ai][m][3]); t += __shfl_xor(t, 16); t += __shfl_xor(t, 32);
            rs[ai][m] = rsqrtf(t * (1.f / 1024.f) + EPS); }
}
struct EpiStore {
    static constexpr bool PERM = true, AFTER_DRAIN = false;
    bf16_t* O; int ldc; int pnmask; const float* ssq;
    DI void operator()(const f32x4 (&acc)[2][2][4][2], const pg8::Unit& u, int wr, int wc, int fr, int fq) const {
        const int row0 = u.pm * 256 + wr * 64 + fr, col0 = (u.pn & pnmask) * 256 + wc * 32 + 8 * fq;
        float rsv[2][4];
        if (ssq) rows_rstd(ssq, row0, fq, rsv);
        else {
#pragma unroll
            for (int ai = 0; ai < 2; ++ai)
#pragma unroll
                for (int m = 0; m < 4; ++m) rsv[ai][m] = 1.f; }
#pragma unroll
        for (int ai = 0; ai < 2; ++ai)
#pragma unroll
            for (int m = 0; m < 4; ++m) { bf16_t* rowp = O + (size_t)(row0 + ai * 128 + m * 16) * ldc + col0;
                const float rs = rsv[ai][m];
#pragma unroll
                for (int bj = 0; bj < 2; ++bj) { const f32x4 v0 = acc[ai][bj][m][0] * rs, v1 = acc[ai][bj][m][1] * rs;
                    u32x4 w; w.x = pk2(v0[0], v0[1]); w.y = pk2(v0[2], v0[3]); w.z = pk2(v1[0], v1[1]); w.w = pk2(v1[2], v1[3]);
                    *(u32x4*)(rowp + bj * 128) = w; } }
    }
};
struct EpiGU {
    static constexpr bool PERM = true, AFTER_DRAIN = false;
    bf16_t* H; const float* ssq;
    DI void operator()(const f32x4 (&acc)[2][2][4][2], const pg8::Unit& u, int wr, int wc, int fr, int fq) const {
        const int row0 = u.pm * 256 + wr * 64 + fr, col0 = u.pn * 128 + wc * 32 + 8 * fq;
        float rsv[2][4]; rows_rstd(ssq, row0, fq, rsv);
#pragma unroll
        for (int ai = 0; ai < 2; ++ai)
#pragma unroll
            for (int m = 0; m < 4; ++m) { bf16_t* rowp = H + (size_t)(row0 + ai * 128 + m * 16) * 2816 + col0;
                const float rs = rsv[ai][m];
                float o[8];
#pragma unroll
                for (int n = 0; n < 2; ++n)
#pragma unroll
                    for (int j = 0; j < 4; ++j) o[4 * n + j] = silu_f(acc[ai][0][m][n][j] * rs) * (acc[ai][1][m][n][j] * rs);
                *(u32x4*)rowp = PACK8(o); }
    }
};
struct EpiRes {
    static constexpr bool PERM = false, AFTER_DRAIN = false;
    bf16_t* XB; float* SSQ; float* OUT; float sc;
    DI void operator()(const f32x4 (&acc)[2][2][4][2], const pg8::Unit& u, int wr, int wc, int fr, int fq) const {
        const int row0 = u.pm * 256 + wr * 64 + fr, col0 = u.pn * 256 + wc * 32 + 4 * fq;
#pragma unroll
        for (int ai = 0; ai < 2; ++ai) {
            u32x2 xv[4][2][2];
#pragma unroll
            for (int m = 0; m < 4; ++m)
#pragma unroll
                for (int bj = 0; bj < 2; ++bj)
#pragma unroll
                    for (int n = 0; n < 2; ++n) xv[m][bj][n] = *(const u32x2*)(XB + (size_t)(row0 + ai * 128 + m * 16) * 1024 + col0 + bj * 128 + n * 16);
#pragma unroll
            for (int m = 0; m < 4; ++m) { const int row = row0 + ai * 128 + m * 16; const size_t ro = (size_t)row * 1024 + col0;
                float ss = 0.f;
#pragma unroll
                for (int bj = 0; bj < 2; ++bj)
#pragma unroll
                    for (int n = 0; n < 2; ++n) { const u32x2 xo = xv[m][bj][n]; const f32x4 a = acc[ai][bj][m][n];
                        const f32x4 v = {bflo(xo.x) + a[0] * sc, bfhi(xo.x) + a[1] * sc, bflo(xo.y) + a[2] * sc, bfhi(xo.y) + a[3] * sc};
                        if (OUT) *(f32x4*)(OUT + ro + bj * 128 + n * 16) = v;
                        else *(u32x2*)(XB + ro + bj * 128 + n * 16) = (u32x2){pk2(v[0], v[1]), pk2(v[2], v[3])};
                        ss += v[0] * v[0] + v[1] * v[1] + v[2] * v[2] + v[3] * v[3]; }
                ss += __shfl_xor(ss, 16); ss += __shfl_xor(ss, 32);
                if (fq == 0) SSQ[(size_t)row * 16 + u.pn * 4 + wc] = ss; }
        }
    }
};
struct EpiMerge {
    static constexpr bool PERM = false, AFTER_DRAIN = false;
    const bf16_t* P; bf16_t* MIX; const float* ssq;
    DI void operator()(const f32x4 (&acc)[2][2][4][2], const pg8::Unit& u, int wr, int wc, int fr, int fq) const {
        const int row0 = u.pm * 256 + wr * 64 + fr, e0 = u.pn * 64 + wc * 16 + 4 * fq;
        float rsv[2][4]; rows_rstd(ssq, row0, fq, rsv);
#pragma unroll
        for (int ai = 0; ai < 2; ++ai) {
            u32x2 pv[4][4];
#pragma unroll
            for (int m = 0; m < 4; ++m)
#pragma unroll
                for (int b = 0; b < 4; ++b) pv[m][b] = *(const u32x2*)(P + (size_t)b * TG * 1024 + (size_t)(row0 + ai * 128 + m * 16) * 1024 + e0);
#pragma unroll
            for (int m = 0; m < 4; ++m) { const float rs = rsv[ai][m];
                float o[4] = {0.f, 0.f, 0.f, 0.f};
#pragma unroll
                for (int bj = 0; bj < 2; ++bj)
#pragma unroll
                    for (int n = 0; n < 2; ++n) { const u32x2 q = pv[m][2 * bj + n]; const f32x4 g = acc[ai][bj][m][n] * rs;
                        o[0] += sigmoid_f(g[0]) * bflo(q.x); o[1] += sigmoid_f(g[1]) * bfhi(q.x); o[2] += sigmoid_f(g[2]) * bflo(q.y); o[3] += sigmoid_f(g[3]) * bfhi(q.y); }
                *(u32x2*)(MIX + (size_t)(row0 + ai * 128 + m * 16) * 1024 + e0) = (u32x2){pk2(o[0], o[1]), pk2(o[2], o[3])}; }
        }
    }
};
struct BranchOrder {
    int G, c;
    DI bool next(int i, pg8::Unit& u) const { const int L = i * G + c; if (L >= 1024) return false; const int br = L >> 8, rem = L & 255; u.pm = br * 64 + (rem >> 2); u.pn = br * 4 + (rem & 3); return true; }
    DI void a_ready(const pg8::Unit&) const {}
    DI void done(const pg8::Unit&) const {}
};
template <class Epi> DI void run_gemm(LAS unsigned char* lds, const bf16_t* A, const bf16_t* Bt, int M, int N, int K, const Epi& E) {
    pg8::Gemm g{A, Bt, M, N, K}; pg8::StaticOrder S; S.init(M, N, nwg_now(), wg_now());
    pg8::gemm_phase<Epi, pg8::StaticOrder>(lds, g, S, E);
}

DI void conv_mat(const float* src, int ld, int c0, int nvalid, int kvalid, int mode, bf16_t* dst, int Nd, int Kd, LAS float* scr, int wg, int nwg, const float* ksc = nullptr, const int use_ksc = 0) {
    const int tid = tid_now(); const int ntk = Kd >> 6, ntiles = (Nd >> 6) * ntk;
    for (int tile = wg; tile < ntiles; tile += nwg) {
        const int n0 = (tile / ntk) << 6, k0 = (tile % ntk) << 6;
        const int nn = tid & 63, kq = tid >> 6, n = n0 + nn;
        int col;
        if (mode == 1) { const int blk = n >> 7; col = ((blk & 1) ? 2816 : 0) + (blk >> 1) * 128 + (n & 127); }
        else if (mode == 2) { const int c = n & 255, br = 2 * (c >> 7) + ((c >> 4) & 1), e = 64 * (n >> 8) + 16 * ((c >> 5) & 3) + (c & 15); col = c0 + br * 1024 + e; }
        else col = c0 + n;
#pragma unroll
        for (int i = 0; i < 8; ++i) { const int kk = i * 8 + kq; float v = 0.f;
            if (k0 + kk < kvalid && n < nvalid) { v = src[(size_t)(k0 + kk) * ld + col]; if (use_ksc) v *= ksc[k0 + kk]; }
            scr[kk * 65 + nn] = v; }
        __syncthreads();
        { const int nr = tid >> 3, kc = tid & 7; const LAS float* sp = scr + (kc * 8) * 65 + nr;
          u32x4 o; o.x = pk2(sp[0], sp[65]); o.y = pk2(sp[130], sp[195]); o.z = pk2(sp[260], sp[325]); o.w = pk2(sp[390], sp[455]);
          *(u32x4*)(dst + (size_t)(n0 + nr) * Kd + k0 + kc * 8) = o; }
        __syncthreads();
    }
}
DI void convert_layer(const Params& p, int l, LAS float* scr, int wg, int nwg) {
    unsigned char* ws = p.ws;
    conv_mat(p.in[3] + (size_t)l * 1024 * 5632, 5632, 0, 5632, 1024, 1, (bf16_t*)(ws + O_WGU1), 5632, 1024, scr, wg, nwg, p.in[2] + l * 1024, 1);
    conv_mat(p.in[26] + (size_t)l * 1024 * 5632, 5632, 0, 5632, 1024, 1, (bf16_t*)(ws + O_WGU2), 5632, 1024, scr, wg, nwg, p.in[25] + l * 1024, 1);
    conv_mat(p.in[4] + (size_t)l * 2816 * 1024, 1024, 0, 1024, 2816, 0, (bf16_t*)(ws + O_WD1), 1024, 2816, scr, wg, nwg);
    conv_mat(p.in[27] + (size_t)l * 2816 * 1024, 1024, 0, 1024, 2816, 0, (bf16_t*)(ws + O_WD2), 1024, 2816, scr, wg, nwg);
    conv_mat(p.in[6] + (size_t)l * 1024 * 8776, 8776, 0, 4680, 1024, 0, (bf16_t*)(ws + O_WIN), 4864, 1024, scr, wg, nwg, p.in[5] + l * 1024, 1);
    conv_mat(p.in[6] + (size_t)l * 1024 * 8776, 8776, 4680, 4096, 1024, 2, (bf16_t*)(ws + O_WGATE), 4096, 1024, scr, wg, nwg, p.in[5] + l * 1024, 1);
#pragma unroll 1
    for (int i = 0; i < 4; ++i)
        conv_mat(p.in[23] + ((size_t)l * 4 + i) * 512 * 1024, 1024, 0, 1024, 512, 0, (bf16_t*)(ws + O_WBR) + (size_t)i * 1024 * 512, 1024, 512, scr, wg, nwg);
    conv_mat(p.in[24] + (size_t)l * 1024 * 1024, 1024, 0, 1024, 1024, 0, (bf16_t*)(ws + O_WOUT), 1024, 1024, scr, wg, nwg);
    conv_mat(p.in[17] + (size_t)l * 384 * 768, 768, 0, 768, 384, 0, (bf16_t*)(ws + O_WQB), 768, 384, scr, wg, nwg);
    conv_mat(p.in[19] + (size_t)l * 128 * 1024, 1024, 0, 1024, 128, 0, (bf16_t*)(ws + O_WKVB), 1024, 256, scr, wg, nwg);
}

DI void init_rows(const float* x, bf16_t* xb, float* ssq) {
    const int tidn = tid_now(); const int lane = tidn & 63, gwave = wg_now() * 8 + (tidn >> 6), ngw = nwg_now() * 8;
    for (int row = gwave; row < T_ALL; row += ngw) {
        const f32x4* xr = (const f32x4*)(x + (size_t)row * 1024);
        f32x4 v[4]; float ss = 0.f;
#pragma unroll
        for (int j = 0; j < 4; ++j) { v[j] = xr[lane + 64 * j]; ss += v[j][0] * v[j][0] + v[j][1] * v[j][1] + v[j][2] * v[j][2] + v[j][3] * v[j][3]; }
        ss = wave_sum(ss);
        u32x2* o = (u32x2*)(xb + (size_t)row * 1024);
#pragma unroll
        for (int j = 0; j < 4; ++j) o[lane + 64 * j] = (u32x2){pk2(v[j][0], v[j][1]), pk2(v[j][2], v[j][3])};
        if (lane < 16) ssq[(size_t)row * 16 + lane] = lane == 0 ? ss : 0.f;
    }
}
DI void zero_f32(float* q, int n) { const int tidn = tid_now(); for (int i = wg_now() * 512 + tidn; i < n; i += nwg_now() * 512) q[i] = 0.f; }

DI void prep1(const Params& p, int l, const bf16_t* __restrict__ proj, bf16_t* __restrict__ xbcc, float* __restrict__ dtb, bf16_t* __restrict__ aq, bf16_t* __restrict__ akv, bf16_t* __restrict__ yd) {
    const int tidn = tid_now(); const int gtid = wg_now() * 512 + tidn, gthreads = nwg_now() * 512;
    const float* cw = p.in[7] + l * 4096; const float* cb = p.in[8] + l * 1024;
    for (int idx = gtid; idx < (TG / 16) * 128; idx += gthreads) {
        const int c8 = (idx & 127) << 3, tl0 = (idx >> 7) << 4, s0 = tl0 & 2047;
        float w[4][8], bb[8], r0[8], r1[8], r2[8];
#pragma unroll
        for (int k = 0; k < 4; ++k) { const f32x4 a = *(const f32x4*)(cw + k * 1024 + c8), b = *(const f32x4*)(cw + k * 1024 + c8 + 4);
#pragma unroll
            for (int j = 0; j < 4; ++j) { w[k][j] = a[j]; w[k][4 + j] = b[j]; } }
        { const f32x4 a = *(const f32x4*)(cb + c8), b = *(const f32x4*)(cb + c8 + 4);
#pragma unroll
          for (int j = 0; j < 4; ++j) { bb[j] = a[j]; bb[4 + j] = b[j]; } }
        const bf16_t* src = proj + (size_t)tl0 * PLD + 512 + c8;
        if (s0 > 0) { const u32x4 v0 = *(const u32x4*)(src - 3 * PLD), v1 = *(const u32x4*)(src - 2 * PLD), v2 = *(const u32x4*)(src - PLD); UNPACK8(v0, r0); UNPACK8(v1, r1); UNPACK8(v2, r2); }
        else {
#pragma unroll
            for (int j = 0; j < 8; ++j) { r0[j] = 0.f; r1[j] = 0.f; r2[j] = 0.f; } }
#pragma unroll 8
        for (int tt = 0; tt < 16; ++tt) {
            const u32x4 v = *(const u32x4*)(src + (size_t)tt * PLD); float cur[8], o[8]; UNPACK8(v, cur);
#pragma unroll
            for (int j = 0; j < 8; ++j) { o[j] = silu_f(bb[j] + w[0][j] * r0[j] + w[1][j] * r1[j] + w[2][j] * r2[j] + w[3][j] * cur[j]); r0[j] = r1[j]; r1[j] = r2[j]; r2[j] = cur[j]; }
            *(u32x4*)(xbcc + (size_t)(tl0 + tt) * 1024 + c8) = PACK8(o);
        }
    }
    const float* sw = p.in[22] + l * 1536;
    for (int idx = gtid; idx < (TG / 16) * 64; idx += gthreads) {
        const int c8 = (idx & 63) << 3, tl0 = (idx >> 6) << 4, s0 = tl0 & 2047;
        float w[3][8], p1[8], p2[8];
#pragma unroll
        for (int k = 0; k < 3; ++k) { const f32x4 a = *(const f32x4*)(sw + k * 512 + c8), b = *(const f32x4*)(sw + k * 512 + c8 + 4);
#pragma unroll
            for (int j = 0; j < 4; ++j) { w[k][j] = a[j]; w[k][4 + j] = b[j]; } }
        const bf16_t* src = proj + (size_t)tl0 * PLD + c8;
        if (s0 > 0) { const u32x4 c1 = *(const u32x4*)(src - 2 * PLD + 3656), x1 = *(const u32x4*)(src - 2 * PLD + 4168), c2 = *(const u32x4*)(src - PLD + 3656), x2 = *(const u32x4*)(src - PLD + 4168);
            float a[8], b[8]; UNPACK8(c1, a); UNPACK8(x1, b);
#pragma unroll
            for (int j = 0; j < 8; ++j) p1[j] = a[j] * b[j];
            UNPACK8(c2, a); UNPACK8(x2, b);
#pragma unroll
            for (int j = 0; j < 8; ++j) p2[j] = a[j] * b[j]; }
        else {
#pragma unroll
            for (int j = 0; j < 8; ++j) { p1[j] = 0.f; p2[j] = 0.f; } }
#pragma unroll 8
        for (int tt = 0; tt < 16; ++tt) {
            const bf16_t* pr = src + (size_t)tt * PLD;
            const u32x4 vc = *(const u32x4*)(pr + 3656), vx = *(const u32x4*)(pr + 4168), vb = *(const u32x4*)(pr + 3144);
            float fc[8], fx[8], fb[8], o[8]; UNPACK8(vc, fc); UNPACK8(vx, fx); UNPACK8(vb, fb);
#pragma unroll
            for (int j = 0; j < 8; ++j) { const float cur = fc[j] * fx[j]; o[j] = fb[j] * (w[0][j] * p1[j] + w[1][j] * p2[j] + w[2][j] * cur); p1[j] = p2[j]; p2[j] = cur; }
            *(u32x4*)(yd + (size_t)(tl0 + tt) * 512 + c8) = PACK8(o);
        }
    }
    const int gwave = gtid >> 6, ngw = gthreads >> 6, lane = tidn & 63;
    const float* qn = p.in[16] + l * 384; const float* kn = p.in[18] + l * 128;
#pragma unroll 4
    for (int tl = gwave; tl < TG; tl += ngw) {
        const bf16_t* pr = proj + (size_t)tl * PLD;
        const u32x4 v = *(const u32x4*)(pr + 2568 + lane * 8); float f[8]; UNPACK8(v, f);
        float ss = 0.f;
#pragma unroll
        for (int j = 0; j < 8; ++j) ss += f[j] * f[j];
        const float ssq = wave_sum(lane < 48 ? ss : 0.f), ssk = wave_sum(lane >= 48 ? ss : 0.f);
        if (lane < 48) {
            const float rstd = rsqrtf(ssq * (1.f / 384.f) + EPS);
#pragma unroll
            for (int j = 0; j < 8; ++j) f[j] *= rstd * qn[lane * 8 + j];
            *(u32x4*)(aq + (size_t)tl * 384 + lane * 8) = PACK8(f);
        } else {
            const float rstd = rsqrtf(ssk * (1.f / 128.f) + EPS);
#pragma unroll
            for (int j = 0; j < 8; ++j) f[j] *= rstd * kn[(lane - 48) * 8 + j];
            *(u32x4*)(akv + (size_t)tl * 256 + (lane - 48) * 8) = PACK8(f);
            { unsigned z = 0u; asm volatile("" : "+v"(z)); *(u32x4*)(akv + (size_t)tl * 256 + 128 + (lane - 48) * 8) = (u32x4){z, z, z, z}; }
        }
        if (lane < 8) {
            const float xr = bf2f(pr[1536 + lane]) + p.in[9][l * 8 + lane];
            const float dt = xr > 20.f ? xr : log1pf(expf(xr));
            const float A = -expf(p.in[10][l * 8 + lane]);
            dtb[(size_t)tl * 16 + lane] = dt; dtb[(size_t)tl * 16 + 8 + lane] = dt * A;
        }
    }
}

DI void rope_table(const Params& p, f32x2* CS) {
    const int* pos = (const int*)p.in[1];
    const int tidn = tid_now();
    for (int idx = wg_now() * 512 + tidn; idx < T_ALL * 32; idx += nwg_now() * 512) {
        const float invf = exp2f(-(float)(idx & 31) * (13.287712379549449f / 32.f));
        const float ang = (float)pos[idx >> 5] * invf;
        CS[idx] = (f32x2){cosf(ang), sinf(ang)};
    }
}
DI void prep2_unit(const Params& p, int l, int g, const bf16_t* __restrict__ proj, const bf16_t* __restrict__ qraw, const bf16_t* __restrict__ kvraw, const f32x2* __restrict__ CSt, bf16_t* __restrict__ Qf, bf16_t* __restrict__ Kf, bf16_t* __restrict__ Vt, int bl, int tile, LAS unsigned char* lds) {
    const int tid = tid_now(), wave = tid >> 6, lane = tid & 63;
    const float* wq = p.in[20] + l * 192; const float* wk = p.in[21] + l * 192;
    const float qscale = 0.07216878364870322f * 1.4426950408889634f;
    const float wq0 = wq[lane], wq1 = wq[64 + lane], wq2 = wq[128 + lane], wk0 = wk[lane], wk1 = wk[64 + lane], wk2 = wk[128 + lane];
    LAS bf16_t* img = (LAS bf16_t*)lds;
    const int t0 = tile * 64;
#pragma unroll 4
    for (int tt = 0; tt < 8; ++tt) {
        const int tloc = wave * 8 + tt, s = t0 + tloc; const size_t tl = (size_t)bl * SEQ + s;
        const f32x2 cssn = CSt[((size_t)(g * BPG + bl) * SEQ + s) * 32 + (lane & 31)];
        const float cs = cssn[0], sn = cssn[1];
        const float kpe = bf2f(proj[tl * PLD + 3080 + lane]);
#pragma unroll
        for (int h = 0; h < 4; ++h) {
            const size_t ob = ((size_t)(bl * 4 + h) * SEQ + s) * 192;
            {
                const bf16_t* qr = qraw + tl * 768 + h * 192;
                float q0 = bf2f(qr[lane]), q1 = bf2f(qr[64 + lane]), q2 = bf2f(qr[128 + lane]);
                const float r = rsqrtf(wave_sum(q0 * q0 + q1 * q1 + q2 * q2) * (1.f / 192.f) + EPS);
                q0 *= r * wq0; q1 *= r * wq1; q2 *= r * wq2;
                const float qp = __shfl_xor(q2, 32);
                q2 = (lane < 32) ? q2 * cs - qp * sn : q2 * cs + qp * sn;
                bf16_t* qo = Qf + ob;
                qo[lane] = f2bf(q0 * qscale); qo[64 + lane] = f2bf(q1 * qscale); qo[128 + lane] = f2bf(q2 * qscale);
            }
            const bf16_t* kr = kvraw + tl * 1024 + h * 256;
            {
                float k0 = bf2f(kr[lane]), k1 = bf2f(kr[64 + lane]), k2 = kpe;
                const float r = rsqrtf(wave_sum(k0 * k0 + k1 * k1 + k2 * k2) * (1.f / 192.f) + EPS);
                k0 *= r * wk0; k1 *= r * wk1; k2 *= r * wk2;
                const float kp = __shfl_xor(k2, 32);
                k2 = (lane < 32) ? k2 * cs - kp * sn : k2 * cs + kp * sn;
                bf16_t* ko = Kf + ob;
                ko[lane] = f2bf(k0); ko[64 + lane] = f2bf(k1); ko[128 + lane] = f2bf(k2);
            }
            img[(h * 128 + lane) * 72 + tloc] = kr[128 + lane]; img[(h * 128 + 64 + lane) * 72 + tloc] = kr[192 + lane];
        }
    }
    __syncthreads();
#pragma unroll
    for (int i = 0; i < 8; ++i) {
        const int ch = tid + 512 * i, row = ch >> 3, cc = ch & 7;
        *(u32x4*)(Vt + ((size_t)(bl * 4 + (row >> 7)) * 128 + (row & 127)) * SEQ + t0 + cc * 8) = *(const LAS u32x4*)(lds + row * 144 + cc * 16);
    }
    __syncthreads();
}

constexpr int KP = 400, VP = 136, KBYTES = 64 * KP, VBYTES = 128 * VP, ASTAGE = KBYTES + VBYTES;
DI void attn_unit(const bf16_t* Qf, const bf16_t* Kf, const bf16_t* Vt, bf16_t* yc, int bh, int qb, LAS unsigned char* lds) {
    const int tid = tid_now(), wave = tid >> 6, lane = tid & 63, r31 = lane & 31, hh = lane >> 5;
    const int q0 = qb * 256, qrow = q0 + wave * 32 + r31;
    const bf16_t* Qp = Qf + ((size_t)bh * SEQ + qrow) * 192 + 8 * hh;
    bf16x8 qf[12];
#pragma unroll
    for (int kk = 0; kk < 12; ++kk) qf[kk] = *(const bf16x8*)(Qp + kk * 16);
    f32x16 o[4];
#pragma unroll
    for (int d = 0; d < 4; ++d)
#pragma unroll
        for (int i = 0; i < 16; ++i) o[d][i] = 0.f;
    float m = -1e30f, l = 0.f;
    const int ntiles = qb * 4 + 4;
    const bf16_t* Kb = Kf + (size_t)bh * SEQ * 192; const bf16_t* Vb = Vt + (size_t)bh * 128 * SEQ;
    int krow[3], kcc[3], vd[2], vcc[2];
#pragma unroll
    for (int i = 0; i < 3; ++i) { const int c = tid + 512 * i; krow[i] = c / 24; kcc[i] = c % 24; }
#pragma unroll
    for (int i = 0; i < 2; ++i) { const int c = tid + 512 * i; vd[i] = c >> 3; vcc[i] = c & 7; }
    u32x4 kA[3], vA[2], kB[3], vB[2];
#define ATT_GLOAD(j, kreg, vreg) do { _Pragma("unroll") for (int i = 0; i < 3; ++i) kreg[i] = *(const u32x4*)(Kb + (size_t)((j) * 64 + krow[i]) * 192 + kcc[i] * 8); \
        _Pragma("unroll") for (int i = 0; i < 2; ++i) vreg[i] = *(const u32x4*)(Vb + (size_t)vd[i] * SEQ + (j) * 64 + vcc[i] * 8); } while (0)
#define ATT_LSTORE(st, kreg, vreg) do { LAS unsigned char* b_ = lds + (st) * ASTAGE; \
        _Pragma("unroll") for (int i = 0; i < 3; ++i) *(LAS u32x4*)(b_ + krow[i] * KP + kcc[i] * 16) = kreg[i]; \
        _Pragma("unroll") for (int i = 0; i < 2; ++i) { LAS u32x2* d_ = (LAS u32x2*)(b_ + KBYTES + vd[i] * VP + vcc[i] * 16); d_[0] = (u32x2){vreg[i].x, vreg[i].y}; d_[1] = (u32x2){vreg[i].z, vreg[i].w}; } } while (0)
    auto compute = [&](const int j, const int cur) __attribute__((always_inline)) {
        if (j * 64 <= q0 + wave * 32 + 31) {
            const LAS unsigned char* Kl = lds + cur * ASTAGE; const LAS unsigned char* Vl = Kl + KBYTES;
            f32x16 s0, s1;
#pragma unroll
            for (int i = 0; i < 16; ++i) { s0[i] = 0.f; s1[i] = 0.f; }
#pragma unroll
            for (int kk = 0; kk < 12; ++kk) {
                const bf16x8 a0 = *(const LAS bf16x8*)(Kl + r31 * KP + (kk * 16 + 8 * hh) * 2);
                const bf16x8 a1 = *(const LAS bf16x8*)(Kl + (32 + r31) * KP + (kk * 16 + 8 * hh) * 2);
                s0 = MFMA32(a0, qf[kk], s0); s1 = MFMA32(a1, qf[kk], s1);
            }
            if (j * 64 + 63 > q0 + wave * 32) {
#pragma unroll
                for (int i = 0; i < 16; ++i) { const int key = j * 64 + crow(i, hh); if (key > qrow) s0[i] = -1e30f; if (key + 32 > qrow) s1[i] = -1e30f; }
            }
            float mx = s0[0];
#pragma unroll
            for (int i = 1; i < 16; ++i) mx = fmaxf(mx, s0[i]);
#pragma unroll
            for (int i = 0; i < 16; ++i) mx = fmaxf(mx, s1[i]);
            mx = fmaxf(mx, __shfl_xor(mx, 32));
            const float mn = fmaxf(m, mx);
            if (__ballot(mx > m) != 0ull) {
                const float alpha = __builtin_amdgcn_exp2f(m - mn);
                l *= alpha;
#pragma unroll
                for (int d = 0; d < 4; ++d)
#pragma unroll
                    for (int i = 0; i < 16; ++i) o[d][i] *= alpha;
            }
            m = mn;
            float ls = 0.f;
#pragma unroll
            for (int i = 0; i < 16; ++i) { s0[i] = __builtin_amdgcn_exp2f(s0[i] - mn); s1[i] = __builtin_amdgcn_exp2f(s1[i] - mn); ls += s0[i] + s1[i]; }
            l += ls;
            bf16x8 pf[2][2];
#pragma unroll
            for (int s = 0; s < 2; ++s) {
                u32x4 w0, w1;
                w0.x = pk2(s0[8 * s], s0[8 * s + 1]); w0.y = pk2(s0[8 * s + 2], s0[8 * s + 3]); w0.z = pk2(s0[8 * s + 4], s0[8 * s + 5]); w0.w = pk2(s0[8 * s + 6], s0[8 * s + 7]);
                w1.x = pk2(s1[8 * s], s1[8 * s + 1]); w1.y = pk2(s1[8 * s + 2], s1[8 * s + 3]); w1.z = pk2(s1[8 * s + 4], s1[8 * s + 5]); w1.w = pk2(s1[8 * s + 6], s1[8 * s + 7]);
                pf[0][s] = __builtin_bit_cast(bf16x8, w0); pf[1][s] = __builtin_bit_cast(bf16x8, w1);
            }
#pragma unroll
            for (int d = 0; d < 4; ++d)
#pragma unroll
                for (int kb = 0; kb < 2; ++kb)
#pragma unroll
                    for (int s = 0; s < 2; ++s) {
                        const LAS unsigned char* vp = Vl + (d * 32 + r31) * VP + (kb * 32 + 16 * s + 4 * hh) * 2;
                        const s16x4 lo = *(const LAS s16x4*)vp, hi = *(const LAS s16x4*)(vp + 16);
                        const bf16x8 a = __builtin_shufflevector(lo, hi, 0, 1, 2, 3, 4, 5, 6, 7);
                        o[d] = MFMA32(a, pf[kb][s], o[d]);
                    }
        }
    };
    ATT_GLOAD(0, kA, vA); ATT_LSTORE(0, kA, vA); ATT_GLOAD(1, kB, vB);
    __syncthreads();
#pragma unroll 1
    for (int j = 0; j < ntiles; j += 2) {
        if (j + 2 < ntiles) ATT_GLOAD(j + 2, kA, vA);
        compute(j, 0);
        ATT_LSTORE(1, kB, vB);
        __syncthreads();
        if (j + 3 < ntiles) ATT_GLOAD(j + 3, kB, vB);
        compute(j + 1, 1);
        if (j + 2 < ntiles) ATT_LSTORE(0, kA, vA);
        __syncthreads();
    }
#undef ATT_GLOAD
#undef ATT_LSTORE
    l += __shfl_xor(l, 32);
    const float inv = 1.f / l;
    const int bl = bh >> 2, h = bh & 3;
    bf16_t* op = yc + ((size_t)bl * SEQ + qrow) * 512 + h * 128 + 4 * hh;
#pragma unroll
    for (int d = 0; d < 4; ++d)
#pragma unroll
        for (int i4 = 0; i4 < 4; ++i4)
            *(u32x2*)(op + d * 32 + 8 * i4) = (u32x2){pk2(o[d][4 * i4] * inv, o[d][4 * i4 + 1] * inv), pk2(o[d][4 * i4 + 2] * inv, o[d][4 * i4 + 3] * inv)};
}

DI void gmlp_unit(const Params& p, int l, const bf16_t* __restrict__ proj, bf16_t* __restrict__ yb, int bl, int c, LAS unsigned char* lds) {
    const int tid = tid_now(), wave = tid >> 6, lane = tid & 63, r31 = lane & 31, hh = lane >> 5;
    const float* wsp = p.in[14] + (size_t)l * 4 * 128 * 128; const float* bs = p.in[15] + l * 512; const float* vn = p.in[13] + l * 512;
    const size_t tl0 = (size_t)bl * SEQ + c * 128;
    float w8[8];
#pragma unroll
    for (int j = 0; j < 8; ++j) w8[j] = vn[lane + 64 * j];
    LAS bf16_t* vt = (LAS bf16_t*)lds;
#pragma unroll
    for (int rr = 0; rr < 16; ++rr) {
        const int row = wave * 16 + rr;
        const bf16_t* vr = proj + (tl0 + row) * PLD + 2056 + lane;
        float f[8]; float ss = 0.f;
#pragma unroll
        for (int j = 0; j < 8; ++j) { f[j] = gelu_f(bf2f(vr[64 * j])); ss += f[j] * f[j]; }
        const float rstd = rsqrtf(wave_sum(ss) * (1.f / 512.f) + EPS);
#pragma unroll
        for (int j = 0; j < 8; ++j) vt[(lane + 64 * j) * 136 + row] = f2bf(f[j] * rstd * w8[j]);
    }
    __syncthreads();
    const int mb = wave & 3, nh = wave >> 2, trow = mb * 32 + r31;
#pragma unroll 1
    for (int g = 0; g < 4; ++g) {
        f32x16 a0, a1;
#pragma unroll
        for (int i = 0; i < 16; ++i) { a0[i] = 0.f; a1[i] = 0.f; }
        const float* wrow = wsp + ((size_t)g * 128 + trow) * 128 + 8 * hh;
#pragma unroll
        for (int kk = 0; kk < 8; ++kk) if (kk * 16 <= mb * 32 + 31) {
            const f32x4 x0 = *(const f32x4*)(wrow + kk * 16), x1 = *(const f32x4*)(wrow + kk * 16 + 4);
            const int sb = kk * 16 + 8 * hh;
            float f[8];
#pragma unroll
            for (int j = 0; j < 4; ++j) { f[j] = (sb + j <= trow) ? x0[j] : 0.f; f[4 + j] = (sb + 4 + j <= trow) ? x1[j] : 0.f; }
            const bf16x8 a = __builtin_bit_cast(bf16x8, PACK8(f));
            const bf16x8 b0 = *(const LAS bf16x8*)(vt + (g * 128 + nh * 64 + r31) * 136 + kk * 16 + 8 * hh);
            const bf16x8 b1 = *(const LAS bf16x8*)(vt + (g * 128 + nh * 64 + 32 + r31) * 136 + kk * 16 + 8 * hh);
            a0 = MFMA32(a, b0, a0); a1 = MFMA32(a, b1, a1);
        }
        __syncthreads();
        LAS bf16_t* og = vt + (g * 128) * 136;
#pragma unroll
        for (int i = 0; i < 16; ++i) {
            const int t = mb * 32 + crow(i, hh); const float bias = bs[g * 128 + t];
            og[t * 136 + nh * 64 + r31] = f2bf(a0[i] + bias); og[t * 136 + nh * 64 + 32 + r31] = f2bf(a1[i] + bias);
        }
        __syncthreads();
#pragma unroll
        for (int k = 0; k < 4; ++k) {
            const int ch = tid + 512 * k, t = ch >> 4, d8 = (ch & 15) * 8;
            const u32x4 sv = *(const LAS u32x4*)(og + t * 136 + d8);
            const u32x4 uv = *(const u32x4*)(proj + (tl0 + t) * PLD + 1544 + g * 128 + d8);
            float fs[8], fu[8]; UNPACK8(sv, fs); UNPACK8(uv, fu);
#pragma unroll
            for (int j = 0; j < 8; ++j) fu[j] = gelu_f(fu[j]) * fs[j];
            *(u32x4*)(yb + (tl0 + t) * 512 + g * 128 + d8) = PACK8(fu);
        }
    }
    __syncthreads();
}

constexpr int SP = 136;
DI void scan128(float& v0, float& v1, int lane) {
#pragma unroll
    for (int o = 1; o < 64; o <<= 1) { const float n0 = __shfl_up(v0, o), n1 = __shfl_up(v1, o); if (lane >= o) { v0 += n0; v1 += n1; } }
    v1 += __shfl(v0, 63);
}
DI void ssd_states_unit(const bf16_t* xbcc, const float* dtb, float* ST, float* ATOT, int bl, int c, int grp, LAS unsigned char* lds) {
    const int tid = tid_now(), wave = tid >> 6, lane = tid & 63, r31 = lane & 31, hh = lane >> 5;
    LAS bf16_t* BT = (LAS bf16_t*)lds; LAS bf16_t* XT = (LAS bf16_t*)(lds + 34816); LAS float* WS = (LAS float*)(lds + 104448);
    const size_t row0 = (size_t)bl * SEQ + c * 128;
    if (wave < 4) {
        const int h = grp * 4 + wave;
        const float d0 = dtb[(row0 + lane) * 16 + h], d1 = dtb[(row0 + 64 + lane) * 16 + h];
        float v0 = dtb[(row0 + lane) * 16 + 8 + h], v1 = dtb[(row0 + 64 + lane) * 16 + 8 + h];
        scan128(v0, v1, lane);
        const float tot = __shfl(v1, 63);
        WS[wave * 128 + lane] = d0 * __expf(tot - v0); WS[wave * 128 + 64 + lane] = d1 * __expf(tot - v1);
        if (lane == 0) ATOT[(bl * 16 + c) * 8 + h] = tot;
    }
    __syncthreads();
#pragma unroll
    for (int i = 0; i < 4; ++i) {
        const int ch = tid + 512 * i, s = ch >> 4, n8 = (ch & 15) * 8;
        const u32x4 v = *(const u32x4*)(xbcc + (row0 + s) * 1024 + 512 + grp * 128 + n8);
        LAS bf16_t* d = BT + n8 * SP + s;
        d[0] = (bf16_t)(v.x & 0xffffu); d[SP] = (bf16_t)(v.x >> 16); d[2 * SP] = (bf16_t)(v.y & 0xffffu); d[3 * SP] = (bf16_t)(v.y >> 16);
        d[4 * SP] = (bf16_t)(v.z & 0xffffu); d[5 * SP] = (bf16_t)(v.z >> 16); d[6 * SP] = (bf16_t)(v.w & 0xffffu); d[7 * SP] = (bf16_t)(v.w >> 16);
    }
#pragma unroll
    for (int i = 0; i < 8; ++i) {
        const int ch = tid + 512 * i, s = ch >> 5, c8 = (ch & 31) * 8;
        const u32x4 v = *(const u32x4*)(xbcc + (row0 + s) * 1024 + grp * 256 + c8); float f[8]; UNPACK8(v, f);
        const float w = WS[(c8 >> 6) * 128 + s];
        LAS bf16_t* d = XT + c8 * SP + s;
#pragma unroll
        for (int j = 0; j < 8; ++j) d[j * SP] = f2bf(f[j] * w);
    }
    __syncthreads();
    const int hl = wave >> 1, pb = wave & 1;
    f32x16 acc[4];
#pragma unroll
    for (int nb = 0; nb < 4; ++nb)
#pragma unroll
        for (int i = 0; i < 16; ++i) acc[nb][i] = 0.f;
#pragma unroll
    for (int k = 0; k < 8; ++k) {
        const bf16x8 a = *(const LAS bf16x8*)(XT + (hl * 64 + pb * 32 + r31) * SP + k * 16 + 8 * hh);
#pragma unroll
        for (int nb = 0; nb < 4; ++nb) { const bf16x8 b = *(const LAS bf16x8*)(BT + (nb * 32 + r31) * SP + k * 16 + 8 * hh); acc[nb] = MFMA32(a, b, acc[nb]); }
    }
    float* so = ST + (((size_t)bl * 16 + c) * 8 + grp * 4 + hl) * 8192;
#pragma unroll
    for (int nb = 0; nb < 4; ++nb)
#pragma unroll
        for (int i = 0; i < 16; ++i) so[(pb * 32 + crow(i, hh)) * 128 + nb * 32 + r31] = acc[nb][i];
    __syncthreads();
}
DI void ssd_scan(const float* ST, bf16_t* STB, const float* ATOT) {
    const int tidn = tid_now();
    for (int idx = wg_now() * 512 + tidn; idx < 64 * 2048; idx += nwg_now() * 512) {
        const int bh = idx >> 11, e4 = idx & 2047, bl = bh >> 3, head = bh & 7;
        const size_t off = ((size_t)bl * 16 * 8 + head) * 8192 + e4 * 4;
        f32x4 sv[16];
#pragma unroll
        for (int c = 0; c < 16; ++c) sv[c] = *(const f32x4*)(ST + off + (size_t)c * 8 * 8192);
        f32x4 run = {0.f, 0.f, 0.f, 0.f};
#pragma unroll
        for (int c = 0; c < 16; ++c) { const float ea = __expf(ATOT[(bl * 16 + c) * 8 + head]);
            *(u32x2*)(STB + off + (size_t)c * 8 * 8192) = (u32x2){pk2(run[0], run[1]), pk2(run[2], run[3])}; run = run * ea + sv[c]; }
    }
}
DI void ssd_out_grp(const Params& p, int l, const bf16_t* proj, const bf16_t* xbcc, const float* dtb, const bf16_t* STB, bf16_t* ya, int bl, int c, int grp, LAS unsigned char* lds) {
    const int tid = tid_now(), wave = tid >> 6, lane = tid & 63, r31 = lane & 31, hh = lane >> 5;
    LAS bf16_t* CL = (LAS bf16_t*)lds; LAS bf16_t* BL = (LAS bf16_t*)(lds + 34816); LAS bf16_t* XT = (LAS bf16_t*)(lds + 69632); LAS bf16_t* PV = (LAS bf16_t*)(lds + 104448);
    LAS float* ACS = (LAS float*)(lds + 139264); LAS float* DTL = (LAS float*)(lds + 141312); LAS float* RS = (LAS float*)(lds + 143360); LAS float* OUT = (LAS float*)lds;
    const size_t row0 = (size_t)bl * SEQ + c * 128;
#pragma unroll
    for (int i = 0; i < 4; ++i) {
        const int ch = tid + 512 * i, s = ch >> 4, n8 = (ch & 15) * 8;
        const bf16_t* xr = xbcc + (row0 + s) * 1024;
        *(LAS u32x4*)(CL + s * SP + n8) = *(const u32x4*)(xr + 768 + grp * 128 + n8);
        *(LAS u32x4*)(BL + s * SP + n8) = *(const u32x4*)(xr + 512 + grp * 128 + n8);
    }
    if (wave < 4) {
        const int h = grp * 4 + wave;
        const float d0 = dtb[(row0 + lane) * 16 + h], d1 = dtb[(row0 + 64 + lane) * 16 + h];
        float v0 = dtb[(row0 + lane) * 16 + 8 + h], v1 = dtb[(row0 + 64 + lane) * 16 + 8 + h];
        scan128(v0, v1, lane);
        ACS[wave * 128 + lane] = v0; ACS[wave * 128 + 64 + lane] = v1; DTL[wave * 128 + lane] = d0; DTL[wave * 128 + 64 + lane] = d1;
    }
    const int tb = wave >> 1, hl = wave & 1;
    f32x16 acc[2][2];
#pragma unroll
    for (int pi = 0; pi < 2; ++pi) {
        const int pair = grp * 2 + pi;
        __syncthreads();
#pragma unroll
        for (int i = 0; i < 4; ++i) {
            const int ch = tid + 512 * i, s = ch >> 4, n8 = (ch & 15) * 8;
            const u32x4 v = *(const u32x4*)(xbcc + (row0 + s) * 1024 + pair * 128 + n8); float f[8]; UNPACK8(v, f);
            const float w = DTL[(pi * 2 + (n8 >> 6)) * 128 + s];
            LAS bf16_t* d = XT + n8 * SP + s;
#pragma unroll
            for (int j = 0; j < 8; ++j) d[j * SP] = f2bf(f[j] * w);
            *(LAS u32x4*)(PV + s * SP + n8) = *(const u32x4*)(STB + (((size_t)bl * 16 + c) * 8 + pair * 2) * 8192 + (size_t)s * 128 + n8);
        }
        __syncthreads();
#pragma unroll
        for (int pb = 0; pb < 2; ++pb)
#pragma unroll
            for (int i = 0; i < 16; ++i) acc[pi][pb][i] = 0.f;
        const LAS bf16_t* crw = CL + (tb * 32 + r31) * SP + 8 * hh;
#pragma unroll
        for (int k = 0; k < 8; ++k) {
            const bf16x8 b = *(const LAS bf16x8*)(crw + k * 16);
#pragma unroll
            for (int pb = 0; pb < 2; ++pb) { const bf16x8 a = *(const LAS bf16x8*)(PV + (hl * 64 + pb * 32 + r31) * SP + k * 16 + 8 * hh); acc[pi][pb] = MFMA32(a, b, acc[pi][pb]); }
        }
        const LAS float* acs = ACS + (pi * 2 + hl) * 128;
        const float at = acs[tb * 32 + r31], eat = __expf(at);
#pragma unroll
        for (int pb = 0; pb < 2; ++pb)
#pragma unroll
            for (int i = 0; i < 16; ++i) acc[pi][pb][i] *= eat;
#pragma unroll 1
        for (int sb = 0; sb <= tb; ++sb) {
            f32x16 cbt;
#pragma unroll
            for (int i = 0; i < 16; ++i) cbt[i] = 0.f;
#pragma unroll
            for (int k = 0; k < 8; ++k) {
                const bf16x8 a = *(const LAS bf16x8*)(BL + (sb * 32 + r31) * SP + k * 16 + 8 * hh);
                const bf16x8 b = *(const LAS bf16x8*)(crw + k * 16);
                cbt = MFMA32(a, b, cbt);
            }
#pragma unroll
            for (int i = 0; i < 16; ++i) {
                const int sl = crow(i, hh); const float as = acs[sb * 32 + sl];
                const float mv = cbt[i] * __expf(fminf(at - as, 0.f));
                cbt[i] = (sb == tb && sl > r31) ? 0.f : mv;
            }
#pragma unroll
            for (int ks = 0; ks < 2; ++ks) {
                u32x4 w; w.x = pk2(cbt[8 * ks], cbt[8 * ks + 1]); w.y = pk2(cbt[8 * ks + 2], cbt[8 * ks + 3]); w.z = pk2(cbt[8 * ks + 4], cbt[8 * ks + 5]); w.w = pk2(cbt[8 * ks + 6], cbt[8 * ks + 7]);
                const bf16x8 pfr = __builtin_bit_cast(bf16x8, w);
#pragma unroll
                for (int pb = 0; pb < 2; ++pb) {
                    const LAS bf16_t* vp = XT + (hl * 64 + pb * 32 + r31) * SP + sb * 32 + 16 * ks + 4 * hh;
                    const s16x4 lo = *(const LAS s16x4*)vp, hi = *(const LAS s16x4*)(vp + 8);
                    const bf16x8 a = __builtin_shufflevector(lo, hi, 0, 1, 2, 3, 4, 5, 6, 7);
                    acc[pi][pb] = MFMA32(a, pfr, acc[pi][pb]);
                }
            }
        }
    }
    __syncthreads();
#pragma unroll
    for (int pi = 0; pi < 2; ++pi)
#pragma unroll
        for (int pb = 0; pb < 2; ++pb)
#pragma unroll
            for (int i = 0; i < 16; ++i) OUT[(tb * 32 + r31) * 260 + pi * 128 + hl * 64 + pb * 32 + crow(i, hh)] = acc[pi][pb][i];
    __syncthreads();
#pragma unroll 2
    for (int i = 0; i < 8; ++i) {
        const int it = tid + 512 * i, t = it >> 5, c8 = (it & 31) * 8;
        LAS f32x4* op = (LAS f32x4*)(OUT + t * 260 + c8);
        const f32x4 y0 = op[0], y1 = op[1];
        const u32x4 xv = *(const u32x4*)(xbcc + (row0 + t) * 1024 + grp * 256 + c8), zv = *(const u32x4*)(proj + (row0 + t) * PLD + grp * 256 + c8);
        float fx[8], fz[8]; UNPACK8(xv, fx); UNPACK8(zv, fz);
        const float Dh = p.in[11][l * 8 + grp * 4 + (c8 >> 6)];
        f32x4 o0, o1;
#pragma unroll
        for (int j = 0; j < 4; ++j) { o0[j] = (y0[j] + Dh * fx[j]) * silu_f(fz[j]); o1[j] = (y1[j] + Dh * fx[4 + j]) * silu_f(fz[4 + j]); }
        op[0] = o0; op[1] = o1;
        float ss = 0.f;
#pragma unroll
        for (int j = 0; j < 4; ++j) ss += o0[j] * o0[j] + o1[j] * o1[j];
        ss += __shfl_xor(ss, 1); ss += __shfl_xor(ss, 2); ss += __shfl_xor(ss, 4); ss += __shfl_xor(ss, 8); ss += __shfl_xor(ss, 16);
        if ((tid & 31) == 0) RS[t] = ss;
    }
    __syncthreads();
    const float* nw = p.in[12] + l * 512 + grp * 256;
#pragma unroll 2
    for (int i = 0; i < 8; ++i) {
        const int it = tid + 512 * i, t = it >> 5, c8 = (it & 31) * 8;
        const LAS f32x4* op = (const LAS f32x4*)(OUT + t * 260 + c8);
        const f32x4 a = op[0], b = op[1], w0 = *(const f32x4*)(nw + c8), w1 = *(const f32x4*)(nw + c8 + 4);
        const float rstd = rsqrtf(RS[t] * (1.f / 256.f) + EPS);
        *(u32x4*)(ya + (row0 + t) * 512 + grp * 256 + c8) = (u32x4){pk2(a[0] * rstd * w0[0], a[1] * rstd * w0[1]), pk2(a[2] * rstd * w0[2], a[3] * rstd * w0[3]),
                                                                      pk2(b[0] * rstd * w1[0], b[1] * rstd * w1[1]), pk2(b[2] * rstd * w1[2], b[3] * rstd * w1[3])};
    }
    __syncthreads();
}

#if MULTI_LAUNCH
#define RUNPH(x) ((x) == p.only_phase)
#define GSYNC() do {} while (0)
#else
#define RUNPH(x) true
#define GSYNC() do { XcdBarrier xb_; xb_.bar = (unsigned*)(p.ws + O_BAR); xb_.x = xb_xcc_id(); xb_.st = (volatile LAS unsigned*)(lds + LDS_BYTES - 16); xcd_barrier(xb_); if (PROBE & 1) xcd_barrier(xb_); } while (0)
#endif
#define PH_BEGIN if (RUNPH(ph)) { size_t z_ = 0; asm volatile("" : "+s"(z_)); unsigned char* ws = p.ws + z_; float* X = p.out + z_; const int wg = wg_now(), nwg = nwg_now();
#define PH_END_C(cls) } ++ph; GSYNC(); if (PROBE_T) { const unsigned long long t1_ = __builtin_amdgcn_s_memrealtime(); if ((PROBE_T >> (cls)) & 1) tacc_ += t1_ - t0_; if ((cls) == 7 && ((PROBE_T >> 14) & 1)) tacc_ += t1_; t0_ = t1_; }
__global__ void __launch_bounds__(512) mega(Params p) {
    extern __shared__ __attribute__((aligned(16))) unsigned char smem[];
    LAS unsigned char* lds = (LAS unsigned char*)smem;
#if !MULTI_LAUNCH
    cg::grid_group grid = cg::this_grid();
    volatile LAS unsigned* xst = (volatile LAS unsigned*)(lds + LDS_BYTES - 16);
    if (threadIdx.x == 0) { xst[0] = 0u; xst[1] = 0u; }
    __syncthreads();
    (void)xcd_barrier_post((unsigned*)(p.ws + O_BAR), xst);
    grid.sync();
#endif
#define XN ((bf16_t*)(ws + O_XN))
#define SSQ0 ((float*)(ws + O_SSQ))
#define SSQ1 (SSQ0 + (size_t)T_ALL * 16)
#define SSQ2 (SSQ0 + (size_t)2 * T_ALL * 16)
#define H ((bf16_t*)(ws + O_H))
#define PROJ ((bf16_t*)(ws + O_PROJ))
#define XBCC ((bf16_t*)(ws + O_XBCC))
#define ST ((float*)(ws + O_ST))
#define ATOT ((float*)(ws + O_ATOT))
#define STB ((bf16_t*)(ws + O_STB))
#define DTB ((float*)(ws + O_DTB))
#define AQ ((bf16_t*)(ws + O_AQ))
#define AKV ((bf16_t*)(ws + O_AKV))
#define QRAW ((bf16_t*)(ws + O_QRAW))
#define KVRAW ((bf16_t*)(ws + O_KVRAW))
#define QF ((bf16_t*)(ws + O_QF))
#define KF ((bf16_t*)(ws + O_KF))
#define VT ((bf16_t*)(ws + O_VT))
#define YRAW ((float*)(ws + O_YRAW))
#define YA ((bf16_t*)(ws + O_YA))
#define YB (YA + (size_t)TG * 512)
#define YC (YA + (size_t)2 * TG * 512)
#define YD (YA + (size_t)3 * TG * 512)
#define CS ((f32x2*)(ws + O_CS))
#define PB ((bf16_t*)(ws + O_PB))
#define MIXB ((bf16_t*)(ws + O_MIXB))
#define WIN ((const bf16_t*)(ws + O_WIN))
#define WGATE ((const bf16_t*)(ws + O_WGATE))
#define WBR ((const bf16_t*)(ws + O_WBR))
#define WOUT ((const bf16_t*)(ws + O_WOUT))
#define WQB ((const bf16_t*)(ws + O_WQB))
#define WKVB ((const bf16_t*)(ws + O_WKVB))
#define XNg (XN + (size_t)g * TG * 1024)
    int ph = 0;
    unsigned long long t0_ = PROBE_T ? __builtin_amdgcn_s_memrealtime() : 0ull, tacc_ = 0ull;
#pragma unroll 1
    for (int l = 0; l < 4; ++l) {
#pragma unroll 1
        for (int f = 0; f < 2; ++f) {
            if (f == 0) {
                PH_BEGIN
                    REP(32) convert_layer(p, l, (LAS float*)lds, wg, nwg);
                    if (l == 0) { rope_table(p, CS); init_rows(p.in[0], XN, SSQ0); }
                PH_END_C(0)
            }
            PH_BEGIN
                EpiGU e{H, f == 0 ? SSQ0 : SSQ2};
#pragma unroll 1
                for (int rep = 0; rep < ((PROBE & 16) ? 2 : 1); ++rep) run_gemm(lds, XN, (const bf16_t*)(ws + (f == 0 ? O_WGU1 : O_WGU2)), T_ALL, 5632, 1024, e);
            PH_END_C(1)
            PH_BEGIN
                if (PROBE & 256) { EpiRes e0{XN, f == 0 ? SSQ1 : SSQ0, (l == 3 && f == 1) ? X : nullptr, 0.0f}; run_gemm(lds, H, (const bf16_t*)(ws + (f == 0 ? O_WD1 : O_WD2)), T_ALL, 1024, 2816, e0); }
                EpiRes e{XN, f == 0 ? SSQ1 : SSQ0, (l == 3 && f == 1) ? X : nullptr, 0.5f}; run_gemm(lds, H, (const bf16_t*)(ws + (f == 0 ? O_WD1 : O_WD2)), T_ALL, 1024, 2816, e);
            PH_END_C(2)
            if (f == 0) {
#pragma unroll 1
                for (int g = 0; g < NGRP; ++g) {
                    if (g == 0) {
                        PH_BEGIN
                            EpiStore e{PROJ, PLD, 0x7fffffff, SSQ1}; run_gemm(lds, XN, WIN, TG, 4864, 1024, e);
                        PH_END_C(3)
                    }
                    PH_BEGIN
                        REP(4) prep1(p, l, PROJ, XBCC, DTB, AQ, AKV, YD);
                    PH_END_C(4)
                    PH_BEGIN
                        REP(64) {
                        { EpiStore e{QRAW, 768, 0x7fffffff, nullptr}; run_gemm(lds, AQ, WQB, TG, 768, 384, e); }
                        { EpiStore e{KVRAW, 1024, 0x7fffffff, nullptr}; run_gemm(lds, AKV, WKVB, TG, 1024, 256, e); }
#pragma unroll 1
                        for (int u = wg; u < 256; u += nwg) {
                            ssd_states_unit(XBCC, DTB, ST, ATOT, u >> 5, (u >> 1) & 15, u & 1, lds);
                        }
                        }
                    PH_END_C(5)
                    PH_BEGIN
                        REP(4) for (int u = wg; u < 256; u += nwg) prep2_unit(p, l, g, PROJ, QRAW, KVRAW, CS, QF, KF, VT, u >> 5, u & 31, lds);
                        ssd_scan(ST, STB, ATOT);
                    PH_END_C(6)
                    PH_BEGIN
                        {
                            unsigned* ctr = (unsigned*)(ws + O_WQ) + (l * 4 + g);
                            volatile LAS unsigned* wq = (volatile LAS unsigned*)(lds + LDS_BYTES - 32);
#pragma unroll 1
                            for (;;) {
                                __syncthreads();
                                if (tid_now() == 0) *wq = atomicAdd(ctr, 1u);
                                __syncthreads();
                                const int u = (int)*wq;
                                unsigned long long tu0_ = PROBE_T ? __builtin_amdgcn_s_memrealtime() : 0ull;
                                if (u >= 640) { if ((PROBE_T >> 14) & 1) { tacc_ -= tu0_; } break; }
                                int cls_;
                                if (u < 64) { attn_unit(QF, KF, VT, YC, u & 31, 7 - (u >> 5), lds); cls_ = 11; }
                                else if (u < 192) { const int k = u - 64; gmlp_unit(p, l, PROJ, YB, k >> 4, k & 15, lds); cls_ = 13; }
                                else if (u < 256) { const int k = u - 192; attn_unit(QF, KF, VT, YC, k & 31, 5 - (k >> 5), lds); cls_ = 11; }
                                else if (u < 512) { const int k = u - 256; ssd_out_grp(p, l, PROJ, XBCC, DTB, STB, YA, k >> 5, (k >> 1) & 15, k & 1, lds); cls_ = 12; }
                                else { const int k = u - 512; attn_unit(QF, KF, VT, YC, k & 31, 3 - (k >> 5), lds); cls_ = 11; }
                                if (PROBE_T) { const unsigned long long tu1_ = __builtin_amdgcn_s_memrealtime(); if ((PROBE_T >> cls_) & 1) tacc_ += tu1_ - tu0_; }
                            }
                        }
                    PH_END_C(7)
                    PH_BEGIN
                        EpiStore e{PB, 1024, 3, nullptr}; pg8::Gemm gm{YA, WBR, 4 * TG, 4096, 512}; BranchOrder S; S.G = nwg; S.c = wg;
                        REP(128) pg8::gemm_phase<EpiStore, BranchOrder>(lds, gm, S, e);
                    PH_END_C(8)
                    PH_BEGIN
                        EpiMerge e{PB, MIXB, SSQ1 + (size_t)g * TG * 16}; REP(128) run_gemm(lds, XNg, WGATE, TG, 4096, 1024, e);
                    PH_END_C(9)
                    PH_BEGIN
                        { EpiRes e{XNg, SSQ2 + (size_t)g * TG * 16, nullptr, 1.0f}; run_gemm(lds, MIXB, WOUT, TG, 1024, 1024, e); }
                        if (g < NGRP - 1) {
                            EpiStore e{PROJ, PLD, 0x7fffffff, SSQ1 + (size_t)(g + 1) * TG * 16}; run_gemm(lds, XN + (size_t)(g + 1) * TG * 1024, WIN, TG, 4864, 1024, e); }
                    PH_END_C(10)
                }
            }
        }
    }
    if (PROBE_T) { const unsigned long long te_ = __builtin_amdgcn_s_memrealtime(); while (__builtin_amdgcn_s_memrealtime() - te_ < tacc_) __builtin_amdgcn_s_sleep(8); }
}

constexpr int N_PHASES = 4 * (1 + 2 + 1 + 4 * 7 + 2);

extern "C" void kernel_launch(void* const* d_in, const int* in_sizes, int n_in, void* d_out, int out_size, void* d_ws, size_t ws_size, hipStream_t stream) {
    static int grid_blocks = 0;
    if (!grid_blocks) {
        if (n_in != 28 || ws_size < WS_NEED) { fprintf(stderr, "kernel_launch: need 28 inputs and %zu bytes of workspace (got %d, %zu)\n", (size_t)WS_NEED, n_in, ws_size); grid_blocks = -1; return; }
        if (hipFuncSetAttribute((const void*)mega, hipFuncAttributeMaxDynamicSharedMemorySize, LDS_BYTES) != hipSuccess) { fprintf(stderr, "kernel_launch: hipFuncSetAttribute failed\n"); grid_blocks = -1; return; }
        int dev = 0, cus = 0, per_cu = 0;
        hipGetDevice(&dev); hipDeviceGetAttribute(&cus, hipDeviceAttributeMultiprocessorCount, dev);
        hipOccupancyMaxActiveBlocksPerMultiprocessor(&per_cu, mega, 512, LDS_BYTES);
        if (per_cu < 1) { fprintf(stderr, "kernel_launch: occupancy query returned %d\n", per_cu); per_cu = 1; }
        (void)hipGetLastError();
        grid_blocks = cus * per_cu;
    }
    if (grid_blocks < 0) return;
    Params p{};
    for (int i = 0; i < 28; ++i) p.in[i] = (const float*)d_in[i];
    p.out = (float*)d_out; p.ws = (unsigned char*)d_ws; p.only_phase = -1; p.pad = 0;
#if MULTI_LAUNCH
    for (int ph = 0; ph < N_PHASES; ++ph) { p.only_phase = ph; hipLaunchKernelGGL(mega, dim3(grid_blocks), dim3(512), LDS_BYTES, stream, p); }
#else
    if (hipMemsetAsync((unsigned char*)d_ws + O_BAR, 0, ZERO_BYTES, stream) != hipSuccess) { fprintf(stderr, "kernel_launch: memset of barrier words failed\n"); return; }
    void* args[] = {&p};
    hipError_t e = hipLaunchCooperativeKernel((void*)mega, dim3(grid_blocks), dim3(512), args, LDS_BYTES, stream);
    if (e != hipSuccess) fprintf(stderr, "cooperative launch failed: %s (grid %d)\n", hipGetErrorString(e), grid_blocks);
#endif
}
```

```cpp
#include <hip/hip_runtime.h>
#include <hip/hip_cooperative_groups.h>
#include <cstdio>
namespace cg = cooperative_groups;

#ifndef PROBE
#define PROBE 0
#endif
#define REP(bit) _Pragma("unroll 1") for (int rep_ = 0; rep_ < ((PROBE & (bit)) ? 2 : 1); ++rep_)
#ifndef PROBE_T
#define PROBE_T 0
#endif
#ifndef MULTI_LAUNCH
#define MULTI_LAUNCH 0
#endif

__device__ __forceinline__ int tid_now() { int t = threadIdx.x; asm volatile("" : "+v"(t)); return t; }
__device__ __forceinline__ int wg_now() { int t = blockIdx.x; asm volatile("" : "+s"(t)); return t; }
__device__ __forceinline__ int nwg_now() { int t = gridDim.x; asm volatile("" : "+s"(t)); return t; }
namespace pg8 {
#define PG8_LAS __attribute__((address_space(3)))
typedef unsigned short bf16_t;
typedef short bf16x8 __attribute__((ext_vector_type(8)));
typedef float f32x4 __attribute__((ext_vector_type(4)));
typedef unsigned u32x4 __attribute__((ext_vector_type(4)));
constexpr int BM = 256, BK = 64, HALF = 128, HTB = HALF * BK * 2  , STAGE_BYTES = 8 * HTB, NXCD = 8, WGM = 8;

__host__ __device__ __forceinline__ int lds_byte(int r, int c) { const int st = (r >> 4) * 2 + (c >> 5), rr = r & 15, cc = c & 31, ob = rr * 64 + cc * 2; return st * 1024 + (ob ^ (((ob >> 9) & 1) << 5)); }
__host__ __device__ __forceinline__ void stage_rc(int b, int& R, int& C) { const int st = b / 1024, sb = b % 1024, swz = sb ^ (((sb >> 9) & 1) << 5); R = (st >> 1) * 16 + swz / 64; C = (st & 1) * 32 + (swz % 64) / 2; }
__host__ __device__ __forceinline__ int perm32(int rho) { const int n = rho >> 4, i = rho & 15; return 8 * (i >> 2) + 4 * n + (i & 3); }

struct Unit { int pm, pn; };
struct Gemm { const bf16_t* A; const bf16_t* Bt; int M, N, K; };

struct StaticOrder {
    int nM, nN, nwg, G, c;
    __host__ __device__ void init(int M, int N, int G_, int c_) { nM = M / BM; nN = N / BM; nwg = nM * nN; G = G_; c = c_; }
    __host__ __device__ bool next(int i, Unit& u) const {
        const long L = (long)i * G + c; if (L >= nwg) return false;
        int wgid = (int)L; { const int q = nwg / NXCD, r = nwg % NXCD, xcd = wgid % NXCD, off = wgid / NXCD; wgid = (xcd < r ? xcd * (q + 1) : r * (q + 1) + (xcd - r) * q) + off; }
        const int nig = WGM * nN, gid = wgid / nig, fm = gid * WGM, gsz = (nM - fm) < WGM ? (nM - fm) : WGM;
        u.pm = fm + ((wgid % nig) % gsz); u.pn = (wgid % nig) / gsz; return true;
    }
    __device__ __forceinline__ void a_ready(const Unit&) const {}
    __device__ __forceinline__ void done(const Unit&) const {}
};

template <class Epi, class Sched>
__device__ __forceinline__ void gemm_phase(PG8_LAS unsigned char* lds, const Gemm g, const Sched& S, const Epi& E) {
    const int tid = tid_now(), wid = __builtin_amdgcn_readfirstlane(tid >> 6), lane = tid & 63, wr = wid >> 2, wc = wid & 3, fr = lane & 15, fq = lane >> 4;
    const int K = g.K, nt = K / BK;
    unsigned voffA[2], voffB[2];
#pragma unroll
    for (int i = 0; i < 2; ++i) { int R, C; stage_rc(tid * 16 + i * 8192, R, C); const int Rb = Epi::PERM ? ((R & ~31) + perm32(R & 31)) : R;
        voffA[i] = (unsigned)(R * K + C) * 2u; voffB[i] = (unsigned)(Rb * K + C) * 2u; }
    const size_t kstep = (size_t)(BK * 2);
    const size_t hstep = (size_t)HALF * K * 2;
    const size_t tstep = 2 * hstep;
    const unsigned ldsw = (unsigned)wid * 1024u;
    const int aoff = lds_byte(wr * 64 + fr, fq * 8), boff = lds_byte(wc * 32 + fr, fq * 8);
#define PG8_SA(b, h) (((b) * 2 + (h)) * HTB)
#define PG8_SB(b, h) ((4 + (b) * 2 + (h)) * HTB)
#define PG8_STAGE(bufoff, gbase, voff) do { _Pragma("unroll") for (int _i = 0; _i < 2; ++_i) \
        __builtin_amdgcn_global_load_lds((const unsigned*)((const char*)(gbase) + (voff)[_i]), (PG8_LAS unsigned*)(lds + (bufoff) + ldsw + _i * 8192), 16, 0, 0); } while (0)
#define PG8_LDA(dst, b, h) do { _Pragma("unroll") for (int m = 0; m < 4; ++m) _Pragma("unroll") for (int k = 0; k < 2; ++k) dst[m][k] = *(const PG8_LAS bf16x8*)(lds + PG8_SA(b, h) + aoff + m * 2048 + k * 1024); } while (0)
#define PG8_LDB(dst, b, h) do { _Pragma("unroll") for (int n = 0; n < 2; ++n) _Pragma("unroll") for (int k = 0; k < 2; ++k) dst[n][k] = *(const PG8_LAS bf16x8*)(lds + PG8_SB(b, h) + boff + n * 2048 + k * 1024); } while (0)
#define PG8_MMA(ai, bj, At, Bt) do { __builtin_amdgcn_s_setprio(1); _Pragma("unroll") for (int m = 0; m < 4; ++m) _Pragma("unroll") for (int n = 0; n < 2; ++n) _Pragma("unroll") for (int k = 0; k < 2; ++k) \
        acc[ai][bj][m][n] = __builtin_amdgcn_mfma_f32_16x16x32_bf16(Bt[n][k], At[m][k], acc[ai][bj][m][n], 0, 0, 0); __builtin_amdgcn_s_setprio(0); } while (0)
#define PG8_WAIT_V(n) asm volatile("s_waitcnt vmcnt(" #n ")" ::: "memory")
#define PG8_WAIT_L(n) asm volatile("s_waitcnt lgkmcnt(" #n ")" ::: "memory")
#define PG8_BAR __builtin_amdgcn_s_barrier()
#define PG8_SCHED __builtin_amdgcn_sched_barrier(0)
    Unit cur, nxt; int ui = 0;
    if (!S.next(0, cur)) return;
    f32x4 acc[2][2][4][2];
#pragma unroll
    for (int a = 0; a < 2; ++a)
#pragma unroll
        for (int b = 0; b < 2; ++b)
#pragma unroll
            for (int m = 0; m < 4; ++m)
#pragma unroll
                for (int n = 0; n < 2; ++n) acc[a][b][m][n] = (f32x4){0.f, 0.f, 0.f, 0.f};
    bf16x8 At[4][2], B0[2][2], B1[2][2];
    const char* cA = (const char*)g.A + (size_t)cur.pm * tstep; const char* cB = (const char*)g.Bt + (size_t)cur.pn * tstep;
    S.a_ready(cur);
    PG8_STAGE(PG8_SB(0, 0), cB, voffB); PG8_STAGE(PG8_SA(0, 0), cA, voffA); PG8_STAGE(PG8_SB(0, 1), cB + hstep, voffB); PG8_STAGE(PG8_SA(0, 1), cA + hstep, voffA);
    if (wr == 1) PG8_BAR;
    PG8_WAIT_V(4); PG8_BAR;
    PG8_STAGE(PG8_SB(1, 0), cB + kstep, voffB); PG8_STAGE(PG8_SA(1, 0), cA + kstep, voffA); PG8_STAGE(PG8_SB(1, 1), cB + hstep + kstep, voffB);
    PG8_WAIT_V(6); PG8_BAR;
    for (;;) {
        const bool has_next = S.next(ui + 1, nxt);
        const char* nA = has_next ? (const char*)g.A + (size_t)nxt.pm * tstep : cA; const char* nB = has_next ? (const char*)g.Bt + (size_t)nxt.pn * tstep : cB;
        for (int t = 0; t < nt; t += 2) {
            const bool last = (t == nt - 2);
            const char* a1 = cA + (size_t)(t + 1) * kstep;
            const char* a2 = last ? nA : cA + (size_t)(t + 2) * kstep; const char* b2 = last ? nB : cB + (size_t)(t + 2) * kstep;
            const char* a3 = a2 + kstep; const char* b3 = b2 + kstep;
            if (last && has_next) S.a_ready(nxt);
            PG8_LDB(B0, 0, 0); PG8_SCHED; PG8_LDA(At, 0, 0); PG8_STAGE(PG8_SA(1, 1), a1 + hstep, voffA);
            PG8_WAIT_L(8); PG8_BAR; PG8_WAIT_L(0); PG8_MMA(0, 0, At, B0); PG8_BAR; PG8_SCHED;
            PG8_LDB(B1, 0, 1); PG8_STAGE(PG8_SB(0, 0), b2, voffB);
            PG8_BAR; PG8_WAIT_L(0); PG8_MMA(0, 1, At, B1); PG8_BAR;
            PG8_LDA(At, 0, 1); PG8_STAGE(PG8_SA(0, 0), a2, voffA);
            PG8_BAR; PG8_WAIT_L(0); PG8_MMA(1, 0, At, B0); PG8_BAR; PG8_SCHED;
            PG8_STAGE(PG8_SB(0, 1), b2 + hstep, voffB);
            PG8_WAIT_V(6); PG8_BAR; PG8_MMA(1, 1, At, B1); PG8_BAR;
            PG8_LDB(B0, 1, 0); PG8_SCHED; PG8_LDA(At, 1, 0); PG8_STAGE(PG8_SA(0, 1), a2 + hstep, voffA);
            PG8_WAIT_L(8); PG8_BAR; PG8_WAIT_L(0); PG8_MMA(0, 0, At, B0); PG8_BAR; PG8_SCHED;
            PG8_LDB(B1, 1, 1); PG8_STAGE(PG8_SB(1, 0), b3, voffB);
            PG8_BAR; PG8_WAIT_L(0); PG8_MMA(0, 1, At, B1); PG8_BAR;
            PG8_LDA(At, 1, 1); PG8_STAGE(PG8_SA(1, 0), a3, voffA);
            PG8_BAR; PG8_WAIT_L(0); PG8_MMA(1, 0, At, B0); PG8_BAR; PG8_SCHED;
            PG8_STAGE(PG8_SB(1, 1), b3 + hstep, voffB);
            PG8_WAIT_V(6); PG8_BAR; PG8_MMA(1, 1, At, B1); PG8_BAR;
        }
        if constexpr (!Epi::AFTER_DRAIN) { E(acc, cur, wr, wc, fr, fq); S.done(cur); }
        if (!has_next) break;
#pragma unroll
        for (int a = 0; a < 2; ++a)
#pragma unroll
            for (int b = 0; b < 2; ++b)
#pragma unroll
                for (int m = 0; m < 4; ++m)
#pragma unroll
                    for (int n = 0; n < 2; ++n) acc[a][b][m][n] = (f32x4){0.f, 0.f, 0.f, 0.f};
        cur = nxt; cA = nA; cB = nB; ++ui;
    }
    PG8_WAIT_V(0);
    if (wr == 0) PG8_BAR;
    PG8_BAR;
    if constexpr (Epi::AFTER_DRAIN) { E.fused(acc, cur, wr, wc, fr, fq, lds, wid, lane); S.done(cur); }
#undef PG8_SA
#undef PG8_SB
#undef PG8_STAGE
#undef PG8_LDA
#undef PG8_LDB
#undef PG8_MMA
#undef PG8_WAIT_V
#undef PG8_WAIT_L
#undef PG8_BAR
#undef PG8_SCHED
}
}


using pg8::bf16_t; using pg8::bf16x8; using pg8::f32x4; using pg8::u32x4;
typedef short s16x4 __attribute__((ext_vector_type(4)));
typedef float f32x2 __attribute__((ext_vector_type(2)));
typedef float f32x16 __attribute__((ext_vector_type(16)));
typedef unsigned u32x2 __attribute__((ext_vector_type(2)));
typedef __bf16 bf16v2 __attribute__((ext_vector_type(2)));
#define LAS __attribute__((address_space(3)))
#define DI __device__ __forceinline__
#define XB_TMO      128
#define XB_XCNT(j)  (256  + 64 * (j))
#define XB_XSUB(j)  (1280 + 64 * (j))
#define XB_XGEN(j)  (2304 + 64 * (j))
#define XB_TOP      3328
#define XB_TOPGEN   3392
#define XCD_BAR_WORDS 3456
#define XB_SPIN_CAP (1u << 18)

__device__ __forceinline__ unsigned xb_ld(unsigned* p)              { return __hip_atomic_load(p, __ATOMIC_RELAXED, __HIP_MEMORY_SCOPE_AGENT); }
__device__ __forceinline__ unsigned xb_add(unsigned* p, unsigned v) { return __hip_atomic_fetch_add(p, v, __ATOMIC_RELAXED, __HIP_MEMORY_SCOPE_AGENT); }
__device__ __forceinline__ unsigned xb_xcc_id() { return (unsigned)__builtin_amdgcn_s_getreg((3 << 11) | 20) & 0xFu; }
#define XB_SPIN(cond, bar) do { unsigned _sp = 0; while (cond) { __builtin_amdgcn_s_sleep(1); \
    if ((++_sp & 255u) == 0u) { if (xb_ld(&(bar)[XB_TMO])) break; if (_sp > XB_SPIN_CAP) { atomicAdd(&(bar)[XB_TMO], 1u); break; } } } } while (0)

struct XcdBarrier {
    unsigned* bar; unsigned x;
    volatile LAS unsigned* st;
};

__device__ __forceinline__ XcdBarrier xcd_barrier_post(unsigned* bar, volatile LAS unsigned* st) {
    XcdBarrier b; b.bar = bar; b.x = xb_xcc_id(); b.st = st;
    if (threadIdx.x == 0) (void)xb_add(&bar[XB_XCNT(b.x)], 1u);
    return b;
}
__device__ __forceinline__ void xcd_barrier_complete(unsigned* bar, unsigned x, unsigned& nloc, unsigned& nx) {
    const unsigned G = (unsigned)nwg_now();
    unsigned sum, cnt, mine, sp = 0u;
    for (;;) {
        sum = 0u; cnt = 0u; mine = 0u;
#pragma unroll
        for (unsigned j = 0; j < 16; ++j) { const unsigned c = xb_ld(&bar[XB_XCNT(j)]); sum += c; cnt += (c > 0u) ? 1u : 0u; mine = (j == x) ? c : mine; }
        if (sum == G) break;
        __builtin_amdgcn_s_sleep(1);
        if ((++sp & 255u) == 0u) { if (xb_ld(&bar[XB_TMO])) break; if (sp > XB_SPIN_CAP) { atomicAdd(&bar[XB_TMO], 1u); break; } }
    }
    nloc = mine > 0u ? mine : 1u; nx = cnt > 0u ? cnt : 1u;
}

__device__ __forceinline__ void xcd_barrier(const XcdBarrier& b) {
    asm volatile("s_waitcnt vmcnt(0)" ::: "memory");
    __syncthreads();
    if (tid_now() == 0) {
        unsigned* bar = b.bar; unsigned bx = b.x; asm volatile("" : "+s"(bar), "+s"(bx));
        __builtin_amdgcn_s_waitcnt(0);
        unsigned nloc = b.st[0], nx = b.st[1];
        if (nloc == 0u) { xcd_barrier_complete(bar, bx, nloc, nx); b.st[0] = nloc; b.st[1] = nx; }
        const unsigned old = xb_add(&bar[XB_XSUB(bx)], 1u);
        const unsigned gen = old / nloc;
        if (old + 1u == (gen + 1u) * nloc) {
            __builtin_amdgcn_fence(__ATOMIC_RELEASE, "agent");
            asm volatile("s_waitcnt vmcnt(0)" ::: "memory");
            const unsigned og = xb_add(&bar[XB_TOP], 1u);
            const unsigned tg = og / nx;
            if (og + 1u == (tg + 1u) * nx) xb_add(&bar[XB_TOPGEN], 1u);
            else XB_SPIN(xb_ld(&bar[XB_TOPGEN]) == tg, bar);
            __builtin_amdgcn_fence(__ATOMIC_ACQUIRE, "agent");
            xb_add(&bar[XB_XGEN(bx)], 1u);
            asm volatile("s_waitcnt vmcnt(0)" ::: "memory");
        } else {
            XB_SPIN(xb_ld(&bar[XB_XGEN(bx)]) == gen, bar);
            __builtin_amdgcn_fence(__ATOMIC_ACQUIRE, "agent");
            asm volatile("s_waitcnt vmcnt(0)" ::: "memory");
        }
    }
    __syncthreads();
}


#define MFMA32(a, b, c) __builtin_amdgcn_mfma_f32_32x32x16_bf16((a), (b), (c), 0, 0, 0)

constexpr int T_ALL = 65536, SEQ = 2048, NGRP = 4, TG = 16384, BPG = 8, PLD = 4864;
constexpr float EPS = 1e-6f;
constexpr size_t SZ_GU = (size_t)5632 * 1024 * 2, SZ_D = (size_t)1024 * 2816 * 2;
constexpr size_t O_WGU1 = 0, O_WD1 = O_WGU1 + SZ_GU, O_WGU2 = O_WD1 + SZ_D, O_WD2 = O_WGU2 + SZ_GU, O_WIN = O_WD2 + SZ_D;
constexpr size_t O_WGATE = O_WIN + (size_t)4864 * 1024 * 2, O_WBR = O_WGATE + (size_t)4096 * 1024 * 2, O_WOUT = O_WBR + (size_t)4 * 1024 * 512 * 2;
constexpr size_t O_WQB = O_WOUT + (size_t)1024 * 1024 * 2, O_WKVB = O_WQB + (size_t)768 * 384 * 2, O_XN = O_WKVB + (size_t)1024 * 256 * 2;
constexpr size_t O_R0 = O_XN + (size_t)T_ALL * 1024 * 2;
constexpr size_t O_H = O_R0;
constexpr size_t O_PROJ = O_R0, O_XBCC = O_PROJ + (size_t)TG * PLD * 2, O_DTB = O_XBCC + (size_t)TG * 1024 * 2, O_AQ = O_DTB + (size_t)TG * 16 * 4;
constexpr size_t O_AKV = O_AQ + (size_t)TG * 384 * 2, O_QRAW = O_AKV + (size_t)TG * 256 * 2, O_KVRAW = O_QRAW + (size_t)TG * 768 * 2;
constexpr size_t O_QF = O_KVRAW + (size_t)TG * 1024 * 2, O_KF = O_QF + (size_t)TG * 768 * 2, O_VT = O_KF + (size_t)TG * 768 * 2;
constexpr size_t O_YRAW = O_VT + (size_t)TG * 512 * 2, O_YA = O_YRAW + (size_t)TG * 512 * 4;
constexpr size_t O_PB = O_YA + (size_t)4 * TG * 512 * 2, O_MIXB = O_PB + (size_t)4 * TG * 1024 * 2;
constexpr size_t O_ST = O_MIXB + (size_t)TG * 1024 * 2, O_ATOT = O_ST + (size_t)BPG * 16 * 8 * 8192 * 4;
constexpr size_t O_STB = O_ATOT + 4096;
constexpr size_t O_BAR = O_STB + (size_t)BPG * 16 * 8 * 8192 * 2;
constexpr size_t O_WQ = O_BAR + (size_t)XCD_BAR_WORDS * 4;
constexpr size_t ZERO_BYTES = (size_t)XCD_BAR_WORDS * 4 + 256;
constexpr size_t O_CS = O_WQ + 256 + 256 - ((size_t)XCD_BAR_WORDS * 4) % 256;
constexpr size_t O_SSQ = O_CS + (size_t)T_ALL * 32 * 8;
constexpr size_t O_END = O_SSQ + (size_t)3 * T_ALL * 16 * 4;
constexpr size_t O_END_H = O_H + (size_t)T_ALL * 2816 * 2;
constexpr size_t WS_NEED = O_END > O_END_H ? O_END : O_END_H;
constexpr int LDS_BYTES = 147456;

struct Params { const float* in[28]; float* out; unsigned char* ws; int only_phase; int pad; };

DI unsigned pk2(float a, float b) { f32x2 v = {a, b}; return __builtin_bit_cast(unsigned, __builtin_convertvector(v, bf16v2)); }
DI bf16_t f2bf(float a) { return (bf16_t)(pk2(a, 0.f) & 0xffffu); }
DI float bf2f(bf16_t b) { return __uint_as_float(((unsigned)b) << 16); }
DI float bflo(unsigned u) { return __uint_as_float(u << 16); }
DI float bfhi(unsigned u) { return __uint_as_float(u & 0xffff0000u); }
#define UNPACK8(v, f) do { f[0] = bflo(v.x); f[1] = bfhi(v.x); f[2] = bflo(v.y); f[3] = bfhi(v.y); f[4] = bflo(v.z); f[5] = bfhi(v.z); f[6] = bflo(v.w); f[7] = bfhi(v.w); } while (0)
#define PACK8(f) ((u32x4){pk2(f[0], f[1]), pk2(f[2], f[3]), pk2(f[4], f[5]), pk2(f[6], f[7])})
DI float wave_sum(float v) {
#pragma unroll
    for (int o = 1; o < 64; o <<= 1) v += __shfl_xor(v, o);
    return v;
}
DI float silu_f(float x) { return x * __builtin_amdgcn_rcpf(1.f + __builtin_amdgcn_exp2f(-1.4426950408889634f * x)); }
DI float sigmoid_f(float x) { return __builtin_amdgcn_rcpf(1.f + __builtin_amdgcn_exp2f(-1.4426950408889634f * x)); }
DI float gelu_f(float v) {
    const float t = __builtin_amdgcn_rcpf(fabsf(v) * 0.2316418882f + 1.0f);
    float q = t * 0.5307027145f + (-0.7265760135f); q = q * t + 0.7107068705f; q = q * t + (-0.142248368f); q = q * t + 0.127414796f; q = q * t;
    const float m = v * (q * __builtin_amdgcn_exp2f(v * v * (-0.72134752044f)));
    return v < 0.f ? m : v - m;
}
DI int crow(int i, int h) { return (i & 3) + 8 * (i >> 2) + 4 * h; }
DI void rows_rstd(const float* ssq, int row0, int fq, float (&rs)[2][4]) {
    f32x4 q[2][4];
#pragma unroll
    for (int ai = 0; ai < 2; ++ai)
#pragma unroll
        for (int m = 0; m < 4; ++m) q[ai][m] = ((const f32x4*)(ssq + (size_t)(row0 + ai * 128 + m * 16) * 16))[fq];
#pragma unroll
    for (int ai = 0; ai < 2; ++ai)
#pragma unroll
        for (int m = 0; m < 4; ++m) { float t = (q[ai][m][0] + q[ai][m][1]) + (q[ai][m][2] + q[ai][m][3]); t += __shfl_xor(t, 16); t += __shfl_xor(t, 32);
            rs[ai][m] = rsqrtf(t * (1.f / 1024.f) + EPS); }
}
struct EpiStore {
    static constexpr bool PERM = true, AFTER_DRAIN = false;
    bf16_t* O; int ldc; int pnmask; const float* ssq;
    DI void operator()(const f32x4 (&acc)[2][2][4][2], const pg8::Unit& u, int wr, int wc, int fr, int fq) const {
        const int row0 = u.pm * 256 + wr * 64 + fr, col0 = (u.pn & pnmask) * 256 + wc * 32 + 8 * fq;
        float rsv[2][4];
        if (ssq) rows_rstd(ssq, row0, fq, rsv);
        else {
#pragma unroll
            for (int ai = 0; ai < 2; ++ai)
#pragma unroll
                for (int m = 0; m < 4; ++m) rsv[ai][m] = 1.f; }
#pragma unroll
        for (int ai = 0; ai < 2; ++ai)
#pragma unroll
            for (int m = 0; m < 4; ++m) { bf16_t* rowp = O + (size_t)(row0 + ai * 128 + m * 16) * ldc + col0;
                const float rs = rsv[ai][m];
#pragma unroll
                for (int bj = 0; bj < 2; ++bj) { const f32x4 v0 = acc[ai][bj][m][0] * rs, v1 = acc[ai][bj][m][1] * rs;
                    u32x4 w; w.x = pk2(v0[0], v0[1]); w.y = pk2(v0[2], v0[3]); w.z = pk2(v1[0], v1[1]); w.w = pk2(v1[2], v1[3]);
                    *(u32x4*)(rowp + bj * 128) = w; } }
    }
};
struct EpiGU {
    static constexpr bool PERM = true, AFTER_DRAIN = false;
    bf16_t* H; const float* ssq;
    DI void operator()(const f32x4 (&acc)[2][2][4][2], const pg8::Unit& u, int wr, int wc, int fr, int fq) const {
        const int row0 = u.pm * 256 + wr * 64 + fr, col0 = u.pn * 128 + wc * 32 + 8 * fq;
        float rsv[2][4]; rows_rstd(ssq, row0, fq, rsv);
#pragma unroll
        for (int ai = 0; ai < 2; ++ai)
#pragma unroll
            for (int m = 0; m < 4; ++m) { bf16_t* rowp = H + (size_t)(row0 + ai * 128 + m * 16) * 2816 + col0;
                const float rs = rsv[ai][m];
                float o[8];
#pragma unroll
                for (int n = 0; n < 2; ++n)
#pragma unroll
                    for (int j = 0; j < 4; ++j) o[4 * n + j] = silu_f(acc[ai][0][m][n][j] * rs) * (acc[ai][1][m][n][j] * rs);
                *(u32x4*)rowp = PACK8(o); }
    }
};
struct EpiRes {
    static constexpr bool PERM = false, AFTER_DRAIN = false;
    bf16_t* XB; float* SSQ; float* OUT; float sc;
    DI void operator()(const f32x4 (&acc)[2][2][4][2], const pg8::Unit& u, int wr, int wc, int fr, int fq) const {
        const int row0 = u.pm * 256 + wr * 64 + fr, col0 = u.pn * 256 + wc * 32 + 4 * fq;
#pragma unroll
        for (int ai = 0; ai < 2; ++ai) {
            u32x2 xv[4][2][2];
#pragma unroll
            for (int m = 0; m < 4; ++m)
#pragma unroll
                for (int bj = 0; bj < 2; ++bj)
#pragma unroll
                    for (int n = 0; n < 2; ++n) xv[m][bj][n] = *(const u32x2*)(XB + (size_t)(row0 + ai * 128 + m * 16) * 1024 + col0 + bj * 128 + n * 16);
#pragma unroll
            for (int m = 0; m < 4; ++m) { const int row = row0 + ai * 128 + m * 16; const size_t ro = (size_t)row * 1024 + col0;
                float ss = 0.f;
#pragma unroll
                for (int bj = 0; bj < 2; ++bj)
#pragma unroll
                    for (int n = 0; n < 2; ++n) { const u32x2 xo = xv[m][bj][n]; const f32x4 a = acc[ai][bj][m][n];
                        const f32x4 v = {bflo(xo.x) + a[0] * sc, bfhi(xo.x) + a[1] * sc, bflo(xo.y) + a[2] * sc, bfhi(xo.y) + a[3] * sc};
                        if (OUT) *(f32x4*)(OUT + ro + bj * 128 + n * 16) = v;
                        else *(u32x2*)(XB + ro + bj * 128 + n * 16) = (u32x2){pk2(v[0], v[1]), pk2(v[2], v[3])};
                        ss += v[0] * v[0] + v[1] * v[1] + v[2] * v[2] + v[3] * v[3]; }
                ss += __shfl_xor(ss, 16); ss += __shfl_xor(ss, 32);
                if (fq == 0) SSQ[(size_t)row * 16 + u.pn * 4 + wc] = ss; }
        }
    }
};
struct EpiMerge {
    static constexpr bool PERM = false, AFTER_DRAIN = false;
    const bf16_t* P; bf16_t* MIX; const float* ssq;
    DI void operator()(const f32x4 (&acc)[2][2][4][2], const pg8::Unit& u, int wr, int wc, int fr, int fq) const {
        const int row0 = u.pm * 256 + wr * 64 + fr, e0 = u.pn * 64 + wc * 16 + 4 * fq;
        float rsv[2][4]; rows_rstd(ssq, row0, fq, rsv);
#pragma unroll
        for (int ai = 0; ai < 2; ++ai) {
            u32x2 pv[4][4];
#pragma unroll
            for (int m = 0; m < 4; ++m)
#pragma unroll
                for (int b = 0; b < 4; ++b) pv[m][b] = *(const u32x2*)(P + (size_t)b * TG * 1024 + (size_t)(row0 + ai * 128 + m * 16) * 1024 + e0);
#pragma unroll
            for (int m = 0; m < 4; ++m) { const float rs = rsv[ai][m];
                float o[4] = {0.f, 0.f, 0.f, 0.f};
#pragma unroll
                for (int bj = 0; bj < 2; ++bj)
#pragma unroll
                    for (int n = 0; n < 2; ++n) { const u32x2 q = pv[m][2 * bj + n]; const f32x4 g = acc[ai][bj][m][n] * rs;
                        o[0] += sigmoid_f(g[0]) * bflo(q.x); o[1] += sigmoid_f(g[1]) * bfhi(q.x); o[2] += sigmoid_f(g[2]) * bflo(q.y); o[3] += sigmoid_f(g[3]) * bfhi(q.y); }
                *(u32x2*)(MIX + (size_t)(row0 + ai * 128 + m * 16) * 1024 + e0) = (u32x2){pk2(o[0], o[1]), pk2(o[2], o[3])}; }
        }
    }
};
struct BranchOrder {
    int G, c;
    DI bool next(int i, pg8::Unit& u) const { const int L = i * G + c; if (L >= 1024) return false; const int br = L >> 8, rem = L & 255; u.pm = br * 64 + (rem >> 2); u.pn = br * 4 + (rem & 3); return true; }
    DI void a_ready(const pg8::Unit&) const {}
    DI void done(const pg8::Unit&) const {}
};
template <class Epi> DI void run_gemm(LAS unsigned char* lds, const bf16_t* A, const bf16_t* Bt, int M, int N, int K, const Epi& E) {
    pg8::Gemm g{A, Bt, M, N, K}; pg8::StaticOrder S; S.init(M, N, nwg_now(), wg_now());
    pg8::gemm_phase<Epi, pg8::StaticOrder>(lds, g, S, E);
}

DI void conv_mat(const float* src, int ld, int c0, int nvalid, int kvalid, int mode, bf16_t* dst, int Nd, int Kd, LAS float* scr, int wg, int nwg, const float* ksc = nullptr, const int use_ksc = 0) {
    const int tid = tid_now(); const int ntk = Kd >> 6, ntiles = (Nd >> 6) * ntk;
    const int nn = tid & 63, kq = tid >> 6, nr = tid >> 3, kc = tid & 7;
    for (int tile = wg; tile < ntiles; tile += 2 * nwg) {
        float v[2][8]; int n0s[2], k0s[2];
#pragma unroll
        for (int h = 0; h < 2; ++h) {
            const int tl = tile + h * nwg; const bool on = tl < ntiles;
            const int n0 = (tl / ntk) << 6, k0 = (tl % ntk) << 6, n = n0 + nn;
            n0s[h] = n0; k0s[h] = k0;
            int col;
            if (mode == 1) { const int blk = n >> 7; col = ((blk & 1) ? 2816 : 0) + (blk >> 1) * 128 + (n & 127); }
            else if (mode == 2) { const int c = n & 255, br = 2 * (c >> 7) + ((c >> 4) & 1), e = 64 * (n >> 8) + 16 * ((c >> 5) & 3) + (c & 15); col = c0 + br * 1024 + e; }
            else col = c0 + n;
#pragma unroll
            for (int i = 0; i < 8; ++i) { const int kk = i * 8 + kq; float x = 0.f;
                if (on && k0 + kk < kvalid && n < nvalid) { x = src[(size_t)(k0 + kk) * ld + col]; if (use_ksc) x *= ksc[k0 + kk]; }
                v[h][i] = x; }
        }
#pragma unroll
        for (int h = 0; h < 2; ++h)
#pragma unroll
            for (int i = 0; i < 8; ++i) scr[h * 4160 + (i * 8 + kq) * 65 + nn] = v[h][i];
        __syncthreads();
#pragma unroll
        for (int h = 0; h < 2; ++h) if (tile + h * nwg < ntiles) {
            const LAS float* sp = scr + h * 4160 + (kc * 8) * 65 + nr;
            u32x4 o; o.x = pk2(sp[0], sp[65]); o.y = pk2(sp[130], sp[195]); o.z = pk2(sp[260], sp[325]); o.w = pk2(sp[390], sp[455]);
            *(u32x4*)(dst + (size_t)(n0s[h] + nr) * Kd + k0s[h] + kc * 8) = o; }
        __syncthreads();
    }
}
DI void convert_layer(const Params& p, int l, LAS float* scr, int wg, int nwg) {
    unsigned char* ws = p.ws;
    conv_mat(p.in[3] + (size_t)l * 1024 * 5632, 5632, 0, 5632, 1024, 1, (bf16_t*)(ws + O_WGU1), 5632, 1024, scr, wg, nwg, p.in[2] + l * 1024, 1);
    conv_mat(p.in[26] + (size_t)l * 1024 * 5632, 5632, 0, 5632, 1024, 1, (bf16_t*)(ws + O_WGU2), 5632, 1024, scr, wg, nwg, p.in[25] + l * 1024, 1);
    conv_mat(p.in[4] + (size_t)l * 2816 * 1024, 1024, 0, 1024, 2816, 0, (bf16_t*)(ws + O_WD1), 1024, 2816, scr, wg, nwg);
    conv_mat(p.in[27] + (size_t)l * 2816 * 1024, 1024, 0, 1024, 2816, 0, (bf16_t*)(ws + O_WD2), 1024, 2816, scr, wg, nwg);
    conv_mat(p.in[6] + (size_t)l * 1024 * 8776, 8776, 0, 4680, 1024, 0, (bf16_t*)(ws + O_WIN), 4864, 1024, scr, wg, nwg, p.in[5] + l * 1024, 1);
    conv_mat(p.in[6] + (size_t)l * 1024 * 8776, 8776, 4680, 4096, 1024, 2, (bf16_t*)(ws + O_WGATE), 4096, 1024, scr, wg, nwg, p.in[5] + l * 1024, 1);
#pragma unroll 1
    for (int i = 0; i < 4; ++i)
        conv_mat(p.in[23] + ((size_t)l * 4 + i) * 512 * 1024, 1024, 0, 1024, 512, 0, (bf16_t*)(ws + O_WBR) + (size_t)i * 1024 * 512, 1024, 512, scr, wg, nwg);
    conv_mat(p.in[24] + (size_t)l * 1024 * 1024, 1024, 0, 1024, 1024, 0, (bf16_t*)(ws + O_WOUT), 1024, 1024, scr, wg, nwg);
    conv_mat(p.in[17] + (size_t)l * 384 * 768, 768, 0, 768, 384, 0, (bf16_t*)(ws + O_WQB), 768, 384, scr, wg, nwg);
    conv_mat(p.in[19] + (size_t)l * 128 * 1024, 1024, 0, 1024, 128, 0, (bf16_t*)(ws + O_WKVB), 1024, 256, scr, wg, nwg);
}

DI void init_rows(const float* x, bf16_t* xb, float* ssq) {
    const int tidn = tid_now(); const int lane = tidn & 63, gwave = wg_now() * 8 + (tidn >> 6), ngw = nwg_now() * 8;
    for (int row = gwave; row < T_ALL; row += ngw) {
        const f32x4* xr = (const f32x4*)(x + (size_t)row * 1024);
        f32x4 v[4]; float ss = 0.f;
#pragma unroll
        for (int j = 0; j < 4; ++j) { v[j] = xr[lane + 64 * j]; ss += v[j][0] * v[j][0] + v[j][1] * v[j][1] + v[j][2] * v[j][2] + v[j][3] * v[j][3]; }
        ss = wave_sum(ss);
        u32x2* o = (u32x2*)(xb + (size_t)row * 1024);
#pragma unroll
        for (int j = 0; j < 4; ++j) o[lane + 64 * j] = (u32x2){pk2(v[j][0], v[j][1]), pk2(v[j][2], v[j][3])};
        if (lane < 16) ssq[(size_t)row * 16 + lane] = lane == 0 ? ss : 0.f;
    }
}
DI void zero_f32(float* q, int n) { const int tidn = tid_now(); for (int i = wg_now() * 512 + tidn; i < n; i += nwg_now() * 512) q[i] = 0.f; }

DI void prep1(const Params& p, int l, const bf16_t* __restrict__ proj, bf16_t* __restrict__ xbcc, float* __restrict__ dtb, bf16_t* __restrict__ aq, bf16_t* __restrict__ akv, bf16_t* __restrict__ yd) {
    const int tidn = tid_now(); const int gtid = wg_now() * 512 + tidn, gthreads = nwg_now() * 512;
    const float* cw = p.in[7] + l * 4096; const float* cb = p.in[8] + l * 1024;
    for (int idx = gtid; idx < (TG / 16) * 128; idx += gthreads) {
        const int c8 = (idx & 127) << 3, tl0 = (idx >> 7) << 4, s0 = tl0 & 2047;
        float w[4][8], bb[8], r0[8], r1[8], r2[8];
#pragma unroll
        for (int k = 0; k < 4; ++k) { const f32x4 a = *(const f32x4*)(cw + k * 1024 + c8), b = *(const f32x4*)(cw + k * 1024 + c8 + 4);
#pragma unroll
            for (int j = 0; j < 4; ++j) { w[k][j] = a[j]; w[k][4 + j] = b[j]; } }
        { const f32x4 a = *(const f32x4*)(cb + c8), b = *(const f32x4*)(cb + c8 + 4);
#pragma unroll
          for (int j = 0; j < 4; ++j) { bb[j] = a[j]; bb[4 + j] = b[j]; } }
        const bf16_t* src = proj + (size_t)tl0 * PLD + 512 + c8;
        if (s0 > 0) { const u32x4 v0 = *(const u32x4*)(src - 3 * PLD), v1 = *(const u32x4*)(src - 2 * PLD), v2 = *(const u32x4*)(src - PLD); UNPACK8(v0, r0); UNPACK8(v1, r1); UNPACK8(v2, r2); }
        else {
#pragma unroll
            for (int j = 0; j < 8; ++j) { r0[j] = 0.f; r1[j] = 0.f; r2[j] = 0.f; } }
#pragma unroll 8
        for (int tt = 0; tt < 16; ++tt) {
            const u32x4 v = *(const u32x4*)(src + (size_t)tt * PLD); float cur[8], o[8]; UNPACK8(v, cur);
#pragma unroll
            for (int j = 0; j < 8; ++j) { o[j] = silu_f(bb[j] + w[0][j] * r0[j] + w[1][j] * r1[j] + w[2][j] * r2[j] + w[3][j] * cur[j]); r0[j] = r1[j]; r1[j] = r2[j]; r2[j] = cur[j]; }
            *(u32x4*)(xbcc + (size_t)(tl0 + tt) * 1024 + c8) = PACK8(o);
        }
    }
    const float* sw = p.in[22] + l * 1536;
    for (int idx = gtid; idx < (TG / 16) * 64; idx += gthreads) {
        const int c8 = (idx & 63) << 3, tl0 = (idx >> 6) << 4, s0 = tl0 & 2047;
        float w[3][8], p1[8], p2[8];
#pragma unroll
        for (int k = 0; k < 3; ++k) { const f32x4 a = *(const f32x4*)(sw + k * 512 + c8), b = *(const f32x4*)(sw + k * 512 + c8 + 4);
#pragma unroll
            for (int j = 0; j < 4; ++j) { w[k][j] = a[j]; w[k][4 + j] = b[j]; } }
        const bf16_t* src = proj + (size_t)tl0 * PLD + c8;
        if (s0 > 0) { const u32x4 c1 = *(const u32x4*)(src - 2 * PLD + 3656), x1 = *(const u32x4*)(src - 2 * PLD + 4168), c2 = *(const u32x4*)(src - PLD + 3656), x2 = *(const u32x4*)(src - PLD + 4168);
            float a[8], b[8]; UNPACK8(c1, a); UNPACK8(x1, b);
#pragma unroll
            for (int j = 0; j < 8; ++j) p1[j] = a[j] * b[j];
            UNPACK8(c2, a); UNPACK8(x2, b);
#pragma unroll
            for (int j = 0; j < 8; ++j) p2[j] = a[j] * b[j]; }
        else {
#pragma unroll
            for (int j = 0; j < 8; ++j) { p1[j] = 0.f; p2[j] = 0.f; } }
#pragma unroll 8
        for (int tt = 0; tt < 16; ++tt) {
            const bf16_t* pr = src + (size_t)tt * PLD;
            const u32x4 vc = *(const u32x4*)(pr + 3656), vx = *(const u32x4*)(pr + 4168), vb = *(const u32x4*)(pr + 3144);
            float fc[8], fx[8], fb[8], o[8]; UNPACK8(vc, fc); UNPACK8(vx, fx); UNPACK8(vb, fb);
#pragma unroll
            for (int j = 0; j < 8; ++j) { const float cur = fc[j] * fx[j]; o[j] = fb[j] * (w[0][j] * p1[j] + w[1][j] * p2[j] + w[2][j] * cur); p1[j] = p2[j]; p2[j] = cur; }
            *(u32x4*)(yd + (size_t)(tl0 + tt) * 512 + c8) = PACK8(o);
        }
    }
    const int gwave = gtid >> 6, ngw = gthreads >> 6, lane = tidn & 63;
    const float* qn = p.in[16] + l * 384; const float* kn = p.in[18] + l * 128;
#pragma unroll 4
    for (int tl = gwave; tl < TG; tl += ngw) {
        const bf16_t* pr = proj + (size_t)tl * PLD;
        const u32x4 v = *(const u32x4*)(pr + 2568 + lane * 8); float f[8]; UNPACK8(v, f);
        float ss = 0.f;
#pragma unroll
        for (int j = 0; j < 8; ++j) ss += f[j] * f[j];
        const float ssq = wave_sum(lane < 48 ? ss : 0.f), ssk = wave_sum(lane >= 48 ? ss : 0.f);
        if (lane < 48) {
            const float rstd = rsqrtf(ssq * (1.f / 384.f) + EPS);
#pragma unroll
            for (int j = 0; j < 8; ++j) f[j] *= rstd * qn[lane * 8 + j];
            *(u32x4*)(aq + (size_t)tl * 384 + lane * 8) = PACK8(f);
        } else {
            const float rstd = rsqrtf(ssk * (1.f / 128.f) + EPS);
#pragma unroll
            for (int j = 0; j < 8; ++j) f[j] *= rstd * kn[(lane - 48) * 8 + j];
            *(u32x4*)(akv + (size_t)tl * 256 + (lane - 48) * 8) = PACK8(f);
            { unsigned z = 0u; asm volatile("" : "+v"(z)); *(u32x4*)(akv + (size_t)tl * 256 + 128 + (lane - 48) * 8) = (u32x4){z, z, z, z}; }
        }
        if (lane < 8) {
            const float xr = bf2f(pr[1536 + lane]) + p.in[9][l * 8 + lane];
            const float dt = xr > 20.f ? xr : log1pf(expf(xr));
            const float A = -expf(p.in[10][l * 8 + lane]);
            dtb[(size_t)tl * 16 + lane] = dt; dtb[(size_t)tl * 16 + 8 + lane] = dt * A;
        }
    }
}

DI void rope_table(const Params& p, f32x2* CS) {
    const int* pos = (const int*)p.in[1];
    const int tidn = tid_now();
    for (int idx = wg_now() * 512 + tidn; idx < T_ALL * 32; idx += nwg_now() * 512) {
        const float invf = exp2f(-(float)(idx & 31) * (13.287712379549449f / 32.f));
        const float ang = (float)pos[idx >> 5] * invf;
        CS[idx] = (f32x2){cosf(ang), sinf(ang)};
    }
}
DI void prep2_unit(const Params& p, int l, int g, const bf16_t* __restrict__ proj, const bf16_t* __restrict__ qraw, const bf16_t* __restrict__ kvraw, const f32x2* __restrict__ CSt, bf16_t* __restrict__ Qf, bf16_t* __restrict__ Kf, bf16_t* __restrict__ Vt, int bl, int tile, LAS unsigned char* lds) {
    const int tid = tid_now(), wave = tid >> 6, lane = tid & 63;
    const float* wq = p.in[20] + l * 192; const float* wk = p.in[21] + l * 192;
    const float qscale = 0.07216878364870322f * 1.4426950408889634f;
    const float wq0 = wq[lane], wq1 = wq[64 + lane], wq2 = wq[128 + lane], wk0 = wk[lane], wk1 = wk[64 + lane], wk2 = wk[128 + lane];
    LAS bf16_t* img = (LAS bf16_t*)lds;
    const int t0 = tile * 64;
#pragma unroll 4
    for (int tt = 0; tt < 8; ++tt) {
        const int tloc = wave * 8 + tt, s = t0 + tloc; const size_t tl = (size_t)bl * SEQ + s;
        const f32x2 cssn = CSt[((size_t)(g * BPG + bl) * SEQ + s) * 32 + (lane & 31)];
        const float cs = cssn[0], sn = cssn[1];
        const float kpe = bf2f(proj[tl * PLD + 3080 + lane]);
#pragma unroll
        for (int h = 0; h < 4; ++h) {
            const size_t ob = ((size_t)(bl * 4 + h) * SEQ + s) * 192;
            {
                const bf16_t* qr = qraw + tl * 768 + h * 192;
                float q0 = bf2f(qr[lane]), q1 = bf2f(qr[64 + lane]), q2 = bf2f(qr[128 + lane]);
                const float r = rsqrtf(wave_sum(q0 * q0 + q1 * q1 + q2 * q2) * (1.f / 192.f) + EPS);
                q0 *= r * wq0; q1 *= r * wq1; q2 *= r * wq2;
                const float qp = __shfl_xor(q2, 32);
                q2 = (lane < 32) ? q2 * cs - qp * sn : q2 * cs + qp * sn;
                bf16_t* qo = Qf + ob;
                qo[lane] = f2bf(q0 * qscale); qo[64 + lane] = f2bf(q1 * qscale); qo[128 + lane] = f2bf(q2 * qscale);
            }
            const bf16_t* kr = kvraw + tl * 1024 + h * 256;
            {
                float k0 = bf2f(kr[lane]), k1 = bf2f(kr[64 + lane]), k2 = kpe;
                const float r = rsqrtf(wave_sum(k0 * k0 + k1 * k1 + k2 * k2) * (1.f / 192.f) + EPS);
                k0 *= r * wk0; k1 *= r * wk1; k2 *= r * wk2;
                const float kp = __shfl_xor(k2, 32);
                k2 = (lane < 32) ? k2 * cs - kp * sn : k2 * cs + kp * sn;
                bf16_t* ko = Kf + ob;
                ko[lane] = f2bf(k0); ko[64 + lane] = f2bf(k1); ko[128 + lane] = f2bf(k2);
            }
            img[(h * 128 + lane) * 72 + tloc] = kr[128 + lane]; img[(h * 128 + 64 + lane) * 72 + tloc] = kr[192 + lane];
        }
    }
    __syncthreads();
#pragma unroll
    for (int i = 0; i < 8; ++i) {
        const int ch = tid + 512 * i, row = ch >> 3, cc = ch & 7;
        *(u32x4*)(Vt + ((size_t)(bl * 4 + (row >> 7)) * 128 + (row & 127)) * SEQ + t0 + cc * 8) = *(const LAS u32x4*)(lds + row * 144 + cc * 16);
    }
    __syncthreads();
}

constexpr int KP = 400, VP = 136, KBYTES = 64 * KP, VBYTES = 128 * VP, ASTAGE = KBYTES + VBYTES;
DI void attn_unit(const bf16_t* Qf, const bf16_t* Kf, const bf16_t* Vt, bf16_t* yc, int bh, int qb, LAS unsigned char* lds) {
    const int tid = tid_now(), wave = tid >> 6, lane = tid & 63, r31 = lane & 31, hh = lane >> 5;
    const int q0 = qb * 256, qrow = q0 + wave * 32 + r31;
    const bf16_t* Qp = Qf + ((size_t)bh * SEQ + qrow) * 192 + 8 * hh;
    bf16x8 qf[12];
#pragma unroll
    for (int kk = 0; kk < 12; ++kk) qf[kk] = *(const bf16x8*)(Qp + kk * 16);
    f32x16 o[4];
#pragma unroll
    for (int d = 0; d < 4; ++d)
#pragma unroll
        for (int i = 0; i < 16; ++i) o[d][i] = 0.f;
    float m = -1e30f, l = 0.f;
    const int ntiles = qb * 4 + 4;
    const bf16_t* Kb = Kf + (size_t)bh * SEQ * 192; const bf16_t* Vb = Vt + (size_t)bh * 128 * SEQ;
    int krow[3], kcc[3], vd[2], vcc[2];
#pragma unroll
    for (int i = 0; i < 3; ++i) { const int c = tid + 512 * i; krow[i] = c / 24; kcc[i] = c % 24; }
#pragma unroll
    for (int i = 0; i < 2; ++i) { const int c = tid + 512 * i; vd[i] = c >> 3; vcc[i] = c & 7; }
    u32x4 kA[3], vA[2], kB[3], vB[2];
#define ATT_GLOAD(j, kreg, vreg) do { _Pragma("unroll") for (int i = 0; i < 3; ++i) kreg[i] = *(const u32x4*)(Kb + (size_t)((j) * 64 + krow[i]) * 192 + kcc[i] * 8); \
        _Pragma("unroll") for (int i = 0; i < 2; ++i) vreg[i] = *(const u32x4*)(Vb + (size_t)vd[i] * SEQ + (j) * 64 + vcc[i] * 8); } while (0)
#define ATT_LSTORE(st, kreg, vreg) do { LAS unsigned char* b_ = lds + (st) * ASTAGE; \
        _Pragma("unroll") for (int i = 0; i < 3; ++i) *(LAS u32x4*)(b_ + krow[i] * KP + kcc[i] * 16) = kreg[i]; \
        _Pragma("unroll") for (int i = 0; i < 2; ++i) { LAS u32x2* d_ = (LAS u32x2*)(b_ + KBYTES + vd[i] * VP + vcc[i] * 16); d_[0] = (u32x2){vreg[i].x, vreg[i].y}; d_[1] = (u32x2){vreg[i].z, vreg[i].w}; } } while (0)
    auto compute = [&](const int j, const int cur) __attribute__((always_inline)) {
        if (j * 64 <= q0 + wave * 32 + 31) {
            const LAS unsigned char* Kl = lds + cur * ASTAGE; const LAS unsigned char* Vl = Kl + KBYTES;
            f32x16 s0, s1;
#pragma unroll
            for (int i = 0; i < 16; ++i) { s0[i] = 0.f; s1[i] = 0.f; }
#pragma unroll
            for (int kk = 0; kk < 12; ++kk) {
                const bf16x8 a0 = *(const LAS bf16x8*)(Kl + r31 * KP + (kk * 16 + 8 * hh) * 2);
                const bf16x8 a1 = *(const LAS bf16x8*)(Kl + (32 + r31) * KP + (kk * 16 + 8 * hh) * 2);
                s0 = MFMA32(a0, qf[kk], s0); s1 = MFMA32(a1, qf[kk], s1);
            }
            if (j * 64 + 63 > q0 + wave * 32) {
#pragma unroll
                for (int i = 0; i < 16; ++i) { const int key = j * 64 + crow(i, hh); if (key > qrow) s0[i] = -1e30f; if (key + 32 > qrow) s1[i] = -1e30f; }
            }
            float mx = s0[0];
#pragma unroll
            for (int i = 1; i < 16; ++i) mx = fmaxf(mx, s0[i]);
#pragma unroll
            for (int i = 0; i < 16; ++i) mx = fmaxf(mx, s1[i]);
            mx = fmaxf(mx, __shfl_xor(mx, 32));
            const float mn = fmaxf(m, mx);
            if (__ballot(mx > m) != 0ull) {
                const float alpha = __builtin_amdgcn_exp2f(m - mn);
                l *= alpha;
#pragma unroll
                for (int d = 0; d < 4; ++d)
#pragma unroll
                    for (int i = 0; i < 16; ++i) o[d][i] *= alpha;
            }
            m = mn;
            float ls = 0.f;
#pragma unroll
            for (int i = 0; i < 16; ++i) { s0[i] = __builtin_amdgcn_exp2f(s0[i] - mn); s1[i] = __builtin_amdgcn_exp2f(s1[i] - mn); ls += s0[i] + s1[i]; }
            l += ls;
            bf16x8 pf[2][2];
#pragma unroll
            for (int s = 0; s < 2; ++s) {
                u32x4 w0, w1;
                w0.x = pk2(s0[8 * s], s0[8 * s + 1]); w0.y = pk2(s0[8 * s + 2], s0[8 * s + 3]); w0.z = pk2(s0[8 * s + 4], s0[8 * s + 5]); w0.w = pk2(s0[8 * s + 6], s0[8 * s + 7]);
                w1.x = pk2(s1[8 * s], s1[8 * s + 1]); w1.y = pk2(s1[8 * s + 2], s1[8 * s + 3]); w1.z = pk2(s1[8 * s + 4], s1[8 * s + 5]); w1.w = pk2(s1[8 * s + 6], s1[8 * s + 7]);
                pf[0][s] = __builtin_bit_cast(bf16x8, w0); pf[1][s] = __builtin_bit_cast(bf16x8, w1);
            }
#pragma unroll
            for (int d = 0; d < 4; ++d)
#pragma unroll
                for (int kb = 0; kb < 2; ++kb)
#pragma unroll
                    for (int s = 0; s < 2; ++s) {
                        const LAS unsigned char* vp = Vl + (d * 32 + r31) * VP + (kb * 32 + 16 * s + 4 * hh) * 2;
                        const s16x4 lo = *(const LAS s16x4*)vp, hi = *(const LAS s16x4*)(vp + 16);
                        const bf16x8 a = __builtin_shufflevector(lo, hi, 0, 1, 2, 3, 4, 5, 6, 7);
                        o[d] = MFMA32(a, pf[kb][s], o[d]);
                    }
        }
    };
    ATT_GLOAD(0, kA, vA); ATT_LSTORE(0, kA, vA); ATT_GLOAD(1, kB, vB);
    __syncthreads();
#pragma unroll 1
    for (int j = 0; j < ntiles; j += 2) {
        if (j + 2 < ntiles) ATT_GLOAD(j + 2, kA, vA);
        compute(j, 0);
        ATT_LSTORE(1, kB, vB);
        __syncthreads();
        if (j + 3 < ntiles) ATT_GLOAD(j + 3, kB, vB);
        compute(j + 1, 1);
        if (j + 2 < ntiles) ATT_LSTORE(0, kA, vA);
        __syncthreads();
    }
#undef ATT_GLOAD
#undef ATT_LSTORE
    l += __shfl_xor(l, 32);
    const float inv = 1.f / l;
    const int bl = bh >> 2, h = bh & 3;
    bf16_t* op = yc + ((size_t)bl * SEQ + qrow) * 512 + h * 128 + 4 * hh;
#pragma unroll
    for (int d = 0; d < 4; ++d)
#pragma unroll
        for (int i4 = 0; i4 < 4; ++i4)
            *(u32x2*)(op + d * 32 + 8 * i4) = (u32x2){pk2(o[d][4 * i4] * inv, o[d][4 * i4 + 1] * inv), pk2(o[d][4 * i4 + 2] * inv, o[d][4 * i4 + 3] * inv)};
}

DI void gmlp_unit(const Params& p, int l, const bf16_t* __restrict__ proj, bf16_t* __restrict__ yb, int bl, int c, LAS unsigned char* lds) {
    const int tid = tid_now(), wave = tid >> 6, lane = tid & 63, r31 = lane & 31, hh = lane >> 5;
    const float* wsp = p.in[14] + (size_t)l * 4 * 128 * 128; const float* bs = p.in[15] + l * 512; const float* vn = p.in[13] + l * 512;
    const size_t tl0 = (size_t)bl * SEQ + c * 128;
    float w8[8];
#pragma unroll
    for (int j = 0; j < 8; ++j) w8[j] = vn[lane + 64 * j];
    LAS bf16_t* vt = (LAS bf16_t*)lds;
#pragma unroll
    for (int rr = 0; rr < 16; ++rr) {
        const int row = wave * 16 + rr;
        const bf16_t* vr = proj + (tl0 + row) * PLD + 2056 + lane;
        float f[8]; float ss = 0.f;
#pragma unroll
        for (int j = 0; j < 8; ++j) { f[j] = gelu_f(bf2f(vr[64 * j])); ss += f[j] * f[j]; }
        const float rstd = rsqrtf(wave_sum(ss) * (1.f / 512.f) + EPS);
#pragma unroll
        for (int j = 0; j < 8; ++j) vt[(lane + 64 * j) * 136 + row] = f2bf(f[j] * rstd * w8[j]);
    }
    __syncthreads();
    const int mb = wave & 3, nh = wave >> 2, trow = mb * 32 + r31;
#pragma unroll 1
    for (int g = 0; g < 4; ++g) {
        f32x16 a0, a1;
#pragma unroll
        for (int i = 0; i < 16; ++i) { a0[i] = 0.f; a1[i] = 0.f; }
        const float* wrow = wsp + ((size_t)g * 128 + trow) * 128 + 8 * hh;
#pragma unroll
        for (int kk = 0; kk < 8; ++kk) if (kk * 16 <= mb * 32 + 31) {
            const f32x4 x0 = *(const f32x4*)(wrow + kk * 16), x1 = *(const f32x4*)(wrow + kk * 16 + 4);
            const int sb = kk * 16 + 8 * hh;
            float f[8];
#pragma unroll
            for (int j = 0; j < 4; ++j) { f[j] = (sb + j <= trow) ? x0[j] : 0.f; f[4 + j] = (sb + 4 + j <= trow) ? x1[j] : 0.f; }
            const bf16x8 a = __builtin_bit_cast(bf16x8, PACK8(f));
            const bf16x8 b0 = *(const LAS bf16x8*)(vt + (g * 128 + nh * 64 + r31) * 136 + kk * 16 + 8 * hh);
            const bf16x8 b1 = *(const LAS bf16x8*)(vt + (g * 128 + nh * 64 + 32 + r31) * 136 + kk * 16 + 8 * hh);
            a0 = MFMA32(a, b0, a0); a1 = MFMA32(a, b1, a1);
        }
        __syncthreads();
        LAS bf16_t* og = vt + (g * 128) * 136;
#pragma unroll
        for (int i = 0; i < 16; ++i) {
            const int t = mb * 32 + crow(i, hh); const float bias = bs[g * 128 + t];
            og[t * 136 + nh * 64 + r31] = f2bf(a0[i] + bias); og[t * 136 + nh * 64 + 32 + r31] = f2bf(a1[i] + bias);
        }
        __syncthreads();
#pragma unroll
        for (int k = 0; k < 4; ++k) {
            const int ch = tid + 512 * k, t = ch >> 4, d8 = (ch & 15) * 8;
            const u32x4 sv = *(const LAS u32x4*)(og + t * 136 + d8);
            const u32x4 uv = *(const u32x4*)(proj + (tl0 + t) * PLD + 1544 + g * 128 + d8);
            float fs[8], fu[8]; UNPACK8(sv, fs); UNPACK8(uv, fu);
#pragma unroll
            for (int j = 0; j < 8; ++j) fu[j] = gelu_f(fu[j]) * fs[j];
            *(u32x4*)(yb + (tl0 + t) * 512 + g * 128 + d8) = PACK8(fu);
        }
    }
    __syncthreads();
}

constexpr int SP = 136;
DI void scan128(float& v0, float& v1, int lane) {
#pragma unroll
    for (int o = 1; o < 64; o <<= 1) { const float n0 = __shfl_up(v0, o), n1 = __shfl_up(v1, o); if (lane >= o) { v0 += n0; v1 += n1; } }
    v1 += __shfl(v0, 63);
}
DI void ssd_states_unit(const bf16_t* xbcc, const float* dtb, float* ST, float* ATOT, int bl, int c, int grp, LAS unsigned char* lds) {
    const int tid = tid_now(), wave = tid >> 6, lane = tid & 63, r31 = lane & 31, hh = lane >> 5;
    LAS bf16_t* BT = (LAS bf16_t*)lds; LAS bf16_t* XT = (LAS bf16_t*)(lds + 34816); LAS float* WS = (LAS float*)(lds + 104448);
    const size_t row0 = (size_t)bl * SEQ + c * 128;
    if (wave < 4) {
        const int h = grp * 4 + wave;
        const float d0 = dtb[(row0 + lane) * 16 + h], d1 = dtb[(row0 + 64 + lane) * 16 + h];
        float v0 = dtb[(row0 + lane) * 16 + 8 + h], v1 = dtb[(row0 + 64 + lane) * 16 + 8 + h];
        scan128(v0, v1, lane);
        const float tot = __shfl(v1, 63);
        WS[wave * 128 + lane] = d0 * __expf(tot - v0); WS[wave * 128 + 64 + lane] = d1 * __expf(tot - v1);
        if (lane == 0) ATOT[(bl * 16 + c) * 8 + h] = tot;
    }
    __syncthreads();
#pragma unroll
    for (int i = 0; i < 4; ++i) {
        const int ch = tid + 512 * i, s = ch >> 4, n8 = (ch & 15) * 8;
        const u32x4 v = *(const u32x4*)(xbcc + (row0 + s) * 1024 + 512 + grp * 128 + n8);
        LAS bf16_t* d = BT + n8 * SP + s;
        d[0] = (bf16_t)(v.x & 0xffffu); d[SP] = (bf16_t)(v.x >> 16); d[2 * SP] = (bf16_t)(v.y & 0xffffu); d[3 * SP] = (bf16_t)(v.y >> 16);
        d[4 * SP] = (bf16_t)(v.z & 0xffffu); d[5 * SP] = (bf16_t)(v.z >> 16); d[6 * SP] = (bf16_t)(v.w & 0xffffu); d[7 * SP] = (bf16_t)(v.w >> 16);
    }
#pragma unroll
    for (int i = 0; i < 8; ++i) {
        const int ch = tid + 512 * i, s = ch >> 5, c8 = (ch & 31) * 8;
        const u32x4 v = *(const u32x4*)(xbcc + (row0 + s) * 1024 + grp * 256 + c8); float f[8]; UNPACK8(v, f);
        const float w = WS[(c8 >> 6) * 128 + s];
        LAS bf16_t* d = XT + c8 * SP + s;
#pragma unroll
        for (int j = 0; j < 8; ++j) d[j * SP] = f2bf(f[j] * w);
    }
    __syncthreads();
    const int hl = wave >> 1, pb = wave & 1;
    f32x16 acc[4];
#pragma unroll
    for (int nb = 0; nb < 4; ++nb)
#pragma unroll
        for (int i = 0; i < 16; ++i) acc[nb][i] = 0.f;
#pragma unroll
    for (int k = 0; k < 8; ++k) {
        const bf16x8 a = *(const LAS bf16x8*)(XT + (hl * 64 + pb * 32 + r31) * SP + k * 16 + 8 * hh);
#pragma unroll
        for (int nb = 0; nb < 4; ++nb) { const bf16x8 b = *(const LAS bf16x8*)(BT + (nb * 32 + r31) * SP + k * 16 + 8 * hh); acc[nb] = MFMA32(a, b, acc[nb]); }
    }
    float* so = ST + (((size_t)bl * 16 + c) * 8 + grp * 4 + hl) * 8192;
#pragma unroll
    for (int nb = 0; nb < 4; ++nb)
#pragma unroll
        for (int i = 0; i < 16; ++i) so[(pb * 32 + crow(i, hh)) * 128 + nb * 32 + r31] = acc[nb][i];
    __syncthreads();
}
DI void ssd_scan(const float* ST, bf16_t* STB, const float* ATOT) {
    const int tidn = tid_now();
    for (int idx = wg_now() * 512 + tidn; idx < 64 * 2048; idx += nwg_now() * 512) {
        const int bh = idx >> 11, e4 = idx & 2047, bl = bh >> 3, head = bh & 7;
        const size_t off = ((size_t)bl * 16 * 8 + head) * 8192 + e4 * 4;
        f32x4 sv[16];
#pragma unroll
        for (int c = 0; c < 16; ++c) sv[c] = *(const f32x4*)(ST + off + (size_t)c * 8 * 8192);
        f32x4 run = {0.f, 0.f, 0.f, 0.f};
#pragma unroll
        for (int c = 0; c < 16; ++c) { const float ea = __expf(ATOT[(bl * 16 + c) * 8 + head]);
            *(u32x2*)(STB + off + (size_t)c * 8 * 8192) = (u32x2){pk2(run[0], run[1]), pk2(run[2], run[3])}; run = run * ea + sv[c]; }
    }
}
DI void ssd_out_grp(const Params& p, int l, const bf16_t* proj, const bf16_t* xbcc, const float* dtb, const bf16_t* STB, bf16_t* ya, int bl, int c, int grp, LAS unsigned char* lds) {
    const int tid = tid_now(), wave = tid >> 6, lane = tid & 63, r31 = lane & 31, hh = lane >> 5;
    LAS bf16_t* CL = (LAS bf16_t*)lds; LAS bf16_t* BL = (LAS bf16_t*)(lds + 34816); LAS bf16_t* XT = (LAS bf16_t*)(lds + 69632); LAS bf16_t* PV = (LAS bf16_t*)(lds + 104448);
    LAS float* ACS = (LAS float*)(lds + 139264); LAS float* DTL = (LAS float*)(lds + 141312); LAS float* RS = (LAS float*)(lds + 143360); LAS float* OUT = (LAS float*)lds;
    const size_t row0 = (size_t)bl * SEQ + c * 128;
#pragma unroll
    for (int i = 0; i < 4; ++i) {
        const int ch = tid + 512 * i, s = ch >> 4, n8 = (ch & 15) * 8;
        const bf16_t* xr = xbcc + (row0 + s) * 1024;
        *(LAS u32x4*)(CL + s * SP + n8) = *(const u32x4*)(xr + 768 + grp * 128 + n8);
        *(LAS u32x4*)(BL + s * SP + n8) = *(const u32x4*)(xr + 512 + grp * 128 + n8);
    }
    if (wave < 4) {
        const int h = grp * 4 + wave;
        const float d0 = dtb[(row0 + lane) * 16 + h], d1 = dtb[(row0 + 64 + lane) * 16 + h];
        float v0 = dtb[(row0 + lane) * 16 + 8 + h], v1 = dtb[(row0 + 64 + lane) * 16 + 8 + h];
        scan128(v0, v1, lane);
        ACS[wave * 128 + lane] = v0; ACS[wave * 128 + 64 + lane] = v1; DTL[wave * 128 + lane] = d0; DTL[wave * 128 + 64 + lane] = d1;
    }
    const int tb = wave >> 1, hl = wave & 1;
    f32x16 acc[2][2];
#pragma unroll
    for (int pi = 0; pi < 2; ++pi) {
        const int pair = grp * 2 + pi;
        __syncthreads();
#pragma unroll
        for (int i = 0; i < 4; ++i) {
            const int ch = tid + 512 * i, s = ch >> 4, n8 = (ch & 15) * 8;
            const u32x4 v = *(const u32x4*)(xbcc + (row0 + s) * 1024 + pair * 128 + n8); float f[8]; UNPACK8(v, f);
            const float w = DTL[(pi * 2 + (n8 >> 6)) * 128 + s];
            LAS bf16_t* d = XT + n8 * SP + s;
#pragma unroll
            for (int j = 0; j < 8; ++j) d[j * SP] = f2bf(f[j] * w);
            *(LAS u32x4*)(PV + s * SP + n8) = *(const u32x4*)(STB + (((size_t)bl * 16 + c) * 8 + pair * 2) * 8192 + (size_t)s * 128 + n8);
        }
        __syncthreads();
#pragma unroll
        for (int pb = 0; pb < 2; ++pb)
#pragma unroll
            for (int i = 0; i < 16; ++i) acc[pi][pb][i] = 0.f;
        const LAS bf16_t* crw = CL + (tb * 32 + r31) * SP + 8 * hh;
#pragma unroll
        for (int k = 0; k < 8; ++k) {
            const bf16x8 b = *(const LAS bf16x8*)(crw + k * 16);
#pragma unroll
            for (int pb = 0; pb < 2; ++pb) { const bf16x8 a = *(const LAS bf16x8*)(PV + (hl * 64 + pb * 32 + r31) * SP + k * 16 + 8 * hh); acc[pi][pb] = MFMA32(a, b, acc[pi][pb]); }
        }
        const LAS float* acs = ACS + (pi * 2 + hl) * 128;
        const float at = acs[tb * 32 + r31], eat = __expf(at);
#pragma unroll
        for (int pb = 0; pb < 2; ++pb)
#pragma unroll
            for (int i = 0; i < 16; ++i) acc[pi][pb][i] *= eat;
#pragma unroll 1
        for (int sb = 0; sb <= tb; ++sb) {
            f32x16 cbt;
#pragma unroll
            for (int i = 0; i < 16; ++i) cbt[i] = 0.f;
#pragma unroll
            for (int k = 0; k < 8; ++k) {
                const bf16x8 a = *(const LAS bf16x8*)(BL + (sb * 32 + r31) * SP + k * 16 + 8 * hh);
                const bf16x8 b = *(const LAS bf16x8*)(crw + k * 16);
                cbt = MFMA32(a, b, cbt);
            }
#pragma unroll
            for (int i = 0; i < 16; ++i) {
                const int sl = crow(i, hh); const float as = acs[sb * 32 + sl];
                const float mv = cbt[i] * __expf(fminf(at - as, 0.f));
                cbt[i] = (sb == tb && sl > r31) ? 0.f : mv;
            }
#pragma unroll
            for (int ks = 0; ks < 2; ++ks) {
                u32x4 w; w.x = pk2(cbt[8 * ks], cbt[8 * ks + 1]); w.y = pk2(cbt[8 * ks + 2], cbt[8 * ks + 3]); w.z = pk2(cbt[8 * ks + 4], cbt[8 * ks + 5]); w.w = pk2(cbt[8 * ks + 6], cbt[8 * ks + 7]);
                const bf16x8 pfr = __builtin_bit_cast(bf16x8, w);
#pragma unroll
                for (int pb = 0; pb < 2; ++pb) {
                    const LAS bf16_t* vp = XT + (hl * 64 + pb * 32 + r31) * SP + sb * 32 + 16 * ks + 4 * hh;
                    const s16x4 lo = *(const LAS s16x4*)vp, hi = *(const LAS s16x4*)(vp + 8);
                    const bf16x8 a = __builtin_shufflevector(lo, hi, 0, 1, 2, 3, 4, 5, 6, 7);
                    acc[pi][pb] = MFMA32(a, pfr, acc[pi][pb]);
                }
            }
        }
    }
    __syncthreads();
#pragma unroll
    for (int pi = 0; pi < 2; ++pi)
#pragma unroll
        for (int pb = 0; pb < 2; ++pb)
#pragma unroll
            for (int i = 0; i < 16; ++i) OUT[(tb * 32 + r31) * 260 + pi * 128 + hl * 64 + pb * 32 + crow(i, hh)] = acc[pi][pb][i];
    __syncthreads();
#pragma unroll 4
    for (int i = 0; i < 8; ++i) {
        const int it = tid + 512 * i, t = it >> 5, c8 = (it & 31) * 8;
        LAS f32x4* op = (LAS f32x4*)(OUT + t * 260 + c8);
        const f32x4 y0 = op[0], y1 = op[1];
        const u32x4 xv = *(const u32x4*)(xbcc + (row0 + t) * 1024 + grp * 256 + c8), zv = *(const u32x4*)(proj + (row0 + t) * PLD + grp * 256 + c8);
        float fx[8], fz[8]; UNPACK8(xv, fx); UNPACK8(zv, fz);
        const float Dh = p.in[11][l * 8 + grp * 4 + (c8 >> 6)];
        f32x4 o0, o1;
#pragma unroll
        for (int j = 0; j < 4; ++j) { o0[j] = (y0[j] + Dh * fx[j]) * silu_f(fz[j]); o1[j] = (y1[j] + Dh * fx[4 + j]) * silu_f(fz[4 + j]); }
        op[0] = o0; op[1] = o1;
        float ss = 0.f;
#pragma unroll
        for (int j = 0; j < 4; ++j) ss += o0[j] * o0[j] + o1[j] * o1[j];
        ss += __shfl_xor(ss, 1); ss += __shfl_xor(ss, 2); ss += __shfl_xor(ss, 4); ss += __shfl_xor(ss, 8); ss += __shfl_xor(ss, 16);
        if ((tid & 31) == 0) RS[t] = ss;
    }
    __syncthreads();
    const float* nw = p.in[12] + l * 512 + grp * 256;
#pragma unroll 4
    for (int i = 0; i < 8; ++i) {
        const int it = tid + 512 * i, t = it >> 5, c8 = (it & 31) * 8;
        const LAS f32x4* op = (const LAS f32x4*)(OUT + t * 260 + c8);
        const f32x4 a = op[0], b = op[1], w0 = *(const f32x4*)(nw + c8), w1 = *(const f32x4*)(nw + c8 + 4);
        const float rstd = rsqrtf(RS[t] * (1.f / 256.f) + EPS);
        *(u32x4*)(ya + (row0 + t) * 512 + grp * 256 + c8) = (u32x4){pk2(a[0] * rstd * w0[0], a[1] * rstd * w0[1]), pk2(a[2] * rstd * w0[2], a[3] * rstd * w0[3]),
                                                                      pk2(b[0] * rstd * w1[0], b[1] * rstd * w1[1]), pk2(b[2] * rstd * w1[2], b[3] * rstd * w1[3])};
    }
    __syncthreads();
}

#if MULTI_LAUNCH
#define RUNPH(x) ((x) == p.only_phase)
#define GSYNC() do {} while (0)
#else
#define RUNPH(x) true
#define GSYNC() do { XcdBarrier xb_; xb_.bar = (unsigned*)(p.ws + O_BAR); xb_.x = xb_xcc_id(); xb_.st = (volatile LAS unsigned*)(lds + LDS_BYTES - 16); xcd_barrier(xb_); if (PROBE & 1) xcd_barrier(xb_); } while (0)
#endif
#define PH_BEGIN if (RUNPH(ph)) { size_t z_ = 0; asm volatile("" : "+s"(z_)); unsigned char* ws = p.ws + z_; float* X = p.out + z_; const int wg = wg_now(), nwg = nwg_now();
#define PH_END_C(cls) } ++ph; GSYNC(); if (PROBE_T) { const unsigned long long t1_ = __builtin_amdgcn_s_memrealtime(); if ((PROBE_T >> (cls)) & 1) tacc_ += t1_ - t0_; if ((cls) == 7 && ((PROBE_T >> 14) & 1)) tacc_ += t1_; t0_ = t1_; }
__global__ void __launch_bounds__(512) mega(Params p) {
    extern __shared__ __attribute__((aligned(16))) unsigned char smem[];
    LAS unsigned char* lds = (LAS unsigned char*)smem;
#if !MULTI_LAUNCH
    cg::grid_group grid = cg::this_grid();
    volatile LAS unsigned* xst = (volatile LAS unsigned*)(lds + LDS_BYTES - 16);
    if (threadIdx.x == 0) { xst[0] = 0u; xst[1] = 0u; }
    __syncthreads();
    (void)xcd_barrier_post((unsigned*)(p.ws + O_BAR), xst);
    grid.sync();
#endif
#define XN ((bf16_t*)(ws + O_XN))
#define SSQ0 ((float*)(ws + O_SSQ))
#define SSQ1 (SSQ0 + (size_t)T_ALL * 16)
#define SSQ2 (SSQ0 + (size_t)2 * T_ALL * 16)
#define H ((bf16_t*)(ws + O_H))
#define PROJ ((bf16_t*)(ws + O_PROJ))
#define XBCC ((bf16_t*)(ws + O_XBCC))
#define ST ((float*)(ws + O_ST))
#define ATOT ((float*)(ws + O_ATOT))
#define STB ((bf16_t*)(ws + O_STB))
#define DTB ((float*)(ws + O_DTB))
#define AQ ((bf16_t*)(ws + O_AQ))
#define AKV ((bf16_t*)(ws + O_AKV))
#define QRAW ((bf16_t*)(ws + O_QRAW))
#define KVRAW ((bf16_t*)(ws + O_KVRAW))
#define QF ((bf16_t*)(ws + O_QF))
#define KF ((bf16_t*)(ws + O_KF))
#define VT ((bf16_t*)(ws + O_VT))
#define YRAW ((float*)(ws + O_YRAW))
#define YA ((bf16_t*)(ws + O_YA))
#define YB (YA + (size_t)TG * 512)
#define YC (YA + (size_t)2 * TG * 512)
#define YD (YA + (size_t)3 * TG * 512)
#define CS ((f32x2*)(ws + O_CS))
#define PB ((bf16_t*)(ws + O_PB))
#define MIXB ((bf16_t*)(ws + O_MIXB))
#define WIN ((const bf16_t*)(ws + O_WIN))
#define WGATE ((const bf16_t*)(ws + O_WGATE))
#define WBR ((const bf16_t*)(ws + O_WBR))
#define WOUT ((const bf16_t*)(ws + O_WOUT))
#define WQB ((const bf16_t*)(ws + O_WQB))
#define WKVB ((const bf16_t*)(ws + O_WKVB))
#define XNg (XN + (size_t)g * TG * 1024)
    int ph = 0;
    unsigned long long t0_ = PROBE_T ? __builtin_amdgcn_s_memrealtime() : 0ull, tacc_ = 0ull;
#pragma unroll 1
    for (int l = 0; l < 4; ++l) {
#pragma unroll 1
        for (int f = 0; f < 2; ++f) {
            if (f == 0) {
                PH_BEGIN
                    REP(32) convert_layer(p, l, (LAS float*)lds, wg, nwg);
                    if (l == 0) { rope_table(p, CS); init_rows(p.in[0], XN, SSQ0); }
                PH_END_C(0)
            }
            PH_BEGIN
                EpiGU e{H, f == 0 ? SSQ0 : SSQ2};
#pragma unroll 1
                for (int rep = 0; rep < ((PROBE & 16) ? 2 : 1); ++rep) run_gemm(lds, XN, (const bf16_t*)(ws + (f == 0 ? O_WGU1 : O_WGU2)), T_ALL, 5632, 1024, e);
            PH_END_C(1)
            PH_BEGIN
                if (PROBE & 256) { EpiRes e0{XN, f == 0 ? SSQ1 : SSQ0, (l == 3 && f == 1) ? X : nullptr, 0.0f}; run_gemm(lds, H, (const bf16_t*)(ws + (f == 0 ? O_WD1 : O_WD2)), T_ALL, 1024, 2816, e0); }
                EpiRes e{XN, f == 0 ? SSQ1 : SSQ0, (l == 3 && f == 1) ? X : nullptr, 0.5f}; run_gemm(lds, H, (const bf16_t*)(ws + (f == 0 ? O_WD1 : O_WD2)), T_ALL, 1024, 2816, e);
            PH_END_C(2)
            if (f == 0) {
#pragma unroll 1
                for (int g = 0; g < NGRP; ++g) {
                    if (g == 0) {
                        PH_BEGIN
                            EpiStore e{PROJ, PLD, 0x7fffffff, SSQ1}; run_gemm(lds, XN, WIN, TG, 4864, 1024, e);
                        PH_END_C(3)
                    }
                    PH_BEGIN
                        REP(4) prep1(p, l, PROJ, XBCC, DTB, AQ, AKV, YD);
                    PH_END_C(4)
                    PH_BEGIN
                        REP(64) {
                        { EpiStore e{QRAW, 768, 0x7fffffff, nullptr}; run_gemm(lds, AQ, WQB, TG, 768, 384, e); }
                        { EpiStore e{KVRAW, 1024, 0x7fffffff, nullptr}; run_gemm(lds, AKV, WKVB, TG, 1024, 256, e); }
#pragma unroll 1
                        for (int u = wg; u < 256; u += nwg) {
                            ssd_states_unit(XBCC, DTB, ST, ATOT, u >> 5, (u >> 1) & 15, u & 1, lds);
                        }
                        }
                    PH_END_C(5)
                    PH_BEGIN
                        REP(4) for (int u = wg; u < 256; u += nwg) prep2_unit(p, l, g, PROJ, QRAW, KVRAW, CS, QF, KF, VT, u >> 5, u & 31, lds);
                        ssd_scan(ST, STB, ATOT);
                    PH_END_C(6)
                    PH_BEGIN
                        {
                            unsigned* ctr = (unsigned*)(ws + O_WQ) + (l * 4 + g);
                            volatile LAS unsigned* wq = (volatile LAS unsigned*)(lds + LDS_BYTES - 32);
#pragma unroll 1
                            for (;;) {
                                __syncthreads();
                                if (tid_now() == 0) *wq = atomicAdd(ctr, 1u);
                                __syncthreads();
                                const int u = (int)*wq;
                                unsigned long long tu0_ = PROBE_T ? __builtin_amdgcn_s_memrealtime() : 0ull;
                                if (u >= 640) { if ((PROBE_T >> 14) & 1) { tacc_ -= tu0_; } break; }
                                int cls_;
                                if (u < 64) { attn_unit(QF, KF, VT, YC, u & 31, 7 - (u >> 5), lds); cls_ = 11; }
                                else if (u < 192) { const int k = u - 64; gmlp_unit(p, l, PROJ, YB, k >> 4, k & 15, lds); cls_ = 13; }
                                else if (u < 256) { const int k = u - 192; attn_unit(QF, KF, VT, YC, k & 31, 5 - (k >> 5), lds); cls_ = 11; }
                                else if (u < 512) { const int k = u - 256; ssd_out_grp(p, l, PROJ, XBCC, DTB, STB, YA, k >> 5, (k >> 1) & 15, k & 1, lds); cls_ = 12; }
                                else { const int k = u - 512; attn_unit(QF, KF, VT, YC, k & 31, 3 - (k >> 5), lds); cls_ = 11; }
                                if (PROBE_T) { const unsigned long long tu1_ = __builtin_amdgcn_s_memrealtime(); if ((PROBE_T >> cls_) & 1) tacc_ += tu1_ - tu0_; }
                            }
                        }
                    PH_END_C(7)
                    PH_BEGIN
                        EpiStore e{PB, 1024, 3, nullptr}; pg8::Gemm gm{YA, WBR, 4 * TG, 4096, 512}; BranchOrder S; S.G = nwg; S.c = wg;
                        REP(128) pg8::gemm_phase<EpiStore, BranchOrder>(lds, gm, S, e);
                    PH_END_C(8)
                    PH_BEGIN
                        EpiMerge e{PB, MIXB, SSQ1 + (size_t)g * TG * 16}; REP(128) run_gemm(lds, XNg, WGATE, TG, 4096, 1024, e);
                    PH_END_C(9)
                    PH_BEGIN
                        { EpiRes e{XNg, SSQ2 + (size_t)g * TG * 16, nullptr, 1.0f}; run_gemm(lds, MIXB, WOUT, TG, 1024, 1024, e); }
                        if (g < NGRP - 1) {
                            EpiStore e{PROJ, PLD, 0x7fffffff, SSQ1 + (size_t)(g + 1) * TG * 16}; run_gemm(lds, XN + (size_t)(g + 1) * TG * 1024, WIN, TG, 4864, 1024, e); }
                    PH_END_C(10)
                }
            }
        }
    }
    if (PROBE_T) { const unsigned long long te_ = __builtin_amdgcn_s_memrealtime(); while (__builtin_amdgcn_s_memrealtime() - te_ < tacc_) __builtin_amdgcn_s_sleep(8); }
}

constexpr int N_PHASES = 4 * (1 + 2 + 1 + 4 * 7 + 2);

extern "C" void kernel_launch(void* const* d_in, const int* in_sizes, int n_in, void* d_out, int out_size, void* d_ws, size_t ws_size, hipStream_t stream) {
    static int grid_blocks = 0;
    if (!grid_blocks) {
        if (n_in != 28 || ws_size < WS_NEED) { fprintf(stderr, "kernel_launch: need 28 inputs and %zu bytes of workspace (got %d, %zu)\n", (size_t)WS_NEED, n_in, ws_size); grid_blocks = -1; return; }
        if (hipFuncSetAttribute((const void*)mega, hipFuncAttributeMaxDynamicSharedMemorySize, LDS_BYTES) != hipSuccess) { fprintf(stderr, "kernel_launch: hipFuncSetAttribute failed\n"); grid_blocks = -1; return; }
        int dev = 0, cus = 0, per_cu = 0;
        hipGetDevice(&dev); hipDeviceGetAttribute(&cus, hipDeviceAttributeMultiprocessorCount, dev);
        hipOccupancyMaxActiveBlocksPerMultiprocessor(&per_cu, mega, 512, LDS_BYTES);
        if (per_cu < 1) { fprintf(stderr, "kernel_launch: occupancy query returned %d\n", per_cu); per_cu = 1; }
        (void)hipGetLastError();
        grid_blocks = cus * per_cu;
    }
    if (grid_blocks < 0) return;
    Params p{};
    for (int i = 0; i < 28; ++i) p.in[i] = (const float*)d_in[i];
    p.out = (float*)d_out; p.ws = (unsigned char*)d_ws; p.only_phase = -1; p.pad = 0;
#if MULTI_LAUNCH
    for (int ph = 0; ph < N_PHASES; ++ph) { p.only_phase = ph; hipLaunchKernelGGL(mega, dim3(grid_blocks), dim3(512), LDS_BYTES, stream, p); }
#else
    if (hipMemsetAsync((unsigned char*)d_ws + O_BAR, 0, ZERO_BYTES, stream) != hipSuccess) { fprintf(stderr, "kernel_launch: memset of barrier words failed\n"); return; }
    void* args[] = {&p};
    hipError_t e = hipLaunchCooperativeKernel((void*)mega, dim3(grid_blocks), dim3(512), args, LDS_BYTES, stream);
    if (e != hipSuccess) fprintf(stderr, "cooperative launch failed: %s (grid %d)\n", hipGetErrorString(e), grid_blocks);
#endif
}
```

```cpp
#include <hip/hip_runtime.h>
#include <hip/hip_cooperative_groups.h>
#include <cstdio>
namespace cg = cooperative_groups;

#ifndef PROBE
#define PROBE 0
#endif
#define REP(bit) _Pragma("unroll 1") for (int rep_ = 0; rep_ < ((PROBE & (bit)) ? 2 : 1); ++rep_)
#ifndef PROBE_T
#define PROBE_T 0
#endif
#ifndef MULTI_LAUNCH
#define MULTI_LAUNCH 0
#endif

__device__ __forceinline__ int tid_now() { int t = threadIdx.x; asm volatile("" : "+v"(t)); return t; }
__device__ __forceinline__ int wg_now() { int t = blockIdx.x; asm volatile("" : "+s"(t)); return t; }
__device__ __forceinline__ int nwg_now() { int t = gridDim.x; asm volatile("" : "+s"(t)); return t; }
namespace pg8 {
#define PG8_LAS __attribute__((address_space(3)))
typedef unsigned short bf16_t;
typedef short bf16x8 __attribute__((ext_vector_type(8)));
typedef float f32x4 __attribute__((ext_vector_type(4)));
typedef unsigned u32x4 __attribute__((ext_vector_type(4)));
constexpr int BM = 256, BK = 64, HALF = 128, HTB = HALF * BK * 2  , STAGE_BYTES = 8 * HTB, NXCD = 8, WGM = 8;

__host__ __device__ __forceinline__ int lds_byte(int r, int c) { const int st = (r >> 4) * 2 + (c >> 5), rr = r & 15, cc = c & 31, ob = rr * 64 + cc * 2; return st * 1024 + (ob ^ (((ob >> 9) & 1) << 5)); }
__host__ __device__ __forceinline__ void stage_rc(int b, int& R, int& C) { const int st = b / 1024, sb = b % 1024, swz = sb ^ (((sb >> 9) & 1) << 5); R = (st >> 1) * 16 + swz / 64; C = (st & 1) * 32 + (swz % 64) / 2; }
__host__ __device__ __forceinline__ int perm32(int rho) { const int n = rho >> 4, i = rho & 15; return 8 * (i >> 2) + 4 * n + (i & 3); }

struct Unit { int pm, pn; };
struct Gemm { const bf16_t* A; const bf16_t* Bt; int M, N, K; };

struct StaticOrder {
    int nM, nN, nwg, G, c;
    __host__ __device__ void init(int M, int N, int G_, int c_) { nM = M / BM; nN = N / BM; nwg = nM * nN; G = G_; c = c_; }
    __host__ __device__ bool next(int i, Unit& u) const {
        const long L = (long)i * G + c; if (L >= nwg) return false;
        int wgid = (int)L; { const int q = nwg / NXCD, r = nwg % NXCD, xcd = wgid % NXCD, off = wgid / NXCD; wgid = (xcd < r ? xcd * (q + 1) : r * (q + 1) + (xcd - r) * q) + off; }
        const int nig = WGM * nN, gid = wgid / nig, fm = gid * WGM, gsz = (nM - fm) < WGM ? (nM - fm) : WGM;
        u.pm = fm + ((wgid % nig) % gsz); u.pn = (wgid % nig) / gsz; return true;
    }
    __device__ __forceinline__ void a_ready(const Unit&) const {}
    __device__ __forceinline__ void done(const Unit&) const {}
};

template <class Epi, class Sched>
__device__ __forceinline__ void gemm_phase(PG8_LAS unsigned char* lds, const Gemm g, const Sched& S, const Epi& E) {
    const int tid = tid_now(), wid = __builtin_amdgcn_readfirstlane(tid >> 6), lane = tid & 63, wr = wid >> 2, wc = wid & 3, fr = lane & 15, fq = lane >> 4;
    const int K = g.K, nt = K / BK;
    unsigned voffA[2], voffB[2];
#pragma unroll
    for (int i = 0; i < 2; ++i) { int R, C; stage_rc(tid * 16 + i * 8192, R, C); const int Rb = Epi::PERM ? ((R & ~31) + perm32(R & 31)) : R;
        voffA[i] = (unsigned)(R * K + C) * 2u; voffB[i] = (unsigned)(Rb * K + C) * 2u; }
    const size_t kstep = (size_t)(BK * 2);
    const size_t hstep = (size_t)HALF * K * 2;
    const size_t tstep = 2 * hstep;
    const unsigned ldsw = (unsigned)wid * 1024u;
    const int aoff = lds_byte(wr * 64 + fr, fq * 8), boff = lds_byte(wc * 32 + fr, fq * 8);
#define PG8_SA(b, h) (((b) * 2 + (h)) * HTB)
#define PG8_SB(b, h) ((4 + (b) * 2 + (h)) * HTB)
#define PG8_STAGE(bufoff, gbase, voff) do { _Pragma("unroll") for (int _i = 0; _i < 2; ++_i) \
        __builtin_amdgcn_global_load_lds((const unsigned*)((const char*)(gbase) + (voff)[_i]), (PG8_LAS unsigned*)(lds + (bufoff) + ldsw + _i * 8192), 16, 0, 0); } while (0)
#define PG8_LDA(dst, b, h) do { _Pragma("unroll") for (int m = 0; m < 4; ++m) _Pragma("unroll") for (int k = 0; k < 2; ++k) dst[m][k] = *(const PG8_LAS bf16x8*)(lds + PG8_SA(b, h) + aoff + m * 2048 + k * 1024); } while (0)
#define PG8_LDB(dst, b, h) do { _Pragma("unroll") for (int n = 0; n < 2; ++n) _Pragma("unroll") for (int k = 0; k < 2; ++k) dst[n][k] = *(const PG8_LAS bf16x8*)(lds + PG8_SB(b, h) + boff + n * 2048 + k * 1024); } while (0)
#define PG8_MMA(ai, bj, At, Bt) do { __builtin_amdgcn_s_setprio(1); _Pragma("unroll") for (int m = 0; m < 4; ++m) _Pragma("unroll") for (int n = 0; n < 2; ++n) _Pragma("unroll") for (int k = 0; k < 2; ++k) \
        acc[ai][bj][m][n] = __builtin_amdgcn_mfma_f32_16x16x32_bf16(Bt[n][k], At[m][k], acc[ai][bj][m][n], 0, 0, 0); __builtin_amdgcn_s_setprio(0); } while (0)
#define PG8_WAIT_V(n) asm volatile("s_waitcnt vmcnt(" #n ")" ::: "memory")
#define PG8_WAIT_L(n) asm volatile("s_waitcnt lgkmcnt(" #n ")" ::: "memory")
#define PG8_BAR __builtin_amdgcn_s_barrier()
#define PG8_SCHED __builtin_amdgcn_sched_barrier(0)
    Unit cur, nxt; int ui = 0;
    if (!S.next(0, cur)) return;
    f32x4 acc[2][2][4][2];
#pragma unroll
    for (int a = 0; a < 2; ++a)
#pragma unroll
        for (int b = 0; b < 2; ++b)
#pragma unroll
            for (int m = 0; m < 4; ++m)
#pragma unroll
                for (int n = 0; n < 2; ++n) acc[a][b][m][n] = (f32x4){0.f, 0.f, 0.f, 0.f};
    bf16x8 At[4][2], B0[2][2], B1[2][2];
    const char* cA = (const char*)g.A + (size_t)cur.pm * tstep; const char* cB = (const char*)g.Bt + (size_t)cur.pn * tstep;
    S.a_ready(cur);
    PG8_STAGE(PG8_SB(0, 0), cB, voffB); PG8_STAGE(PG8_SA(0, 0), cA, voffA); PG8_STAGE(PG8_SB(0, 1), cB + hstep, voffB); PG8_STAGE(PG8_SA(0, 1), cA + hstep, voffA);
    if (wr == 1) PG8_BAR;
    PG8_WAIT_V(4); PG8_BAR;
    PG8_STAGE(PG8_SB(1, 0), cB + kstep, voffB); PG8_STAGE(PG8_SA(1, 0), cA + kstep, voffA); PG8_STAGE(PG8_SB(1, 1), cB + hstep + kstep, voffB);
    PG8_WAIT_V(6); PG8_BAR;
    for (;;) {
        const bool has_next = S.next(ui + 1, nxt);
        const char* nA = has_next ? (const char*)g.A + (size_t)nxt.pm * tstep : cA; const char* nB = has_next ? (const char*)g.Bt + (size_t)nxt.pn * tstep : cB;
        for (int t = 0; t < nt; t += 2) {
            const bool last = (t == nt - 2);
            const char* a1 = cA + (size_t)(t + 1) * kstep;
            const char* a2 = last ? nA : cA + (size_t)(t + 2) * kstep; const char* b2 = last ? nB : cB + (size_t)(t + 2) * kstep;
            const char* a3 = a2 + kstep; const char* b3 = b2 + kstep;
            if (last && has_next) S.a_ready(nxt);
            PG8_LDB(B0, 0, 0); PG8_SCHED; PG8_LDA(At, 0, 0); PG8_STAGE(PG8_SA(1, 1), a1 + hstep, voffA);
            PG8_WAIT_L(8); PG8_BAR; PG8_WAIT_L(0); PG8_MMA(0, 0, At, B0); PG8_BAR; PG8_SCHED;
            PG8_LDB(B1, 0, 1); PG8_STAGE(PG8_SB(0, 0), b2, voffB);
            PG8_BAR; PG8_WAIT_L(0); PG8_MMA(0, 1, At, B1); PG8_BAR;
            PG8_LDA(At, 0, 1); PG8_STAGE(PG8_SA(0, 0), a2, voffA);
            PG8_BAR; PG8_WAIT_L(0); PG8_MMA(1, 0, At, B0); PG8_BAR; PG8_SCHED;
            PG8_STAGE(PG8_SB(0, 1), b2 + hstep, voffB);
            PG8_WAIT_V(6); PG8_BAR; PG8_MMA(1, 1, At, B1); PG8_BAR;
            PG8_LDB(B0, 1, 0); PG8_SCHED; PG8_LDA(At, 1, 0); PG8_STAGE(PG8_SA(0, 1), a2 + hstep, voffA);
            PG8_WAIT_L(8); PG8_BAR; PG8_WAIT_L(0); PG8_MMA(0, 0, At, B0); PG8_BAR; PG8_SCHED;
            PG8_LDB(B1, 1, 1); PG8_STAGE(PG8_SB(1, 0), b3, voffB);
            PG8_BAR; PG8_WAIT_L(0); PG8_MMA(0, 1, At, B1); PG8_BAR;
            PG8_LDA(At, 1, 1); PG8_STAGE(PG8_SA(1, 0), a3, voffA);
            PG8_BAR; PG8_WAIT_L(0); PG8_MMA(1, 0, At, B0); PG8_BAR; PG8_SCHED;
            PG8_STAGE(PG8_SB(1, 1), b3 + hstep, voffB);
            PG8_WAIT_V(6); PG8_BAR; PG8_MMA(1, 1, At, B1); PG8_BAR;
        }
        if constexpr (!Epi::AFTER_DRAIN) { E(acc, cur, wr, wc, fr, fq); S.done(cur); }
        if (!has_next) break;
#pragma unroll
        for (int a = 0; a < 2; ++a)
#pragma unroll
            for (int b = 0; b < 2; ++b)
#pragma unroll
                for (int m = 0; m < 4; ++m)
#pragma unroll
                    for (int n = 0; n < 2; ++n) acc[a][b][m][n] = (f32x4){0.f, 0.f, 0.f, 0.f};
        cur = nxt; cA = nA; cB = nB; ++ui;
    }
    PG8_WAIT_V(0);
    if (wr == 0) PG8_BAR;
    PG8_BAR;
    if constexpr (Epi::AFTER_DRAIN) { E.fused(acc, cur, wr, wc, fr, fq, lds, wid, lane); S.done(cur); }
#undef PG8_SA
#undef PG8_SB
#undef PG8_STAGE
#undef PG8_LDA
#undef PG8_LDB
#undef PG8_MMA
#undef PG8_WAIT_V
#undef PG8_WAIT_L
#undef PG8_BAR
#undef PG8_SCHED
}
}


using pg8::bf16_t; using pg8::bf16x8; using pg8::f32x4; using pg8::u32x4;
typedef short s16x4 __attribute__((ext_vector_type(4)));
typedef float f32x2 __attribute__((ext_vector_type(2)));
typedef float f32x16 __attribute__((ext_vector_type(16)));
typedef unsigned u32x2 __attribute__((ext_vector_type(2)));
typedef __bf16 bf16v2 __attribute__((ext_vector_type(2)));
#define LAS __attribute__((address_space(3)))
#define DI __device__ __forceinline__
#define XB_TMO      128
#define XB_XCNT(j)  (256  + 64 * (j))
#define XB_XSUB(j)  (1280 + 64 * (j))
#define XB_XGEN(j)  (2304 + 64 * (j))
#define XB_TOP      3328
#define XB_TOPGEN   3392
#define XCD_BAR_WORDS 3456
#define XB_SPIN_CAP (1u << 18)

__device__ __forceinline__ unsigned xb_ld(unsigned* p)              { return __hip_atomic_load(p, __ATOMIC_RELAXED, __HIP_MEMORY_SCOPE_AGENT); }
__device__ __forceinline__ unsigned xb_add(unsigned* p, unsigned v) { return __hip_atomic_fetch_add(p, v, __ATOMIC_RELAXED, __HIP_MEMORY_SCOPE_AGENT); }
__device__ __forceinline__ unsigned xb_xcc_id() { return (unsigned)__builtin_amdgcn_s_getreg((3 << 11) | 20) & 0xFu; }
#define XB_SPIN(cond, bar) do { unsigned _sp = 0; while (cond) { __builtin_amdgcn_s_sleep(1); \
    if ((++_sp & 255u) == 0u) { if (xb_ld(&(bar)[XB_TMO])) break; if (_sp > XB_SPIN_CAP) { atomicAdd(&(bar)[XB_TMO], 1u); break; } } } } while (0)

struct XcdBarrier {
    unsigned* bar; unsigned x;
    volatile LAS unsigned* st;
};

__device__ __forceinline__ XcdBarrier xcd_barrier_post(unsigned* bar, volatile LAS unsigned* st) {
    XcdBarrier b; b.bar = bar; b.x = xb_xcc_id(); b.st = st;
    if (threadIdx.x == 0) (void)xb_add(&bar[XB_XCNT(b.x)], 1u);
    return b;
}
__device__ __forceinline__ void xcd_barrier_complete(unsigned* bar, unsigned x, unsigned& nloc, unsigned& nx) {
    const unsigned G = (unsigned)nwg_now();
    unsigned sum, cnt, mine, sp = 0u;
    for (;;) {
        sum = 0u; cnt = 0u; mine = 0u;
#pragma unroll
        for (unsigned j = 0; j < 16; ++j) { const unsigned c = xb_ld(&bar[XB_XCNT(j)]); sum += c; cnt += (c > 0u) ? 1u : 0u; mine = (j == x) ? c : mine; }
        if (sum == G) break;
        __builtin_amdgcn_s_sleep(1);
        if ((++sp & 255u) == 0u) { if (xb_ld(&bar[XB_TMO])) break; if (sp > XB_SPIN_CAP) { atomicAdd(&bar[XB_TMO], 1u); break; } }
    }
    nloc = mine > 0u ? mine : 1u; nx = cnt > 0u ? cnt : 1u;
}

__device__ __forceinline__ void xcd_barrier(const XcdBarrier& b) {
    asm volatile("s_waitcnt vmcnt(0)" ::: "memory");
    __syncthreads();
    if (tid_now() == 0) {
        unsigned* bar = b.bar; unsigned bx = b.x; asm volatile("" : "+s"(bar), "+s"(bx));
        __builtin_amdgcn_s_waitcnt(0);
        unsigned nloc = b.st[0], nx = b.st[1];
        if (nloc == 0u) { xcd_barrier_complete(bar, bx, nloc, nx); b.st[0] = nloc; b.st[1] = nx; }
        const unsigned old = xb_add(&bar[XB_XSUB(bx)], 1u);
        const unsigned gen = old / nloc;
        if (old + 1u == (gen + 1u) * nloc) {
            __builtin_amdgcn_fence(__ATOMIC_RELEASE, "agent");
            asm volatile("s_waitcnt vmcnt(0)" ::: "memory");
            const unsigned og = xb_add(&bar[XB_TOP], 1u);
            const unsigned tg = og / nx;
            if (og + 1u == (tg + 1u) * nx) xb_add(&bar[XB_TOPGEN], 1u);
            else XB_SPIN(xb_ld(&bar[XB_TOPGEN]) == tg, bar);
            __builtin_amdgcn_fence(__ATOMIC_ACQUIRE, "agent");
            xb_add(&bar[XB_XGEN(bx)], 1u);
            asm volatile("s_waitcnt vmcnt(0)" ::: "memory");
        } else {
            XB_SPIN(xb_ld(&bar[XB_XGEN(bx)]) == gen, bar);
            __builtin_amdgcn_fence(__ATOMIC_ACQUIRE, "agent");
            asm volatile("s_waitcnt vmcnt(0)" ::: "memory");
        }
    }
    __syncthreads();
}


#define MFMA32(a, b, c) __builtin_amdgcn_mfma_f32_32x32x16_bf16((a), (b), (c), 0, 0, 0)

constexpr int T_ALL = 65536, SEQ = 2048, NGRP = 4, TG = 16384, BPG = 8, PLD = 4864;
constexpr float EPS = 1e-6f;
constexpr size_t SZ_GU = (size_t)5632 * 1024 * 2, SZ_D = (size_t)1024 * 2816 * 2;
constexpr size_t O_WGU1 = 0, O_WD1 = O_WGU1 + SZ_GU, O_WGU2 = O_WD1 + SZ_D, O_WD2 = O_WGU2 + SZ_GU, O_WIN = O_WD2 + SZ_D;
constexpr size_t O_WGATE = O_WIN + (size_t)4864 * 1024 * 2, O_WBR = O_WGATE + (size_t)4096 * 1024 * 2, O_WOUT = O_WBR + (size_t)4 * 1024 * 512 * 2;
constexpr size_t O_WQB = O_WOUT + (size_t)1024 * 1024 * 2, O_WKVB = O_WQB + (size_t)768 * 384 * 2, O_XN = O_WKVB + (size_t)1024 * 256 * 2;
constexpr size_t O_R0 = O_XN + (size_t)T_ALL * 1024 * 2;
constexpr size_t O_H = O_R0;
constexpr size_t O_PROJ = O_R0, O_XBCC = O_PROJ + (size_t)TG * PLD * 2, O_DTB = O_XBCC + (size_t)TG * 1024 * 2, O_AQ = O_DTB + (size_t)TG * 16 * 4;
constexpr size_t O_AKV = O_AQ + (size_t)TG * 384 * 2, O_QRAW = O_AKV + (size_t)TG * 256 * 2, O_KVRAW = O_QRAW + (size_t)TG * 768 * 2;
constexpr size_t O_QF = O_KVRAW + (size_t)TG * 1024 * 2, O_KF = O_QF + (size_t)TG * 768 * 2, O_VT = O_KF + (size_t)TG * 768 * 2;
constexpr size_t O_YRAW = O_VT + (size_t)TG * 512 * 2, O_YA = O_YRAW + (size_t)TG * 512 * 4;
constexpr size_t O_PB = O_YA + (size_t)4 * TG * 512 * 2, O_MIXB = O_PB + (size_t)4 * TG * 1024 * 2;
constexpr size_t O_ST = O_MIXB + (size_t)TG * 1024 * 2, O_ATOT = O_ST + (size_t)BPG * 16 * 8 * 8192 * 4;
constexpr size_t O_STB = O_ATOT + 4096;
constexpr size_t O_BAR = O_STB + (size_t)BPG * 16 * 8 * 8192 * 2;
constexpr size_t O_WQ = O_BAR + (size_t)XCD_BAR_WORDS * 4;
constexpr size_t ZERO_BYTES = (size_t)XCD_BAR_WORDS * 4 + 256;
constexpr size_t O_CS = O_WQ + 256 + 256 - ((size_t)XCD_BAR_WORDS * 4) % 256;
constexpr size_t O_SSQ = O_CS + (size_t)T_ALL * 32 * 8;
constexpr size_t O_END = O_SSQ + (size_t)3 * T_ALL * 16 * 4;
constexpr size_t O_END_H = O_H + (size_t)T_ALL * 2816 * 2;
constexpr size_t WS_NEED = O_END > O_END_H ? O_END : O_END_H;
constexpr int LDS_BYTES = 147456;

struct Params { const float* in[28]; float* out; unsigned char* ws; int only_phase; int pad; };

DI unsigned pk2(float a, float b) { f32x2 v = {a, b}; return __builtin_bit_cast(unsigned, __builtin_convertvector(v, bf16v2)); }
DI bf16_t f2bf(float a) { return (bf16_t)(pk2(a, 0.f) & 0xffffu); }
DI float bf2f(bf16_t b) { return __uint_as_float(((unsigned)b) << 16); }
DI float bflo(unsigned u) { return __uint_as_float(u << 16); }
DI float bfhi(unsigned u) { return __uint_as_float(u & 0xffff0000u); }
#define UNPACK8(v, f) do { f[0] = bflo(v.x); f[1] = bfhi(v.x); f[2] = bflo(v.y); f[3] = bfhi(v.y); f[4] = bflo(v.z); f[5] = bfhi(v.z); f[6] = bflo(v.w); f[7] = bfhi(v.w); } while (0)
#define PACK8(f) ((u32x4){pk2(f[0], f[1]), pk2(f[2], f[3]), pk2(f[4], f[5]), pk2(f[6], f[7])})
DI float wave_sum(float v) {
#pragma unroll
    for (int o = 1; o < 64; o <<= 1) v += __shfl_xor(v, o);
    return v;
}
DI float silu_f(float x) { return x * __builtin_amdgcn_rcpf(1.f + __builtin_amdgcn_exp2f(-1.4426950408889634f * x)); }
DI float sigmoid_f(float x) { return __builtin_amdgcn_rcpf(1.f + __builtin_amdgcn_exp2f(-1.4426950408889634f * x)); }
DI float gelu_f(float v) {
    const float t = __builtin_amdgcn_rcpf(fabsf(v) * 0.2316418882f + 1.0f);
    float q = t * 0.5307027145f + (-0.7265760135f); q = q * t + 0.7107068705f; q = q * t + (-0.142248368f); q = q * t + 0.127414796f; q = q * t;
    const float m = v * (q * __builtin_amdgcn_exp2f(v * v * (-0.72134752044f)));
    return v < 0.f ? m : v - m;
}
DI int crow(int i, int h) { return (i & 3) + 8 * (i >> 2) + 4 * h; }
DI void rows_rstd(const float* ssq, int row0, int fq, float (&rs)[2][4]) {
    f32x4 q[2][4];
#pragma unroll
    for (int ai = 0; ai < 2; ++ai)
#pragma unroll
        for (int m = 0; m < 4; ++m) q[ai][m] = ((const f32x4*)(ssq + (size_t)(row0 + ai * 128 + m * 16) * 16))[fq];
#pragma unroll
    for (int ai = 0; ai < 2; ++ai)
#pragma unroll
        for (int m = 0; m < 4; ++m) { float t = (q[ai][m][0] + q[ai][m][1]) + (q[ai][m][2] + q[ai][m][3]); t += __shfl_xor(t, 16); t += __shfl_xor(t, 32);
            rs[ai][m] = rsqrtf(t * (1.f / 1024.f) + EPS); }
}
struct EpiStore {
    static constexpr bool PERM = true, AFTER_DRAIN = false;
    bf16_t* O; int ldc; int pnmask; const float* ssq;
    DI void operator()(const f32x4 (&acc)[2][2][4][2], const pg8::Unit& u, int wr, int wc, int fr, int fq) const {
        const int row0 = u.pm * 256 + wr * 64 + fr, col0 = (u.pn & pnmask) * 256 + wc * 32 + 8 * fq;
        float rsv[2][4];
        if (ssq) rows_rstd(ssq, row0, fq, rsv);
        else {
#pragma unroll
            for (int ai = 0; ai < 2; ++ai)
#pragma unroll
                for (int m = 0; m < 4; ++m) rsv[ai][m] = 1.f; }
#pragma unroll
        for (int ai = 0; ai < 2; ++ai)
#pragma unroll
            for (int m = 0; m < 4; ++m) { bf16_t* rowp = O + (size_t)(row0 + ai * 128 + m * 16) * ldc + col0;
                const float rs = rsv[ai][m];
#pragma unroll
                for (int bj = 0; bj < 2; ++bj) { const f32x4 v0 = acc[ai][bj][m][0] * rs, v1 = acc[ai][bj][m][1] * rs;
                    u32x4 w; w.x = pk2(v0[0], v0[1]); w.y = pk2(v0[2], v0[3]); w.z = pk2(v1[0], v1[1]); w.w = pk2(v1[2], v1[3]);
                    *(u32x4*)(rowp + bj * 128) = w; } }
    }
};
struct EpiGU {
    static constexpr bool PERM = true, AFTER_DRAIN = false;
    bf16_t* H; const float* ssq;
    DI void operator()(const f32x4 (&acc)[2][2][4][2], const pg8::Unit& u, int wr, int wc, int fr, int fq) const {
        const int row0 = u.pm * 256 + wr * 64 + fr, col0 = u.pn * 128 + wc * 32 + 8 * fq;
        float rsv[2][4]; rows_rstd(ssq, row0, fq, rsv);
#pragma unroll
        for (int ai = 0; ai < 2; ++ai)
#pragma unroll
            for (int m = 0; m < 4; ++m) { bf16_t* rowp = H + (size_t)(row0 + ai * 128 + m * 16) * 2816 + col0;
                const float rs = rsv[ai][m];
                float o[8];
#pragma unroll
                for (int n = 0; n < 2; ++n)
#pragma unroll
                    for (int j = 0; j < 4; ++j) o[4 * n + j] = silu_f(acc[ai][0][m][n][j] * rs) * (acc[ai][1][m][n][j] * rs);
                *(u32x4*)rowp = PACK8(o); }
    }
};
struct EpiRes {
    static constexpr bool PERM = false, AFTER_DRAIN = false;
    bf16_t* XB; float* SSQ; float* OUT; float sc;
    DI void operator()(const f32x4 (&acc)[2][2][4][2], const pg8::Unit& u, int wr, int wc, int fr, int fq) const {
        const int row0 = u.pm * 256 + wr * 64 + fr, col0 = u.pn * 256 + wc * 32 + 4 * fq;
#pragma unroll
        for (int ai = 0; ai < 2; ++ai) {
            u32x2 xv[4][2][2];
#pragma unroll
            for (int m = 0; m < 4; ++m)
#pragma unroll
                for (int bj = 0; bj < 2; ++bj)
#pragma unroll
                    for (int n = 0; n < 2; ++n) xv[m][bj][n] = *(const u32x2*)(XB + (size_t)(row0 + ai * 128 + m * 16) * 1024 + col0 + bj * 128 + n * 16);
#pragma unroll
            for (int m = 0; m < 4; ++m) { const int row = row0 + ai * 128 + m * 16; const size_t ro = (size_t)row * 1024 + col0;
                float ss = 0.f;
#pragma unroll
                for (int bj = 0; bj < 2; ++bj)
#pragma unroll
                    for (int n = 0; n < 2; ++n) { const u32x2 xo = xv[m][bj][n]; const f32x4 a = acc[ai][bj][m][n];
                        const f32x4 v = {bflo(xo.x) + a[0] * sc, bfhi(xo.x) + a[1] * sc, bflo(xo.y) + a[2] * sc, bfhi(xo.y) + a[3] * sc};
                        if (OUT) *(f32x4*)(OUT + ro + bj * 128 + n * 16) = v;
                        else *(u32x2*)(XB + ro + bj * 128 + n * 16) = (u32x2){pk2(v[0], v[1]), pk2(v[2], v[3])};
                        ss += v[0] * v[0] + v[1] * v[1] + v[2] * v[2] + v[3] * v[3]; }
                ss += __shfl_xor(ss, 16); ss += __shfl_xor(ss, 32);
                if (fq == 0) SSQ[(size_t)row * 16 + u.pn * 4 + wc] = ss; }
        }
    }
};
struct EpiMerge {
    static constexpr bool PERM = false, AFTER_DRAIN = false;
    const bf16_t* P; bf16_t* MIX; const float* ssq;
    DI void operator()(const f32x4 (&acc)[2][2][4][2], const pg8::Unit& u, int wr, int wc, int fr, int fq) const {
        const int row0 = u.pm * 256 + wr * 64 + fr, e0 = u.pn * 64 + wc * 16 + 4 * fq;
        float rsv[2][4]; rows_rstd(ssq, row0, fq, rsv);
#pragma unroll
        for (int ai = 0; ai < 2; ++ai) {
            u32x2 pv[4][4];
#pragma unroll
            for (int m = 0; m < 4; ++m)
#pragma unroll
                for (int b = 0; b < 4; ++b) pv[m][b] = *(const u32x2*)(P + (size_t)b * TG * 1024 + (size_t)(row0 + ai * 128 + m * 16) * 1024 + e0);
#pragma unroll
            for (int m = 0; m < 4; ++m) { const float rs = rsv[ai][m];
                float o[4] = {0.f, 0.f, 0.f, 0.f};
#pragma unroll
                for (int bj = 0; bj < 2; ++bj)
#pragma unroll
                    for (int n = 0; n < 2; ++n) { const u32x2 q = pv[m][2 * bj + n]; const f32x4 g = acc[ai][bj][m][n] * rs;
                        o[0] += sigmoid_f(g[0]) * bflo(q.x); o[1] += sigmoid_f(g[1]) * bfhi(q.x); o[2] += sigmoid_f(g[2]) * bflo(q.y); o[3] += sigmoid_f(g[3]) * bfhi(q.y); }
                *(u32x2*)(MIX + (size_t)(row0 + ai * 128 + m * 16) * 1024 + e0) = (u32x2){pk2(o[0], o[1]), pk2(o[2], o[3])}; }
        }
    }
};
struct BranchOrder {
    int G, c;
    DI bool next(int i, pg8::Unit& u) const { const int L = i * G + c; if (L >= 1024) return false; const int br = L >> 8, rem = L & 255; u.pm = br * 64 + (rem >> 2); u.pn = br * 4 + (rem & 3); return true; }
    DI void a_ready(const pg8::Unit&) const {}
    DI void done(const pg8::Unit&) const {}
};
template <class Epi> DI void run_gemm(LAS unsigned char* lds, const bf16_t* A, const bf16_t* Bt, int M, int N, int K, const Epi& E) {
    pg8::Gemm g{A, Bt, M, N, K}; pg8::StaticOrder S; S.init(M, N, nwg_now(), wg_now());
    pg8::gemm_phase<Epi, pg8::StaticOrder>(lds, g, S, E);
}

DI void conv_mat(const float* src, int ld, int c0, int nvalid, int kvalid, int mode, bf16_t* dst, int Nd, int Kd, LAS float* scr, int wg, int nwg, const float* ksc = nullptr, const int use_ksc = 0) {
    const int tid = tid_now(); const int ntk = Kd >> 6, ntiles = (Nd >> 6) * ntk;
    const int nn = tid & 63, kq = tid >> 6, nr = tid >> 3, kc = tid & 7;
    for (int tile = wg; tile < ntiles; tile += 2 * nwg) {
        float v[2][8]; int n0s[2], k0s[2];
#pragma unroll
        for (int h = 0; h < 2; ++h) {
            const int tl = tile + h * nwg; const bool on = tl < ntiles;
            const int n0 = (tl / ntk) << 6, k0 = (tl % ntk) << 6, n = n0 + nn;
            n0s[h] = n0; k0s[h] = k0;
            int col;
            if (mode == 1) { const int blk = n >> 7; col = ((blk & 1) ? 2816 : 0) + (blk >> 1) * 128 + (n & 127); }
            else if (mode == 2) { const int c = n & 255, br = 2 * (c >> 7) + ((c >> 4) & 1), e = 64 * (n >> 8) + 16 * ((c >> 5) & 3) + (c & 15); col = c0 + br * 1024 + e; }
            else col = c0 + n;
#pragma unroll
            for (int i = 0; i < 8; ++i) { const int kk = i * 8 + kq; float x = 0.f;
                if (on && k0 + kk < kvalid && n < nvalid) { x = src[(size_t)(k0 + kk) * ld + col]; if (use_ksc) x *= ksc[k0 + kk]; }
                v[h][i] = x; }
        }
#pragma unroll
        for (int h = 0; h < 2; ++h)
#pragma unroll
            for (int i = 0; i < 8; ++i) scr[h * 4160 + (i * 8 + kq) * 65 + nn] = v[h][i];
        __syncthreads();
#pragma unroll
        for (int h = 0; h < 2; ++h) if (tile + h * nwg < ntiles) {
            const LAS float* sp = scr + h * 4160 + (kc * 8) * 65 + nr;
            u32x4 o; o.x = pk2(sp[0], sp[65]); o.y = pk2(sp[130], sp[195]); o.z = pk2(sp[260], sp[325]); o.w = pk2(sp[390], sp[455]);
            *(u32x4*)(dst + (size_t)(n0s[h] + nr) * Kd + k0s[h] + kc * 8) = o; }
        __syncthreads();
    }
}
DI void convert_layer(const Params& p, int l, LAS float* scr, int wg, int nwg) {
    unsigned char* ws = p.ws;
    conv_mat(p.in[3] + (size_t)l * 1024 * 5632, 5632, 0, 5632, 1024, 1, (bf16_t*)(ws + O_WGU1), 5632, 1024, scr, wg, nwg, p.in[2] + l * 1024, 1);
    conv_mat(p.in[26] + (size_t)l * 1024 * 5632, 5632, 0, 5632, 1024, 1, (bf16_t*)(ws + O_WGU2), 5632, 1024, scr, wg, nwg, p.in[25] + l * 1024, 1);
    conv_mat(p.in[4] + (size_t)l * 2816 * 1024, 1024, 0, 1024, 2816, 0, (bf16_t*)(ws + O_WD1), 1024, 2816, scr, wg, nwg);
    conv_mat(p.in[27] + (size_t)l * 2816 * 1024, 1024, 0, 1024, 2816, 0, (bf16_t*)(ws + O_WD2), 1024, 2816, scr, wg, nwg);
    conv_mat(p.in[6] + (size_t)l * 1024 * 8776, 8776, 0, 4680, 1024, 0, (bf16_t*)(ws + O_WIN), 4864, 1024, scr, wg, nwg, p.in[5] + l * 1024, 1);
    conv_mat(p.in[6] + (size_t)l * 1024 * 8776, 8776, 4680, 4096, 1024, 2, (bf16_t*)(ws + O_WGATE), 4096, 1024, scr, wg, nwg, p.in[5] + l * 1024, 1);
#pragma unroll 1
    for (int i = 0; i < 4; ++i)
        conv_mat(p.in[23] + ((size_t)l * 4 + i) * 512 * 1024, 1024, 0, 1024, 512, 0, (bf16_t*)(ws + O_WBR) + (size_t)i * 1024 * 512, 1024, 512, scr, wg, nwg);
    conv_mat(p.in[24] + (size_t)l * 1024 * 1024, 1024, 0, 1024, 1024, 0, (bf16_t*)(ws + O_WOUT), 1024, 1024, scr, wg, nwg);
    conv_mat(p.in[17] + (size_t)l * 384 * 768, 768, 0, 768, 384, 0, (bf16_t*)(ws + O_WQB), 768, 384, scr, wg, nwg);
    conv_mat(p.in[19] + (size_t)l * 128 * 1024, 1024, 0, 1024, 128, 0, (bf16_t*)(ws + O_WKVB), 1024, 256, scr, wg, nwg);
}

DI void init_rows(const float* x, bf16_t* xb, float* ssq) {
    const int tidn = tid_now(); const int lane = tidn & 63, gwave = wg_now() * 8 + (tidn >> 6), ngw = nwg_now() * 8;
    for (int row = gwave; row < T_ALL; row += ngw) {
        const f32x4* xr = (const f32x4*)(x + (size_t)row * 1024);
        f32x4 v[4]; float ss = 0.f;
#pragma unroll
        for (int j = 0; j < 4; ++j) { v[j] = xr[lane + 64 * j]; ss += v[j][0] * v[j][0] + v[j][1] * v[j][1] + v[j][2] * v[j][2] + v[j][3] * v[j][3]; }
        ss = wave_sum(ss);
        u32x2* o = (u32x2*)(xb + (size_t)row * 1024);
#pragma unroll
        for (int j = 0; j < 4; ++j) o[lane + 64 * j] = (u32x2){pk2(v[j][0], v[j][1]), pk2(v[j][2], v[j][3])};
        if (lane < 16) ssq[(size_t)row * 16 + lane] = lane == 0 ? ss : 0.f;
    }
}
DI void zero_f32(float* q, int n) { const int tidn = tid_now(); for (int i = wg_now() * 512 + tidn; i < n; i += nwg_now() * 512) q[i] = 0.f; }

DI void prep1(const Params& p, int l, const bf16_t* __restrict__ proj, bf16_t* __restrict__ xbcc, float* __restrict__ dtb, bf16_t* __restrict__ aq, bf16_t* __restrict__ akv, bf16_t* __restrict__ yd) {
    const int tidn = tid_now(); const int gtid = wg_now() * 512 + tidn, gthreads = nwg_now() * 512;
    const float* cw = p.in[7] + l * 4096; const float* cb = p.in[8] + l * 1024;
    for (int idx = gtid; idx < (TG / 16) * 128; idx += gthreads) {
        const int c8 = (idx & 127) << 3, tl0 = (idx >> 7) << 4, s0 = tl0 & 2047;
        float w[4][8], bb[8], r0[8], r1[8], r2[8];
#pragma unroll
        for (int k = 0; k < 4; ++k) { const f32x4 a = *(const f32x4*)(cw + k * 1024 + c8), b = *(const f32x4*)(cw + k * 1024 + c8 + 4);
#pragma unroll
            for (int j = 0; j < 4; ++j) { w[k][j] = a[j]; w[k][4 + j] = b[j]; } }
        { const f32x4 a = *(const f32x4*)(cb + c8), b = *(const f32x4*)(cb + c8 + 4);
#pragma unroll
          for (int j = 0; j < 4; ++j) { bb[j] = a[j]; bb[4 + j] = b[j]; } }
        const bf16_t* src = proj + (size_t)tl0 * PLD + 512 + c8;
        if (s0 > 0) { const u32x4 v0 = *(const u32x4*)(src - 3 * PLD), v1 = *(const u32x4*)(src - 2 * PLD), v2 = *(const u32x4*)(src - PLD); UNPACK8(v0, r0); UNPACK8(v1, r1); UNPACK8(v2, r2); }
        else {
#pragma unroll
            for (int j = 0; j < 8; ++j) { r0[j] = 0.f; r1[j] = 0.f; r2[j] = 0.f; } }
#pragma unroll 8
        for (int tt = 0; tt < 16; ++tt) {
            const u32x4 v = *(const u32x4*)(src + (size_t)tt * PLD); float cur[8], o[8]; UNPACK8(v, cur);
#pragma unroll
            for (int j = 0; j < 8; ++j) { o[j] = silu_f(bb[j] + w[0][j] * r0[j] + w[1][j] * r1[j] + w[2][j] * r2[j] + w[3][j] * cur[j]); r0[j] = r1[j]; r1[j] = r2[j]; r2[j] = cur[j]; }
            *(u32x4*)(xbcc + (size_t)(tl0 + tt) * 1024 + c8) = PACK8(o);
        }
    }
    const float* sw = p.in[22] + l * 1536;
    for (int idx = gtid; idx < (TG / 16) * 64; idx += gthreads) {
        const int c8 = (idx & 63) << 3, tl0 = (idx >> 6) << 4, s0 = tl0 & 2047;
        float w[3][8], p1[8], p2[8];
#pragma unroll
        for (int k = 0; k < 3; ++k) { const f32x4 a = *(const f32x4*)(sw + k * 512 + c8), b = *(const f32x4*)(sw + k * 512 + c8 + 4);
#pragma unroll
            for (int j = 0; j < 4; ++j) { w[k][j] = a[j]; w[k][4 + j] = b[j]; } }
        const bf16_t* src = proj + (size_t)tl0 * PLD + c8;
        if (s0 > 0) { const u32x4 c1 = *(const u32x4*)(src - 2 * PLD + 3656), x1 = *(const u32x4*)(src - 2 * PLD + 4168), c2 = *(const u32x4*)(src - PLD + 3656), x2 = *(const u32x4*)(src - PLD + 4168);
            float a[8], b[8]; UNPACK8(c1, a); UNPACK8(x1, b);
#pragma unroll
            for (int j = 0; j < 8; ++j) p1[j] = a[j] * b[j];
            UNPACK8(c2, a); UNPACK8(x2, b);
#pragma unroll
            for (int j = 0; j < 8; ++j) p2[j] = a[j] * b[j]; }
        else {
#pragma unroll
            for (int j = 0; j < 8; ++j) { p1[j] = 0.f; p2[j] = 0.f; } }
#pragma unroll 8
        for (int tt = 0; tt < 16; ++tt) {
            const bf16_t* pr = src + (size_t)tt * PLD;
            const u32x4 vc = *(const u32x4*)(pr + 3656), vx = *(const u32x4*)(pr + 4168), vb = *(const u32x4*)(pr + 3144);
            float fc[8], fx[8], fb[8], o[8]; UNPACK8(vc, fc); UNPACK8(vx, fx); UNPACK8(vb, fb);
#pragma unroll
            for (int j = 0; j < 8; ++j) { const float cur = fc[j] * fx[j]; o[j] = fb[j] * (w[0][j] * p1[j] + w[1][j] * p2[j] + w[2][j] * cur); p1[j] = p2[j]; p2[j] = cur; }
            *(u32x4*)(yd + (size_t)(tl0 + tt) * 512 + c8) = PACK8(o);
        }
    }
    const int gwave = gtid >> 6, ngw = gthreads >> 6, lane = tidn & 63;
    const float* qn = p.in[16] + l * 384; const float* kn = p.in[18] + l * 128;
#pragma unroll 4
    for (int tl = gwave; tl < TG; tl += ngw) {
        const bf16_t* pr = proj + (size_t)tl * PLD;
        const u32x4 v = *(const u32x4*)(pr + 2568 + lane * 8); float f[8]; UNPACK8(v, f);
        float ss = 0.f;
#pragma unroll
        for (int j = 0; j < 8; ++j) ss += f[j] * f[j];
        const float ssq = wave_sum(lane < 48 ? ss : 0.f), ssk = wave_sum(lane >= 48 ? ss : 0.f);
        if (lane < 48) {
            const float rstd = rsqrtf(ssq * (1.f / 384.f) + EPS);
#pragma unroll
            for (int j = 0; j < 8; ++j) f[j] *= rstd * qn[lane * 8 + j];
            *(u32x4*)(aq + (size_t)tl * 384 + lane * 8) = PACK8(f);
        } else {
            const float rstd = rsqrtf(ssk * (1.f / 128.f) + EPS);
#pragma unroll
            for (int j = 0; j < 8; ++j) f[j] *= rstd * kn[(lane - 48) * 8 + j];
            *(u32x4*)(akv + (size_t)tl * 256 + (lane - 48) * 8) = PACK8(f);
            { unsigned z = 0u; asm volatile("" : "+v"(z)); *(u32x4*)(akv + (size_t)tl * 256 + 128 + (lane - 48) * 8) = (u32x4){z, z, z, z}; }
        }
        if (lane < 8) {
            const float xr = bf2f(pr[1536 + lane]) + p.in[9][l * 8 + lane];
            const float dt = xr > 20.f ? xr : log1pf(expf(xr));
            const float A = -expf(p.in[10][l * 8 + lane]);
            dtb[(size_t)tl * 16 + lane] = dt; dtb[(size_t)tl * 16 + 8 + lane] = dt * A;
        }
    }
}

DI void rope_table(const Params& p, f32x2* CS) {
    const int* pos = (const int*)p.in[1];
    const int tidn = tid_now();
    for (int idx = wg_now() * 512 + tidn; idx < T_ALL * 32; idx += nwg_now() * 512) {
        const float invf = exp2f(-(float)(idx & 31) * (13.287712379549449f / 32.f));
        const float ang = (float)pos[idx >> 5] * invf;
        CS[idx] = (f32x2){cosf(ang), sinf(ang)};
    }
}
DI void prep2_unit(const Params& p, int l, int g, const bf16_t* __restrict__ proj, const bf16_t* __restrict__ qraw, const bf16_t* __restrict__ kvraw, const f32x2* __restrict__ CSt, bf16_t* __restrict__ Qf, bf16_t* __restrict__ Kf, bf16_t* __restrict__ Vt, int bl, int tile, LAS unsigned char* lds) {
    const int tid = tid_now(), wave = tid >> 6, lane = tid & 63;
    const float* wq = p.in[20] + l * 192; const float* wk = p.in[21] + l * 192;
    const float qscale = 0.07216878364870322f * 1.4426950408889634f;
    const float wq0 = wq[lane], wq1 = wq[64 + lane], wq2 = wq[128 + lane], wk0 = wk[lane], wk1 = wk[64 + lane], wk2 = wk[128 + lane];
    LAS bf16_t* img = (LAS bf16_t*)lds;
    const int t0 = tile * 64;
#pragma unroll 4
    for (int tt = 0; tt < 8; ++tt) {
        const int tloc = wave * 8 + tt, s = t0 + tloc; const size_t tl = (size_t)bl * SEQ + s;
        const f32x2 cssn = CSt[((size_t)(g * BPG + bl) * SEQ + s) * 32 + (lane & 31)];
        const float cs = cssn[0], sn = cssn[1];
        const float kpe = bf2f(proj[tl * PLD + 3080 + lane]);
#pragma unroll
        for (int h = 0; h < 4; ++h) {
            const size_t ob = ((size_t)(bl * 4 + h) * SEQ + s) * 192;
            {
                const bf16_t* qr = qraw + tl * 768 + h * 192;
                float q0 = bf2f(qr[lane]), q1 = bf2f(qr[64 + lane]), q2 = bf2f(qr[128 + lane]);
                const float r = rsqrtf(wave_sum(q0 * q0 + q1 * q1 + q2 * q2) * (1.f / 192.f) + EPS);
                q0 *= r * wq0; q1 *= r * wq1; q2 *= r * wq2;
                const float qp = __shfl_xor(q2, 32);
                q2 = (lane < 32) ? q2 * cs - qp * sn : q2 * cs + qp * sn;
                bf16_t* qo = Qf + ob;
                qo[lane] = f2bf(q0 * qscale); qo[64 + lane] = f2bf(q1 * qscale); qo[128 + lane] = f2bf(q2 * qscale);
            }
            const bf16_t* kr = kvraw + tl * 1024 + h * 256;
            {
                float k0 = bf2f(kr[lane]), k1 = bf2f(kr[64 + lane]), k2 = kpe;
                const float r = rsqrtf(wave_sum(k0 * k0 + k1 * k1 + k2 * k2) * (1.f / 192.f) + EPS);
                k0 *= r * wk0; k1 *= r * wk1; k2 *= r * wk2;
                const float kp = __shfl_xor(k2, 32);
                k2 = (lane < 32) ? k2 * cs - kp * sn : k2 * cs + kp * sn;
                bf16_t* ko = Kf + ob;
                ko[lane] = f2bf(k0); ko[64 + lane] = f2bf(k1); ko[128 + lane] = f2bf(k2);
            }
            img[(h * 128 + lane) * 72 + tloc] = kr[128 + lane]; img[(h * 128 + 64 + lane) * 72 + tloc] = kr[192 + lane];
        }
    }
    __syncthreads();
#pragma unroll
    for (int i = 0; i < 8; ++i) {
        const int ch = tid + 512 * i, row = ch >> 3, cc = ch & 7;
        *(u32x4*)(Vt + ((size_t)(bl * 4 + (row >> 7)) * 128 + (row & 127)) * SEQ + t0 + cc * 8) = *(const LAS u32x4*)(lds + row * 144 + cc * 16);
    }
    __syncthreads();
}

constexpr int KP = 400, VP = 136, KBYTES = 64 * KP, VBYTES = 128 * VP, ASTAGE = KBYTES + VBYTES;
DI void attn_unit(const bf16_t* Qf, const bf16_t* Kf, const bf16_t* Vt, bf16_t* yc, int bh, int qb, LAS unsigned char* lds) {
    const int tid = tid_now(), wave = tid >> 6, lane = tid & 63, r31 = lane & 31, hh = lane >> 5;
    const int q0 = qb * 256, qrow = q0 + wave * 32 + r31;
    const bf16_t* Qp = Qf + ((size_t)bh * SEQ + qrow) * 192 + 8 * hh;
    bf16x8 qf[12];
#pragma unroll
    for (int kk = 0; kk < 12; ++kk) qf[kk] = *(const bf16x8*)(Qp + kk * 16);
    f32x16 o[4];
#pragma unroll
    for (int d = 0; d < 4; ++d)
#pragma unroll
        for (int i = 0; i < 16; ++i) o[d][i] = 0.f;
    float m = -1e30f, l = 0.f;
    const int ntiles = qb * 4 + 4;
    const bf16_t* Kb = Kf + (size_t)bh * SEQ * 192; const bf16_t* Vb = Vt + (size_t)bh * 128 * SEQ;
    int krow[3], kcc[3], vd[2], vcc[2];
#pragma unroll
    for (int i = 0; i < 3; ++i) { const int c = tid + 512 * i; krow[i] = c / 24; kcc[i] = c % 24; }
#pragma unroll
    for (int i = 0; i < 2; ++i) { const int c = tid + 512 * i; vd[i] = c >> 3; vcc[i] = c & 7; }
    u32x4 kA[3], vA[2], kB[3], vB[2];
#define ATT_GLOAD(j, kreg, vreg) do { _Pragma("unroll") for (int i = 0; i < 3; ++i) kreg[i] = *(const u32x4*)(Kb + (size_t)((j) * 64 + krow[i]) * 192 + kcc[i] * 8); \
        _Pragma("unroll") for (int i = 0; i < 2; ++i) vreg[i] = *(const u32x4*)(Vb + (size_t)vd[i] * SEQ + (j) * 64 + vcc[i] * 8); } while (0)
#define ATT_LSTORE(st, kreg, vreg) do { LAS unsigned char* b_ = lds + (st) * ASTAGE; \
        _Pragma("unroll") for (int i = 0; i < 3; ++i) *(LAS u32x4*)(b_ + krow[i] * KP + kcc[i] * 16) = kreg[i]; \
        _Pragma("unroll") for (int i = 0; i < 2; ++i) { LAS u32x2* d_ = (LAS u32x2*)(b_ + KBYTES + vd[i] * VP + vcc[i] * 16); d_[0] = (u32x2){vreg[i].x, vreg[i].y}; d_[1] = (u32x2){vreg[i].z, vreg[i].w}; } } while (0)
    auto compute = [&](const int j, const int cur) __attribute__((always_inline)) {
        if (j * 64 <= q0 + wave * 32 + 31) {
            const LAS unsigned char* Kl = lds + cur * ASTAGE; const LAS unsigned char* Vl = Kl + KBYTES;
            f32x16 s0, s1;
#pragma unroll
            for (int i = 0; i < 16; ++i) { s0[i] = 0.f; s1[i] = 0.f; }
#pragma unroll
            for (int kk = 0; kk < 12; ++kk) {
                const bf16x8 a0 = *(const LAS bf16x8*)(Kl + r31 * KP + (kk * 16 + 8 * hh) * 2);
                const bf16x8 a1 = *(const LAS bf16x8*)(Kl + (32 + r31) * KP + (kk * 16 + 8 * hh) * 2);
                s0 = MFMA32(a0, qf[kk], s0); s1 = MFMA32(a1, qf[kk], s1);
            }
            if (j * 64 + 63 > q0 + wave * 32) {
#pragma unroll
                for (int i = 0; i < 16; ++i) { const int key = j * 64 + crow(i, hh); if (key > qrow) s0[i] = -1e30f; if (key + 32 > qrow) s1[i] = -1e30f; }
            }
            float mx = s0[0];
#pragma unroll
            for (int i = 1; i < 16; ++i) mx = fmaxf(mx, s0[i]);
#pragma unroll
            for (int i = 0; i < 16; ++i) mx = fmaxf(mx, s1[i]);
            mx = fmaxf(mx, __shfl_xor(mx, 32));
            const float mn = fmaxf(m, mx);
            if (__ballot(mx > m) != 0ull) {
                const float alpha = __builtin_amdgcn_exp2f(m - mn);
                l *= alpha;
#pragma unroll
                for (int d = 0; d < 4; ++d)
#pragma unroll
                    for (int i = 0; i < 16; ++i) o[d][i] *= alpha;
            }
            m = mn;
            float ls = 0.f;
#pragma unroll
            for (int i = 0; i < 16; ++i) { s0[i] = __builtin_amdgcn_exp2f(s0[i] - mn); s1[i] = __builtin_amdgcn_exp2f(s1[i] - mn); ls += s0[i] + s1[i]; }
            l += ls;
            bf16x8 pf[2][2];
#pragma unroll
            for (int s = 0; s < 2; ++s) {
                u32x4 w0, w1;
                w0.x = pk2(s0[8 * s], s0[8 * s + 1]); w0.y = pk2(s0[8 * s + 2], s0[8 * s + 3]); w0.z = pk2(s0[8 * s + 4], s0[8 * s + 5]); w0.w = pk2(s0[8 * s + 6], s0[8 * s + 7]);
                w1.x = pk2(s1[8 * s], s1[8 * s + 1]); w1.y = pk2(s1[8 * s + 2], s1[8 * s + 3]); w1.z = pk2(s1[8 * s + 4], s1[8 * s + 5]); w1.w = pk2(s1[8 * s + 6], s1[8 * s + 7]);
                pf[0][s] = __builtin_bit_cast(bf16x8, w0); pf[1][s] = __builtin_bit_cast(bf16x8, w1);
            }
#pragma unroll
            for (int d = 0; d < 4; ++d)
#pragma unroll
                for (int kb = 0; kb < 2; ++kb)
#pragma unroll
                    for (int s = 0; s < 2; ++s) {
                        const LAS unsigned char* vp = Vl + (d * 32 + r31) * VP + (kb * 32 + 16 * s + 4 * hh) * 2;
                        const s16x4 lo = *(const LAS s16x4*)vp, hi = *(const LAS s16x4*)(vp + 16);
                        const bf16x8 a = __builtin_shufflevector(lo, hi, 0, 1, 2, 3, 4, 5, 6, 7);
                        o[d] = MFMA32(a, pf[kb][s], o[d]);
                    }
        }
    };
    ATT_GLOAD(0, kA, vA); ATT_LSTORE(0, kA, vA); ATT_GLOAD(1, kB, vB);
    __syncthreads();
#pragma unroll 1
    for (int j = 0; j < ntiles; j += 2) {
        if (j + 2 < ntiles) ATT_GLOAD(j + 2, kA, vA);
        compute(j, 0);
        ATT_LSTORE(1, kB, vB);
        __syncthreads();
        if (j + 3 < ntiles) ATT_GLOAD(j + 3, kB, vB);
        compute(j + 1, 1);
        if (j + 2 < ntiles) ATT_LSTORE(0, kA, vA);
        __syncthreads();
    }
#undef ATT_GLOAD
#undef ATT_LSTORE
    l += __shfl_xor(l, 32);
    const float inv = 1.f / l;
    const int bl = bh >> 2, h = bh & 3;
    bf16_t* op = yc + ((size_t)bl * SEQ + qrow) * 512 + h * 128 + 4 * hh;
#pragma unroll
    for (int d = 0; d < 4; ++d)
#pragma unroll
        for (int i4 = 0; i4 < 4; ++i4)
            *(u32x2*)(op + d * 32 + 8 * i4) = (u32x2){pk2(o[d][4 * i4] * inv, o[d][4 * i4 + 1] * inv), pk2(o[d][4 * i4 + 2] * inv, o[d][4 * i4 + 3] * inv)};
}

DI void gmlp_unit(const Params& p, int l, const bf16_t* __restrict__ proj, bf16_t* __restrict__ yb, int bl, int c, LAS unsigned char* lds) {
    const int tid = tid_now(), wave = tid >> 6, lane = tid & 63, r31 = lane & 31, hh = lane >> 5;
    const float* wsp = p.in[14] + (size_t)l * 4 * 128 * 128; const float* bs = p.in[15] + l * 512; const float* vn = p.in[13] + l * 512;
    const size_t tl0 = (size_t)bl * SEQ + c * 128;
    float w8[8];
#pragma unroll
    for (int j = 0; j < 8; ++j) w8[j] = vn[lane + 64 * j];
    LAS bf16_t* vt = (LAS bf16_t*)lds;
#pragma unroll
    for (int rr = 0; rr < 16; ++rr) {
        const int row = wave * 16 + rr;
        const bf16_t* vr = proj + (tl0 + row) * PLD + 2056 + lane;
        float f[8]; float ss = 0.f;
#pragma unroll
        for (int j = 0; j < 8; ++j) { f[j] = gelu_f(bf2f(vr[64 * j])); ss += f[j] * f[j]; }
        const float rstd = rsqrtf(wave_sum(ss) * (1.f / 512.f) + EPS);
#pragma unroll
        for (int j = 0; j < 8; ++j) vt[(lane + 64 * j) * 136 + row] = f2bf(f[j] * rstd * w8[j]);
    }
    __syncthreads();
    const int mb = wave & 3, nh = wave >> 2, trow = mb * 32 + r31;
#pragma unroll 1
    for (int g = 0; g < 4; ++g) {
        f32x16 a0, a1;
#pragma unroll
        for (int i = 0; i < 16; ++i) { a0[i] = 0.f; a1[i] = 0.f; }
        const float* wrow = wsp + ((size_t)g * 128 + trow) * 128 + 8 * hh;
#pragma unroll
        for (int kk = 0; kk < 8; ++kk) if (kk * 16 <= mb * 32 + 31) {
            const f32x4 x0 = *(const f32x4*)(wrow + kk * 16), x1 = *(const f32x4*)(wrow + kk * 16 + 4);
            const int sb = kk * 16 + 8 * hh;
            float f[8];
#pragma unroll
            for (int j = 0; j < 4; ++j) { f[j] = (sb + j <= trow) ? x0[j] : 0.f; f[4 + j] = (sb + 4 + j <= trow) ? x1[j] : 0.f; }
            const bf16x8 a = __builtin_bit_cast(bf16x8, PACK8(f));
            const bf16x8 b0 = *(const LAS bf16x8*)(vt + (g * 128 + nh * 64 + r31) * 136 + kk * 16 + 8 * hh);
            const bf16x8 b1 = *(const LAS bf16x8*)(vt + (g * 128 + nh * 64 + 32 + r31) * 136 + kk * 16 + 8 * hh);
            a0 = MFMA32(a, b0, a0); a1 = MFMA32(a, b1, a1);
        }
        __syncthreads();
        LAS bf16_t* og = vt + (g * 128) * 136;
#pragma unroll
        for (int i = 0; i < 16; ++i) {
            const int t = mb * 32 + crow(i, hh); const float bias = bs[g * 128 + t];
            og[t * 136 + nh * 64 + r31] = f2bf(a0[i] + bias); og[t * 136 + nh * 64 + 32 + r31] = f2bf(a1[i] + bias);
        }
        __syncthreads();
#pragma unroll
        for (int k = 0; k < 4; ++k) {
            const int ch = tid + 512 * k, t = ch >> 4, d8 = (ch & 15) * 8;
            const u32x4 sv = *(const LAS u32x4*)(og + t * 136 + d8);
            const u32x4 uv = *(const u32x4*)(proj + (tl0 + t) * PLD + 1544 + g * 128 + d8);
            float fs[8], fu[8]; UNPACK8(sv, fs); UNPACK8(uv, fu);
#pragma unroll
            for (int j = 0; j < 8; ++j) fu[j] = gelu_f(fu[j]) * fs[j];
            *(u32x4*)(yb + (tl0 + t) * 512 + g * 128 + d8) = PACK8(fu);
        }
    }
    __syncthreads();
}

constexpr int SP = 136;
DI void scan128(float& v0, float& v1, int lane) {
#pragma unroll
    for (int o = 1; o < 64; o <<= 1) { const float n0 = __shfl_up(v0, o), n1 = __shfl_up(v1, o); if (lane >= o) { v0 += n0; v1 += n1; } }
    v1 += __shfl(v0, 63);
}
DI void ssd_states_unit(const bf16_t* xbcc, const float* dtb, float* ST, float* ATOT, int bl, int c, int grp, LAS unsigned char* lds) {
    const int tid = tid_now(), wave = tid >> 6, lane = tid & 63, r31 = lane & 31, hh = lane >> 5;
    LAS bf16_t* BT = (LAS bf16_t*)lds; LAS bf16_t* XT = (LAS bf16_t*)(lds + 34816); LAS float* WS = (LAS float*)(lds + 104448);
    const size_t row0 = (size_t)bl * SEQ + c * 128;
    if (wave < 4) {
        const int h = grp * 4 + wave;
        const float d0 = dtb[(row0 + lane) * 16 + h], d1 = dtb[(row0 + 64 + lane) * 16 + h];
        float v0 = dtb[(row0 + lane) * 16 + 8 + h], v1 = dtb[(row0 + 64 + lane) * 16 + 8 + h];
        scan128(v0, v1, lane);
        const float tot = __shfl(v1, 63);
        WS[wave * 128 + lane] = d0 * __expf(tot - v0); WS[wave * 128 + 64 + lane] = d1 * __expf(tot - v1);
        if (lane == 0) ATOT[(bl * 16 + c) * 8 + h] = tot;
    }
    __syncthreads();
#pragma unroll
    for (int i = 0; i < 4; ++i) {
        const int ch = tid + 512 * i, s = ch >> 4, n8 = (ch & 15) * 8;
        const u32x4 v = *(const u32x4*)(xbcc + (row0 + s) * 1024 + 512 + grp * 128 + n8);
        LAS bf16_t* d = BT + n8 * SP + s;
        d[0] = (bf16_t)(v.x & 0xffffu); d[SP] = (bf16_t)(v.x >> 16); d[2 * SP] = (bf16_t)(v.y & 0xffffu); d[3 * SP] = (bf16_t)(v.y >> 16);
        d[4 * SP] = (bf16_t)(v.z & 0xffffu); d[5 * SP] = (bf16_t)(v.z >> 16); d[6 * SP] = (bf16_t)(v.w & 0xffffu); d[7 * SP] = (bf16_t)(v.w >> 16);
    }
#pragma unroll
    for (int i = 0; i < 8; ++i) {
        const int ch = tid + 512 * i, s = ch >> 5, c8 = (ch & 31) * 8;
        const u32x4 v = *(const u32x4*)(xbcc + (row0 + s) * 1024 + grp * 256 + c8); float f[8]; UNPACK8(v, f);
        const float w = WS[(c8 >> 6) * 128 + s];
        LAS bf16_t* d = XT + c8 * SP + s;
#pragma unroll
        for (int j = 0; j < 8; ++j) d[j * SP] = f2bf(f[j] * w);
    }
    __syncthreads();
    const int hl = wave >> 1, pb = wave & 1;
    f32x16 acc[4];
#pragma unroll
    for (int nb = 0; nb < 4; ++nb)
#pragma unroll
        for (int i = 0; i < 16; ++i) acc[nb][i] = 0.f;
#pragma unroll
    for (int k = 0; k < 8; ++k) {
        const bf16x8 a = *(const LAS bf16x8*)(XT + (hl * 64 + pb * 32 + r31) * SP + k * 16 + 8 * hh);
#pragma unroll
        for (int nb = 0; nb < 4; ++nb) { const bf16x8 b = *(const LAS bf16x8*)(BT + (nb * 32 + r31) * SP + k * 16 + 8 * hh); acc[nb] = MFMA32(a, b, acc[nb]); }
    }
    float* so = ST + (((size_t)bl * 16 + c) * 8 + grp * 4 + hl) * 8192;
#pragma unroll
    for (int nb = 0; nb < 4; ++nb)
#pragma unroll
        for (int i = 0; i < 16; ++i) so[(pb * 32 + crow(i, hh)) * 128 + nb * 32 + r31] = acc[nb][i];
    __syncthreads();
}
DI void ssd_scan(const float* ST, bf16_t* STB, const float* ATOT) {
    const int tidn = tid_now();
    for (int idx = wg_now() * 512 + tidn; idx < 64 * 2048; idx += nwg_now() * 512) {
        const int bh = idx >> 11, e4 = idx & 2047, bl = bh >> 3, head = bh & 7;
        const size_t off = ((size_t)bl * 16 * 8 + head) * 8192 + e4 * 4;
        f32x4 sv[16];
#pragma unroll
        for (int c = 0; c < 16; ++c) sv[c] = *(const f32x4*)(ST + off + (size_t)c * 8 * 8192);
        f32x4 run = {0.f, 0.f, 0.f, 0.f};
#pragma unroll
        for (int c = 0; c < 16; ++c) { const float ea = __expf(ATOT[(bl * 16 + c) * 8 + head]);
            *(u32x2*)(STB + off + (size_t)c * 8 * 8192) = (u32x2){pk2(run[0], run[1]), pk2(run[2], run[3])}; run = run * ea + sv[c]; }
    }
}
DI void ssd_out_grp(const Params& p, int l, const bf16_t* proj, const bf16_t* xbcc, const float* dtb, const bf16_t* STB, bf16_t* ya, int bl, int c, int grp, LAS unsigned char* lds) {
    const int tid = tid_now(), wave = tid >> 6, lane = tid & 63, r31 = lane & 31, hh = lane >> 5;
    LAS bf16_t* CL = (LAS bf16_t*)lds; LAS bf16_t* BL = (LAS bf16_t*)(lds + 34816); LAS bf16_t* XT = (LAS bf16_t*)(lds + 69632); LAS bf16_t* PV = (LAS bf16_t*)(lds + 104448);
    LAS float* ACS = (LAS float*)(lds + 139264); LAS float* DTL = (LAS float*)(lds + 141312); LAS float* RS = (LAS float*)(lds + 143360); LAS float* OUT = (LAS float*)lds;
    const size_t row0 = (size_t)bl * SEQ + c * 128;
#pragma unroll
    for (int i = 0; i < 4; ++i) {
        const int ch = tid + 512 * i, s = ch >> 4, n8 = (ch & 15) * 8;
        const bf16_t* xr = xbcc + (row0 + s) * 1024;
        *(LAS u32x4*)(CL + s * SP + n8) = *(const u32x4*)(xr + 768 + grp * 128 + n8);
        *(LAS u32x4*)(BL + s * SP + n8) = *(const u32x4*)(xr + 512 + grp * 128 + n8);
    }
    if (wave < 4) {
        const int h = grp * 4 + wave;
        const float d0 = dtb[(row0 + lane) * 16 + h], d1 = dtb[(row0 + 64 + lane) * 16 + h];
        float v0 = dtb[(row0 + lane) * 16 + 8 + h], v1 = dtb[(row0 + 64 + lane) * 16 + 8 + h];
        scan128(v0, v1, lane);
        ACS[wave * 128 + lane] = v0; ACS[wave * 128 + 64 + lane] = v1; DTL[wave * 128 + lane] = d0; DTL[wave * 128 + 64 + lane] = d1;
    }
    const int tb = wave >> 1, hl = wave & 1;
    f32x16 acc[2][2];
#pragma unroll
    for (int pi = 0; pi < 2; ++pi) {
        const int pair = grp * 2 + pi;
        __syncthreads();
#pragma unroll
        for (int i = 0; i < 4; ++i) {
            const int ch = tid + 512 * i, s = ch >> 4, n8 = (ch & 15) * 8;
            const u32x4 v = *(const u32x4*)(xbcc + (row0 + s) * 1024 + pair * 128 + n8); float f[8]; UNPACK8(v, f);
            const float w = DTL[(pi * 2 + (n8 >> 6)) * 128 + s];
            LAS bf16_t* d = XT + n8 * SP + s;
#pragma unroll
            for (int j = 0; j < 8; ++j) d[j * SP] = f2bf(f[j] * w);
            *(LAS u32x4*)(PV + s * SP + n8) = *(const u32x4*)(STB + (((size_t)bl * 16 + c) * 8 + pair * 2) * 8192 + (size_t)s * 128 + n8);
        }
        __syncthreads();
#pragma unroll
        for (int pb = 0; pb < 2; ++pb)
#pragma unroll
            for (int i = 0; i < 16; ++i) acc[pi][pb][i] = 0.f;
        const LAS bf16_t* crw = CL + (tb * 32 + r31) * SP + 8 * hh;
#pragma unroll
        for (int k = 0; k < 8; ++k) {
            const bf16x8 b = *(const LAS bf16x8*)(crw + k * 16);
#pragma unroll
            for (int pb = 0; pb < 2; ++pb) { const bf16x8 a = *(const LAS bf16x8*)(PV + (hl * 64 + pb * 32 + r31) * SP + k * 16 + 8 * hh); acc[pi][pb] = MFMA32(a, b, acc[pi][pb]); }
        }
        const LAS float* acs = ACS + (pi * 2 + hl) * 128;
        const float at = acs[tb * 32 + r31], eat = __expf(at);
#pragma unroll
        for (int pb = 0; pb < 2; ++pb)
#pragma unroll
            for (int i = 0; i < 16; ++i) acc[pi][pb][i] *= eat;
#pragma unroll 1
        for (int sb = 0; sb <= tb; ++sb) {
            f32x16 cbt;
#pragma unroll
            for (int i = 0; i < 16; ++i) cbt[i] = 0.f;
#pragma unroll
            for (int k = 0; k < 8; ++k) {
                const bf16x8 a = *(const LAS bf16x8*)(BL + (sb * 32 + r31) * SP + k * 16 + 8 * hh);
                const bf16x8 b = *(const LAS bf16x8*)(crw + k * 16);
                cbt = MFMA32(a, b, cbt);
            }
#pragma unroll
            for (int i = 0; i < 16; ++i) {
                const int sl = crow(i, hh); const float as = acs[sb * 32 + sl];
                const float mv = cbt[i] * __expf(fminf(at - as, 0.f));
                cbt[i] = (sb == tb && sl > r31) ? 0.f : mv;
            }
#pragma unroll
            for (int ks = 0; ks < 2; ++ks) {
                u32x4 w; w.x = pk2(cbt[8 * ks], cbt[8 * ks + 1]); w.y = pk2(cbt[8 * ks + 2], cbt[8 * ks + 3]); w.z = pk2(cbt[8 * ks + 4], cbt[8 * ks + 5]); w.w = pk2(cbt[8 * ks + 6], cbt[8 * ks + 7]);
                const bf16x8 pfr = __builtin_bit_cast(bf16x8, w);
#pragma unroll
                for (int pb = 0; pb < 2; ++pb) {
                    const LAS bf16_t* vp = XT + (hl * 64 + pb * 32 + r31) * SP + sb * 32 + 16 * ks + 4 * hh;
                    const s16x4 lo = *(const LAS s16x4*)vp, hi = *(const LAS s16x4*)(vp + 8);
                    const bf16x8 a = __builtin_shufflevector(lo, hi, 0, 1, 2, 3, 4, 5, 6, 7);
                    acc[pi][pb] = MFMA32(a, pfr, acc[pi][pb]);
                }
            }
        }
    }
    __syncthreads();
#pragma unroll
    for (int pi = 0; pi < 2; ++pi)
#pragma unroll
        for (int pb = 0; pb < 2; ++pb)
#pragma unroll
            for (int i = 0; i < 16; ++i) OUT[(tb * 32 + r31) * 260 + pi * 128 + hl * 64 + pb * 32 + crow(i, hh)] = acc[pi][pb][i];
    __syncthreads();
#pragma unroll 4
    for (int i = 0; i < 8; ++i) {
        const int it = tid + 512 * i, t = it >> 5, c8 = (it & 31) * 8;
        LAS f32x4* op = (LAS f32x4*)(OUT + t * 260 + c8);
        const f32x4 y0 = op[0], y1 = op[1];
        const u32x4 xv = *(const u32x4*)(xbcc + (row0 + t) * 1024 + grp * 256 + c8), zv = *(const u32x4*)(proj + (row0 + t) * PLD + grp * 256 + c8);
        float fx[8], fz[8]; UNPACK8(xv, fx); UNPACK8(zv, fz);
        const float Dh = p.in[11][l * 8 + grp * 4 + (c8 >> 6)];
        f32x4 o0, o1;
#pragma unroll
        for (int j = 0; j < 4; ++j) { o0[j] = (y0[j] + Dh * fx[j]) * silu_f(fz[j]); o1[j] = (y1[j] + Dh * fx[4 + j]) * silu_f(fz[4 + j]); }
        op[0] = o0; op[1] = o1;
        float ss = 0.f;
#pragma unroll
        for (int j = 0; j < 4; ++j) ss += o0[j] * o0[j] + o1[j] * o1[j];
        ss += __shfl_xor(ss, 1); ss += __shfl_xor(ss, 2); ss += __shfl_xor(ss, 4); ss += __shfl_xor(ss, 8); ss += __shfl_xor(ss, 16);
        if ((tid & 31) == 0) RS[t] = ss;
    }
    __syncthreads();
    const float* nw = p.in[12] + l * 512 + grp * 256;
#pragma unroll 4
    for (int i = 0; i < 8; ++i) {
        const int it = tid + 512 * i, t = it >> 5, c8 = (it & 31) * 8;
        const LAS f32x4* op = (const LAS f32x4*)(OUT + t * 260 + c8);
        const f32x4 a = op[0], b = op[1], w0 = *(const f32x4*)(nw + c8), w1 = *(const f32x4*)(nw + c8 + 4);
        const float rstd = rsqrtf(RS[t] * (1.f / 256.f) + EPS);
        *(u32x4*)(ya + (row0 + t) * 512 + grp * 256 + c8) = (u32x4){pk2(a[0] * rstd * w0[0], a[1] * rstd * w0[1]), pk2(a[2] * rstd * w0[2], a[3] * rstd * w0[3]),
                                                                      pk2(b[0] * rstd * w1[0], b[1] * rstd * w1[1]), pk2(b[2] * rstd * w1[2], b[3] * rstd * w1[3])};
    }
    __syncthreads();
}

#if MULTI_LAUNCH
#define RUNPH(x) ((x) == p.only_phase)
#define GSYNC() do {} while (0)
#else
#define RUNPH(x) true
#define GSYNC() do { XcdBarrier xb_; xb_.bar = (unsigned*)(p.ws + O_BAR); xb_.x = xb_xcc_id(); xb_.st = (volatile LAS unsigned*)(lds + LDS_BYTES - 16); xcd_barrier(xb_); if (PROBE & 1) xcd_barrier(xb_); } while (0)
#endif
#define PH_BEGIN if (RUNPH(ph)) { size_t z_ = 0; asm volatile("" : "+s"(z_)); unsigned char* ws = p.ws + z_; float* X = p.out + z_; const int wg = wg_now(), nwg = nwg_now();
#define PH_END_C(cls) } ++ph; GSYNC(); if (PROBE_T) { const unsigned long long t1_ = __builtin_amdgcn_s_memrealtime(); if ((PROBE_T >> (cls)) & 1) tacc_ += t1_ - t0_; if ((cls) == 7 && ((PROBE_T >> 14) & 1)) tacc_ += t1_; t0_ = t1_; }
__global__ void __launch_bounds__(512) mega(Params p) {
    extern __shared__ __attribute__((aligned(16))) unsigned char smem[];
    LAS unsigned char* lds = (LAS unsigned char*)smem;
#if !MULTI_LAUNCH
    cg::grid_group grid = cg::this_grid();
    volatile LAS unsigned* xst = (volatile LAS unsigned*)(lds + LDS_BYTES - 16);
    if (threadIdx.x == 0) { xst[0] = 0u; xst[1] = 0u; }
    __syncthreads();
    (void)xcd_barrier_post((unsigned*)(p.ws + O_BAR), xst);
    grid.sync();
#endif
#define XN ((bf16_t*)(ws + O_XN))
#define SSQ0 ((float*)(ws + O_SSQ))
#define SSQ1 (SSQ0 + (size_t)T_ALL * 16)
#define SSQ2 (SSQ0 + (size_t)2 * T_ALL * 16)
#define H ((bf16_t*)(ws + O_H))
#define PROJ ((bf16_t*)(ws + O_PROJ))
#define XBCC ((bf16_t*)(ws + O_XBCC))
#define ST ((float*)(ws + O_ST))
#define ATOT ((float*)(ws + O_ATOT))
#define STB ((bf16_t*)(ws + O_STB))
#define DTB ((float*)(ws + O_DTB))
#define AQ ((bf16_t*)(ws + O_AQ))
#define AKV ((bf16_t*)(ws + O_AKV))
#define QRAW ((bf16_t*)(ws + O_QRAW))
#define KVRAW ((bf16_t*)(ws + O_KVRAW))
#define QF ((bf16_t*)(ws + O_QF))
#define KF ((bf16_t*)(ws + O_KF))
#define VT ((bf16_t*)(ws + O_VT))
#define YRAW ((float*)(ws + O_YRAW))
#define YA ((bf16_t*)(ws + O_YA))
#define YB (YA + (size_t)TG * 512)
#define YC (YA + (size_t)2 * TG * 512)
#define YD (YA + (size_t)3 * TG * 512)
#define CS ((f32x2*)(ws + O_CS))
#define PB ((bf16_t*)(ws + O_PB))
#define MIXB ((bf16_t*)(ws + O_MIXB))
#define WIN ((const bf16_t*)(ws + O_WIN))
#define WGATE ((const bf16_t*)(ws + O_WGATE))
#define WBR ((const bf16_t*)(ws + O_WBR))
#define WOUT ((const bf16_t*)(ws + O_WOUT))
#define WQB ((const bf16_t*)(ws + O_WQB))
#define WKVB ((const bf16_t*)(ws + O_WKVB))
#define XNg (XN + (size_t)g * TG * 1024)
    int ph = 0;
    unsigned long long t0_ = PROBE_T ? __builtin_amdgcn_s_memrealtime() : 0ull, tacc_ = 0ull;
#pragma unroll 1
    for (int l = 0; l < 4; ++l) {
#pragma unroll 1
        for (int f = 0; f < 2; ++f) {
            if (f == 0) {
                PH_BEGIN
                    REP(32) convert_layer(p, l, (LAS float*)lds, wg, nwg);
                    if (l == 0) { rope_table(p, CS); init_rows(p.in[0], XN, SSQ0); }
                PH_END_C(0)
            }
            PH_BEGIN
                EpiGU e{H, f == 0 ? SSQ0 : SSQ2};
#pragma unroll 1
                for (int rep = 0; rep < ((PROBE & 16) ? 2 : 1); ++rep) run_gemm(lds, XN, (const bf16_t*)(ws + (f == 0 ? O_WGU1 : O_WGU2)), T_ALL, 5632, 1024, e);
            PH_END_C(1)
            PH_BEGIN
                if (PROBE & 256) { EpiRes e0{XN, f == 0 ? SSQ1 : SSQ0, (l == 3 && f == 1) ? X : nullptr, 0.0f}; run_gemm(lds, H, (const bf16_t*)(ws + (f == 0 ? O_WD1 : O_WD2)), T_ALL, 1024, 2816, e0); }
                EpiRes e{XN, f == 0 ? SSQ1 : SSQ0, (l == 3 && f == 1) ? X : nullptr, 0.5f}; run_gemm(lds, H, (const bf16_t*)(ws + (f == 0 ? O_WD1 : O_WD2)), T_ALL, 1024, 2816, e);
            PH_END_C(2)
            if (f == 0) {
#pragma unroll 1
                for (int g = 0; g < NGRP; ++g) {
                    if (g == 0) {
                        PH_BEGIN
                            EpiStore e{PROJ, PLD, 0x7fffffff, SSQ1}; run_gemm(lds, XN, WIN, TG, 4864, 1024, e);
                        PH_END_C(3)
                    }
                    PH_BEGIN
                        REP(4) prep1(p, l, PROJ, XBCC, DTB, AQ, AKV, YD);
                    PH_END_C(4)
                    PH_BEGIN
                        REP(64) {
                        { EpiStore e{QRAW, 768, 0x7fffffff, nullptr}; run_gemm(lds, AQ, WQB, TG, 768, 384, e); }
                        { EpiStore e{KVRAW, 1024, 0x7fffffff, nullptr}; run_gemm(lds, AKV, WKVB, TG, 1024, 256, e); }
#pragma unroll 1
                        for (int u = wg; u < 256; u += nwg) {
                            ssd_states_unit(XBCC, DTB, ST, ATOT, u >> 5, (u >> 1) & 15, u & 1, lds);
                        }
                        }
                    PH_END_C(5)
                    PH_BEGIN
                        REP(4) for (int u = wg; u < 256; u += nwg) prep2_unit(p, l, g, PROJ, QRAW, KVRAW, CS, QF, KF, VT, u >> 5, u & 31, lds);
                        ssd_scan(ST, STB, ATOT);
                    PH_END_C(6)
                    PH_BEGIN
                        {
                            unsigned* ctr = (unsigned*)(ws + O_WQ) + (l * 4 + g);
                            volatile LAS unsigned* wq = (volatile LAS unsigned*)(lds + LDS_BYTES - 32);
#pragma unroll 1
                            for (;;) {
                                __syncthreads();
                                if (tid_now() == 0) *wq = atomicAdd(ctr, 1u);
                                __syncthreads();
                                const int u = (int)*wq;
                                unsigned long long tu0_ = PROBE_T ? __builtin_amdgcn_s_memrealtime() : 0ull;
                                if (u >= 640) { if ((PROBE_T >> 14) & 1) { tacc_ -= tu0_; } break; }
                                int cls_;
                                if (u < 160) { attn_unit(QF, KF, VT, YC, u & 31, 7 - (u >> 5), lds); cls_ = 11; }
                                else if (u < 416) { const int k = u - 160; ssd_out_grp(p, l, PROJ, XBCC, DTB, STB, YA, k >> 5, (k >> 1) & 15, k & 1, lds); cls_ = 12; }
                                else if (u < 544) { const int k = u - 416; gmlp_unit(p, l, PROJ, YB, k >> 4, k & 15, lds); cls_ = 13; }
                                else { const int k = u - 544; attn_unit(QF, KF, VT, YC, k & 31, 2 - (k >> 5), lds); cls_ = 11; }
                                if (PROBE_T) { const unsigned long long tu1_ = __builtin_amdgcn_s_memrealtime(); if ((PROBE_T >> cls_) & 1) tacc_ += tu1_ - tu0_; }
                            }
                        }
                    PH_END_C(7)
                    PH_BEGIN
                        EpiStore e{PB, 1024, 3, nullptr}; pg8::Gemm gm{YA, WBR, 4 * TG, 4096, 512}; BranchOrder S; S.G = nwg; S.c = wg;
                        REP(128) pg8::gemm_phase<EpiStore, BranchOrder>(lds, gm, S, e);
                    PH_END_C(8)
                    PH_BEGIN
                        EpiMerge e{PB, MIXB, SSQ1 + (size_t)g * TG * 16}; REP(128) run_gemm(lds, XNg, WGATE, TG, 4096, 1024, e);
                    PH_END_C(9)
                    PH_BEGIN
                        { EpiRes e{XNg, SSQ2 + (size_t)g * TG * 16, nullptr, 1.0f}; run_gemm(lds, MIXB, WOUT, TG, 1024, 1024, e); }
                        if (g < NGRP - 1) {
                            EpiStore e{PROJ, PLD, 0x7fffffff, SSQ1 + (size_t)(g + 1) * TG * 16}; run_gemm(lds, XN + (size_t)(g + 1) * TG * 1024, WIN, TG, 4864, 1024, e); }
                    PH_END_C(10)
                }
            }
        }
    }
    if (PROBE_T) { const unsigned long long te_ = __builtin_amdgcn_s_memrealtime(); while (__builtin_amdgcn_s_memrealtime() - te_ < tacc_) __builtin_amdgcn_s_sleep(8); }
}

constexpr int N_PHASES = 4 * (1 + 2 + 1 + 4 * 7 + 2);

extern "C" void kernel_launch(void* const* d_in, const int* in_sizes, int n_in, void* d_out, int out_size, void* d_ws, size_t ws_size, hipStream_t stream) {
    static int grid_blocks = 0;
    if (!grid_blocks) {
        if (n_in != 28 || ws_size < WS_NEED) { fprintf(stderr, "kernel_launch: need 28 inputs and %zu bytes of workspace (got %d, %zu)\n", (size_t)WS_NEED, n_in, ws_size); grid_blocks = -1; return; }
        if (hipFuncSetAttribute((const void*)mega, hipFuncAttributeMaxDynamicSharedMemorySize, LDS_BYTES) != hipSuccess) { fprintf(stderr, "kernel_launch: hipFuncSetAttribute failed\n"); grid_blocks = -1; return; }
        int dev = 0, cus = 0, per_cu = 0;
        hipGetDevice(&dev); hipDeviceGetAttribute(&cus, hipDeviceAttributeMultiprocessorCount, dev);
        hipOccupancyMaxActiveBlocksPerMultiprocessor(&per_cu, mega, 512, LDS_BYTES);
        if (per_cu < 1) { fprintf(stderr, "kernel_launch: occupancy query returned %d\n", per_cu); per_cu = 1; }
        (void)hipGetLastError();
        grid_blocks = cus * per_cu;
    }
    if (grid_blocks < 0) return;
    Params p{};
    for (int i = 0; i < 28; ++i) p.in[i] = (const float*)d_in[i];
    p.out = (float*)d_out; p.ws = (unsigned char*)d_ws; p.only_phase = -1; p.pad = 0;
#if MULTI_LAUNCH
    for (int ph = 0; ph < N_PHASES; ++ph) { p.only_phase = ph; hipLaunchKernelGGL(mega, dim3(grid_blocks), dim3(512), LDS_BYTES, stream, p); }
#else
    if (hipMemsetAsync((unsigned char*)d_ws + O_BAR, 0, ZERO_BYTES, stream) != hipSuccess) { fprintf(stderr, "kernel_launch: memset of barrier words failed\n"); return; }
    void* args[] = {&p};
    hipError_t e = hipLaunchCooperativeKernel((void*)mega, dim3(grid_blocks), dim3(512), args, LDS_BYTES, stream);
    if (e != hipSuccess) fprintf(stderr, "cooperative launch failed: %s (grid %d)\n", hipGetErrorString(e), grid_blocks);
#endif
}
```
